# Optimizing an MI355X kernel written in HIP

```python
import jax, jax.numpy as jnp
from jax import lax
import numpy as np

D_MODEL = 1024
BATCH = 4
SEQ = 8192
DEPTH = 1

GRID_W = 64
HEAD_DIM = 64
NA_HEADS = 8
NA_WIN_ROWS = 8
NA_WIN_COLS = 16
GQA_HEADS = 8
GQA_KV_HEADS = 2
ROPE_BASE = 10000.0
Q_BLOCK = 128
N_EXPERTS = 16
EC_CAPACITY_FACTOR = 2
EXPERT_FF = 2048
N_BRANCHES = 2
EPS = 1e-6

NA_WIDTH = NA_HEADS * HEAD_DIM
GQA_WIDTH = GQA_HEADS * HEAD_DIM
GQA_KV_WIDTH = GQA_KV_HEADS * HEAD_DIM
IN_WIDTH = 3 * NA_WIDTH + GQA_WIDTH + 2 * GQA_KV_WIDTH + N_BRANCHES * D_MODEL

kernel_name = "hybrid_na_gqa_ec_moe_block"


def rmsnorm(x, g):
    x32 = x.astype(jnp.float32)
    y = x32 * lax.rsqrt(jnp.mean(x32 * x32, axis=-1, keepdims=True) + EPS)
    return y.astype(x.dtype) * g


def neighbourhood_attention(q, k, v, rpb):
    B, T, H, hd = q.shape
    rows = T // GRID_W
    kh = min(NA_WIN_ROWS, rows)
    kw = NA_WIN_COLS
    qg = q.reshape(B, rows, GRID_W, H, hd)
    kg = k.reshape(B, rows, GRID_W, H, hd)
    vg = v.reshape(B, rows, GRID_W, H, hd)
    cols = jnp.arange(GRID_W)
    col_start = jnp.clip(cols - kw // 2, 0, GRID_W - kw)
    col_idx = col_start[:, None] + jnp.arange(kw)[None, :]
    dc = col_idx - cols[:, None] + (NA_WIN_COLS - 1)
    scale = hd ** -0.5

    def one_row(r):
        r_start = jnp.clip(r - kh // 2, 0, rows - kh)
        k_band = lax.dynamic_slice_in_dim(kg, r_start, kh, axis=1)
        v_band = lax.dynamic_slice_in_dim(vg, r_start, kh, axis=1)
        k_nb = k_band[:, :, col_idx]
        v_nb = v_band[:, :, col_idx]
        q_r = lax.dynamic_index_in_dim(qg, r, axis=1, keepdims=False)
        dr = r_start + jnp.arange(kh) - r + (NA_WIN_ROWS - 1)
        bias = rpb[:, dr][:, :, dc]
        bias = bias.transpose(0, 2, 1, 3).astype(jnp.float32)
        s = jnp.einsum('bqhd,brqjhd->bhqrj', q_r, k_nb).astype(jnp.float32) * scale + bias[None]
        p = jax.nn.softmax(s.reshape(B, H, GRID_W, kh * kw), axis=-1)
        p = p.reshape(B, H, GRID_W, kh, kw).astype(v.dtype)
        return jnp.einsum('bhqrj,brqjhd->bqhd', p, v_nb)

    out = lax.map(one_row, jnp.arange(rows))
    return out.transpose(1, 0, 2, 3, 4).reshape(B, T, H * hd)


def axial_rope_tables(T):
    t = jnp.arange(T)
    row = (t // GRID_W).astype(jnp.float32)
    col = (t % GRID_W).astype(jnp.float32)
    half = HEAD_DIM // 2
    inv_freq = ROPE_BASE ** (-jnp.arange(0, half, 2, dtype=jnp.float32) / half)
    ang = jnp.concatenate([row[:, None] * inv_freq[None], col[:, None] * inv_freq[None]], axis=-1)
    return jnp.cos(ang), jnp.sin(ang)


def apply_rope(x, cos, sin):
    xp = x.astype(jnp.float32).reshape(*x.shape[:-1], HEAD_DIM // 2, 2)
    x0, x1 = xp[..., 0], xp[..., 1]
    c = cos[None, :, None, :]
    s = sin[None, :, None, :]
    out = jnp.stack([x0 * c - x1 * s, x0 * s + x1 * c], axis=-1).reshape(x.shape)
    return out.astype(x.dtype)


def gqa_attention(q, k, v):
    B, T, Hq, hd = q.shape
    G = Hq // GQA_KV_HEADS
    nblk = T // Q_BLOCK
    qb = q.reshape(B, nblk, Q_BLOCK, GQA_KV_HEADS, G, hd).transpose(1, 0, 2, 3, 4, 5)
    scale = hd ** -0.5

    def one_block(q_blk):
        s = jnp.einsum('bqkgd,bskd->bkgqs', q_blk, k).astype(jnp.float32) * scale
        p = jax.nn.softmax(s, axis=-1).astype(v.dtype)
        return jnp.einsum('bkgqs,bskd->bqkgd', p, v)

    out = lax.map(one_block, qb)
    return out.transpose(1, 0, 2, 3, 4, 5).reshape(B, T, Hq * hd)


def expert_choice_ffn(h, w_router, w_gate, w_up, w_down):
    B, T, D = h.shape
    cap = EC_CAPACITY_FACTOR * T // N_EXPERTS
    logits = jnp.einsum('btd,de->bte', h, w_router).astype(jnp.float32)
    aff = jax.nn.softmax(logits, axis=-1)
    g, idx = lax.top_k(aff.transpose(0, 2, 1), cap)
    xin = jax.vmap(lambda hb, ib: hb[ib])(h, idx)
    a = jnp.einsum('becd,edf->becf', xin, w_gate)
    u = jnp.einsum('becd,edf->becf', xin, w_up)
    y = jnp.einsum('becf,efd->becd', jax.nn.silu(a) * u, w_down)
    y = y * g[..., None].astype(y.dtype)
    flat = (jnp.arange(B)[:, None, None] * T + idx).reshape(-1)
    out = jax.ops.segment_sum(y.reshape(-1, D), flat, num_segments=B * T)
    return out.reshape(B, T, D).astype(h.dtype)


def setup_inputs(seed: int = 0) -> dict:
    key = jax.random.key(seed)
    ks = jax.random.split(key, 20)
    f32 = jnp.float32
    D, L, F, E = D_MODEL, DEPTH, EXPERT_FF, N_EXPERTS
    nrm = lambda k, shape, s: jax.random.normal(k, shape, f32) * s
    return {
        "x": nrm(ks[0], (BATCH, SEQ, D), 1.0),
        "c": nrm(ks[1], (BATCH, D), 1.0),
        "w_ada": nrm(ks[2], (L, D, 6 * D), 0.5 * D ** -0.5),
        "b_ada": nrm(ks[3], (L, 6 * D), 0.02),
        "norm1_g": 1.0 + nrm(ks[4], (L, D), 0.02),
        "w_in": nrm(ks[5], (L, D, IN_WIDTH), D ** -0.5),
        "q_norm_g": 1.0 + nrm(ks[6], (L, HEAD_DIM), 0.02),
        "k_norm_g": 1.0 + nrm(ks[7], (L, HEAD_DIM), 0.02),
        "na_rpb": nrm(ks[8], (L, NA_HEADS, 2 * NA_WIN_ROWS - 1, 2 * NA_WIN_COLS - 1), 0.1),
        "w_branch_na": nrm(ks[9], (L, NA_WIDTH, D), NA_WIDTH ** -0.5),
        "w_branch_gqa": nrm(ks[10], (L, GQA_WIDTH, D), GQA_WIDTH ** -0.5),
        "w_out": nrm(ks[11], (L, D, D), D ** -0.5),
        "norm2_g": 1.0 + nrm(ks[12], (L, D), 0.02),
        "w_router": nrm(ks[13], (L, D, E), D ** -0.5),
        "w_exp_gate": nrm(ks[14], (L, E, D, F), D ** -0.5),
        "w_exp_up": nrm(ks[15], (L, E, D, F), D ** -0.5),
        "w_exp_down": nrm(ks[16], (L, E, F, D), F ** -0.5),
        "final_g": 1.0 + nrm(ks[17], (D,), 0.02),
    }


def reference(x, c, w_ada, b_ada, norm1_g, w_in, q_norm_g, k_norm_g, na_rpb, w_branch_na, w_branch_gqa,
              w_out, norm2_g, w_router, w_exp_gate, w_exp_up, w_exp_down, final_g):
    B, T, D = x.shape
    cos, sin = axial_rope_tables(T)
    split_points = np.cumsum([NA_WIDTH, NA_WIDTH, NA_WIDTH, GQA_WIDTH, GQA_KV_WIDTH, GQA_KV_WIDTH]).tolist()
    for l in range(DEPTH):
        mod = jnp.einsum('bd,de->be', jax.nn.silu(c), w_ada[l]) + b_ada[l]
        shift1, scale1, gate1, shift2, scale2, gate2 = [m[:, None, :] for m in jnp.split(mod, 6, axis=-1)]

        h = rmsnorm(x, norm1_g[l]) * (1.0 + scale1) + shift1
        proj = jnp.einsum('btd,de->bte', h, w_in[l])
        q_na, k_na, v_na, q_g, k_g, v_g, gate_logits = jnp.split(proj, split_points, axis=-1)

        heads = lambda t, n: t.reshape(B, T, n, HEAD_DIM)
        y_na = neighbourhood_attention(heads(q_na, NA_HEADS), heads(k_na, NA_HEADS),
                                       heads(v_na, NA_HEADS), na_rpb[l])

        qg = apply_rope(rmsnorm(heads(q_g, GQA_HEADS), q_norm_g[l]), cos, sin)
        kg = apply_rope(rmsnorm(heads(k_g, GQA_KV_HEADS), k_norm_g[l]), cos, sin)
        y_gqa = gqa_attention(qg, kg, heads(v_g, GQA_KV_HEADS))

        gates = jax.nn.sigmoid(gate_logits.astype(jnp.float32)).astype(x.dtype)
        g_na, g_gqa = jnp.split(gates, N_BRANCHES, axis=-1)
        merged = (g_na * jnp.einsum('btk,kd->btd', y_na, w_branch_na[l])
                  + g_gqa * jnp.einsum('btk,kd->btd', y_gqa, w_branch_gqa[l]))
        x = x + gate1 * jnp.einsum('btd,de->bte', merged, w_out[l])

        h2 = rmsnorm(x, norm2_g[l]) * (1.0 + scale2) + shift2
        x = x + gate2 * expert_choice_ffn(h2, w_router[l], w_exp_gate[l], w_exp_up[l], w_exp_down[l])
    return rmsnorm(x, final_g)
```

```cpp
#include <hip/hip_runtime.h>
#include <hip/hip_bf16.h>
#include <cstdio>
#include <cstdint>

#ifndef MK_N_LAUNCHES
#define MK_N_LAUNCHES 1
#endif

#define LAS __attribute__((address_space(3)))
#define GAS __attribute__((address_space(1)))
typedef unsigned short bf16_t;
typedef short bf16x8 __attribute__((ext_vector_type(8)));
typedef short s16x4 __attribute__((ext_vector_type(4)));
typedef float f32x4 __attribute__((ext_vector_type(4)));
typedef float f32x2 __attribute__((ext_vector_type(2)));
typedef float f32x16 __attribute__((ext_vector_type(16)));
typedef unsigned u32x4 __attribute__((ext_vector_type(4)));
typedef unsigned u32x2 __attribute__((ext_vector_type(2)));
typedef int v8i __attribute__((ext_vector_type(8)));
typedef int v4i __attribute__((ext_vector_type(4)));

constexpr int BATCH = 4, SEQ = 8192, DMODEL = 1024, MT = BATCH * SEQ;
constexpr int NQKV = 2304, NGATE = 2048, NIN = 4352;
constexpr int C_QNA = 0, C_KNA = 512, C_VNA = 1024, C_QG = 1536, C_KG = 2048, C_VG = 2176;
constexpr int NEXP = 16, CAP = 1024, FF = 2048;
constexpr float EPS = 1e-6f;
constexpr float LOG2E = 1.4426950408889634f;
constexpr float C2 = 0.125f * LOG2E;

__device__ __forceinline__ unsigned f2bf(float f) { unsigned u = __builtin_bit_cast(unsigned, f); return (u + 0x7fffu + ((u >> 16) & 1u)) >> 16; }
__device__ __forceinline__ unsigned pk2(float lo, float hi) { return f2bf(lo) | (f2bf(hi) << 16); }
__device__ __forceinline__ float bf_lo(unsigned w) { return __builtin_bit_cast(float, w << 16); }
__device__ __forceinline__ float bf_hi(unsigned w) { return __builtin_bit_cast(float, w & 0xffff0000u); }
__device__ __forceinline__ unsigned cvt_pk_bf16(float lo, float hi) { unsigned r; asm volatile("v_cvt_pk_bf16_f32 %0, %1, %2" : "=v"(r) : "v"(lo), "v"(hi)); return r; }
__device__ __forceinline__ unsigned pk4_fp8(float a, float b, float c, float d) {
    a = __builtin_amdgcn_fmed3f(a, -448.f, 448.f); b = __builtin_amdgcn_fmed3f(b, -448.f, 448.f); c = __builtin_amdgcn_fmed3f(c, -448.f, 448.f); d = __builtin_amdgcn_fmed3f(d, -448.f, 448.f);
    int w = 0; w = __builtin_amdgcn_cvt_pk_fp8_f32(a, b, w, false); w = __builtin_amdgcn_cvt_pk_fp8_f32(c, d, w, true); return (unsigned)w; }
__device__ __forceinline__ unsigned pk4_fp8_nc(float a, float b, float c, float d) { int w = 0; w = __builtin_amdgcn_cvt_pk_fp8_f32(a, b, w, false); w = __builtin_amdgcn_cvt_pk_fp8_f32(c, d, w, true); return (unsigned)w; }
constexpr float F8_SC_H2 = 8.0f, F8_SC_W = 64.0f, F8_SC_HMID = 4.0f, F8_SC_GA = 256.0f, F8_SC_R = 2.0f, F8_SC_Y = 32.0f;
__device__ __forceinline__ float sigmoidf_fast(float v) { return __builtin_amdgcn_rcpf(1.0f + __builtin_amdgcn_exp2f(-v * LOG2E)); }
__device__ __forceinline__ int fresh_tid() { int t = threadIdx.x; asm volatile("" : "+v"(t)); return t; }
template <int CTRL> __device__ __forceinline__ float dppf(float x) { return __builtin_bit_cast(float, __builtin_amdgcn_mov_dpp(__builtin_bit_cast(int, x), CTRL, 0xf, 0xf, true)); }
constexpr int DPP_XOR1 = 0xB1, DPP_XOR2 = 0x4E, DPP_XOR3 = 0x1B, DPP_XOR7 = 0x141, DPP_XOR8 = 0x128;
__device__ __forceinline__ float lane_xor4(float x) { return dppf<DPP_XOR3>(dppf<DPP_XOR7>(x)); }
__device__ __forceinline__ float swap16_sum(float a, float b) { asm("s_nop 1\n\tv_permlane16_swap_b32 %0, %1" : "+v"(a), "+v"(b)); return a + b; }
__device__ __forceinline__ float swap32_sum(float a, float b) { asm("s_nop 1\n\tv_permlane32_swap_b32 %0, %1" : "+v"(a), "+v"(b)); return a + b; }
__device__ __forceinline__ float swap16_max(float a) { float b = a; asm("s_nop 1\n\tv_permlane16_swap_b32 %0, %1" : "+v"(a), "+v"(b)); return fmaxf(a, b); }
__device__ __forceinline__ float wave_sum(float v) {
    v += dppf<DPP_XOR1>(v); v += dppf<DPP_XOR2>(v); v += lane_xor4(v); v += dppf<DPP_XOR8>(v);
    v = swap16_sum(v, v); return swap32_sum(v, v);
}

__constant__ float INV_FREQ_D[16] = {1.0f, 0.5623413251903491f, 0.31622776601683794f, 0.1778279410038923f, 0.1f, 0.05623413251903491f, 0.03162277660168379f, 0.01778279410038923f,
                                     0.01f, 0.005623413251903491f, 0.0031622776601683794f, 0.001778279410038923f, 0.001f, 0.0005623413251903491f, 0.00031622776601683794f, 0.0001778279410038923f};
namespace pg8 {
constexpr int BM = 256, BK = 64, HALF = 128, HTB = HALF * BK * 2, STAGE_BYTES = 8 * HTB, NXCD = 8, WGM = 8;
__host__ __device__ __forceinline__ int lds_byte(int r, int c) { const int st = (r >> 4) * 2 + (c >> 5), rr = r & 15, cc = c & 31, ob = rr * 64 + cc * 2; return st * 1024 + (ob ^ (((ob >> 9) & 1) << 5)); }
__host__ __device__ __forceinline__ void stage_rc(int b, int& R, int& C) { const int st = b / 1024, sb = b % 1024, swz = sb ^ (((sb >> 9) & 1) << 5); R = (st >> 1) * 16 + swz / 64; C = (st & 1) * 32 + (swz % 64) / 2; }
__host__ __device__ __forceinline__ int perm32(int rho) { const int n = rho >> 4, i = rho & 15; return 8 * (i >> 2) + 4 * n + (i & 3); }

struct Unit { int pm, pn, g; };

struct SchedPlain {
    int nM, nN, nwg, G, c; const char* A; const char* B; unsigned lda, ldb;
    static constexpr bool GATHER = false;
    __device__ void init(int M, int N, int G_, int c_, const void* A_, unsigned lda_, const void* B_, unsigned ldb_) { nM = M / BM; nN = N / BM; nwg = nM * nN; G = G_; c = c_; A = (const char*)A_; B = (const char*)B_; lda = lda_; ldb = ldb_; }
    __device__ bool next(int i, Unit& u) const {
        const long L = (long)i * G + c; if (L >= nwg) return false;
        int wgid = (int)L; { const int q = nwg / NXCD, r = nwg % NXCD, xcd = wgid % NXCD, off = wgid / NXCD; wgid = (xcd < r ? xcd * (q + 1) : r * (q + 1) + (xcd - r) * q) + off; }
        const int nig = WGM * nN, gid = wgid / nig, fm = gid * WGM, gsz = (nM - fm) < WGM ? (nM - fm) : WGM;
        u.pm = fm + ((wgid % nig) % gsz); u.pn = (wgid % nig) / gsz; u.g = 0; return true;
    }
    __device__ __forceinline__ const char* a_ptr(const Unit& u) const { return A + (size_t)u.pm * BM * lda; }
    __device__ __forceinline__ const char* b_ptr(const Unit& u) const { return B + (size_t)u.pn * BM * ldb; }
    __device__ __forceinline__ const int* rows(const Unit&) const { return nullptr; }
    const char* A2 = nullptr; const char* B2 = nullptr; int nt1 = 0;
    __device__ __forceinline__ const char* a_ptr2(const Unit& u) const { return A2 + (size_t)u.pm * BM * lda; }
    __device__ __forceinline__ const char* b_ptr2(const Unit& u) const { return B2 + (size_t)u.pn * BM * ldb; }
};
struct SchedGate {
    int G, c; const char* A; const char* B; unsigned lda, ldb;
    static constexpr bool GATHER = false;
    __device__ bool next(int i, Unit& u) const {
        int id;
        if (G == 256) { if (c < 128) { if (i >= 3) return false; id = c * 3 + i; } else { if (i >= 5) return false; id = 384 + (c - 128) * 5 + i; } }
        else { const long L = (long)i * G + c; if (L >= 1024) return false; id = (int)L; }
        u.pm = id >> 3; u.pn = id & 7; u.g = 0; return true;
    }
    __device__ __forceinline__ const char* a_ptr(const Unit& u) const { return A + (size_t)u.pm * BM * lda; }
    __device__ __forceinline__ const char* b_ptr(const Unit& u) const { return B + (size_t)u.pn * BM * ldb; }
    __device__ __forceinline__ const int* rows(const Unit&) const { return nullptr; }
};
struct SchedFfn1 {
    int G, vcu; const char* A; const char* B; const int* idx; unsigned lda, ldb;
    static constexpr bool GATHER = true;
    __device__ bool next(int i, Unit& u) const {
        const long L = (long)i * G + vcu; if (L >= 4096) return false;
        const int ii = (int)(L >> 8), v = (int)(L & 255), x = v >> 5, c = v & 31;
        const int e = 2 * x + (ii >> 3), b = (ii & 7) >> 1, half = ii & 1;
        u.g = b * 16 + e; u.pm = c & 3; u.pn = half * 8 + (c >> 2); return true;
    }
    __device__ __forceinline__ const char* a_ptr(const Unit& u) const { return A + (size_t)(u.g >> 4) * SEQ * lda; }
    __device__ __forceinline__ const char* b_ptr(const Unit& u) const { return B + ((size_t)(u.g & 15) * 4096 + (size_t)u.pn * BM) * ldb; }
    __device__ __forceinline__ const int* rows(const Unit& u) const { return idx + u.g * CAP + u.pm * BM; }
};
struct SchedFfn2 {
    int G, vcu; const char* A; const char* B; unsigned lda, ldb;
    static constexpr bool GATHER = false;
    __device__ bool next(int i, Unit& u) const {
        const long L = (long)i * G + vcu; if (L >= 1024) return false;
        const int ii = (int)(L >> 8), v = (int)(L & 255), x = v >> 5, c = v & 31;
        const int e = 2 * x + (ii >> 1), b = 2 * (ii & 1) + (c >> 4);
        u.g = b * 16 + e; u.pm = (c & 15) >> 2; u.pn = c & 3; return true;
    }
    __device__ __forceinline__ const char* a_ptr(const Unit& u) const { return A + ((size_t)u.g * CAP + (size_t)u.pm * BM) * lda; }
    __device__ __forceinline__ const char* b_ptr(const Unit& u) const { return B + ((size_t)(u.g & 15) * 1024 + (size_t)u.pn * BM) * ldb; }
    __device__ __forceinline__ const int* rows(const Unit&) const { return nullptr; }
};

typedef f32x4 Acc[2][2][4][2];

struct EpiProj {
    static constexpr bool PERM = true;
    bf16_t* QKV; unsigned char* Q8; unsigned char* K8; unsigned char* V8T; const float* qg; const float* kg; bool gqa_bf16;
    __device__ __forceinline__ void operator()(const Acc& acc, const Unit& u, int wr, int wc, int fr_, int fq_) const { run<false>(acc, u, wr, wc, fr_, fq_); }
    template <bool ASC8> __device__ __forceinline__ void run(const Acc& acc, const Unit& u, int wr, int wc, int fr_, int fq_) const {
        constexpr float asc = ASC8 ? 1.0f / (F8_SC_H2 * F8_SC_W) : 1.0f;
        int fr = fr_, fq = fq_; asm volatile("" : "+v"(fr), "+v"(fq));
        const int row0 = u.pm * BM + wr * 64 + fr;
        if (u.pn < 6) {
            const int col0 = u.pn * BM + wc * 32 + 8 * fq;
            const float sc = ((u.pn < 2) ? 0.125f : 1.0f) * asc;
#pragma unroll
            for (int ai = 0; ai < 2; ++ai)
#pragma unroll
                for (int m = 0; m < 4; ++m) { bf16_t* rowp = QKV + (size_t)(row0 + ai * HALF + m * 16) * NQKV + col0;
#pragma unroll
                    for (int bj = 0; bj < 2; ++bj) { const f32x4 v0 = acc[ai][bj][m][0] * sc, v1 = acc[ai][bj][m][1] * sc;
                        u32x4 w; w.x = cvt_pk_bf16(v0[0], v0[1]); w.y = cvt_pk_bf16(v0[2], v0[3]); w.z = cvt_pk_bf16(v1[0], v1[1]); w.w = cvt_pk_bf16(v1[2], v1[3]);
                        *(u32x4*)(rowp + bj * HALF) = w; } }
            return;
        }
        const int colb = u.pn * BM + wc * 64 + 8 * fq;
        const bool isv = (u.pn == 8) && (wc >= 2), isq = u.pn < 8;
        if (isv) {
            const int kvh = wc - 2;
#pragma unroll
            for (int ai = 0; ai < 2; ++ai)
#pragma unroll
                for (int m = 0; m < 4; ++m) { const int tok = row0 + ai * HALF + m * 16; bf16_t* rowp = QKV + (size_t)tok * NQKV + colb;
                    const int b = tok >> 13, t = tok & (SEQ - 1), kap = t & 63;
                    const int pos = 32 * ((kap >> 2) & 1) + 16 * (kap >> 5) + (kap & 3) + 4 * ((kap & 31) >> 3);
                    unsigned char* vt = V8T + ((size_t)(b * 2 + kvh) * SEQ + (size_t)(t & ~63)) * 64 + (8 * fq) * 64 + pos;
#pragma unroll
                    for (int bj = 0; bj < 2; ++bj) { const f32x4 v0 = acc[ai][bj][m][0] * asc, v1 = acc[ai][bj][m][1] * asc;
                        if (gqa_bf16) { u32x4 w; w.x = cvt_pk_bf16(v0[0], v0[1]); w.y = cvt_pk_bf16(v0[2], v0[3]); w.z = cvt_pk_bf16(v1[0], v1[1]); w.w = cvt_pk_bf16(v1[2], v1[3]);
                            *(u32x4*)(rowp + bj * 32) = w; }
                        const unsigned p0 = pk4_fp8(v0[0] * 8.f, v0[1] * 8.f, v0[2] * 8.f, v0[3] * 8.f), p1 = pk4_fp8(v1[0] * 8.f, v1[1] * 8.f, v1[2] * 8.f, v1[3] * 8.f);
#pragma unroll
                        for (int i = 0; i < 4; ++i) { vt[(32 * bj + i) * 64] = (unsigned char)(p0 >> (8 * i)); vt[(32 * bj + 4 + i) * 64] = (unsigned char)(p1 >> (8 * i)); } } }
            return;
        }
        const float* gp = (isq ? qg : kg) + 8 * fq;
        float frq[2][2];
#pragma unroll
        for (int n = 0; n < 2; ++n)
#pragma unroll
            for (int k = 0; k < 2; ++k) frq[n][k] = INV_FREQ_D[4 * fq + 2 * n + k] * 0.15915494309189535f;
        const float osc = isq ? C2 : 1.0f, f8s = isq ? 32.0f : 8.0f;
        const int head = isq ? (u.pn - 6) * 4 + wc : wc;
#pragma unroll
        for (int ai = 0; ai < 2; ++ai)
#pragma unroll
            for (int m = 0; m < 4; ++m) { const int tok = row0 + ai * HALF + m * 16; const int t = tok & (SEQ - 1);
                float ss = 0.f;
#pragma unroll
                for (int bj = 0; bj < 2; ++bj)
#pragma unroll
                    for (int n = 0; n < 2; ++n) { const f32x4 v = acc[ai][bj][m][n]; ss += (v[0] * v[0] + v[1] * v[1]) + (v[2] * v[2] + v[3] * v[3]); }
                ss += __shfl_xor(ss, 16); ss += __shfl_xor(ss, 32);
                const float rinv = asc * __builtin_amdgcn_rsqf(ss * (asc * asc / 64.f) + EPS);
                bf16_t* rowp = QKV + ((unsigned)tok * (unsigned)NQKV + (unsigned)colb);
#pragma unroll
                for (int bj = 0; bj < 2; ++bj) { const float pos = (float)(bj == 0 ? (t >> 6) : (t & 63));
                    f32x4 gn[2][2]; gn[bj][0] = *(const f32x4*)(gp + 32 * bj); gn[bj][1] = *(const f32x4*)(gp + 32 * bj + 4);
                    float ov[8];
#pragma unroll
                    for (int n = 0; n < 2; ++n)
#pragma unroll
                        for (int k = 0; k < 2; ++k) { float rev = pos * frq[n][k]; rev = rev - floorf(rev);
                            const float sn = __builtin_amdgcn_sinf(rev), cs = __builtin_amdgcn_cosf(rev);
                            const float y0 = acc[ai][bj][m][n][2 * k] * rinv * gn[bj][n][2 * k], y1 = acc[ai][bj][m][n][2 * k + 1] * rinv * gn[bj][n][2 * k + 1];
                            ov[4 * n + 2 * k] = (y0 * cs - y1 * sn) * osc; ov[4 * n + 2 * k + 1] = (y0 * sn + y1 * cs) * osc; }
                    if (gqa_bf16) { u32x4 w; w.x = cvt_pk_bf16(ov[0], ov[1]); w.y = cvt_pk_bf16(ov[2], ov[3]); w.z = cvt_pk_bf16(ov[4], ov[5]); w.w = cvt_pk_bf16(ov[6], ov[7]);
                        *(u32x4*)(rowp + bj * 32) = w; }
                    u32x2 f8; f8.x = pk4_fp8(ov[0] * f8s, ov[1] * f8s, ov[2] * f8s, ov[3] * f8s); f8.y = pk4_fp8(ov[4] * f8s, ov[5] * f8s, ov[6] * f8s, ov[7] * f8s);
                    if (isq) *(u32x2*)(Q8 + ((unsigned)tok * 512u + (unsigned)(head * 64 + 32 * bj + 8 * fq))) = f8;
                    else     *(u32x2*)(K8 + ((unsigned)tok * 128u + (unsigned)(head * 64 + 32 * bj + 8 * fq))) = f8; }
                __builtin_amdgcn_sched_barrier(0); }
    }
};
struct EpiGate {
    static constexpr bool PERM = true;
    bf16_t* GA; unsigned char* R8;
    __device__ __forceinline__ void operator()(const Acc& acc, const Unit& u, int wr, int wc, int fr, int fq) const {
        const size_t row0 = (size_t)u.pm * BM + wr * 64 + fr; const int col0 = u.pn * HALF + wc * 32 + 8 * fq;
        constexpr float inv = -LOG2E / (F8_SC_H2 * F8_SC_W);
#pragma unroll
        for (int ai = 0; ai < 2; ++ai)
#pragma unroll
            for (int m = 0; m < 4; ++m) { const size_t off = (row0 + ai * HALF + m * 16) * DMODEL + col0;
                float ga[8], rr[8];
#pragma unroll
                for (int n = 0; n < 2; ++n)
#pragma unroll
                    for (int i = 0; i < 4; ++i) { const float ea = 1.0f + __builtin_amdgcn_exp2f(acc[ai][0][m][n][i] * inv), eb = 1.0f + __builtin_amdgcn_exp2f(acc[ai][1][m][n][i] * inv);
                        ga[n * 4 + i] = __builtin_amdgcn_rcpf(ea); rr[n * 4 + i] = ea * __builtin_amdgcn_rcpf(eb) * F8_SC_R; }
                u32x4 w; w.x = cvt_pk_bf16(ga[0], ga[1]); w.y = cvt_pk_bf16(ga[2], ga[3]); w.z = cvt_pk_bf16(ga[4], ga[5]); w.w = cvt_pk_bf16(ga[6], ga[7]); *(u32x4*)(GA + off) = w;
                u32x2 q; q.x = pk4_fp8(rr[0], rr[1], rr[2], rr[3]); q.y = pk4_fp8(rr[4], rr[5], rr[6], rr[7]); *(u32x2*)(R8 + off) = q; }
    }
};
struct EpiHeadGate {
    static constexpr bool PERM = true;
    EpiProj P; EpiGate Gt;
    __device__ __forceinline__ void operator()(const Acc& acc, const Unit& u, int wr, int wc, int fr, int fq) const {
        Unit v = u;
        if (u.pn < 9) { P.run<true>(acc, v, wr, wc, fr, fq); }
        else { v.pn = u.pn - 9; Gt(acc, v, wr, wc, fr, fq); }
    }
};
struct EpiMerge {
    static constexpr bool PERM = true;
    bf16_t* MERGED; const bf16_t* GA; const unsigned char* R8;
    __device__ __forceinline__ void mid(Acc& acc, const Unit& u, int wr, int wc, int fr, int fq) const {
        const int row0 = u.pm * BM + wr * 64 + fr, col0 = u.pn * BM + wc * 32 + 8 * fq;
#pragma unroll
        for (int ai = 0; ai < 2; ++ai)
#pragma unroll
            for (int m = 0; m < 4; ++m) { const size_t r = (size_t)(row0 + ai * HALF + m * 16);
#pragma unroll
                for (int bj = 0; bj < 2; ++bj) { const u32x2 q = *(const u32x2*)(R8 + r * DMODEL + col0 + bj * HALF);
                    const auto a = __builtin_amdgcn_cvt_pk_f32_fp8((int)q.x, false), b = __builtin_amdgcn_cvt_pk_f32_fp8((int)q.x, true), c = __builtin_amdgcn_cvt_pk_f32_fp8((int)q.y, false), d = __builtin_amdgcn_cvt_pk_f32_fp8((int)q.y, true);
                    constexpr float k = 1.0f / F8_SC_R;
                    acc[ai][bj][m][0][0] *= a[0] * k; acc[ai][bj][m][0][1] *= a[1] * k; acc[ai][bj][m][0][2] *= b[0] * k; acc[ai][bj][m][0][3] *= b[1] * k;
                    acc[ai][bj][m][1][0] *= c[0] * k; acc[ai][bj][m][1][1] *= c[1] * k; acc[ai][bj][m][1][2] *= d[0] * k; acc[ai][bj][m][1][3] *= d[1] * k; } }
    }
    __device__ __forceinline__ void operator()(const Acc& acc, const Unit& u, int wr, int wc, int fr, int fq) const {
        const int row0 = u.pm * BM + wr * 64 + fr, col0 = u.pn * BM + wc * 32 + 8 * fq;
#pragma unroll
        for (int ai = 0; ai < 2; ++ai)
#pragma unroll
            for (int m = 0; m < 4; ++m) { const size_t r = (size_t)(row0 + ai * HALF + m * 16);
#pragma unroll
                for (int bj = 0; bj < 2; ++bj) { const u32x4 g = *(const u32x4*)(GA + r * DMODEL + col0 + bj * HALF);
                    const f32x4 v0 = acc[ai][bj][m][0], v1 = acc[ai][bj][m][1];
                    u32x4 w; w.x = cvt_pk_bf16(bf_lo(g.x) * v0[0], bf_hi(g.x) * v0[1]); w.y = cvt_pk_bf16(bf_lo(g.y) * v0[2], bf_hi(g.y) * v0[3]);
                    w.z = cvt_pk_bf16(bf_lo(g.z) * v1[0], bf_hi(g.z) * v1[1]); w.w = cvt_pk_bf16(bf_lo(g.w) * v1[2], bf_hi(g.w) * v1[3]);
                    *(u32x4*)(MERGED + r * DMODEL + col0 + bj * HALF) = w; } }
    }
};
struct EpiOut {
    static constexpr bool PERM = false;
    const float* x; float* out; const float* mod;
    __device__ __forceinline__ void operator()(const Acc& acc, const Unit& u, int wr, int wc, int fr, int fq) const {
        const int row0 = u.pm * BM + wr * 64 + fr, col0 = u.pn * BM + wc * 32 + 4 * fq;
        const float* g1 = mod + (size_t)(u.pm >> 5) * 6144 + 2048;
        f32x4 gv[2][2];
#pragma unroll
        for (int bj = 0; bj < 2; ++bj)
#pragma unroll
            for (int n = 0; n < 2; ++n) gv[bj][n] = *(const f32x4*)(g1 + col0 + bj * HALF + n * 16);
#pragma unroll
        for (int ai = 0; ai < 2; ++ai)
#pragma unroll
            for (int m = 0; m < 4; ++m) { const size_t off = (size_t)(row0 + ai * HALF + m * 16) * DMODEL + col0;
#pragma unroll
                for (int bj = 0; bj < 2; ++bj)
#pragma unroll
                    for (int n = 0; n < 2; ++n) { const f32x4 xv = __builtin_nontemporal_load((const f32x4*)(x + off + bj * HALF + n * 16)); *(f32x4*)(out + off + bj * HALF + n * 16) = xv + gv[bj][n] * acc[ai][bj][m][n]; } }
    }
};
struct EpiDelta {
    static constexpr bool PERM = true;
    bf16_t* DELTA; const float* mod;
    __device__ __forceinline__ void operator()(const Acc& acc, const Unit& u, int wr, int wc, int fr, int fq) const {
        const unsigned row0 = u.pm * BM + wr * 64 + fr, col0 = u.pn * BM + wc * 32 + 8 * fq;
        const float* g1 = mod + (size_t)(u.pm >> 5) * 6144 + 2048 + col0;
        f32x4 gv[2][2];
#pragma unroll
        for (int bj = 0; bj < 2; ++bj)
#pragma unroll
            for (int n = 0; n < 2; ++n) gv[bj][n] = *(const f32x4*)(g1 + bj * HALF + n * 4);
#pragma unroll
        for (int ai = 0; ai < 2; ++ai)
#pragma unroll
            for (int m = 0; m < 4; ++m) { bf16_t* rowp = DELTA + ((row0 + ai * HALF + m * 16) * (unsigned)DMODEL + col0);
#pragma unroll
                for (int bj = 0; bj < 2; ++bj) { const f32x4 v0 = acc[ai][bj][m][0] * gv[bj][0], v1 = acc[ai][bj][m][1] * gv[bj][1];
                    u32x4 w; w.x = cvt_pk_bf16(v0[0], v0[1]); w.y = cvt_pk_bf16(v0[2], v0[3]); w.z = cvt_pk_bf16(v1[0], v1[1]); w.w = cvt_pk_bf16(v1[2], v1[3]);
                    *(u32x4*)(rowp + bj * HALF) = w; } }
    }
};
struct EpiFfn1 {
    static constexpr bool PERM = true;
    unsigned char* HMID;
    __device__ __forceinline__ void operator()(const Acc& acc, const Unit& u, int wr, int wc, int fr, int fq) const {
        const size_t row0 = (size_t)u.g * CAP + u.pm * BM + wr * 64 + fr; const int col0 = u.pn * HALF + wc * 32 + 8 * fq;
        constexpr float inv = 1.0f / (F8_SC_H2 * F8_SC_W);
        constexpr float RC = 1.0f / (inv * inv * F8_SC_HMID);
        static_assert(RC == 65536.0f, "LOG2_RC below assumes 2^16");
        constexpr float LOG2_RC = 16.0f;
#pragma unroll
        for (int ai = 0; ai < 2; ++ai)
#pragma unroll
            for (int m = 0; m < 4; ++m) { unsigned char* rowp = HMID + (row0 + ai * HALF + m * 16) * FF + col0;
                float o[8];
#pragma unroll
                for (int n = 0; n < 2; ++n)
#pragma unroll
                    for (int i = 0; i < 4; i += 2) {
                        const f32x2 ag = {acc[ai][0][m][n][i], acc[ai][0][m][n][i + 1]}, au = {acc[ai][1][m][n][i], acc[ai][1][m][n][i + 1]};
                        const f32x2 e = ag * (-inv * LOG2E) + LOG2_RC;
                        f32x2 t; t.x = __builtin_amdgcn_exp2f(e.x); t.y = __builtin_amdgcn_exp2f(e.y);
                        t = t + RC;
                        f32x2 r; r.x = __builtin_amdgcn_rcpf(t.x); r.y = __builtin_amdgcn_rcpf(t.y);
                        const f32x2 q = (ag * au) * r;
                        o[n * 4 + i] = q.x; o[n * 4 + i + 1] = q.y; }
                u32x2 w; w.x = pk4_fp8(o[0], o[1], o[2], o[3]); w.y = pk4_fp8(o[4], o[5], o[6], o[7]);
                *(u32x2*)rowp = w; }
    }
};
struct EpiFfn2 {
    static constexpr bool PERM = true;
    unsigned char* YB8; const float* gsel;
    __device__ __forceinline__ void operator()(const Acc& acc, const Unit& u, int wr, int wc, int fr, int fq) const {
        const unsigned row0 = (unsigned)u.g * CAP + u.pm * BM + wr * 64 + fr; const unsigned col0 = u.pn * BM + wc * 32 + 8 * fq;
#pragma unroll
        for (int ai = 0; ai < 2; ++ai)
#pragma unroll
            for (int m = 0; m < 4; ++m) { const unsigned r = row0 + ai * HALF + m * 16; const float gs = gsel[r] * (F8_SC_Y / (F8_SC_HMID * F8_SC_W)); unsigned char* rowp = YB8 + (r * (unsigned)DMODEL + col0);
#pragma unroll
                for (int bj = 0; bj < 2; ++bj) { const f32x4 v0 = acc[ai][bj][m][0] * gs, v1 = acc[ai][bj][m][1] * gs;
                    u32x2 w; w.x = pk4_fp8(v0[0], v0[1], v0[2], v0[3]); w.y = pk4_fp8(v1[0], v1[1], v1[2], v1[3]);
                    *(u32x2*)(rowp + bj * HALF) = w; } }
    }
};

template <bool F8> __device__ __forceinline__ f32x4 mma_step(bf16x8 b0, bf16x8 b1, bf16x8 a0, bf16x8 a1, f32x4 c) {
    if constexpr (F8) {
        const v8i b = __builtin_shufflevector(__builtin_bit_cast(v4i, b0), __builtin_bit_cast(v4i, b1), 0, 1, 2, 3, 4, 5, 6, 7);
        const v8i a = __builtin_shufflevector(__builtin_bit_cast(v4i, a0), __builtin_bit_cast(v4i, a1), 0, 1, 2, 3, 4, 5, 6, 7);
        asm volatile("v_mfma_f32_16x16x128_f8f6f4 %0, %1, %2, %0" : "+v"(c) : "v"(b), "v"(a));
        return c;
    } else {
        c = __builtin_amdgcn_mfma_f32_16x16x32_bf16(b0, a0, c, 0, 0, 0);
        return __builtin_amdgcn_mfma_f32_16x16x32_bf16(b1, a1, c, 0, 0, 0);
    }
}
__device__ __forceinline__ const char* uni_ptr(const char* p) {
    const unsigned long long v = (unsigned long long)p; const unsigned lo = __builtin_amdgcn_readfirstlane((unsigned)v), hi = __builtin_amdgcn_readfirstlane((unsigned)(v >> 32));
    return (const char*)(((unsigned long long)hi << 32) | lo); }
template <bool F8, class Epi, class Sched, bool SEG2 = false>
__device__ __forceinline__ void gemm_phase(LAS unsigned char* lds, const int nt, const Sched& S, const Epi& E) {
    const int tid = fresh_tid(), wid = __builtin_amdgcn_readfirstlane(tid >> 6), lane = tid & 63, wr = wid >> 2, wc = wid & 3, fr = lane & 15, fq = lane >> 4;
    constexpr bool GA = Sched::GATHER;
    int Rr[2], Cc[2];
#pragma unroll
    for (int i = 0; i < 2; ++i) stage_rc(tid * 16 + i * 8192, Rr[i], Cc[i]);
    unsigned voffB[2];
#pragma unroll
    for (int i = 0; i < 2; ++i) { const int Rb = Epi::PERM ? ((Rr[i] & ~31) + perm32(Rr[i] & 31)) : Rr[i]; voffB[i] = (unsigned)Rb * S.ldb + (unsigned)Cc[i] * 2u; }
    const size_t kstep = (size_t)(BK * 2);
    const size_t hstepB = (size_t)HALF * S.ldb;
    const size_t hstepA = GA ? (size_t)0 : (size_t)HALF * S.lda;
    const unsigned ldsw = (unsigned)wid * 1024u;
    const int aoff = lds_byte(wr * 64 + fr, fq * 8), boff = lds_byte(wc * 32 + fr, fq * 8);
#define PG8_SA(b, h) (((b) * 2 + (h)) * HTB)
#define PG8_SB(b, h) ((4 + (b) * 2 + (h)) * HTB)
#define PG8_STAGE(bufoff, gbase, voff) do { _Pragma("unroll") for (int _i = 0; _i < 2; ++_i) \
        __builtin_amdgcn_global_load_lds((GAS const unsigned*)((GAS const char*)(gbase) + (voff)[_i]), (LAS unsigned*)(lds + (bufoff) + ldsw + _i * 8192), 16, 0, 0); } while (0)
#define PG8_LDA(dst, b, h) do { _Pragma("unroll") for (int m = 0; m < 4; ++m) _Pragma("unroll") for (int k = 0; k < 2; ++k) dst[m][k] = *(const LAS bf16x8*)(lds + PG8_SA(b, h) + aoff + m * 2048 + k * 1024); } while (0)
#define PG8_LDB(dst, b, h) do { _Pragma("unroll") for (int n = 0; n < 2; ++n) _Pragma("unroll") for (int k = 0; k < 2; ++k) dst[n][k] = *(const LAS bf16x8*)(lds + PG8_SB(b, h) + boff + n * 2048 + k * 1024); } while (0)
#define PG8_MMA(ai, bj, At, Bt) do { __builtin_amdgcn_s_setprio(1); _Pragma("unroll") for (int m = 0; m < 4; ++m) _Pragma("unroll") for (int n = 0; n < 2; ++n) \
        acc[ai][bj][m][n] = mma_step<F8>(Bt[n][0], Bt[n][1], At[m][0], At[m][1], acc[ai][bj][m][n]); __builtin_amdgcn_s_setprio(0); } while (0)
#define PG8_WAIT_V(n) asm volatile("s_waitcnt vmcnt(" #n ")" ::: "memory")
#define PG8_WAIT_L(n) asm volatile("s_waitcnt lgkmcnt(" #n ")" ::: "memory")
#define PG8_BAR __builtin_amdgcn_s_barrier()
#define PG8_SCHED __builtin_amdgcn_sched_barrier(0)
#define PG8_ROWOFFS(dst, u_) do { if constexpr (GA) { const int* _rw = S.rows(u_); _Pragma("unroll") for (int _h = 0; _h < 2; ++_h) _Pragma("unroll") for (int _i = 0; _i < 2; ++_i) \
        dst[_h][_i] = (unsigned)_rw[_h * HALF + Rr[_i]] * S.lda + (unsigned)Cc[_i] * 2u; } } while (0)
    Unit cur, nxt; int ui = 0;
    if (!S.next(0, cur)) return;
    f32x4 acc[2][2][4][2];
#pragma unroll
    for (int a = 0; a < 2; ++a)
#pragma unroll
        for (int b = 0; b < 2; ++b)
#pragma unroll
            for (int m = 0; m < 4; ++m)
#pragma unroll
                for (int n = 0; n < 2; ++n) acc[a][b][m][n] = (f32x4){0.f, 0.f, 0.f, 0.f};
    bf16x8 At[4][2], B0[2][2], B1[2][2];
    unsigned voffP[2];
#pragma unroll
    for (int i = 0; i < 2; ++i) voffP[i] = (unsigned)Rr[i] * S.lda + (unsigned)Cc[i] * 2u;
    unsigned voffA[2][2], voffAn[2][2];
    PG8_ROWOFFS(voffA, cur);
#define PG8_VA(h) (GA ? voffA[h] : voffP)
#define PG8_VA2(h) (GA ? va2[h] : voffP)
    const char* cA = uni_ptr(S.a_ptr(cur)); const char* cB = uni_ptr(S.b_ptr(cur));
    const char* cA2 = cA; const char* cB2 = cB; int nt1 = nt;
    if constexpr (SEG2) { cA2 = uni_ptr(S.a_ptr2(cur)); cB2 = uni_ptr(S.b_ptr2(cur)); nt1 = S.nt1; }
#define PG8_KA(tau) ((!SEG2 || (tau) < nt1) ? cA + (size_t)(tau) * kstep : cA2 + (size_t)((tau) - nt1) * kstep)
#define PG8_KB(tau) ((!SEG2 || (tau) < nt1) ? cB + (size_t)(tau) * kstep : cB2 + (size_t)((tau) - nt1) * kstep)
    PG8_STAGE(PG8_SB(0, 0), cB, voffB); PG8_STAGE(PG8_SB(0, 1), cB + hstepB, voffB); PG8_STAGE(PG8_SA(0, 0), cA, PG8_VA(0)); PG8_STAGE(PG8_SA(0, 1), cA + hstepA, PG8_VA(1));
    if (wr == 1) PG8_BAR;
    PG8_WAIT_V(2); PG8_BAR;
    PG8_STAGE(PG8_SB(1, 0), cB + kstep, voffB); PG8_STAGE(PG8_SA(1, 0), cA + kstep, PG8_VA(0)); PG8_STAGE(PG8_SB(1, 1), cB + hstepB + kstep, voffB);
    PG8_WAIT_V(6); PG8_BAR;
    for (;;) {
        const bool has_next = S.next(ui + 1, nxt);
        const char* nA = has_next ? uni_ptr(S.a_ptr(nxt)) : cA; const char* nB = has_next ? uni_ptr(S.b_ptr(nxt)) : cB;
        if constexpr (GA) {
            if (has_next) { PG8_ROWOFFS(voffAn, nxt); } else {
#pragma unroll
                for (int h = 0; h < 2; ++h)
#pragma unroll
                    for (int i = 0; i < 2; ++i) voffAn[h][i] = voffA[h][i]; } }
        for (int t = 0; t < nt; t += 2) {
            const bool last = (t == nt - 2);
            const char* a1 = PG8_KA(t + 1);
            const char* a2 = last ? nA : PG8_KA(t + 2); const char* b2 = last ? nB : PG8_KB(t + 2);
            const char* a3 = a2 + kstep; const char* b3 = b2 + kstep;
            unsigned va2[2][2];
            if constexpr (GA) {
#pragma unroll
                for (int h = 0; h < 2; ++h)
#pragma unroll
                    for (int i = 0; i < 2; ++i) va2[h][i] = last ? voffAn[h][i] : voffA[h][i]; }
            PG8_LDB(B0, 0, 0); PG8_LDB(B1, 0, 1); PG8_SCHED; PG8_LDA(At, 0, 0); PG8_STAGE(PG8_SA(1, 1), a1 + hstepA, PG8_VA(1));
            PG8_WAIT_V(8); PG8_WAIT_L(0); PG8_BAR; PG8_MMA(0, 0, At, B0); PG8_MMA(0, 1, At, B1); PG8_BAR; PG8_SCHED;
            PG8_LDA(At, 0, 1); PG8_STAGE(PG8_SB(0, 0), b2, voffB); PG8_STAGE(PG8_SB(0, 1), b2 + hstepB, voffB); PG8_STAGE(PG8_SA(0, 0), a2, PG8_VA2(0));
            PG8_WAIT_V(8); PG8_WAIT_L(0); PG8_BAR; PG8_MMA(1, 0, At, B0); PG8_MMA(1, 1, At, B1); PG8_BAR; PG8_SCHED;
            PG8_LDB(B0, 1, 0); PG8_LDB(B1, 1, 1); PG8_SCHED; PG8_LDA(At, 1, 0); PG8_STAGE(PG8_SA(0, 1), a2 + hstepA, PG8_VA2(1));
            PG8_WAIT_V(8); PG8_WAIT_L(0); PG8_BAR; PG8_MMA(0, 0, At, B0); PG8_MMA(0, 1, At, B1); PG8_BAR; PG8_SCHED;
            PG8_LDA(At, 1, 1); PG8_STAGE(PG8_SB(1, 0), b3, voffB); PG8_STAGE(PG8_SB(1, 1), b3 + hstepB, voffB); PG8_STAGE(PG8_SA(1, 0), a3, PG8_VA2(0));
            PG8_WAIT_V(8); PG8_WAIT_L(0); PG8_BAR; PG8_MMA(1, 0, At, B0); PG8_MMA(1, 1, At, B1); PG8_BAR; PG8_SCHED;
            if constexpr (SEG2) { if (t + 2 == nt1) { E.mid(acc, cur, wr, wc, fr, fq); PG8_SCHED; } }
        }
        if (wr == 0) PG8_BAR;
        if constexpr (F8) asm volatile("s_nop 15\n\ts_nop 3" ::: "memory");
        E(acc, cur, wr, wc, fr, fq);
        if (!has_next) break;
#pragma unroll
        for (int a = 0; a < 2; ++a)
#pragma unroll
            for (int b = 0; b < 2; ++b)
#pragma unroll
                for (int m = 0; m < 4; ++m)
#pragma unroll
                    for (int n = 0; n < 2; ++n) acc[a][b][m][n] = (f32x4){0.f, 0.f, 0.f, 0.f};
        cur = nxt; cA = nA; cB = nB; ++ui;
        if constexpr (SEG2) { cA2 = uni_ptr(S.a_ptr2(cur)); cB2 = uni_ptr(S.b_ptr2(cur)); }
        if constexpr (GA) {
#pragma unroll
            for (int h = 0; h < 2; ++h)
#pragma unroll
                for (int i = 0; i < 2; ++i) voffA[h][i] = voffAn[h][i]; }
        if (wr == 1) PG8_BAR;
    }
    PG8_WAIT_V(0);
    PG8_BAR;
#undef PG8_SA
#undef PG8_SB
#undef PG8_STAGE
#undef PG8_LDA
#undef PG8_LDB
#undef PG8_MMA
#undef PG8_WAIT_V
#undef PG8_WAIT_L
#undef PG8_BAR
#undef PG8_SCHED
#undef PG8_ROWOFFS
#undef PG8_VA
#undef PG8_VA2
#undef PG8_KA
#undef PG8_KB
}
}

namespace attn_body {
using bf16 = __hip_bfloat16;
constexpr int D = 64, QP = NQKV, KP = NQKV, OP = DMODEL;
constexpr int NW = 8, QBLK = 32, QB = QBLK * NW, KVBLK = 64;
__device__ __forceinline__ int crow(int r, int hi) { return (r & 3) + 8 * (r >> 2) + 4 * hi; }
#define SBAR() __builtin_amdgcn_sched_barrier(0)
constexpr int NSLOT = 3, SLOTB = 8192;
constexpr int LDS_K = 0, LDS_V = NSLOT * SLOTB, LDS_WS = 2 * NSLOT * SLOTB, LDS_OST = LDS_WS + NW * 64 * 4, LDS_BYTES = LDS_OST + NW * 4096;
__device__ __forceinline__ void glds16(const void* gsrc, unsigned lds_dst) { unsigned keep;
    asm volatile("s_mov_b32 %0, m0\n\ts_mov_b32 m0, %2\n\ts_nop 0\n\tglobal_load_lds_dwordx4 %1, off\n\ts_mov_b32 m0, %0" : "=&s"(keep) : "v"(gsrc), "s"(lds_dst) : "memory"); }
__device__ __forceinline__ float max3f(float a, float b, float c) { float r; asm("v_max3_f32 %0, %1, %2, %3" : "=v"(r) : "v"(a), "v"(b), "v"(c)); return r; }
__device__ __forceinline__ float max2f(float a, float b) { float r; asm("v_max_f32_e32 %0, %1, %2" : "=v"(r) : "v"(a), "v"(b)); return r; }
__device__ __forceinline__ float fadd_s(float a, float b) { float r; asm("v_add_f32_e32 %0, %1, %2" : "=v"(r) : "v"(a), "v"(b)); return r; }
__device__ __forceinline__ float fsub_s(float a, float b) { float r; asm("v_sub_f32_e32 %0, %1, %2" : "=v"(r) : "v"(a), "v"(b)); return r; }
typedef float f32x2_t __attribute__((ext_vector_type(2))); typedef __bf16 bf16x2_t __attribute__((ext_vector_type(2)));
__device__ __forceinline__ unsigned cvtpk_s(float lo, float hi) { f32x2_t v = {lo, hi}; bf16x2_t b = __builtin_convertvector(v, bf16x2_t); return __builtin_bit_cast(unsigned, b); }
#define WAIT_BAR(N) asm volatile("s_waitcnt vmcnt(" #N ") lgkmcnt(0)\n\ts_barrier" ::: "memory")

__device__ __forceinline__ void qkt(f32x16& p0, f32x16& p1, const char* Kslot, const bf16x8* qr, const f32x16& negm, int r32, int hi) {
    const char* kb = Kslot + hi * 1024 + r32 * 16;
#pragma unroll
    for (int d0 = 0; d0 < 4; ++d0) {
        const bf16x8 b0 = *reinterpret_cast<const bf16x8*>(kb + d0 * 2048);
        const bf16x8 b1 = *reinterpret_cast<const bf16x8*>(kb + d0 * 2048 + 512);
        if (d0 == 0) { p0 = __builtin_amdgcn_mfma_f32_32x32x16_bf16(b0, qr[0], negm, 0, 0, 0); p1 = __builtin_amdgcn_mfma_f32_32x32x16_bf16(b1, qr[0], negm, 0, 0, 0); }
        else { p0 = __builtin_amdgcn_mfma_f32_32x32x16_bf16(b0, qr[d0], p0, 0, 0, 0); p1 = __builtin_amdgcn_mfma_f32_32x32x16_bf16(b1, qr[d0], p1, 0, 0, 0); } }
}
typedef LAS const char* lds_cptr;
typedef short v4i16_t __attribute__((ext_vector_type(4)));
__device__ __forceinline__ void kload8(bf16x8* kf, lds_cptr kp) {
    kf[0] = *(const LAS bf16x8*)(kp);        kf[1] = *(const LAS bf16x8*)(kp + 512);
    kf[2] = *(const LAS bf16x8*)(kp + 2048); kf[3] = *(const LAS bf16x8*)(kp + 2560);
    kf[4] = *(const LAS bf16x8*)(kp + 4096); kf[5] = *(const LAS bf16x8*)(kp + 4608);
    kf[6] = *(const LAS bf16x8*)(kp + 6144); kf[7] = *(const LAS bf16x8*)(kp + 6656);
}
__device__ __forceinline__ void kload2(bf16x8* kf, lds_cptr kp, int j) { kf[2 * j] = *(const LAS bf16x8*)(kp + j * 2048); kf[2 * j + 1] = *(const LAS bf16x8*)(kp + j * 2048 + 512); }
__device__ __forceinline__ s16x4 vtr(lds_cptr p) { return __builtin_bit_cast(s16x4, __builtin_amdgcn_ds_read_tr16_b64_v4i16((LAS v4i16_t*)p)); }
__device__ __forceinline__ float rowmax(const f32x16& p0, const f32x16& p1) {
    float a = max3f(p0[0], p0[1], p1[0]), b = max3f(p0[2], p0[3], p1[1]); a = max3f(a, p1[2], p1[3]);
#pragma unroll
    for (int r = 4; r < 16; r += 4) { a = max3f(a, p0[r], p0[r + 1]); b = max3f(b, p0[r + 2], p0[r + 3]); a = max3f(a, p1[r], p1[r + 1]); b = max3f(b, p1[r + 2], p1[r + 3]); }
    const float m = max2f(a, b);
    auto rr = __builtin_amdgcn_permlane32_swap(__float_as_uint(m), __float_as_uint(m), false, false);
    return max2f(__uint_as_float(rr[0]), __uint_as_float(rr[1]));
}
__device__ __forceinline__ void pv(f32x16* o, int vb, bf16x8 pa0, bf16x8 pa1, bf16x8 pa2, bf16x8 pa3) {
#pragma unroll
    for (int d0 = 0; d0 < 2; ++d0) { s16x4 lo[4], hi[4];
#pragma unroll
        for (int ks = 0; ks < 4; ++ks) {
            asm volatile("ds_read_b64_tr_b16 %0,%1 offset:%c2" : "=&v"(lo[ks]) : "v"(vb), "i"(d0 * 4096 + ks * 1024) : "memory");
            asm volatile("ds_read_b64_tr_b16 %0,%1 offset:%c2" : "=&v"(hi[ks]) : "v"(vb), "i"(d0 * 4096 + ks * 1024 + 512) : "memory"); }
        asm volatile("s_waitcnt lgkmcnt(0)" ::: "memory"); SBAR();
#define PK(k) (bf16x8){lo[k][0], lo[k][1], lo[k][2], lo[k][3], hi[k][0], hi[k][1], hi[k][2], hi[k][3]}
        o[d0] = __builtin_amdgcn_mfma_f32_32x32x16_bf16(pa0, PK(0), o[d0], 0, 0, 0);
        o[d0] = __builtin_amdgcn_mfma_f32_32x32x16_bf16(pa1, PK(1), o[d0], 0, 0, 0);
        o[d0] = __builtin_amdgcn_mfma_f32_32x32x16_bf16(pa2, PK(2), o[d0], 0, 0, 0);
        o[d0] = __builtin_amdgcn_mfma_f32_32x32x16_bf16(pa3, PK(3), o[d0], 0, 0, 0);
#undef PK
    }
}
#define ATTN_STORE16(p, v) (*(u32x4*)(p) = (v))
template <int THRL> __device__ __forceinline__ void attn_unit(int qb, const bf16* Qh, const bf16* __restrict__ Kh, const bf16* __restrict__ Vh, bf16* Oh, char* shm) {
    const int tid = fresh_tid(), lane = tid & 63, r32 = lane & 31, hi = lane >> 5; const int wid = __builtin_amdgcn_readfirstlane(tid >> 6);
    const int q0 = qb * QB;
    const bf16* Qw = Qh + (long)(q0 + wid * QBLK) * QP;
    const unsigned lds0 = (unsigned)(uintptr_t)shm;
    float* wsf = (float*)(shm + LDS_WS) + wid * 64;
    const bf16* ksrc = Kh + (long)lane * KP + wid * 8;
    const bf16* vsrc = Vh + (long)(16 * (wid & 3) + (lane >> 2)) * KP + (wid >> 2) * 32 + (lane & 3) * 8;
    const unsigned kdst = lds0 + LDS_K + wid * 1024, vdst = lds0 + LDS_V + wid * 1024;
#define DMA_K(t, slot) glds16(ksrc + (long)(t) * KVBLK * KP, (unsigned)__builtin_amdgcn_readfirstlane(kdst + (slot)))
#define DMA_V(t, slot) glds16(vsrc + (long)(t) * KVBLK * KP, (unsigned)__builtin_amdgcn_readfirstlane(vdst + (slot)))
    const int vb0 = (int)(lds0 + LDS_V) + ((lane >> 4) & 1) * 32 + (lane & 3) * 8 + (4 * hi + ((lane & 15) >> 2)) * 64;
    const char* Kbase = shm + LDS_K; bf16x8 kf[8];
    const lds_cptr shm3 = (lds_cptr)shm; const lds_cptr kp0 = shm3 + LDS_K + hi * 1024 + r32 * 16; const lds_cptr vp0 = shm3 + LDS_V + ((lane >> 4) & 1) * 32 + (lane & 3) * 8 + (4 * hi + ((lane & 15) >> 2)) * 64;
    constexpr int NT = SEQ / KVBLK;
    DMA_K(0, 0); DMA_V(0, 0); DMA_K(1, SLOTB);
    bf16x8 qr[4];
#pragma unroll
    for (int d0 = 0; d0 < 4; ++d0) qr[d0] = *reinterpret_cast<const bf16x8*>(&Qw[(long)r32 * QP + d0 * 16 + hi * 8]);
    float mhat = 0.f, l_reg = 0.f; f32x16 o[2]; o[0] = f32x16{}; o[1] = f32x16{}; f32x16 negm = f32x16{}; asm volatile("" : "+v"(negm));
    bool resc = false;
#define START(P0, P1) do { const float rm = rowmax(P0, P1); resc = false; \
    { const float dl = rm; mhat = fadd_s(mhat, dl); \
      _Pragma("unroll") for (int r = 0; r < 16; ++r) { P0[r] = fsub_s(P0[r], dl); P1[r] = fsub_s(P1[r], dl); } \
      _Pragma("unroll") for (int r = 0; r < 16; ++r) negm[r] = -mhat; asm volatile("" : "+v"(negm)); } \
    _Pragma("unroll") for (int r = 0; r < 16; ++r) P0[r] = __builtin_amdgcn_exp2f(P0[r]); } while (0)
#define RESC() do { if (resc) { asm volatile("s_waitcnt lgkmcnt(0)" ::: "memory"); \
      _Pragma("unroll") for (int d_ = 0; d_ < 2; ++d_) _Pragma("unroll") for (int r = 0; r < 16; ++r) o[d_][r] *= wsf[crow(r, hi)]; } } while (0)
    f32x16 pA0, pA1, pB0, pB1;
    int sl_prev = 0, sl_cur = 0, sl_next = SLOTB;
#define ROT() do { sl_prev = sl_cur; sl_cur = sl_next; sl_next = (sl_next == (NSLOT - 1) * SLOTB) ? 0 : sl_next + SLOTB; } while (0)
    DMA_K(2, 2 * SLOTB);
    WAIT_BAR(3);
    qkt(pA0, pA1, Kbase, qr, negm, r32, hi); asm volatile("s_nop 15\n\ts_nop 7" : "+v"(pA0), "+v"(pA1));
    START(pA0, pA1);
    _Pragma("unroll") for (int r = 0; r < 16; ++r) pA1[r] = __builtin_amdgcn_exp2f(pA1[r]);
    WAIT_BAR(0);
    DMA_K(3, 0); DMA_V(1, SLOTB);
    ROT();
    kload8(kf, kp0 + sl_cur);
    WAIT_BAR(2);
    s16x4 vlo[8], vhi[8]; u32x4 pw0, pw1, pw2, pw3;
#define PKW(P, B) cvtpk_s(P[B], P[B + 1])
#define PAF(k) __builtin_bit_cast(bf16x8, pw##k)
#define VFR(i) (bf16x8){vlo[i][0], vlo[i][1], vlo[i][2], vlo[i][3], vhi[i][0], vhi[i][1], vhi[i][2], vhi[i][3]}
#define PIN(x) asm volatile("" : "+v"(x))
#define MX3(a, b, c) __builtin_fmaxf(__builtin_fmaxf((a), (b)), (c))
#define GAPA(MF, A0, A1, A2, A3, W0, W1, PW) do { MF; sacc += A0; sacc += A1; sacc += A2; sacc += A3; PIN(sacc); W0; W1; PIN(PW); SBAR(); } while (0)
#define EX(v) __builtin_amdgcn_exp2f(v)
#define GAPB(MF, X, B) do { MF; X[B] = EX(X[B]); X[B + 1] = EX(X[B + 1]); X[B + 2] = EX(X[B + 2]); X[B + 3] = EX(X[B + 3]); PIN(X); SBAR(); } while (0)
#define VRD(i) do { vlo[i] = vtr(vp_ + (((i) >> 2) * 4096 + ((i) & 3) * 1024)); vhi[i] = vtr(vp_ + (((i) >> 2) * 4096 + ((i) & 3) * 1024 + 512)); } while (0)
#define KRD(G, j) do { if (G) { kload2(kf, kp0 + sl_next, j); SBAR(); } } while (0)
#define STEP(C0, C1, P0, P1, t, GK, GV, GL) do { SBAR(); \
    const lds_cptr vp_ = vp0 + sl_prev; \
    VRD(0); SBAR(); float sacc = (P0[0] + P0[1]); \
    GAPA(C0 = __builtin_amdgcn_mfma_f32_32x32x16_bf16(kf[0], qr[0], negm, 0, 0, 0), P0[2], P0[3], P0[4], P0[5],     pw0[0] = PKW(P0, 0), pw0[1] = PKW(P0, 2), pw0); \
    VRD(4); SBAR(); GAPA(C1 = __builtin_amdgcn_mfma_f32_32x32x16_bf16(kf[1], qr[0], negm, 0, 0, 0), P0[6], P0[7], P0[8], P0[9],     pw0[2] = PKW(P0, 4), pw0[3] = PKW(P0, 6), pw0); \
    VRD(1); SBAR(); GAPA(C0 = __builtin_amdgcn_mfma_f32_32x32x16_bf16(kf[2], qr[1], C0, 0, 0, 0),   P0[10], P0[11], P0[12], P0[13], pw1[0] = PKW(P0, 8), pw1[1] = PKW(P0, 10), pw1); \
    VRD(5); SBAR(); GAPA(C1 = __builtin_amdgcn_mfma_f32_32x32x16_bf16(kf[3], qr[1], C1, 0, 0, 0),   P0[14], P0[15], P1[0], P1[1],   pw1[2] = PKW(P0, 12), pw1[3] = PKW(P0, 14), pw1); \
    VRD(2); SBAR(); GAPA(C0 = __builtin_amdgcn_mfma_f32_32x32x16_bf16(kf[4], qr[2], C0, 0, 0, 0),   P1[2], P1[3], P1[4], P1[5],     pw2[0] = PKW(P1, 0), pw2[1] = PKW(P1, 2), pw2); \
    VRD(6); SBAR(); GAPA(C1 = __builtin_amdgcn_mfma_f32_32x32x16_bf16(kf[5], qr[2], C1, 0, 0, 0),   P1[6], P1[7], P1[8], P1[9],     pw2[2] = PKW(P1, 4), pw2[3] = PKW(P1, 6), pw2); \
    VRD(3); SBAR(); GAPA(C0 = __builtin_amdgcn_mfma_f32_32x32x16_bf16(kf[6], qr[3], C0, 0, 0, 0),   P1[10], P1[11], P1[12], P1[13], pw3[0] = PKW(P1, 8), pw3[1] = PKW(P1, 10), pw3); \
    VRD(7); SBAR(); GAPA(C1 = __builtin_amdgcn_mfma_f32_32x32x16_bf16(kf[7], qr[3], C1, 0, 0, 0),   P1[14], P1[15], 0.f, 0.f,       pw3[2] = PKW(P1, 12), pw3[3] = PKW(P1, 14), pw3); \
    l_reg += sacc; \
    if (GK) { DMA_K((t) + 3, sl_cur); } if (GV) { DMA_V((t) + 1, sl_next); } \
    { float a = MX3(C0[0], C0[1], C1[0]), b = MX3(C0[2], C0[3], C1[1]); a = MX3(a, C1[2], C1[3]); \
      _Pragma("unroll") for (int r = 4; r < 16; r += 4) { a = MX3(a, C0[r], C0[r + 1]); b = MX3(b, C0[r + 2], C0[r + 3]); a = MX3(a, C1[r], C1[r + 1]); b = MX3(b, C1[r + 2], C1[r + 3]); } \
      float rm = __builtin_fmaxf(a, b); { auto rr = __builtin_amdgcn_permlane32_swap(__float_as_uint(rm), __float_as_uint(rm), false, false); rm = __builtin_fmaxf(__uint_as_float(rr[0]), __uint_as_float(rr[1])); } \
      resc = false; \
      if (__builtin_expect(__any(rm > (float)THRL), 0)) { const float dl = __builtin_fmaxf(rm, 0.f); mhat += dl; \
        _Pragma("unroll") for (int r = 0; r < 16; ++r) { C0[r] -= dl; C1[r] -= dl; } \
        _Pragma("unroll") for (int r = 0; r < 16; ++r) negm[r] = -mhat; asm volatile("" : "+v"(negm)); \
        const float f = __builtin_amdgcn_exp2f(-dl); l_reg *= f; if (hi == 0) wsf[r32] = f; resc = true; } } \
    SBAR(); \
    GAPB(o[0] = __builtin_amdgcn_mfma_f32_32x32x16_bf16(PAF(0), VFR(0), o[0], 0, 0, 0), C0, 0); \
    GAPB(o[1] = __builtin_amdgcn_mfma_f32_32x32x16_bf16(PAF(0), VFR(4), o[1], 0, 0, 0), C0, 4); \
    KRD(GL, 0); GAPB(o[0] = __builtin_amdgcn_mfma_f32_32x32x16_bf16(PAF(1), VFR(1), o[0], 0, 0, 0), C0, 8); \
    KRD(GL, 1); GAPB(o[1] = __builtin_amdgcn_mfma_f32_32x32x16_bf16(PAF(1), VFR(5), o[1], 0, 0, 0), C0, 12); \
    KRD(GL, 2); GAPB(o[0] = __builtin_amdgcn_mfma_f32_32x32x16_bf16(PAF(2), VFR(2), o[0], 0, 0, 0), C1, 0); \
    KRD(GL, 3); GAPB(o[1] = __builtin_amdgcn_mfma_f32_32x32x16_bf16(PAF(2), VFR(6), o[1], 0, 0, 0), C1, 4); \
    GAPB(o[0] = __builtin_amdgcn_mfma_f32_32x32x16_bf16(PAF(3), VFR(3), o[0], 0, 0, 0), C1, 8); \
    GAPB(o[1] = __builtin_amdgcn_mfma_f32_32x32x16_bf16(PAF(3), VFR(7), o[1], 0, 0, 0), C1, 12); \
    } while (0)
    int t = 1;
    for (; t + 5 < NT; t += 2) {
        STEP(pB0, pB1, pA0, pA1, t, true, true, true);     WAIT_BAR(2); RESC(); ROT();
        STEP(pA0, pA1, pB0, pB1, t + 1, true, true, true); WAIT_BAR(2); RESC(); ROT();
    }
#define ENDW(tt) do { if ((tt) + 3 < NT) { WAIT_BAR(2); } else if ((tt) + 2 < NT) { WAIT_BAR(1); } else { WAIT_BAR(0); } } while (0)
    for (; t + 1 < NT; t += 2) {
        STEP(pB0, pB1, pA0, pA1, t, (t + 3 < NT), (t + 1 < NT), (t + 1 < NT));         ENDW(t);     RESC(); ROT();
        STEP(pA0, pA1, pB0, pB1, t + 1, (t + 4 < NT), (t + 2 < NT), (t + 2 < NT));     ENDW(t + 1); RESC(); ROT();
    }
    STEP(pB0, pB1, pA0, pA1, NT - 1, false, false, false); RESC();
    { float sacc = pB0[0] + pB0[1]; _Pragma("unroll") for (int r = 2; r < 16; ++r) sacc += pB0[r]; _Pragma("unroll") for (int r = 0; r < 16; ++r) sacc += pB1[r]; l_reg += sacc;
      pw0 = (u32x4){PKW(pB0, 0), PKW(pB0, 2), PKW(pB0, 4), PKW(pB0, 6)}; pw1 = (u32x4){PKW(pB0, 8), PKW(pB0, 10), PKW(pB0, 12), PKW(pB0, 14)}; pw2 = (u32x4){PKW(pB1, 0), PKW(pB1, 2), PKW(pB1, 4), PKW(pB1, 6)}; pw3 = (u32x4){PKW(pB1, 8), PKW(pB1, 10), PKW(pB1, 12), PKW(pB1, 14)};
      SBAR(); pv(o, vb0 + sl_cur, PAF(0), PAF(1), PAF(2), PAF(3)); }
#undef PKW
#undef PAF
#undef VFR
#undef PIN
#undef MX3
#undef GAPA
#undef GAPB
#undef EX
#undef VRD
#undef KRD
#undef STEP
#undef ENDW
    { auto rr = __builtin_amdgcn_permlane32_swap(__float_as_uint(l_reg), __float_as_uint(l_reg), false, false); l_reg = __uint_as_float(rr[0]) + __uint_as_float(rr[1]); }
    if (hi == 0) wsf[32 + r32] = l_reg; asm volatile("s_waitcnt lgkmcnt(0)" ::: "memory");
    float rli[16];
#pragma unroll
    for (int r = 0; r < 16; ++r) rli[r] = __builtin_amdgcn_rcpf(wsf[32 + crow(r, hi)]);
    bf16* Ow = Oh + (long)(q0 + wid * QBLK) * OP;
    { bf16* stg = (bf16*)(shm + LDS_OST) + wid * 2048;
#pragma unroll
      for (int r = 0; r < 16; ++r) { const int orow = crow(r, hi);
#pragma unroll
        for (int d0 = 0; d0 < 2; ++d0) stg[orow * 64 + d0 * 32 + r32] = __float2bfloat16(o[d0][r] * rli[r]); }
      asm volatile("s_waitcnt lgkmcnt(0)" ::: "memory");
#pragma unroll
      for (int i = 0; i < 4; ++i) { const int row = i * 8 + (lane >> 3), ch = lane & 7; const u32x4 v = *(const u32x4*)(stg + row * 64 + ch * 8); ATTN_STORE16(Ow + (long)row * OP + ch * 8, v); } }
    asm volatile("s_waitcnt lgkmcnt(0)\n\ts_barrier" ::: "memory");
#undef DMA_K
#undef DMA_V
#undef START
#undef RESC
#undef ROT
}

__device__ __forceinline__ void attn_unit_fast(int qb, const bf16* Qh, const bf16* __restrict__ Kh, const bf16* __restrict__ Vh, bf16* Oh, char* shm) {
    const int tid = fresh_tid(), lane = tid & 63, r32 = lane & 31, hi = lane >> 5; const int wid = __builtin_amdgcn_readfirstlane(tid >> 6);
    const int q0 = qb * QB;
    const bf16* Qw = Qh + (long)(q0 + wid * QBLK) * QP;
    const unsigned lds0 = (unsigned)(uintptr_t)shm;
    const bf16* ksrc = Kh + (long)lane * KP + wid * 8;
    const bf16* vsrc = Vh + (long)(16 * (wid & 3) + (lane >> 2)) * KP + (wid >> 2) * 32 + (lane & 3) * 8;
    const unsigned kdst = lds0 + LDS_K + wid * 1024, vdst = lds0 + LDS_V + wid * 1024;
#define DMA_K(t, slot) glds16(ksrc + (long)(t) * KVBLK * KP, (unsigned)__builtin_amdgcn_readfirstlane(kdst + (slot)))
#define DMA_V(t, slot) glds16(vsrc + (long)(t) * KVBLK * KP, (unsigned)__builtin_amdgcn_readfirstlane(vdst + (slot)))
    const int vb0 = (int)(lds0 + LDS_V) + ((lane >> 4) & 1) * 32 + (lane & 3) * 8 + (4 * hi + ((lane & 15) >> 2)) * 64;
    const char* Kbase = shm + LDS_K; bf16x8 kf[8];
    const lds_cptr shm3 = (lds_cptr)shm; const lds_cptr kp0 = shm3 + LDS_K + hi * 1024 + r32 * 16; const lds_cptr vp0 = shm3 + LDS_V + ((lane >> 4) & 1) * 32 + (lane & 3) * 8 + (4 * hi + ((lane & 15) >> 2)) * 64;
    constexpr int NT = SEQ / KVBLK;
    DMA_K(0, 0); DMA_V(0, 0); DMA_K(1, SLOTB);
    bf16x8 qr[4];
#pragma unroll
    for (int d0 = 0; d0 < 4; ++d0) qr[d0] = *reinterpret_cast<const bf16x8*>(&Qw[(long)r32 * QP + d0 * 16 + hi * 8]);
    f32x16 o[2]; o[0] = f32x16{}; o[1] = f32x16{}; f32x16 lsum = f32x16{};
    const f32x16 zero16 = f32x16{};
    bf16x8 ones; { const short one = (short)0x3F80; ones = (bf16x8){one, one, one, one, one, one, one, one}; asm volatile("" : "+v"(ones)); }
    f32x16 pA0, pA1, pB0, pB1;
    int sl_prev = 0, sl_cur = 0, sl_next = SLOTB;
#define ROT() do { sl_prev = sl_cur; sl_cur = sl_next; sl_next = (sl_next == (NSLOT - 1) * SLOTB) ? 0 : sl_next + SLOTB; } while (0)
    DMA_K(2, 2 * SLOTB);
    WAIT_BAR(3);
    qkt(pA0, pA1, Kbase, qr, zero16, r32, hi);
    _Pragma("unroll") for (int r = 0; r < 16; ++r) pA0[r] = __builtin_amdgcn_exp2f(pA0[r]);
    _Pragma("unroll") for (int r = 0; r < 16; ++r) pA1[r] = __builtin_amdgcn_exp2f(pA1[r]);
    WAIT_BAR(0);
    DMA_K(3, 0); DMA_V(1, SLOTB);
    ROT();
    kload8(kf, kp0 + sl_cur);
    WAIT_BAR(2);
    s16x4 vlo[8], vhi[8]; u32x4 pw0, pw1, pw2, pw3;
#define PKW(P, B) cvtpk_s(P[B], P[B + 1])
#define PAF(k) __builtin_bit_cast(bf16x8, pw##k)
#define VFR(i) (bf16x8){vlo[i][0], vlo[i][1], vlo[i][2], vlo[i][3], vhi[i][0], vhi[i][1], vhi[i][2], vhi[i][3]}
#define PIN(x) asm volatile("" : "+v"(x))
#define GAPA(MF, W0, W1, PW) do { MF; W0; W1; PIN(PW); SBAR(); } while (0)
#define EX(v) __builtin_amdgcn_exp2f(v)
#define GAPB(MF, X, B) do { MF; X[B] = EX(X[B]); X[B + 1] = EX(X[B + 1]); X[B + 2] = EX(X[B + 2]); PIN(X); SBAR(); } while (0)
#define GAPS(k, X, B) do { lsum = __builtin_amdgcn_mfma_f32_32x32x16_bf16(PAF(k), ones, lsum, 0, 0, 0); X[B] = EX(X[B]); X[B + 1] = EX(X[B + 1]); PIN(X); SBAR(); } while (0)
#define VRD(i) do { vlo[i] = vtr(vp_ + (((i) >> 2) * 4096 + ((i) & 3) * 1024)); vhi[i] = vtr(vp_ + (((i) >> 2) * 4096 + ((i) & 3) * 1024 + 512)); } while (0)
#define KRD(G, j) do { if (G) { kload2(kf, kp0 + sl_next, j); SBAR(); } } while (0)
#define STEP(C0, C1, P0, P1, t, GK, GV, GL) do { SBAR(); \
    const lds_cptr vp_ = vp0 + sl_prev; \
    VRD(0); SBAR(); \
    GAPA(C0 = __builtin_amdgcn_mfma_f32_32x32x16_bf16(kf[0], qr[0], zero16, 0, 0, 0), pw0[0] = PKW(P0, 0), pw0[1] = PKW(P0, 2), pw0); \
    VRD(4); SBAR(); GAPA(C1 = __builtin_amdgcn_mfma_f32_32x32x16_bf16(kf[1], qr[0], zero16, 0, 0, 0), pw0[2] = PKW(P0, 4), pw0[3] = PKW(P0, 6), pw0); \
    VRD(1); SBAR(); GAPA(C0 = __builtin_amdgcn_mfma_f32_32x32x16_bf16(kf[2], qr[1], C0, 0, 0, 0),   pw1[0] = PKW(P0, 8), pw1[1] = PKW(P0, 10), pw1); \
    VRD(5); SBAR(); GAPA(C1 = __builtin_amdgcn_mfma_f32_32x32x16_bf16(kf[3], qr[1], C1, 0, 0, 0),   pw1[2] = PKW(P0, 12), pw1[3] = PKW(P0, 14), pw1); \
    VRD(2); SBAR(); GAPA(C0 = __builtin_amdgcn_mfma_f32_32x32x16_bf16(kf[4], qr[2], C0, 0, 0, 0),   pw2[0] = PKW(P1, 0), pw2[1] = PKW(P1, 2), pw2); \
    VRD(6); SBAR(); GAPA(C1 = __builtin_amdgcn_mfma_f32_32x32x16_bf16(kf[5], qr[2], C1, 0, 0, 0),   pw2[2] = PKW(P1, 4), pw2[3] = PKW(P1, 6), pw2); \
    VRD(3); SBAR(); GAPA(C0 = __builtin_amdgcn_mfma_f32_32x32x16_bf16(kf[6], qr[3], C0, 0, 0, 0),   pw3[0] = PKW(P1, 8), pw3[1] = PKW(P1, 10), pw3); \
    VRD(7); SBAR(); GAPA(C1 = __builtin_amdgcn_mfma_f32_32x32x16_bf16(kf[7], qr[3], C1, 0, 0, 0),   pw3[2] = PKW(P1, 12), pw3[3] = PKW(P1, 14), pw3); \
    if (GK) { DMA_K((t) + 3, sl_cur); } if (GV) { DMA_V((t) + 1, sl_next); } \
    SBAR(); \
    GAPB(o[0] = __builtin_amdgcn_mfma_f32_32x32x16_bf16(PAF(0), VFR(0), o[0], 0, 0, 0), C0, 0); \
    GAPB(o[1] = __builtin_amdgcn_mfma_f32_32x32x16_bf16(PAF(0), VFR(4), o[1], 0, 0, 0), C0, 3); \
    KRD(GL, 0); GAPS(0, C0, 6); \
    GAPB(o[0] = __builtin_amdgcn_mfma_f32_32x32x16_bf16(PAF(1), VFR(1), o[0], 0, 0, 0), C0, 8); \
    KRD(GL, 1); GAPB(o[1] = __builtin_amdgcn_mfma_f32_32x32x16_bf16(PAF(1), VFR(5), o[1], 0, 0, 0), C0, 11); \
    GAPS(1, C0, 14); \
    KRD(GL, 2); GAPB(o[0] = __builtin_amdgcn_mfma_f32_32x32x16_bf16(PAF(2), VFR(2), o[0], 0, 0, 0), C1, 0); \
    KRD(GL, 3); GAPB(o[1] = __builtin_amdgcn_mfma_f32_32x32x16_bf16(PAF(2), VFR(6), o[1], 0, 0, 0), C1, 3); \
    GAPS(2, C1, 6); \
    GAPB(o[0] = __builtin_amdgcn_mfma_f32_32x32x16_bf16(PAF(3), VFR(3), o[0], 0, 0, 0), C1, 8); \
    GAPB(o[1] = __builtin_amdgcn_mfma_f32_32x32x16_bf16(PAF(3), VFR(7), o[1], 0, 0, 0), C1, 11); \
    GAPS(3, C1, 14); \
    } while (0)
    int t = 1;
    for (; t + 5 < NT; t += 2) {
        STEP(pB0, pB1, pA0, pA1, t, true, true, true);     WAIT_BAR(2); ROT();
        STEP(pA0, pA1, pB0, pB1, t + 1, true, true, true); WAIT_BAR(2); ROT();
    }
#define ENDW(tt) do { if ((tt) + 3 < NT) { WAIT_BAR(2); } else if ((tt) + 2 < NT) { WAIT_BAR(1); } else { WAIT_BAR(0); } } while (0)
    for (; t + 1 < NT; t += 2) {
        STEP(pB0, pB1, pA0, pA1, t, (t + 3 < NT), (t + 1 < NT), (t + 1 < NT));         ENDW(t);     ROT();
        STEP(pA0, pA1, pB0, pB1, t + 1, (t + 4 < NT), (t + 2 < NT), (t + 2 < NT));     ENDW(t + 1); ROT();
    }
    STEP(pB0, pB1, pA0, pA1, NT - 1, false, false, false);
    { pw0 = (u32x4){PKW(pB0, 0), PKW(pB0, 2), PKW(pB0, 4), PKW(pB0, 6)}; pw1 = (u32x4){PKW(pB0, 8), PKW(pB0, 10), PKW(pB0, 12), PKW(pB0, 14)}; pw2 = (u32x4){PKW(pB1, 0), PKW(pB1, 2), PKW(pB1, 4), PKW(pB1, 6)}; pw3 = (u32x4){PKW(pB1, 8), PKW(pB1, 10), PKW(pB1, 12), PKW(pB1, 14)};
      SBAR(); pv(o, vb0 + sl_cur, PAF(0), PAF(1), PAF(2), PAF(3));
      lsum = __builtin_amdgcn_mfma_f32_32x32x16_bf16(PAF(0), ones, lsum, 0, 0, 0); lsum = __builtin_amdgcn_mfma_f32_32x32x16_bf16(PAF(1), ones, lsum, 0, 0, 0);
      lsum = __builtin_amdgcn_mfma_f32_32x32x16_bf16(PAF(2), ones, lsum, 0, 0, 0); lsum = __builtin_amdgcn_mfma_f32_32x32x16_bf16(PAF(3), ones, lsum, 0, 0, 0); }
#undef PKW
#undef PAF
#undef VFR
#undef PIN
#undef GAPA
#undef GAPB
#undef GAPS
#undef EX
#undef VRD
#undef KRD
#undef STEP
#undef ENDW
    bf16* Ow = Oh + (long)(q0 + wid * QBLK) * OP;
    { bf16* stg = (bf16*)(shm + LDS_OST) + wid * 2048;
#pragma unroll
      for (int r = 0; r < 16; ++r) { const int orow = crow(r, hi); const float rl = __builtin_amdgcn_rcpf(lsum[r]);
#pragma unroll
        for (int d0 = 0; d0 < 2; ++d0) stg[orow * 64 + d0 * 32 + r32] = __float2bfloat16(o[d0][r] * rl); }
      asm volatile("s_waitcnt lgkmcnt(0)" ::: "memory");
#pragma unroll
      for (int i = 0; i < 4; ++i) { const int row = i * 8 + (lane >> 3), ch = lane & 7; const u32x4 v = *(const u32x4*)(stg + row * 64 + ch * 8); ATTN_STORE16(Ow + (long)row * OP + ch * 8, v); } }
    asm volatile("s_waitcnt lgkmcnt(0)\n\ts_barrier" ::: "memory");
#undef DMA_K
#undef DMA_V
#undef ROT
}
__device__ __forceinline__ void attn_unit_f8(int qb, const unsigned char* Q8h, const unsigned char* __restrict__ K8h, const unsigned char* __restrict__ V8Th, bf16* Oh, char* shm, float shift) {
    const int tid = fresh_tid(), lane = tid & 63, r32 = lane & 31, hi = lane >> 5; const int wid = __builtin_amdgcn_readfirstlane(tid >> 6);
    const int q0 = qb * QB;
    const unsigned lds0 = (unsigned)(uintptr_t)shm;
    constexpr int KSL = 4096;
    const int prow = 8 * wid + ((lane & 31) >> 2), pch = ((lane & 3) ^ ((prow >> 2) & 3)) * 16;
    const unsigned char* ksrc = K8h + (long)prow * 128 + pch;
    const unsigned char* vsrc = V8Th + (long)prow * 64 + pch;
    const unsigned kdst = lds0 + LDS_K + wid * 512, vdst = lds0 + LDS_V + wid * 512;
#define DMA_K(t, slot) do { if (lane < 32) glds16(ksrc + (long)(t) * KVBLK * 128, (unsigned)__builtin_amdgcn_readfirstlane(kdst + (slot))); } while (0)
#define DMA_V(t, slot) do { if (lane < 32) glds16(vsrc + (long)(t) * 4096, (unsigned)__builtin_amdgcn_readfirstlane(vdst + (slot))); } while (0)
    const lds_cptr shm3 = (lds_cptr)shm; const int ksw = (r32 >> 2) & 3;
    const int fo0 = r32 * 64 + (((2 * hi) ^ ksw) * 16), fo1 = r32 * 64 + (((2 * hi + 1) ^ ksw) * 16);
    const lds_cptr kp0 = shm3 + LDS_K, vp0 = shm3 + LDS_V;
    constexpr int NT = SEQ / KVBLK;
    DMA_K(0, 0); DMA_V(0, 0); DMA_K(1, KSL);
    v8i qf; { const unsigned char* qp = Q8h + (long)(q0 + wid * QBLK + r32) * 512 + hi * 32; qf = __builtin_shufflevector(*(const v4i*)qp, *(const v4i*)(qp + 16), 0, 1, 2, 3, 4, 5, 6, 7); }
    const int sc_k = 127 - 3, sc_q = 127 - 5, sc_v = 127 - 3, sc_1 = 127;
    v8i kf8[2], vf8[2], pa;
    v8i ones8; { const int o4 = 0x38383838; ones8 = (v8i){o4, o4, o4, o4, o4, o4, o4, o4}; asm volatile("" : "+v"(ones8)); }
    f32x16 cin; { const float ns = -shift; _Pragma("unroll") for (int r = 0; r < 16; ++r) cin[r] = ns; asm volatile("" : "+v"(cin)); }
#define LD8(dst, base, slotoff) do { _Pragma("unroll") for (int n_ = 0; n_ < 2; ++n_) dst[n_] = __builtin_shufflevector(*(const LAS v4i*)((base) + (slotoff) + n_ * 2048 + fo0), *(const LAS v4i*)((base) + (slotoff) + n_ * 2048 + fo1), 0, 1, 2, 3, 4, 5, 6, 7); } while (0)
#define QK8(n_) __builtin_amdgcn_mfma_scale_f32_32x32x64_f8f6f4(kf8[n_], qf, cin, 0, 0, 0, sc_k, 0, sc_q)
#define ACC8(acc, a_, b_, sb_) asm volatile("s_nop 1\n\tv_mfma_scale_f32_32x32x64_f8f6f4 %0, %1, %2, %0, %3, %4 op_sel_hi:[0,0,0]" : "+v"(acc) : "v"(a_), "v"(b_), "v"(sc_1), "v"(sb_))
#define PACK8(P0, P1) do { pa[0] = (int)pk4_fp8_nc(P0[0], P0[1], P0[2], P0[3]); pa[1] = (int)pk4_fp8_nc(P0[4], P0[5], P0[6], P0[7]); pa[2] = (int)pk4_fp8_nc(P0[8], P0[9], P0[10], P0[11]); pa[3] = (int)pk4_fp8_nc(P0[12], P0[13], P0[14], P0[15]); \
    pa[4] = (int)pk4_fp8_nc(P1[0], P1[1], P1[2], P1[3]); pa[5] = (int)pk4_fp8_nc(P1[4], P1[5], P1[6], P1[7]); pa[6] = (int)pk4_fp8_nc(P1[8], P1[9], P1[10], P1[11]); pa[7] = (int)pk4_fp8_nc(P1[12], P1[13], P1[14], P1[15]); } while (0)
    f32x16 o[2]; o[0] = f32x16{}; o[1] = f32x16{}; f32x16 lsum = f32x16{};
    f32x16 pA0, pA1, pB0, pB1;
    int sl_prev = 0, sl_cur = 0, sl_next = KSL;
#define ROT() do { sl_prev = sl_cur; sl_cur = sl_next; sl_next = (sl_next == (NSLOT - 1) * KSL) ? 0 : sl_next + KSL; } while (0)
    DMA_K(2, 2 * KSL);
    WAIT_BAR(3);
    LD8(kf8, kp0, 0); pA0 = QK8(0); pA1 = QK8(1);
    _Pragma("unroll") for (int r = 0; r < 16; ++r) pA0[r] = __builtin_amdgcn_exp2f(pA0[r]);
    _Pragma("unroll") for (int r = 0; r < 16; ++r) pA1[r] = __builtin_amdgcn_exp2f(pA1[r]);
    WAIT_BAR(0);
    DMA_K(3, 0); DMA_V(1, KSL);
    ROT();
    LD8(kf8, kp0, sl_cur);
    WAIT_BAR(2);
#define PIN(x) asm volatile("" : "+v"(x))
#define EX(v) __builtin_amdgcn_exp2f(v)
#define EX4(X, B) do { X[B] = EX(X[B]); X[B + 1] = EX(X[B + 1]); X[B + 2] = EX(X[B + 2]); X[B + 3] = EX(X[B + 3]); } while (0)
#define STEP(C0, C1, P0, P1, t, GK, GV, GL) do { SBAR(); \
    LD8(vf8, vp0, sl_prev); \
    C0 = QK8(0); PACK8(P0, P1); PIN(pa); \
    C1 = QK8(1); \
    if (GK) { DMA_K((t) + 3, sl_cur); } if (GV) { DMA_V((t) + 1, sl_next); } \
    \
    ACC8(o[0], pa, vf8[0], sc_v); EX4(C0, 0); EX4(C0, 4); EX4(C0, 8); PIN(C0); \
    ACC8(o[1], pa, vf8[1], sc_v); EX4(C0, 12); EX4(C1, 0); EX4(C1, 4); PIN(C0); PIN(C1); \
    if (GL) { LD8(kf8, kp0, sl_next); } \
    ACC8(lsum, pa, ones8, sc_1); EX4(C1, 8); EX4(C1, 12); PIN(C1); \
    } while (0)
    int t = 1;
    for (; t + 5 < NT; t += 2) {
        STEP(pB0, pB1, pA0, pA1, t, true, true, true);     WAIT_BAR(2); ROT();
        STEP(pA0, pA1, pB0, pB1, t + 1, true, true, true); WAIT_BAR(2); ROT();
    }
#define ENDW(tt) do { if ((tt) + 3 < NT) { WAIT_BAR(2); } else if ((tt) + 2 < NT) { WAIT_BAR(1); } else { WAIT_BAR(0); } } while (0)
    for (; t + 1 < NT; t += 2) {
        STEP(pB0, pB1, pA0, pA1, t, (t + 3 < NT), (t + 1 < NT), (t + 1 < NT));         ENDW(t);     ROT();
        STEP(pA0, pA1, pB0, pB1, t + 1, (t + 4 < NT), (t + 2 < NT), (t + 2 < NT));     ENDW(t + 1); ROT();
    }
    STEP(pB0, pB1, pA0, pA1, NT - 1, false, false, false);
    { PACK8(pB0, pB1); PIN(pa); SBAR(); LD8(vf8, vp0, sl_cur); SBAR();
      ACC8(o[0], pa, vf8[0], sc_v); ACC8(o[1], pa, vf8[1], sc_v); ACC8(lsum, pa, ones8, sc_1); }
    asm volatile("s_nop 15\n\ts_nop 15" : "+v"(o[0]), "+v"(o[1]), "+v"(lsum));
#undef PIN
#undef EX
#undef EX4
#undef STEP
#undef ENDW
    bf16* Ow = Oh + (long)(q0 + wid * QBLK) * OP;
    { bf16* stg = (bf16*)(shm + LDS_OST) + wid * 2048;
#pragma unroll
      for (int r = 0; r < 16; ++r) { const int orow = crow(r, hi); const float rl = lsum[r] > 0.f ? __builtin_amdgcn_rcpf(lsum[r]) : 0.f;
#pragma unroll
        for (int d0 = 0; d0 < 2; ++d0) stg[orow * 64 + d0 * 32 + r32] = __float2bfloat16(o[d0][r] * rl); }
      asm volatile("s_waitcnt lgkmcnt(0)" ::: "memory");
#pragma unroll
      for (int i = 0; i < 4; ++i) { const int row = i * 8 + (lane >> 3), ch = lane & 7; const u32x4 v = *(const u32x4*)(stg + row * 64 + ch * 8); ATTN_STORE16(Ow + (long)row * OP + ch * 8, v); } }
    asm volatile("s_waitcnt lgkmcnt(0)\n\ts_barrier" ::: "memory");
#undef DMA_K
#undef DMA_V
#undef ROT
#undef LD8
#undef QK8
#undef ACC8
#undef PACK8
}
constexpr int ATTN_LDS_BYTES = LDS_BYTES;
#undef SBAR
#undef WAIT_BAR
}

namespace na_body {
constexpr int NA_K = 0, NA_V = 65536;
typedef short v4i16_t __attribute__((ext_vector_type(4)));
__device__ __forceinline__ int clampi(int v, int lo, int hi) { return v < lo ? lo : (v > hi ? hi : v); }
__device__ __forceinline__ void na_phase(LAS unsigned char* lds, LAS float* biasL, LAS float* xch, const bf16_t* QKV, bf16_t* Y, const float* rpb, int vcu) {
    const int tid = fresh_tid(), lane = tid & 63, wid = __builtin_amdgcn_readfirstlane(tid >> 6);
    const int bh = vcu >> 3, b = bh >> 3, h = bh & 7, rbase = (vcu & 7) * 16;
    for (int i = tid; i < 15 * 31; i += 512) biasL[i] = rpb[h * 465 + i];
    const int lc = tid >> 3, lch = tid & 7;
    const unsigned kwoff = (unsigned)(lc * 128 + ((lch ^ (lc & 7)) * 16));
    const unsigned vwoff = (unsigned)(lc * 128 + (((lch >> 1) ^ ((lc >> 1) & 3)) * 32) + (lch & 1) * 16);
    const int q = lane & 15, g = lane >> 4;
    { const int rs0 = clampi(rbase - 4, 0, 120);
      for (int row = rs0; row < rs0 + 8; ++row) { const size_t tok = (size_t)b * SEQ + (size_t)row * 64 + lc;
          const u32x4 kv = *(const u32x4*)(QKV + tok * NQKV + C_KNA + h * 64 + lch * 8); const u32x4 vv = *(const u32x4*)(QKV + tok * NQKV + C_VNA + h * 64 + lch * 8);
          *(LAS u32x4*)(lds + NA_K + (row & 7) * 8192 + kwoff) = kv; *(LAS u32x4*)(lds + NA_V + (row & 7) * 8192 + vwoff) = vv; } }
    __syncthreads();
    const int tile_ = wid & 3, c0_ = tile_ * 16;
    bf16x8 qn[2];
#pragma unroll
    for (int ks = 0; ks < 2; ++ks) qn[ks] = *(const bf16x8*)(QKV + ((size_t)b * SEQ + (size_t)rbase * 64 + c0_ + q) * NQKV + C_QNA + h * 64 + ks * 32 + g * 8);
    for (int rr = 0; rr < 16; ++rr) {
        const int r = rbase + rr, rs = clampi(r - 4, 0, 120);
        const int rsn = (rr < 15) ? clampi(r + 1 - 4, 0, 120) : rs; const bool pf = rsn != rs;
        u32x4 pk = (u32x4){0u, 0u, 0u, 0u}, pv = (u32x4){0u, 0u, 0u, 0u};
        if (pf) { const size_t tok = (size_t)b * SEQ + (size_t)(rsn + 7) * 64 + lc;
            pk = *(const u32x4*)(QKV + tok * NQKV + C_KNA + h * 64 + lch * 8); pv = *(const u32x4*)(QKV + tok * NQKV + C_VNA + h * 64 + lch * 8); }
        {
            const int tile = wid & 3, kh = wid >> 2;
            const int c0 = tile * 16, u0 = clampi(c0 - 8, 0, 32);
            const size_t tq = (size_t)b * SEQ + (size_t)r * 64 + c0 + q;
            bf16x8 qf[2]; qf[0] = qn[0]; qf[1] = qn[1];
            { const int rn = (rr < 15) ? r + 1 : r; const size_t tqn = (size_t)b * SEQ + (size_t)rn * 64 + c0 + q;
#pragma unroll
              for (int ks = 0; ks < 2; ++ks) qn[ks] = *(const bf16x8*)(QKV + tqn * NQKV + C_QNA + h * 64 + ks * 32 + g * 8); }
            f32x4 s[4][2];
#pragma unroll
            for (int kk = 0; kk < 4; ++kk) { const int slot = (rs + 4 * kh + kk) & 7;
#pragma unroll
                for (int hf = 0; hf < 2; ++hf) { const int kc = u0 + hf * 16 + q;
                    f32x4 a = (f32x4){0.f, 0.f, 0.f, 0.f};
#pragma unroll
                    for (int ks = 0; ks < 2; ++ks) { const bf16x8 kfr = *(const LAS bf16x8*)(lds + NA_K + slot * 8192 + kc * 128 + (((ks * 4 + g) ^ (kc & 7)) * 16));
                        a = __builtin_amdgcn_mfma_f32_16x16x32_bf16(kfr, qf[ks], a, 0, 0, 0); }
                    s[kk][hf] = a; } }
            const int c = c0 + q, cs = clampi(c - 8, 0, 48), lo = cs - u0;
            const int dcb = u0 - c + 15 + 4 * g;
            float mx = -1e30f;
#pragma unroll
            for (int kk = 0; kk < 4; ++kk) { const int dr = rs + 4 * kh + kk - r + 7;
#pragma unroll
                for (int hf = 0; hf < 2; ++hf)
#pragma unroll
                    for (int i = 0; i < 4; ++i) { const int kcl = 16 * hf + 4 * g + i; const bool valid = (kcl >= lo) && (kcl < lo + 16);
                        const int dc = clampi(dcb + 16 * hf + i, 0, 30);
                        const float v = valid ? (s[kk][hf][i] + biasL[dr * 31 + dc]) * LOG2E : -1e30f;
                        s[kk][hf][i] = v; mx = fmaxf(mx, v); } }
            mx = fmaxf(mx, __shfl_xor(mx, 16)); mx = fmaxf(mx, __shfl_xor(mx, 32));
            float l = 0.f;
#pragma unroll
            for (int kk = 0; kk < 4; ++kk)
#pragma unroll
                for (int hf = 0; hf < 2; ++hf)
#pragma unroll
                    for (int i = 0; i < 4; ++i) { const float p = __builtin_amdgcn_exp2f(s[kk][hf][i] - mx); s[kk][hf][i] = p; l += p; }
            l += __shfl_xor(l, 16); l += __shfl_xor(l, 32);
            f32x4 o[4];
#pragma unroll
            for (int nb = 0; nb < 4; ++nb) o[nb] = (f32x4){0.f, 0.f, 0.f, 0.f};
            const int qq = (lane & 15) >> 2, pp = lane & 3;
            const int kcA = u0 + 4 * g + qq, kcB = kcA + 16;
#pragma unroll
            for (int kk = 0; kk < 4; ++kk) { const int slot = (rs + 4 * kh + kk) & 7;
                u32x4 pw; pw.x = pk2(s[kk][0][0], s[kk][0][1]); pw.y = pk2(s[kk][0][2], s[kk][0][3]); pw.z = pk2(s[kk][1][0], s[kk][1][1]); pw.w = pk2(s[kk][1][2], s[kk][1][3]);
                const bf16x8 pf = __builtin_bit_cast(bf16x8, pw);
#pragma unroll
                for (int nb = 0; nb < 4; ++nb) {
                    const s16x4 va = __builtin_bit_cast(s16x4, __builtin_amdgcn_ds_read_tr16_b64_v4i16((LAS v4i16_t*)(lds + NA_V + slot * 8192 + kcA * 128 + ((nb ^ ((kcA >> 1) & 3)) * 32) + pp * 8)));
                    const s16x4 vb = __builtin_bit_cast(s16x4, __builtin_amdgcn_ds_read_tr16_b64_v4i16((LAS v4i16_t*)(lds + NA_V + slot * 8192 + kcB * 128 + ((nb ^ ((kcB >> 1) & 3)) * 32) + pp * 8)));
                    const bf16x8 vf = (bf16x8){va[0], va[1], va[2], va[3], vb[0], vb[1], vb[2], vb[3]};
                    o[nb] = __builtin_amdgcn_mfma_f32_16x16x32_bf16(vf, pf, o[nb], 0, 0, 0); } }
            LAS float* px = xch + (size_t)(tile * 64 + lane) * 18;
            if (kh == 1) { px[0] = mx; px[1] = l;
#pragma unroll
                for (int nb = 0; nb < 4; ++nb)
#pragma unroll
                    for (int i = 0; i < 4; ++i) px[2 + nb * 4 + i] = o[nb][i]; }
            __syncthreads();
            if (kh == 0) { const float mb = px[0], lb = px[1]; const float m = fmaxf(mx, mb), fa = __builtin_amdgcn_exp2f(mx - m), fb = __builtin_amdgcn_exp2f(mb - m);
                const float rl = 1.0f / (l * fa + lb * fb);
#pragma unroll
                for (int nb = 0; nb < 4; ++nb) { float t[4];
#pragma unroll
                    for (int i = 0; i < 4; ++i) t[i] = (o[nb][i] * fa + px[2 + nb * 4 + i] * fb) * rl;
                    u32x2 w; w.x = pk2(t[0], t[1]); w.y = pk2(t[2], t[3]);
                    *(u32x2*)(Y + tq * DMODEL + h * 64 + nb * 16 + 4 * g) = w; } }
        }
        if (pf) { *(LAS u32x4*)(lds + NA_K + ((rsn + 7) & 7) * 8192 + kwoff) = pk; *(LAS u32x4*)(lds + NA_V + ((rsn + 7) & 7) * 8192 + vwoff) = pv; }
        __syncthreads();
    }
}
}

constexpr size_t MiB = 1u << 20;
constexpr size_t WS_CTL = 0, CTL_ZERO_BYTES = 1 * MiB;
constexpr size_t WS_MOD = 1 * MiB;
constexpr size_t WS_IDX = 2 * MiB;
constexpr size_t WS_GSEL = 2 * MiB + 256 * 1024;
constexpr size_t WS_AFF = 3 * MiB;
constexpr size_t WS_SLOT = 5 * MiB;
constexpr size_t WS_WIN = 7 * MiB;
constexpr size_t WS_WG8 = 12 * MiB;
constexpr size_t WS_WA = 16 * MiB, WS_WB = 17 * MiB, WS_WOUT = 18 * MiB;
constexpr size_t WS_WGU = 20 * MiB;
constexpr size_t WS_WD = 148 * MiB;
constexpr size_t WS_H = 212 * MiB;
constexpr size_t WS_QKV = 276 * MiB;
constexpr size_t WS_GATES = 420 * MiB;
constexpr size_t WS_END = 548 * MiB;
constexpr size_t WS_YBUF = WS_WGU;
static_assert(WS_QKV + (size_t)65536 * 2048 * 2 <= WS_END, "HMID fits");
constexpr int CW_BAR = 4096;

constexpr int RING_OFF = 0, RING_BYTES = 131072;
constexpr int LDSCTL_OFF = RING_BYTES, MISC_OFF = LDSCTL_OFF + 320;
constexpr int NABIAS_OFF = RING_BYTES + 1024;
constexpr int NAXCH_OFF = RING_BYTES + 4096;
constexpr int LDS_BYTES = 163840;

#define XB_TMO      128
#define XB_XCNT(j)  (256  + 64 * (j))
#define XB_XSUB(j)  (1280 + 64 * (j))
#define XB_XGEN(j)  (2304 + 64 * (j))
#define XB_TOP      3328
#define XB_TOPGEN   3392
#define XCD_BAR_WORDS 3456
#define XB_SPIN_CAP (1u << 22)
__device__ __forceinline__ unsigned xb_ld(unsigned* p)              { return __hip_atomic_load(p, __ATOMIC_RELAXED, __HIP_MEMORY_SCOPE_AGENT); }
__device__ __forceinline__ unsigned xb_add(unsigned* p, unsigned v) { return __hip_atomic_fetch_add(p, v, __ATOMIC_RELAXED, __HIP_MEMORY_SCOPE_AGENT); }
__device__ __forceinline__ unsigned xb_xcc_id() { return (unsigned)__builtin_amdgcn_s_getreg((3 << 11) | 20) & 0xFu; }
#define XB_SPIN(cond, bar) do { unsigned _sp = 0; while (cond) { __builtin_amdgcn_s_sleep(1); \
    if ((++_sp & 255u) == 0u) { if (xb_ld(&(bar)[XB_TMO])) break; if (_sp > XB_SPIN_CAP) { atomicAdd(&(bar)[XB_TMO], 1u); break; } } } } while (0)
struct XcdBarrier { unsigned* bar; unsigned x; volatile LAS unsigned* st; };
__device__ __forceinline__ XcdBarrier xcd_barrier_post(unsigned* bar, volatile LAS unsigned* st) {
    XcdBarrier b; b.bar = bar; b.x = xb_xcc_id(); b.st = st;
    if (threadIdx.x == 0) (void)xb_add(&bar[XB_XCNT(b.x)], 1u);
    return b;
}
__device__ __forceinline__ void xcd_barrier_complete(unsigned* bar, unsigned x, unsigned& nloc, unsigned& nx) {
    const unsigned G = gridDim.x * gridDim.y * gridDim.z;
    unsigned sum, cnt, mine, sp = 0u;
    for (;;) {
        sum = 0u; cnt = 0u; mine = 0u;
#pragma unroll
        for (unsigned j = 0; j < 16; ++j) { const unsigned c = xb_ld(&bar[XB_XCNT(j)]); sum += c; cnt += (c > 0u) ? 1u : 0u; mine = (j == x) ? c : mine; }
        if (sum == G) break;
        __builtin_amdgcn_s_sleep(1);
        if ((++sp & 255u) == 0u) { if (xb_ld(&bar[XB_TMO])) break; if (sp > XB_SPIN_CAP) { atomicAdd(&bar[XB_TMO], 1u); break; } }
    }
    nloc = mine > 0u ? mine : 1u; nx = cnt > 0u ? cnt : 1u;
}
__device__ __forceinline__ void xcd_barrier(const XcdBarrier& b) {
    asm volatile("s_waitcnt vmcnt(0)" ::: "memory");
    __syncthreads();
    if (threadIdx.x == 0) {
        unsigned* bar = b.bar;
        __builtin_amdgcn_s_waitcnt(0);
        unsigned nloc = b.st[0], nx = b.st[1];
        if (nloc == 0u) { xcd_barrier_complete(bar, b.x, nloc, nx); b.st[0] = nloc; b.st[1] = nx; }
        const unsigned old = xb_add(&bar[XB_XSUB(b.x)], 1u);
        const unsigned gen = old / nloc;
        if (old + 1u == (gen + 1u) * nloc) {
            __builtin_amdgcn_fence(__ATOMIC_RELEASE, "agent");
            asm volatile("s_waitcnt vmcnt(0)" ::: "memory");
            const unsigned og = xb_add(&bar[XB_TOP], 1u);
            const unsigned tg = og / nx;
            if (og + 1u == (tg + 1u) * nx) xb_add(&bar[XB_TOPGEN], 1u);
            else XB_SPIN(xb_ld(&bar[XB_TOPGEN]) == tg, bar);
            __builtin_amdgcn_fence(__ATOMIC_ACQUIRE, "agent");
            xb_add(&bar[XB_XGEN(b.x)], 1u);
            asm volatile("s_waitcnt vmcnt(0)" ::: "memory");
        } else {
            XB_SPIN(xb_ld(&bar[XB_XGEN(b.x)]) == gen, bar);
            __builtin_amdgcn_fence(__ATOMIC_ACQUIRE, "agent");
            asm volatile("s_waitcnt vmcnt(0)" ::: "memory");
        }
    }
    __syncthreads();
}

#define LDS_WAIT() asm volatile("s_waitcnt lgkmcnt(0)" ::: "memory")
template <class RowMap>
__device__ __forceinline__ void p0_transpose_item(const float* W, int K, int N, bf16_t* WT, LAS float* scr, int item, int lane, const RowMap& rowmap) {
    const int nblk = N / 32, kb = item / nblk, nb = item % nblk, k0 = 64 * kb, n0 = 32 * nb;
    float ld_[32];
#pragma unroll
    for (int i = 0; i < 32; ++i) ld_[i] = __builtin_nontemporal_load(&W[(size_t)(k0 + 2 * i + (lane >> 5)) * N + n0 + (lane & 31)]);
#pragma unroll
    for (int i = 0; i < 32; ++i) scr[(2 * i + (lane >> 5)) * 33 + (lane & 31)] = ld_[i];
    LDS_WAIT(); asm volatile("" ::: "memory");
    const int c = lane & 7;
#pragma unroll
    for (int j = 0; j < 4; ++j) { const int n = (lane >> 3) + 8 * j; const LAS float* s = scr + (8 * c) * 33 + n;
        u32x4 o; o.x = pk2(s[0 * 33], s[1 * 33]); o.y = pk2(s[2 * 33], s[3 * 33]); o.z = pk2(s[4 * 33], s[5 * 33]); o.w = pk2(s[6 * 33], s[7 * 33]);
        *(u32x4*)(WT + (size_t)rowmap(n0 + n) * K + k0 + 8 * c) = o; }
    LDS_WAIT(); asm volatile("" ::: "memory");
}
template <class RowMap>
__device__ __forceinline__ void p0_transpose_item_f8(const float* W, int K, int N, unsigned char* WT, LAS float* scr, int item, int lane, const RowMap& rowmap, float scale) {
    const int nblk = N / 32, kb = item / nblk, nb = item % nblk, k0 = 64 * kb, n0 = 32 * nb;
    float ld_[32];
#pragma unroll
    for (int i = 0; i < 32; ++i) ld_[i] = __builtin_nontemporal_load(&W[(size_t)(k0 + 2 * i + (lane >> 5)) * N + n0 + (lane & 31)]);
#pragma unroll
    for (int i = 0; i < 32; ++i) scr[(2 * i + (lane >> 5)) * 33 + (lane & 31)] = ld_[i];
    LDS_WAIT(); asm volatile("" ::: "memory");
#pragma unroll
    for (int j = 0; j < 2; ++j) { const int p = lane + 64 * j, n = p >> 2, c = p & 3; const LAS float* s = scr + (16 * c) * 33 + n;
        u32x4 o;
        o.x = pk4_fp8(s[0 * 33] * scale, s[1 * 33] * scale, s[2 * 33] * scale, s[3 * 33] * scale);
        o.y = pk4_fp8(s[4 * 33] * scale, s[5 * 33] * scale, s[6 * 33] * scale, s[7 * 33] * scale);
        o.z = pk4_fp8(s[8 * 33] * scale, s[9 * 33] * scale, s[10 * 33] * scale, s[11 * 33] * scale);
        o.w = pk4_fp8(s[12 * 33] * scale, s[13 * 33] * scale, s[14 * 33] * scale, s[15 * 33] * scale);
        *(u32x4*)(WT + (size_t)rowmap(n0 + n) * K + k0 + 16 * c) = o; }
    LDS_WAIT(); asm volatile("" ::: "memory");
}
struct RowId { __device__ __forceinline__ int operator()(int n) const { return n; } };
struct RowIn { __device__ __forceinline__ int operator()(int n) const { if (n < 1536) return n; const int oc = n & 255; return (n & ~255) + 128 * ((oc >> 5) & 1) + 32 * (oc >> 6) + (oc & 31); } };
struct RowGate { __device__ __forceinline__ int operator()(int n) const { const int g = n - NQKV, c = g & 1023; return 768 + (c >> 7) * 256 + (g >> 10) * 128 + (c & 127); } };
struct RowAll8 { __device__ __forceinline__ int operator()(int n) const { if (n < NQKV) return RowIn{}(n); const int g = n - NQKV, c = g & 1023; return NQKV + (c >> 7) * 256 + (g >> 10) * 128 + (c & 127); } };
struct RowHead8 { __device__ __forceinline__ int operator()(int n) const { return RowIn{}(n) - 1536; } };
struct RowGU { int up; __device__ __forceinline__ int operator()(int f) const { return (f >> 7) * 256 + up * 128 + (f & 127); } };

struct CvDesc { const float* W; unsigned char* WT; int K, N, k0, n0, gu, up; };
__device__ __forceinline__ CvDesc cv_decode(int r, const float* w_eg, const float* w_eu, const float* w_ed, unsigned char* WGU, unsigned char* WD) {
    constexpr int I_GU = 16 * 64, I_D = 32 * 32;
    CvDesc d; const int e = r / (2 * I_GU + I_D); int q = r - e * (2 * I_GU + I_D);
    if (q < 2 * I_GU) { d.up = q >= I_GU; q -= d.up * I_GU; d.W = (d.up ? w_eu : w_eg) + (size_t)e * 1024 * 2048; d.WT = WGU + (size_t)e * 4096 * 1024; d.K = 1024; d.N = 2048; d.gu = 1; }
    else { q -= 2 * I_GU; d.W = w_ed + (size_t)e * 2048 * 1024; d.WT = WD + (size_t)e * 1024 * 2048; d.K = 2048; d.N = 1024; d.gu = 0; d.up = 0; }
    const int nblk = d.N / 32; d.k0 = 64 * (q / nblk); d.n0 = 32 * (q % nblk);
    return d;
}
#define CV_LOAD(ld_, d_) do { _Pragma("unroll") for (int i_ = 0; i_ < 8; ++i_) ld_[i_] = __builtin_nontemporal_load((const f32x4*)&(d_).W[(size_t)((d_).k0 + 8 * i_ + (lane >> 3)) * (d_).N + (d_).n0 + 4 * (lane & 7)]); } while (0)
#define CV_FINISH(ld_, d_) do { _Pragma("unroll") for (int i_ = 0; i_ < 8; ++i_) { LAS float* w_ = scr + (8 * i_ + (lane >> 3)) * 33 + 4 * (lane & 7); w_[0] = ld_[i_].x; w_[1] = ld_[i_].y; w_[2] = ld_[i_].z; w_[3] = ld_[i_].w; } \
        LDS_WAIT(); asm volatile("" ::: "memory"); \
        _Pragma("unroll") for (int j_ = 0; j_ < 2; ++j_) { const int p_ = lane + 64 * j_, n_ = p_ >> 2, c_ = p_ & 3; const LAS float* s_ = scr + (16 * c_) * 33 + n_; const int f_ = (d_).n0 + n_; \
            const int row_ = (d_).gu ? ((f_ >> 7) * 256 + (d_).up * 128 + (f_ & 127)) : f_; u32x4 o_; \
            o_.x = pk4_fp8(s_[0 * 33] * F8_SC_W, s_[1 * 33] * F8_SC_W, s_[2 * 33] * F8_SC_W, s_[3 * 33] * F8_SC_W); \
            o_.y = pk4_fp8(s_[4 * 33] * F8_SC_W, s_[5 * 33] * F8_SC_W, s_[6 * 33] * F8_SC_W, s_[7 * 33] * F8_SC_W); \
            o_.z = pk4_fp8(s_[8 * 33] * F8_SC_W, s_[9 * 33] * F8_SC_W, s_[10 * 33] * F8_SC_W, s_[11 * 33] * F8_SC_W); \
            o_.w = pk4_fp8(s_[12 * 33] * F8_SC_W, s_[13 * 33] * F8_SC_W, s_[14 * 33] * F8_SC_W, s_[15 * 33] * F8_SC_W); \
            *(u32x4*)((d_).WT + (size_t)row_ * (d_).K + (d_).k0 + 16 * c_) = o_; } \
        LDS_WAIT(); asm volatile("" ::: "memory"); } while (0)
__device__ __forceinline__ void conv_experts_pipelined(int first, int end, int step, int lane, LAS float* scr, const float* w_eg, const float* w_eu, const float* w_ed, unsigned char* WGU, unsigned char* WD) {
    f32x4 ldA[8], ldB[8], ldC[8], ldD[8]; CvDesc dA, dB, dC, dD; int itA = first, itB = first + step, itC = first + 2 * step, itD = first + 3 * step;
    if (itA < end) { dA = cv_decode(itA, w_eg, w_eu, w_ed, WGU, WD); CV_LOAD(ldA, dA); }
    if (itB < end) { dB = cv_decode(itB, w_eg, w_eu, w_ed, WGU, WD); CV_LOAD(ldB, dB); }
    if (itC < end) { dC = cv_decode(itC, w_eg, w_eu, w_ed, WGU, WD); CV_LOAD(ldC, dC); }
    if (itD < end) { dD = cv_decode(itD, w_eg, w_eu, w_ed, WGU, WD); CV_LOAD(ldD, dD); }
    for (;;) {
        if (itA >= end) break;
        CV_FINISH(ldA, dA); itA += 4 * step;
        if (itA < end) { dA = cv_decode(itA, w_eg, w_eu, w_ed, WGU, WD); CV_LOAD(ldA, dA); }
        if (itB >= end) break;
        CV_FINISH(ldB, dB); itB += 4 * step;
        if (itB < end) { dB = cv_decode(itB, w_eg, w_eu, w_ed, WGU, WD); CV_LOAD(ldB, dB); }
        if (itC >= end) break;
        CV_FINISH(ldC, dC); itC += 4 * step;
        if (itC < end) { dC = cv_decode(itC, w_eg, w_eu, w_ed, WGU, WD); CV_LOAD(ldC, dC); }
        if (itD >= end) break;
        CV_FINISH(ldD, dD); itD += 4 * step;
        if (itD < end) { dD = cv_decode(itD, w_eg, w_eu, w_ed, WGU, WD); CV_LOAD(ldD, dD); }
    }
}
template <int NITEMS> __device__ __forceinline__ void conv_experts_static(int first, int step, int lane, LAS float* scr, const float* w_eg, const float* w_eu, const float* w_ed, unsigned char* WGU, unsigned char* WD) {
    f32x4 ld0[8], ld1[8], ld2[8], ld3[8]; CvDesc d0, d1, d2, d3;
    d0 = cv_decode(first, w_eg, w_eu, w_ed, WGU, WD); CV_LOAD(ld0, d0);
    d1 = cv_decode(first + step, w_eg, w_eu, w_ed, WGU, WD); CV_LOAD(ld1, d1);
    d2 = cv_decode(first + 2 * step, w_eg, w_eu, w_ed, WGU, WD); CV_LOAD(ld2, d2);
    d3 = cv_decode(first + 3 * step, w_eg, w_eu, w_ed, WGU, WD); CV_LOAD(ld3, d3);
#pragma unroll
    for (int t = 0; t < NITEMS; t += 4) {
        CV_FINISH(ld0, d0); if (t + 4 < NITEMS) { d0 = cv_decode(first + (t + 4) * step, w_eg, w_eu, w_ed, WGU, WD); CV_LOAD(ld0, d0); }
        CV_FINISH(ld1, d1); if (t + 5 < NITEMS) { d1 = cv_decode(first + (t + 5) * step, w_eg, w_eu, w_ed, WGU, WD); CV_LOAD(ld1, d1); }
        CV_FINISH(ld2, d2); if (t + 6 < NITEMS) { d2 = cv_decode(first + (t + 6) * step, w_eg, w_eu, w_ed, WGU, WD); CV_LOAD(ld2, d2); }
        CV_FINISH(ld3, d3); if (t + 7 < NITEMS) { d3 = cv_decode(first + (t + 7) * step, w_eg, w_eu, w_ed, WGU, WD); CV_LOAD(ld3, d3); }
    }
}
#undef CV_LOAD
#undef CV_FINISH

__constant__ float INV_FREQ[16] = {1.0f, 0.5623413251903491f, 0.31622776601683794f, 0.1778279410038923f, 0.1f, 0.05623413251903491f, 0.03162277660168379f, 0.01778279410038923f,
                                   0.01f, 0.005623413251903491f, 0.0031622776601683794f, 0.001778279410038923f, 0.001f, 0.0005623413251903491f, 0.00031622776601683794f, 0.0001778279410038923f};

struct Args { const float* in[18]; float* out; unsigned char* ws; int ph_lo, ph_hi, li, pad; };
constexpr int NPHASE = 12;

__global__ void __launch_bounds__(512, 2) mk_fwd(Args args) {
    extern __shared__ __attribute__((aligned(16))) unsigned char lds_raw[];
    LAS unsigned char* lds = (LAS unsigned char*)lds_raw;
    volatile LAS unsigned* MISC = (volatile LAS unsigned*)(lds + MISC_OFF);
    const int G = gridDim.x; const int bx = blockIdx.x; const int vcu = (G % 8 == 0) ? (bx % 8) * (G / 8) + bx / 8 : bx;
    const int NGW = G * 8;
#define PH_IDS() const int tid = fresh_tid(), lane = tid & 63, wave = __builtin_amdgcn_readfirstlane(tid >> 6), gw = vcu * 8 + wave; (void)lane; (void)gw
    constexpr int I_IN = 16 * 136, I_BR = 8 * 32, I_OUT = 16 * 32, I_GU = 16 * 64, I_D = 32 * 32;
    constexpr int N_SMALL_ITEMS = I_IN + 2 * I_BR + I_OUT, N_EXP_ITEMS = 16 * (2 * I_GU + I_D);
#define CONV_ITEM(it_) do { LAS float* scr_ = (LAS float*)(lds + RING_OFF + wave * 16384); int r_ = (it_); \
        if (r_ < I_IN) { p0_transpose_item_f8(w_in, 1024, NIN, WG8, scr_, r_, lane, RowAll8{}, F8_SC_W); break; } r_ -= I_IN; \
        if (r_ < I_BR) { p0_transpose_item(w_bna, 512, 1024, WA, scr_, r_, lane, RowId{}); break; } r_ -= I_BR; \
        if (r_ < I_BR) { p0_transpose_item(w_bgqa, 512, 1024, WB, scr_, r_, lane, RowId{}); break; } r_ -= I_BR; \
        if (r_ < I_OUT) { p0_transpose_item(w_out, 1024, 1024, WOUT, scr_, r_, lane, RowId{}); break; } r_ -= I_OUT; \
        const int e_ = r_ / (2 * I_GU + I_D); r_ -= e_ * (2 * I_GU + I_D); \
        if (r_ < I_GU) { p0_transpose_item_f8(w_eg + (size_t)e_ * 1024 * 2048, 1024, 2048, (unsigned char*)WGU + (size_t)e_ * 4096 * 1024, scr_, r_, lane, RowGU{0}, F8_SC_W); break; } r_ -= I_GU; \
        if (r_ < I_GU) { p0_transpose_item_f8(w_eu + (size_t)e_ * 1024 * 2048, 1024, 2048, (unsigned char*)WGU + (size_t)e_ * 4096 * 1024, scr_, r_, lane, RowGU{1}, F8_SC_W); break; } r_ -= I_GU; \
        p0_transpose_item_f8(w_ed + (size_t)e_ * 2048 * 1024, 2048, 1024, (unsigned char*)WD + (size_t)e_ * 1024 * 2048, scr_, r_, lane, RowId{}, F8_SC_W); } while (0)
    unsigned char* ws = args.ws;
    const float* x = args.in[0]; const float* cvec = args.in[1]; const float* w_ada = args.in[2]; const float* b_ada = args.in[3]; const float* norm1_g = args.in[4];
    const float* w_in = args.in[5]; const float* q_norm_g = args.in[6]; const float* k_norm_g = args.in[7]; const float* na_rpb = args.in[8];
    const float* w_bna = args.in[9]; const float* w_bgqa = args.in[10]; const float* w_out = args.in[11]; const float* norm2_g = args.in[12]; const float* w_router = args.in[13];
    const float* w_eg = args.in[14]; const float* w_eu = args.in[15]; const float* w_ed = args.in[16]; const float* final_g = args.in[17];
    float* out = args.out;
    unsigned* ctl = (unsigned*)(ws + WS_CTL);
    float* MOD = (float*)(ws + WS_MOD); int* IDX = (int*)(ws + WS_IDX); float* GSEL = (float*)(ws + WS_GSEL); float* AFF = (float*)(ws + WS_AFF); int* SLOT = (int*)(ws + WS_SLOT);
    bf16_t* WIN = (bf16_t*)(ws + WS_WIN); bf16_t* WA = (bf16_t*)(ws + WS_WA); bf16_t* WB = (bf16_t*)(ws + WS_WB); bf16_t* WOUT = (bf16_t*)(ws + WS_WOUT);
    bf16_t* WGU = (bf16_t*)(ws + WS_WGU); bf16_t* WD = (bf16_t*)(ws + WS_WD);
    bf16_t* HB = (bf16_t*)(ws + WS_H); bf16_t* QKV = (bf16_t*)(ws + WS_QKV);
    bf16_t* GA = (bf16_t*)(ws + WS_GATES); unsigned char* R8 = ws + WS_GATES + 64 * MiB; unsigned char* H8 = ws + WS_GATES + 96 * MiB; unsigned char* WG8 = ws + WS_WIN;
    unsigned char* Q8 = ws + WS_WGU + 64 * MiB; unsigned char* K8 = ws + WS_WGU + 80 * MiB; unsigned char* V8T = ws + WS_WGU + 84 * MiB;
    bf16_t* DELTA = (bf16_t*)(ws + WS_GATES);
    bf16_t* MERGED = (bf16_t*)(ws + WS_QKV); bf16_t* HMID = (bf16_t*)(ws + WS_QKV); bf16_t* YBUF = (bf16_t*)(ws + WS_YBUF);

    { PH_IDS(); for (int u = tid; u < (LDS_BYTES - LDSCTL_OFF) / 4; u += 512) ((LAS unsigned*)(lds + LDSCTL_OFF))[u] = 0u; }
    __syncthreads();
    const bool use_bar = (MK_N_LAUNCHES != NPHASE);
    XcdBarrier bar; bar.bar = ctl + CW_BAR + args.li * XCD_BAR_WORDS; bar.x = 0; bar.st = nullptr;
    if (use_bar) bar = xcd_barrier_post(ctl + CW_BAR + args.li * XCD_BAR_WORDS, MISC + 8);
    const int lo = args.ph_lo, hi = args.ph_hi;
#ifndef PHASE_MASK
#define PHASE_MASK 0xFFF
#endif
#define IN(k) (((PHASE_MASK >> (k)) & 1) && lo <= (k) && (k) < hi)
#define SEAM(k) do { if (IN(k) && IN((k) + 1)) xcd_barrier(bar); } while (0)

    if (IN(0)) {
        PH_IDS();
        LAS float* scr = (LAS float*)(lds + RING_OFF + wave * 16384);
        if (vcu < 96) {
            LAS float* sl = (LAS float*)(lds + RING_OFF);
            for (int i = tid; i < 4096; i += 512) { const float cv = cvec[i]; sl[i] = cv * sigmoidf_fast(cv); }
            __syncthreads();
        }
        for (int it = vcu; it < 96; it += G) {
            const LAS float* sl = (const LAS float*)(lds + RING_OFF);
            const int col = it * 64 + lane; float a0 = 0.f, a1 = 0.f, a2 = 0.f, a3 = 0.f;
#pragma unroll 16
            for (int dd = 0; dd < 128; ++dd) { const int d = wave * 128 + dd; const float w = w_ada[(size_t)d * 6144 + col];
                a0 += sl[d] * w; a1 += sl[1024 + d] * w; a2 += sl[2048 + d] * w; a3 += sl[3072 + d] * w; }
            LAS float* part = (LAS float*)(lds + RING_OFF + 8 * 16384 - 8192);
            part[(wave * 4 + 0) * 64 + lane] = a0; part[(wave * 4 + 1) * 64 + lane] = a1; part[(wave * 4 + 2) * 64 + lane] = a2; part[(wave * 4 + 3) * 64 + lane] = a3;
            __syncthreads();
            if (tid < 256) { const int bb = tid >> 6, l = tid & 63; float s = 0.f;
#pragma unroll
                for (int w = 0; w < 8; ++w) s += part[(w * 4 + bb) * 64 + l];
                MOD[bb * 6144 + it * 64 + l] = s + b_ada[it * 64 + l]; }
            __syncthreads();
        }
        for (int it = gw; it < N_SMALL_ITEMS; it += NGW) { CONV_ITEM(it); }
    }
    SEAM(0);

    if (IN(1)) {
        PH_IDS();
        f32x4 gnv[4], nx[4];
#pragma unroll
        for (int j = 0; j < 4; ++j) { gnv[j] = *(const f32x4*)(norm1_g + 4 * lane + 256 * j); nx[j] = __builtin_nontemporal_load((const f32x4*)(x + (size_t)gw * DMODEL) + lane + 64 * j); }
        for (int m = gw; m < MT; m += NGW) { const int b = m >> 13; const float* mb = MOD + b * 6144;
            f32x4 v[4], scv[4], shv[4]; float s = 0.f;
#pragma unroll
            for (int j = 0; j < 4; ++j) { v[j] = nx[j]; scv[j] = *(const f32x4*)(mb + 1024 + 4 * lane + 256 * j); shv[j] = *(const f32x4*)(mb + 4 * lane + 256 * j); }
            const int mn = (m + NGW < MT) ? m + NGW : m;
#pragma unroll
            for (int j = 0; j < 4; ++j) nx[j] = __builtin_nontemporal_load((const f32x4*)(x + (size_t)mn * DMODEL) + lane + 64 * j);
#pragma unroll
            for (int j = 0; j < 4; ++j) s += (v[j].x * v[j].x + v[j].y * v[j].y) + (v[j].z * v[j].z + v[j].w * v[j].w);
            const float rinv = __builtin_amdgcn_rsqf(wave_sum(s) * (1.f / DMODEL) + EPS);
#pragma unroll
            for (int j = 0; j < 4; ++j) {
                const f32x4 hv = v[j] * rinv * gnv[j] * (scv[j] + 1.0f) + shv[j];
                ((unsigned*)(H8 + (size_t)m * DMODEL) + lane)[64 * j] = pk4_fp8(hv.x * F8_SC_H2, hv.y * F8_SC_H2, hv.z * F8_SC_H2, hv.w * F8_SC_H2); }
        }
    }
    SEAM(1);

#define ATTN_BOUND() float smaxp; { const int l_ = fresh_tid() & 63; float mq_ = fabsf(q_norm_g[l_]), mk_ = fabsf(k_norm_g[l_]); \
        _Pragma("unroll") for (int o_ = 1; o_ < 64; o_ <<= 1) { mq_ = fmaxf(mq_, __shfl_xor(mq_, o_)); mk_ = fmaxf(mk_, __shfl_xor(mk_, o_)); } smaxp = LOG2E * 8.0f * mq_ * mk_; } \
        const bool fast = __builtin_amdgcn_readfirstlane((int)(smaxp <= 24.0f)) != 0
    if (IN(2)) {
        ATTN_BOUND();
        { pg8::SchedPlain S; S.init(MT, NIN, G, bx, H8, DMODEL, WG8, DMODEL);
          pg8::EpiHeadGate E{pg8::EpiProj{QKV, Q8, K8, V8T, q_norm_g, k_norm_g, !fast}, pg8::EpiGate{GA, R8}};
          pg8::gemm_phase<true>(lds + RING_OFF, 8, S, E); }
    }
    SEAM(2);


    if (IN(4)) {
        PH_IDS();
        static_assert(attn_body::ATTN_LDS_BYTES <= RING_BYTES, "attention LDS");
        ATTN_BOUND(); const float shiftv = fmaxf(smaxp - 8.0f, 0.0f);
        const int cls = vcu & 3, convpos = cls, napos = (cls == 0) ? 1 : 0;
        int gi = 0;
#pragma unroll 1
        for (int st = 0; st < 6; ++st) {
            if (st == convpos) { PH_IDS();
                if (G == 256) conv_experts_static<N_EXP_ITEMS / 2048>(gw, NGW, lane, (LAS float*)(lds + RING_OFF + wave * 16384), w_eg, w_eu, w_ed, (unsigned char*)WGU, (unsigned char*)WD);
                else conv_experts_pipelined(gw, N_EXP_ITEMS, NGW, lane, (LAS float*)(lds + RING_OFF + wave * 16384), w_eg, w_eu, w_ed, (unsigned char*)WGU, (unsigned char*)WD);
                __syncthreads(); }
            else if (st == napos) { if (G == 256) na_body::na_phase(lds + RING_OFF, (LAS float*)(lds + NABIAS_OFF), (LAS float*)(lds + NAXCH_OFF), QKV, HB, na_rpb, vcu); }
            else { const long L = (long)gi * G + vcu; ++gi; if (L >= 1024) continue;
                const int ii = (int)(L >> 8), v = (int)(L & 255), bh = v >> 3, qb = (v & 7) * 4 + ii, b = bh >> 3, h = bh & 7;
                const attn_body::bf16* base = (const attn_body::bf16*)QKV + (size_t)b * SEQ * NQKV;
                if (fast) attn_body::attn_unit_f8(qb, Q8 + (size_t)b * SEQ * 512 + h * 64, K8 + (size_t)b * SEQ * 128 + (h >> 2) * 64, V8T + (size_t)(b * 2 + (h >> 2)) * 64 * SEQ,
                                        (attn_body::bf16*)HB + (size_t)b * SEQ * DMODEL + 512 + h * 64, (char*)lds_raw + RING_OFF, shiftv);
                else attn_body::attn_unit<8>(qb, base + C_QG + h * 64, base + C_KG + (h >> 2) * 64, base + C_VG + (h >> 2) * 64,
                                        (attn_body::bf16*)HB + (size_t)b * SEQ * DMODEL + 512 + h * 64, (char*)lds_raw + RING_OFF); }
        }
    }
    SEAM(4);

    if (IN(5)) {
        pg8::SchedPlain S; S.init(MT, DMODEL, G, bx, HB + 512, DMODEL * 2, WB, 512 * 2); S.A2 = (const char*)HB; S.B2 = (const char*)WA; S.nt1 = 8;
        pg8::EpiMerge E{MERGED, GA, R8};
        pg8::gemm_phase<false, pg8::EpiMerge, pg8::SchedPlain, true>(lds + RING_OFF, 16, S, E);
    }
    SEAM(5);

    if (IN(6)) {
        pg8::SchedPlain S; S.init(MT, DMODEL, G, bx, MERGED, DMODEL * 2, WOUT, DMODEL * 2);
        pg8::EpiDelta E{DELTA, MOD};
        pg8::gemm_phase<false>(lds + RING_OFF, 16, S, E);
    }
    SEAM(6);

    if (IN(7)) {
        PH_IDS();
        LAS float* wr = (LAS float*)(lds + RING_OFF);
        for (int i = tid; i < 16384; i += 512) { const int d = i >> 4, e = i & 15; wr[e * 1024 + d] = w_router[i]; }
        __syncthreads();
        f32x4 nv[2][4]; u32x2 nd[2][4];
#define P7_LOADX(row_) do { const f32x4* p_ = (const f32x4*)(x + (size_t)(row_) * DMODEL) + lane; const u32x2* d_ = (const u32x2*)(DELTA + (size_t)(row_) * DMODEL) + lane; \
            _Pragma("unroll") for (int j_ = 0; j_ < 4; ++j_) { nv[0][j_] = __builtin_nontemporal_load(&p_[64 * j_]); nv[1][j_] = __builtin_nontemporal_load(&p_[256 + 64 * j_]); \
                nd[0][j_] = d_[64 * j_]; nd[1][j_] = d_[256 + 64 * j_]; } } while (0)
        P7_LOADX(gw * 2);
        for (int m = gw * 2; m < MT; m += NGW * 2) { const int b = m >> 13; const float* mb = MOD + b * 6144;
            f32x4 v[2][4], gnv[4], scv[4], shv[4]; float s0 = 0.f, s1 = 0.f;
            const int mn = (m + NGW * 2 < MT) ? m + NGW * 2 : m;
#pragma unroll
            for (int j = 0; j < 4; ++j) { const int col = 4 * lane + 256 * j;
#pragma unroll
                for (int r = 0; r < 2; ++r) { const u32x2 dd = nd[r][j]; v[r][j] = nv[r][j] + (f32x4){bf_lo(dd.x), bf_hi(dd.x), bf_lo(dd.y), bf_hi(dd.y)}; }
                gnv[j] = *(const f32x4*)(norm2_g + col); scv[j] = *(const f32x4*)(mb + 4096 + col); shv[j] = *(const f32x4*)(mb + 3072 + col); }
            P7_LOADX(mn);
            asm volatile("" ::: "memory");
#pragma unroll
            for (int j = 0; j < 4; ++j) {
                s0 += (v[0][j].x * v[0][j].x + v[0][j].y * v[0][j].y) + (v[0][j].z * v[0][j].z + v[0][j].w * v[0][j].w);
                s1 += (v[1][j].x * v[1][j].x + v[1][j].y * v[1][j].y) + (v[1][j].z * v[1][j].z + v[1][j].w * v[1][j].w); }
            s0 = wave_sum(s0); s1 = wave_sum(s1);
            const float rinv0 = __builtin_amdgcn_rsqf(s0 * (1.f / DMODEL) + EPS), rinv1 = __builtin_amdgcn_rsqf(s1 * (1.f / DMODEL) + EPS);
#pragma unroll
            for (int j = 0; j < 4; ++j) {
                const f32x4 a = gnv[j] * (scv[j] + 1.0f);
                v[0][j] = v[0][j] * rinv0 * a + shv[j]; v[1][j] = v[1][j] * rinv1 * a + shv[j];
                ((unsigned*)((unsigned char*)HB + (size_t)m * DMODEL) + lane)[64 * j] = pk4_fp8(v[0][j].x * F8_SC_H2, v[0][j].y * F8_SC_H2, v[0][j].z * F8_SC_H2, v[0][j].w * F8_SC_H2);
                ((unsigned*)((unsigned char*)HB + (size_t)(m + 1) * DMODEL) + lane)[64 * j] = pk4_fp8(v[1][j].x * F8_SC_H2, v[1][j].y * F8_SC_H2, v[1][j].z * F8_SC_H2, v[1][j].w * F8_SC_H2); }
            float pr[32];
#pragma unroll
            for (int e = 0; e < 16; ++e) { float a0 = 0.f, a1 = 0.f;
#pragma unroll
                for (int j = 0; j < 4; ++j) { const f32x4 w = *(const LAS f32x4*)(wr + e * 1024 + 4 * lane + 256 * j);
                    a0 += (v[0][j].x * w.x + v[0][j].y * w.y) + (v[0][j].z * w.z + v[0][j].w * w.w);
                    a1 += (v[1][j].x * w.x + v[1][j].y * w.y) + (v[1][j].z * w.z + v[1][j].w * w.w); }
                pr[e] = a0; pr[16 + e] = a1; if ((e & 3) == 3) asm volatile("" ::: "memory"); }
            float q16[16], q8[8];
#pragma unroll
            for (int i = 0; i < 16; ++i) q16[i] = swap32_sum(pr[i], pr[i + 16]);
#pragma unroll
            for (int i = 0; i < 8; ++i) q8[i] = swap16_sum(q16[i], q16[i + 8]);
            const bool up8 = (lane & 8) != 0, up4 = (lane & 4) != 0, up2 = (lane & 2) != 0;
            float q4[4], q2[2];
#pragma unroll
            for (int i = 0; i < 4; ++i) { float lo = q8[i], hi = q8[i + 4]; asm volatile("" : "+v"(lo), "+v"(hi)); q4[i] = (up8 ? hi : lo) + dppf<DPP_XOR8>(up8 ? lo : hi); }
#pragma unroll
            for (int i = 0; i < 2; ++i) { float lo = q4[i], hi = q4[i + 2]; asm volatile("" : "+v"(lo), "+v"(hi)); q2[i] = (up4 ? hi : lo) + lane_xor4(up4 ? lo : hi); }
            float mylog;
            { float lo = q2[0], hi = q2[1]; asm volatile("" : "+v"(lo), "+v"(hi)); mylog = (up2 ? hi : lo) + dppf<DPP_XOR2>(up2 ? lo : hi); }
            mylog += dppf<DPP_XOR1>(mylog);
            float mx = mylog;
            mx = fmaxf(mx, dppf<DPP_XOR2>(mx)); mx = fmaxf(mx, lane_xor4(mx)); mx = fmaxf(mx, dppf<DPP_XOR8>(mx)); mx = swap16_max(mx);
            const float ex = __expf(mylog - mx); float sum = ex;
            sum += dppf<DPP_XOR2>(sum); sum += lane_xor4(sum); sum += dppf<DPP_XOR8>(sum); sum = swap16_sum(sum, sum);
            if ((lane & 1) == 0) AFF[(unsigned)(m + (lane >> 5)) * 16u + (unsigned)((lane >> 1) & 15)] = ex * __builtin_amdgcn_rcpf(sum);
        }
#undef P7_LOADX
        __syncthreads();
    }
    SEAM(7);

    if (IN(8)) {
        PH_IDS();
        LAS unsigned* vals = (LAS unsigned*)(lds + RING_OFF);
        LAS unsigned* hist = (LAS unsigned*)(lds + RING_OFF + 32768);
        LAS unsigned* sel = (LAS unsigned*)(lds + RING_OFF + 32768 + 1024);
        LAS unsigned* wtot = (LAS unsigned*)(lds + RING_OFF + 32768 + 2048);
        for (int item = vcu; item < 64; item += G) { const int b = item >> 4, e = item & 15;
            __syncthreads();
            for (int k = 0; k < 16; ++k) { const int t = tid + 512 * k; vals[t] = __builtin_bit_cast(unsigned, AFF[((size_t)b * SEQ + t) * 16 + e]); }
            __syncthreads();
            unsigned mv[16];
#pragma unroll
            for (int k = 0; k < 16; ++k) mv[k] = vals[tid + 512 * k];
            unsigned T = 0u;
            for (int bit = 30; bit >= 0; --bit) { const unsigned cand = T | (1u << bit);
                unsigned c = 0u;
#pragma unroll
                for (int k = 0; k < 16; ++k) c += (unsigned)__popcll(__ballot(mv[k] >= cand));
                if (lane == 0) wtot[(bit & 1) * 8 + wave] = c;
                __syncthreads();
                unsigned tot = 0u;
#pragma unroll
                for (int w = 0; w < 8; ++w) tot += wtot[(bit & 1) * 8 + w];
                if (tot >= (unsigned)CAP) T = cand; }
            unsigned cgt = 0u;
#pragma unroll
            for (int k = 0; k < 16; ++k) cgt += (unsigned)__popcll(__ballot(mv[k] > T));
            __syncthreads();
            if (lane == 0) wtot[wave] = cgt;
            __syncthreads();
            unsigned ngt = 0u;
#pragma unroll
            for (int w = 0; w < 8; ++w) ngt += wtot[w];
            const unsigned need_eq = (unsigned)CAP - ngt;
            __syncthreads();
            unsigned cg = 0u, ce = 0u;
            for (int k = 0; k < 16; ++k) { const unsigned v = vals[16 * tid + k]; cg += (v > T) ? 1u : 0u; ce += (v == T) ? 1u : 0u; }
            unsigned packed = cg | (ce << 16), incl = packed;
#pragma unroll
            for (int o = 1; o < 64; o <<= 1) { const unsigned n = __shfl_up(incl, o); if (lane >= o) incl += n; }
            if (lane == 63) wtot[wave] = incl;
            __syncthreads();
            unsigned wbase = 0u;
            for (int w = 0; w < wave; ++w) wbase += wtot[w];
            const unsigned excl = wbase + incl - packed;
            unsigned g_before = excl & 0xffffu, e_before = excl >> 16;
            for (int k = 0; k < 16; ++k) { const int t = 16 * tid + k; const unsigned v = vals[t]; int slot = -1;
                if (v > T) { slot = (int)(g_before + (e_before < need_eq ? e_before : need_eq)); ++g_before; }
                else if (v == T) { if (e_before < need_eq) slot = (int)(g_before + e_before); ++e_before; }
                SLOT[((size_t)b * SEQ + t) * 16 + e] = slot;
                if (slot >= 0) { IDX[item * CAP + slot] = t; GSEL[item * CAP + slot] = __builtin_bit_cast(float, v); } }
        }
        __syncthreads();
    }
    SEAM(8);

    if (IN(9)) {
        pg8::SchedFfn1 S{G, vcu, (const char*)HB, (const char*)WGU, IDX, DMODEL, DMODEL};
        pg8::EpiFfn1 E{(unsigned char*)HMID};
        pg8::gemm_phase<true>(lds + RING_OFF, 8, S, E);
    }
    SEAM(9);

    if (IN(10)) {
        pg8::SchedFfn2 S{G, vcu, (const char*)HMID, (const char*)WD, FF, FF};
        pg8::EpiFfn2 E{(unsigned char*)YBUF, GSEL};
        pg8::gemm_phase<true>(lds + RING_OFF, 16, S, E);
    }
    SEAM(10);

    if (IN(11)) {
        PH_IDS();
        f32x4 fgv[4];
#pragma unroll
        for (int j = 0; j < 4; ++j) fgv[j] = *(const f32x4*)(final_g + 4 * lane + 256 * j);
        f32x4 nx[4]; u32x2 ndl[4]; int nsl;
#define P11_LOADX(row_) do { const f32x4* p_ = (const f32x4*)(x + (size_t)(row_) * DMODEL) + lane; const u32x2* d_ = (const u32x2*)(DELTA + (size_t)(row_) * DMODEL) + lane; \
            _Pragma("unroll") for (int j_ = 0; j_ < 4; ++j_) { nx[j_] = __builtin_nontemporal_load(&p_[64 * j_]); ndl[j_] = __builtin_nontemporal_load(&d_[64 * j_]); } \
            nsl = (lane < 16) ? SLOT[(size_t)(row_) * 16 + lane] : -1; } while (0)
#define P11_ISSUE() do { _Pragma("unroll") for (int k_ = 0; k_ < 4; ++k_) { if (mask) { const int e_ = __builtin_ctz(mask); mask &= mask - 1u; const int s_ = __builtin_amdgcn_readlane(sl, e_); \
                const unsigned* yr_ = (const unsigned*)((const unsigned char*)YBUF + ((size_t)(b * 16 + e_) * CAP + s_) * DMODEL) + lane; _Pragma("unroll") for (int j_ = 0; j_ < 4; ++j_) y[k_][j_] = __builtin_nontemporal_load(&yr_[64 * j_]); } \
            else { _Pragma("unroll") for (int j_ = 0; j_ < 4; ++j_) y[k_][j_] = 0u; } } } while (0)
#define P11_ACC() do { _Pragma("unroll") for (int k_ = 0; k_ < 4; ++k_) _Pragma("unroll") for (int j_ = 0; j_ < 4; ++j_) { const unsigned w_ = y[k_][j_]; \
            const auto lo_ = __builtin_amdgcn_cvt_pk_f32_fp8((int)w_, false), hi_ = __builtin_amdgcn_cvt_pk_f32_fp8((int)w_, true); a[j_].x += lo_[0]; a[j_].y += lo_[1]; a[j_].z += hi_[0]; a[j_].w += hi_[1]; } } while (0)
        P11_LOADX(gw);
        for (int m = gw; m < MT; m += NGW) { const int b = m >> 13; const float* g2 = MOD + b * 6144 + 5120;
            f32x4 v[4], a[4], g2v[4]; const int sl = nsl;
#pragma unroll
            for (int j = 0; j < 4; ++j) { const u32x2 dd = ndl[j]; v[j] = nx[j] + (f32x4){bf_lo(dd.x), bf_hi(dd.x), bf_lo(dd.y), bf_hi(dd.y)}; a[j] = (f32x4){0.f, 0.f, 0.f, 0.f}; g2v[j] = *(const f32x4*)(g2 + 4 * lane + 256 * j) * (1.0f / F8_SC_Y); }
            unsigned mask = (unsigned)__ballot(sl >= 0) & 0xFFFFu;
            const int mn = (m + NGW < MT) ? m + NGW : m;
            unsigned y[4][4];
            P11_ISSUE();
            P11_LOADX(mn);
            P11_ACC();
            while (mask) { P11_ISSUE(); P11_ACC(); }
            float s2 = 0.f;
#pragma unroll
            for (int j = 0; j < 4; ++j) { v[j] = v[j] + g2v[j] * a[j]; s2 += (v[j].x * v[j].x + v[j].y * v[j].y) + (v[j].z * v[j].z + v[j].w * v[j].w); }
            const float rinv = __builtin_amdgcn_rsqf(wave_sum(s2) * (1.f / DMODEL) + EPS);
            f32x4* xr = (f32x4*)(out + (size_t)m * DMODEL) + lane;
#pragma unroll
            for (int j = 0; j < 4; ++j) __builtin_nontemporal_store(v[j] * rinv * fgv[j], &xr[64 * j]);
        }
#undef P11_LOADX
#undef P11_ISSUE
#undef P11_ACC
    }
#undef IN
#undef SEAM
}

extern "C" void kernel_launch(void* const* d_in, const int* in_sizes, int n_in, void* d_out, int out_size, void* d_ws, size_t ws_size, hipStream_t stream) {
    static int grid = 0;
    if (grid == 0) {
        if (n_in != 18 || in_sizes[0] != MT * DMODEL || out_size != MT * DMODEL || ws_size < WS_END) {
            fprintf(stderr, "kernel_launch: unexpected shapes / workspace: n_in %d in0 %d out %d ws %zu (need %zu); nothing launched\n", n_in, n_in > 0 ? in_sizes[0] : -1, out_size, ws_size, (size_t)WS_END); grid = -1; return; }
        int dev = 0, cus = 0, per_cu = 0;
        if (hipGetDevice(&dev) != hipSuccess || hipDeviceGetAttribute(&cus, hipDeviceAttributeMultiprocessorCount, dev) != hipSuccess) { grid = -1; return; }
        if (hipFuncSetAttribute((const void*)mk_fwd, hipFuncAttributeMaxDynamicSharedMemorySize, LDS_BYTES) != hipSuccess) { fprintf(stderr, "kernel_launch: hipFuncSetAttribute failed\n"); grid = -1; return; }
        if (hipOccupancyMaxActiveBlocksPerMultiprocessor(&per_cu, (const void*)mk_fwd, 512, LDS_BYTES) != hipSuccess || per_cu < 1) fprintf(stderr, "kernel_launch: occupancy query reports %d\n", per_cu);
        (void)hipGetLastError();
        grid = cus;
        if (grid != 256) fprintf(stderr, "kernel_launch: %d CUs (expected 256)\n", grid);
    }
    if (grid < 0) return;
    if (hipMemsetAsync((char*)d_ws + WS_CTL, 0, CTL_ZERO_BYTES, stream) != hipSuccess) return;
    Args a{};
    for (int i = 0; i < 18; ++i) a.in[i] = (const float*)d_in[i];
    a.out = (float*)d_out; a.ws = (unsigned char*)d_ws;
#ifndef PROBE_DUP
#define PROBE_DUP -1
#endif
    constexpr int NL = (PROBE_DUP >= 0) ? 2 : MK_N_LAUNCHES;
    for (int li = 0; li < NL; ++li) {
        if (PROBE_DUP >= 0) { a.ph_lo = li == 0 ? 0 : PROBE_DUP; a.ph_hi = li == 0 ? PROBE_DUP + 1 : NPHASE; }
        else { a.ph_lo = (NL == NPHASE) ? li : (li * NPHASE) / NL; a.ph_hi = (NL == NPHASE) ? li + 1 : ((li + 1) * NPHASE) / NL; }
        a.li = li; a.pad = 0;
        hipLaunchKernelGGL(mk_fwd, dim3(grid), dim3(512), LDS_BYTES, stream, a);
        const hipError_t le = hipPeekAtLastError();
        if (le != hipSuccess) { fprintf(stderr, "kernel_launch: launch %d failed: %s\n", li, hipGetErrorName(le)); break; }
    }
}
```

```cpp
#include <hip/hip_runtime.h>
#include <hip/hip_bf16.h>
#include <cstdio>
#include <cstdint>

#ifndef MK_N_LAUNCHES
#define MK_N_LAUNCHES 1
#endif

#define LAS __attribute__((address_space(3)))
#define GAS __attribute__((address_space(1)))
typedef unsigned short bf16_t;
typedef short bf16x8 __attribute__((ext_vector_type(8)));
typedef short s16x4 __attribute__((ext_vector_type(4)));
typedef float f32x4 __attribute__((ext_vector_type(4)));
typedef float f32x2 __attribute__((ext_vector_type(2)));
typedef float f32x16 __attribute__((ext_vector_type(16)));
typedef unsigned u32x4 __attribute__((ext_vector_type(4)));
typedef unsigned u32x2 __attribute__((ext_vector_type(2)));
typedef int v8i __attribute__((ext_vector_type(8)));
typedef int v4i __attribute__((ext_vector_type(4)));

constexpr int BATCH = 4, SEQ = 8192, DMODEL = 1024, MT = BATCH * SEQ;
constexpr int NQKV = 2304, NGATE = 2048, NIN = 4352;
constexpr int C_QNA = 0, C_KNA = 512, C_VNA = 1024, C_QG = 1536, C_KG = 2048, C_VG = 2176;
constexpr int NEXP = 16, CAP = 1024, FF = 2048;
constexpr float EPS = 1e-6f;
constexpr float LOG2E = 1.4426950408889634f;
constexpr float C2 = 0.125f * LOG2E;

__device__ __forceinline__ unsigned f2bf(float f) { unsigned u = __builtin_bit_cast(unsigned, f); return (u + 0x7fffu + ((u >> 16) & 1u)) >> 16; }
__device__ __forceinline__ unsigned pk2(float lo, float hi) { return f2bf(lo) | (f2bf(hi) << 16); }
__device__ __forceinline__ float bf_lo(unsigned w) { return __builtin_bit_cast(float, w << 16); }
__device__ __forceinline__ float bf_hi(unsigned w) { return __builtin_bit_cast(float, w & 0xffff0000u); }
__device__ __forceinline__ unsigned cvt_pk_bf16(float lo, float hi) { unsigned r; asm volatile("v_cvt_pk_bf16_f32 %0, %1, %2" : "=v"(r) : "v"(lo), "v"(hi)); return r; }
__device__ __forceinline__ unsigned pk4_fp8(float a, float b, float c, float d) {
    a = __builtin_amdgcn_fmed3f(a, -448.f, 448.f); b = __builtin_amdgcn_fmed3f(b, -448.f, 448.f); c = __builtin_amdgcn_fmed3f(c, -448.f, 448.f); d = __builtin_amdgcn_fmed3f(d, -448.f, 448.f);
    int w = 0; w = __builtin_amdgcn_cvt_pk_fp8_f32(a, b, w, false); w = __builtin_amdgcn_cvt_pk_fp8_f32(c, d, w, true); return (unsigned)w; }
__device__ __forceinline__ unsigned pk4_fp8_nc(float a, float b, float c, float d) { int w = 0; w = __builtin_amdgcn_cvt_pk_fp8_f32(a, b, w, false); w = __builtin_amdgcn_cvt_pk_fp8_f32(c, d, w, true); return (unsigned)w; }
constexpr float F8_SC_H2 = 8.0f, F8_SC_W = 64.0f, F8_SC_HMID = 4.0f, F8_SC_GA = 256.0f, F8_SC_R = 2.0f, F8_SC_Y = 32.0f;
__device__ __forceinline__ float sigmoidf_fast(float v) { return __builtin_amdgcn_rcpf(1.0f + __builtin_amdgcn_exp2f(-v * LOG2E)); }
__device__ __forceinline__ int fresh_tid() { int t = threadIdx.x; asm volatile("" : "+v"(t)); return t; }
template <int CTRL> __device__ __forceinline__ float dppf(float x) { return __builtin_bit_cast(float, __builtin_amdgcn_mov_dpp(__builtin_bit_cast(int, x), CTRL, 0xf, 0xf, true)); }
constexpr int DPP_XOR1 = 0xB1, DPP_XOR2 = 0x4E, DPP_XOR3 = 0x1B, DPP_XOR7 = 0x141, DPP_XOR8 = 0x128;
__device__ __forceinline__ float lane_xor4(float x) { return dppf<DPP_XOR3>(dppf<DPP_XOR7>(x)); }
__device__ __forceinline__ float swap16_sum(float a, float b) { asm("s_nop 1\n\tv_permlane16_swap_b32 %0, %1" : "+v"(a), "+v"(b)); return a + b; }
__device__ __forceinline__ float swap32_sum(float a, float b) { asm("s_nop 1\n\tv_permlane32_swap_b32 %0, %1" : "+v"(a), "+v"(b)); return a + b; }
__device__ __forceinline__ float swap16_max(float a) { float b = a; asm("s_nop 1\n\tv_permlane16_swap_b32 %0, %1" : "+v"(a), "+v"(b)); return fmaxf(a, b); }
__device__ __forceinline__ float swap32_max(float a) { float b = a; asm("s_nop 1\n\tv_permlane32_swap_b32 %0, %1" : "+v"(a), "+v"(b)); return fmaxf(a, b); }
__device__ __forceinline__ float wave_sum(float v) {
    v += dppf<DPP_XOR1>(v); v += dppf<DPP_XOR2>(v); v += lane_xor4(v); v += dppf<DPP_XOR8>(v);
    v = swap16_sum(v, v); return swap32_sum(v, v);
}

__constant__ float INV_FREQ_D[16] = {1.0f, 0.5623413251903491f, 0.31622776601683794f, 0.1778279410038923f, 0.1f, 0.05623413251903491f, 0.03162277660168379f, 0.01778279410038923f,
                                     0.01f, 0.005623413251903491f, 0.0031622776601683794f, 0.001778279410038923f, 0.001f, 0.0005623413251903491f, 0.00031622776601683794f, 0.0001778279410038923f};
namespace pg8 {
constexpr int BM = 256, BK = 64, HALF = 128, HTB = HALF * BK * 2, STAGE_BYTES = 8 * HTB, NXCD = 8, WGM = 8;
__host__ __device__ __forceinline__ int lds_byte(int r, int c) { const int st = (r >> 4) * 2 + (c >> 5), rr = r & 15, cc = c & 31, ob = rr * 64 + cc * 2; return st * 1024 + (ob ^ (((ob >> 9) & 1) << 5)); }
__host__ __device__ __forceinline__ void stage_rc(int b, int& R, int& C) { const int st = b / 1024, sb = b % 1024, swz = sb ^ (((sb >> 9) & 1) << 5); R = (st >> 1) * 16 + swz / 64; C = (st & 1) * 32 + (swz % 64) / 2; }
__host__ __device__ __forceinline__ int perm32(int rho) { const int n = rho >> 4, i = rho & 15; return 8 * (i >> 2) + 4 * n + (i & 3); }

struct Unit { int pm, pn, g; };

struct SchedPlain {
    int nM, nN, nwg, G, c; const char* A; const char* B; unsigned lda, ldb;
    static constexpr bool GATHER = false;
    __device__ void init(int M, int N, int G_, int c_, const void* A_, unsigned lda_, const void* B_, unsigned ldb_) { nM = M / BM; nN = N / BM; nwg = nM * nN; G = G_; c = c_; A = (const char*)A_; B = (const char*)B_; lda = lda_; ldb = ldb_; }
    __device__ bool next(int i, Unit& u) const {
        const long L = (long)i * G + c; if (L >= nwg) return false;
        int wgid = (int)L; { const int q = nwg / NXCD, r = nwg % NXCD, xcd = wgid % NXCD, off = wgid / NXCD; wgid = (xcd < r ? xcd * (q + 1) : r * (q + 1) + (xcd - r) * q) + off; }
        const int nig = WGM * nN, gid = wgid / nig, fm = gid * WGM, gsz = (nM - fm) < WGM ? (nM - fm) : WGM;
        u.pm = fm + ((wgid % nig) % gsz); u.pn = (wgid % nig) / gsz; u.g = 0; return true;
    }
    __device__ __forceinline__ const char* a_ptr(const Unit& u) const { return A + (size_t)u.pm * BM * lda; }
    __device__ __forceinline__ const char* b_ptr(const Unit& u) const { return B + (size_t)u.pn * BM * ldb; }
    __device__ __forceinline__ const int* rows(const Unit&) const { return nullptr; }
    const char* A2 = nullptr; const char* B2 = nullptr; int nt1 = 0;
    __device__ __forceinline__ const char* a_ptr2(const Unit& u) const { return A2 + (size_t)u.pm * BM * lda; }
    __device__ __forceinline__ const char* b_ptr2(const Unit& u) const { return B2 + (size_t)u.pn * BM * ldb; }
};
struct SchedGate {
    int G, c; const char* A; const char* B; unsigned lda, ldb;
    static constexpr bool GATHER = false;
    __device__ bool next(int i, Unit& u) const {
        int id;
        if (G == 256) { if (c < 128) { if (i >= 3) return false; id = c * 3 + i; } else { if (i >= 5) return false; id = 384 + (c - 128) * 5 + i; } }
        else { const long L = (long)i * G + c; if (L >= 1024) return false; id = (int)L; }
        u.pm = id >> 3; u.pn = id & 7; u.g = 0; return true;
    }
    __device__ __forceinline__ const char* a_ptr(const Unit& u) const { return A + (size_t)u.pm * BM * lda; }
    __device__ __forceinline__ const char* b_ptr(const Unit& u) const { return B + (size_t)u.pn * BM * ldb; }
    __device__ __forceinline__ const int* rows(const Unit&) const { return nullptr; }
};
struct SchedFfn1 {
    int G, vcu; const char* A; const char* B; const int* idx; unsigned lda, ldb;
    static constexpr bool GATHER = true;
    __device__ bool next(int i, Unit& u) const {
        const long L = (long)i * G + vcu; if (L >= 4096) return false;
        const int ii = (int)(L >> 8), v = (int)(L & 255), x = v >> 5, c = v & 31;
        const int e = 2 * x + (ii >> 3), b = (ii & 7) >> 1, half = ii & 1;
        u.g = b * 16 + e; u.pm = c & 3; u.pn = half * 8 + (c >> 2); return true;
    }
    __device__ __forceinline__ const char* a_ptr(const Unit& u) const { return A + (size_t)(u.g >> 4) * SEQ * lda; }
    __device__ __forceinline__ const char* b_ptr(const Unit& u) const { return B + ((size_t)(u.g & 15) * 4096 + (size_t)u.pn * BM) * ldb; }
    __device__ __forceinline__ const int* rows(const Unit& u) const { return idx + u.g * CAP + u.pm * BM; }
};
struct SchedFfn2 {
    int G, vcu; const char* A; const char* B; unsigned lda, ldb;
    static constexpr bool GATHER = false;
    __device__ bool next(int i, Unit& u) const {
        const long L = (long)i * G + vcu; if (L >= 1024) return false;
        const int ii = (int)(L >> 8), v = (int)(L & 255), x = v >> 5, c = v & 31;
        const int e = 2 * x + (ii >> 1), b = 2 * (ii & 1) + (c >> 4);
        u.g = b * 16 + e; u.pm = (c & 15) >> 2; u.pn = c & 3; return true;
    }
    __device__ __forceinline__ const char* a_ptr(const Unit& u) const { return A + ((size_t)u.g * CAP + (size_t)u.pm * BM) * lda; }
    __device__ __forceinline__ const char* b_ptr(const Unit& u) const { return B + ((size_t)(u.g & 15) * 1024 + (size_t)u.pn * BM) * ldb; }
    __device__ __forceinline__ const int* rows(const Unit&) const { return nullptr; }
};

typedef f32x4 Acc[2][2][4][2];

struct EpiProj {
    static constexpr bool PERM = true;
    bf16_t* QKV; unsigned char* Q8; unsigned char* K8; unsigned char* V8T; const float* qg; const float* kg; bool gqa_bf16;
    __device__ __forceinline__ void operator()(const Acc& acc, const Unit& u, int wr, int wc, int fr_, int fq_) const { run<false>(acc, u, wr, wc, fr_, fq_); }
    template <bool ASC8> __device__ __forceinline__ void run(const Acc& acc, const Unit& u, int wr, int wc, int fr_, int fq_) const {
        constexpr float asc = ASC8 ? 1.0f / (F8_SC_H2 * F8_SC_W) : 1.0f;
        int fr = fr_, fq = fq_; asm volatile("" : "+v"(fr), "+v"(fq));
        const int row0 = u.pm * BM + wr * 64 + fr;
        if (u.pn < 6) {
            const int col0 = u.pn * BM + wc * 32 + 8 * fq;
            const float sc = ((u.pn < 2) ? 0.125f : 1.0f) * asc;
#pragma unroll
            for (int ai = 0; ai < 2; ++ai)
#pragma unroll
                for (int m = 0; m < 4; ++m) { bf16_t* rowp = QKV + (size_t)(row0 + ai * HALF + m * 16) * NQKV + col0;
#pragma unroll
                    for (int bj = 0; bj < 2; ++bj) { const f32x4 v0 = acc[ai][bj][m][0] * sc, v1 = acc[ai][bj][m][1] * sc;
                        u32x4 w; w.x = cvt_pk_bf16(v0[0], v0[1]); w.y = cvt_pk_bf16(v0[2], v0[3]); w.z = cvt_pk_bf16(v1[0], v1[1]); w.w = cvt_pk_bf16(v1[2], v1[3]);
                        *(u32x4*)(rowp + bj * HALF) = w; } }
            return;
        }
        const int colb = u.pn * BM + wc * 64 + 8 * fq;
        const bool isv = (u.pn == 8) && (wc >= 2), isq = u.pn < 8;
        if (isv) {
            const int kvh = wc - 2;
#pragma unroll
            for (int ai = 0; ai < 2; ++ai)
#pragma unroll
                for (int m = 0; m < 4; ++m) { const int tok = row0 + ai * HALF + m * 16; bf16_t* rowp = QKV + (size_t)tok * NQKV + colb;
                    const int b = tok >> 13, t = tok & (SEQ - 1), kap = t & 63;
                    const int pos = 32 * ((kap >> 2) & 1) + 16 * (kap >> 5) + (kap & 3) + 4 * ((kap & 31) >> 3);
                    unsigned char* vt = V8T + ((size_t)(b * 2 + kvh) * SEQ + (size_t)(t & ~63)) * 64 + (8 * fq) * 64 + pos;
#pragma unroll
                    for (int bj = 0; bj < 2; ++bj) { const f32x4 v0 = acc[ai][bj][m][0] * asc, v1 = acc[ai][bj][m][1] * asc;
                        if (gqa_bf16) { u32x4 w; w.x = cvt_pk_bf16(v0[0], v0[1]); w.y = cvt_pk_bf16(v0[2], v0[3]); w.z = cvt_pk_bf16(v1[0], v1[1]); w.w = cvt_pk_bf16(v1[2], v1[3]);
                            *(u32x4*)(rowp + bj * 32) = w; }
                        const unsigned p0 = pk4_fp8(v0[0] * 8.f, v0[1] * 8.f, v0[2] * 8.f, v0[3] * 8.f), p1 = pk4_fp8(v1[0] * 8.f, v1[1] * 8.f, v1[2] * 8.f, v1[3] * 8.f);
#pragma unroll
                        for (int i = 0; i < 4; ++i) { vt[(32 * bj + i) * 64] = (unsigned char)(p0 >> (8 * i)); vt[(32 * bj + 4 + i) * 64] = (unsigned char)(p1 >> (8 * i)); } } }
            return;
        }
        const float* gp = (isq ? qg : kg) + 8 * fq;
        float frq[2][2];
#pragma unroll
        for (int n = 0; n < 2; ++n)
#pragma unroll
            for (int k = 0; k < 2; ++k) frq[n][k] = INV_FREQ_D[4 * fq + 2 * n + k] * 0.15915494309189535f;
        const float osc = isq ? C2 : 1.0f, f8s = isq ? 32.0f : 8.0f;
        const int head = isq ? (u.pn - 6) * 4 + wc : wc;
#pragma unroll
        for (int ai = 0; ai < 2; ++ai)
#pragma unroll
            for (int m = 0; m < 4; ++m) { const int tok = row0 + ai * HALF + m * 16; const int t = tok & (SEQ - 1);
                float ss = 0.f;
#pragma unroll
                for (int bj = 0; bj < 2; ++bj)
#pragma unroll
                    for (int n = 0; n < 2; ++n) { const f32x4 v = acc[ai][bj][m][n]; ss += (v[0] * v[0] + v[1] * v[1]) + (v[2] * v[2] + v[3] * v[3]); }
                ss += __shfl_xor(ss, 16); ss += __shfl_xor(ss, 32);
                const float rinv = asc * __builtin_amdgcn_rsqf(ss * (asc * asc / 64.f) + EPS);
                bf16_t* rowp = QKV + ((unsigned)tok * (unsigned)NQKV + (unsigned)colb);
#pragma unroll
                for (int bj = 0; bj < 2; ++bj) { const float pos = (float)(bj == 0 ? (t >> 6) : (t & 63));
                    f32x4 gn[2][2]; gn[bj][0] = *(const f32x4*)(gp + 32 * bj); gn[bj][1] = *(const f32x4*)(gp + 32 * bj + 4);
                    float ov[8];
#pragma unroll
                    for (int n = 0; n < 2; ++n)
#pragma unroll
                        for (int k = 0; k < 2; ++k) { float rev = pos * frq[n][k]; rev = rev - floorf(rev);
                            const float sn = __builtin_amdgcn_sinf(rev), cs = __builtin_amdgcn_cosf(rev);
                            const float y0 = acc[ai][bj][m][n][2 * k] * rinv * gn[bj][n][2 * k], y1 = acc[ai][bj][m][n][2 * k + 1] * rinv * gn[bj][n][2 * k + 1];
                            ov[4 * n + 2 * k] = (y0 * cs - y1 * sn) * osc; ov[4 * n + 2 * k + 1] = (y0 * sn + y1 * cs) * osc; }
                    if (gqa_bf16) { u32x4 w; w.x = cvt_pk_bf16(ov[0], ov[1]); w.y = cvt_pk_bf16(ov[2], ov[3]); w.z = cvt_pk_bf16(ov[4], ov[5]); w.w = cvt_pk_bf16(ov[6], ov[7]);
                        *(u32x4*)(rowp + bj * 32) = w; }
                    u32x2 f8; f8.x = pk4_fp8(ov[0] * f8s, ov[1] * f8s, ov[2] * f8s, ov[3] * f8s); f8.y = pk4_fp8(ov[4] * f8s, ov[5] * f8s, ov[6] * f8s, ov[7] * f8s);
                    if (isq) *(u32x2*)(Q8 + ((unsigned)tok * 512u + (unsigned)(head * 64 + 32 * bj + 8 * fq))) = f8;
                    else     *(u32x2*)(K8 + ((unsigned)tok * 128u + (unsigned)(head * 64 + 32 * bj + 8 * fq))) = f8; }
                __builtin_amdgcn_sched_barrier(0); }
    }
};
struct EpiGate {
    static constexpr bool PERM = true;
    bf16_t* GA; unsigned char* R8;
    __device__ __forceinline__ void operator()(const Acc& acc, const Unit& u, int wr, int wc, int fr, int fq) const {
        const size_t row0 = (size_t)u.pm * BM + wr * 64 + fr; const int col0 = u.pn * HALF + wc * 32 + 8 * fq;
        constexpr float inv = -LOG2E / (F8_SC_H2 * F8_SC_W);
#pragma unroll
        for (int ai = 0; ai < 2; ++ai)
#pragma unroll
            for (int m = 0; m < 4; ++m) { const size_t off = (row0 + ai * HALF + m * 16) * DMODEL + col0;
                float ga[8], rr[8];
#pragma unroll
                for (int n = 0; n < 2; ++n)
#pragma unroll
                    for (int i = 0; i < 4; ++i) { const float ea = 1.0f + __builtin_amdgcn_exp2f(acc[ai][0][m][n][i] * inv), eb = 1.0f + __builtin_amdgcn_exp2f(acc[ai][1][m][n][i] * inv);
                        ga[n * 4 + i] = __builtin_amdgcn_rcpf(ea); rr[n * 4 + i] = ea * __builtin_amdgcn_rcpf(eb) * F8_SC_R; }
                u32x4 w; w.x = cvt_pk_bf16(ga[0], ga[1]); w.y = cvt_pk_bf16(ga[2], ga[3]); w.z = cvt_pk_bf16(ga[4], ga[5]); w.w = cvt_pk_bf16(ga[6], ga[7]); *(u32x4*)(GA + off) = w;
                u32x2 q; q.x = pk4_fp8(rr[0], rr[1], rr[2], rr[3]); q.y = pk4_fp8(rr[4], rr[5], rr[6], rr[7]); *(u32x2*)(R8 + off) = q; }
    }
};
struct EpiHeadGate {
    static constexpr bool PERM = true;
    EpiProj P; EpiGate Gt;
    __device__ __forceinline__ void operator()(const Acc& acc, const Unit& u, int wr, int wc, int fr, int fq) const {
        Unit v = u;
        if (u.pn < 9) { P.run<true>(acc, v, wr, wc, fr, fq); }
        else { v.pn = u.pn - 9; Gt(acc, v, wr, wc, fr, fq); }
    }
};
struct EpiMerge {
    static constexpr bool PERM = true;
    bf16_t* MERGED; const bf16_t* GA; const unsigned char* R8;
    __device__ __forceinline__ void mid(Acc& acc, const Unit& u, int wr, int wc, int fr, int fq) const {
        const int row0 = u.pm * BM + wr * 64 + fr, col0 = u.pn * BM + wc * 32 + 8 * fq;
#pragma unroll
        for (int ai = 0; ai < 2; ++ai)
#pragma unroll
            for (int m = 0; m < 4; ++m) { const size_t r = (size_t)(row0 + ai * HALF + m * 16);
#pragma unroll
                for (int bj = 0; bj < 2; ++bj) { const u32x2 q = *(const u32x2*)(R8 + r * DMODEL + col0 + bj * HALF);
                    const auto a = __builtin_amdgcn_cvt_pk_f32_fp8((int)q.x, false), b = __builtin_amdgcn_cvt_pk_f32_fp8((int)q.x, true), c = __builtin_amdgcn_cvt_pk_f32_fp8((int)q.y, false), d = __builtin_amdgcn_cvt_pk_f32_fp8((int)q.y, true);
                    constexpr float k = 1.0f / F8_SC_R;
                    acc[ai][bj][m][0][0] *= a[0] * k; acc[ai][bj][m][0][1] *= a[1] * k; acc[ai][bj][m][0][2] *= b[0] * k; acc[ai][bj][m][0][3] *= b[1] * k;
                    acc[ai][bj][m][1][0] *= c[0] * k; acc[ai][bj][m][1][1] *= c[1] * k; acc[ai][bj][m][1][2] *= d[0] * k; acc[ai][bj][m][1][3] *= d[1] * k; } }
    }
    __device__ __forceinline__ void operator()(const Acc& acc, const Unit& u, int wr, int wc, int fr, int fq) const {
        const int row0 = u.pm * BM + wr * 64 + fr, col0 = u.pn * BM + wc * 32 + 8 * fq;
        u32x4 gq[2][4][2];
#pragma unroll
        for (int ai = 0; ai < 2; ++ai)
#pragma unroll
            for (int m = 0; m < 4; ++m)
#pragma unroll
                for (int bj = 0; bj < 2; ++bj) gq[ai][m][bj] = *(const u32x4*)(GA + (size_t)(row0 + ai * HALF + m * 16) * DMODEL + col0 + bj * HALF);
        asm volatile("" ::: "memory");
#pragma unroll
        for (int ai = 0; ai < 2; ++ai)
#pragma unroll
            for (int m = 0; m < 4; ++m) { const size_t r = (size_t)(row0 + ai * HALF + m * 16);
#pragma unroll
                for (int bj = 0; bj < 2; ++bj) { const u32x4 g = gq[ai][m][bj];
                    const f32x4 v0 = acc[ai][bj][m][0], v1 = acc[ai][bj][m][1];
                    u32x4 w; w.x = cvt_pk_bf16(bf_lo(g.x) * v0[0], bf_hi(g.x) * v0[1]); w.y = cvt_pk_bf16(bf_lo(g.y) * v0[2], bf_hi(g.y) * v0[3]);
                    w.z = cvt_pk_bf16(bf_lo(g.z) * v1[0], bf_hi(g.z) * v1[1]); w.w = cvt_pk_bf16(bf_lo(g.w) * v1[2], bf_hi(g.w) * v1[3]);
                    *(u32x4*)(MERGED + r * DMODEL + col0 + bj * HALF) = w; } }
    }
};
struct EpiOut {
    static constexpr bool PERM = false;
    const float* x; float* out; const float* mod;
    __device__ __forceinline__ void operator()(const Acc& acc, const Unit& u, int wr, int wc, int fr, int fq) const {
        const int row0 = u.pm * BM + wr * 64 + fr, col0 = u.pn * BM + wc * 32 + 4 * fq;
        const float* g1 = mod + (size_t)(u.pm >> 5) * 6144 + 2048;
        f32x4 gv[2][2];
#pragma unroll
        for (int bj = 0; bj < 2; ++bj)
#pragma unroll
            for (int n = 0; n < 2; ++n) gv[bj][n] = *(const f32x4*)(g1 + col0 + bj * HALF + n * 16);
#pragma unroll
        for (int ai = 0; ai < 2; ++ai)
#pragma unroll
            for (int m = 0; m < 4; ++m) { const size_t off = (size_t)(row0 + ai * HALF + m * 16) * DMODEL + col0;
#pragma unroll
                for (int bj = 0; bj < 2; ++bj)
#pragma unroll
                    for (int n = 0; n < 2; ++n) { const f32x4 xv = __builtin_nontemporal_load((const f32x4*)(x + off + bj * HALF + n * 16)); *(f32x4*)(out + off + bj * HALF + n * 16) = xv + gv[bj][n] * acc[ai][bj][m][n]; } }
    }
};
struct EpiDelta {
    static constexpr bool PERM = true;
    bf16_t* DELTA; const float* mod;
    __device__ __forceinline__ void operator()(const Acc& acc, const Unit& u, int wr, int wc, int fr, int fq) const {
        const unsigned row0 = u.pm * BM + wr * 64 + fr, col0 = u.pn * BM + wc * 32 + 8 * fq;
        const float* g1 = mod + (size_t)(u.pm >> 5) * 6144 + 2048 + col0;
        f32x4 gv[2][2];
#pragma unroll
        for (int bj = 0; bj < 2; ++bj)
#pragma unroll
            for (int n = 0; n < 2; ++n) gv[bj][n] = *(const f32x4*)(g1 + bj * HALF + n * 4);
#pragma unroll
        for (int ai = 0; ai < 2; ++ai)
#pragma unroll
            for (int m = 0; m < 4; ++m) { bf16_t* rowp = DELTA + ((row0 + ai * HALF + m * 16) * (unsigned)DMODEL + col0);
#pragma unroll
                for (int bj = 0; bj < 2; ++bj) { const f32x4 v0 = acc[ai][bj][m][0] * gv[bj][0], v1 = acc[ai][bj][m][1] * gv[bj][1];
                    u32x4 w; w.x = cvt_pk_bf16(v0[0], v0[1]); w.y = cvt_pk_bf16(v0[2], v0[3]); w.z = cvt_pk_bf16(v1[0], v1[1]); w.w = cvt_pk_bf16(v1[2], v1[3]);
                    *(u32x4*)(rowp + bj * HALF) = w; } }
    }
};
struct EpiFfn1 {
    static constexpr bool PERM = true;
    unsigned char* HMID;
    __device__ __forceinline__ void operator()(const Acc& acc, const Unit& u, int wr, int wc, int fr, int fq) const {
        const size_t row0 = (size_t)u.g * CAP + u.pm * BM + wr * 64 + fr; const int col0 = u.pn * HALF + wc * 32 + 8 * fq;
        constexpr float inv = 1.0f / (F8_SC_H2 * F8_SC_W);
        constexpr float RC = 1.0f / (inv * inv * F8_SC_HMID);
        static_assert(RC == 65536.0f, "LOG2_RC below assumes 2^16");
        constexpr float LOG2_RC = 16.0f;
#pragma unroll
        for (int ai = 0; ai < 2; ++ai)
#pragma unroll
            for (int m = 0; m < 4; ++m) { unsigned char* rowp = HMID + (row0 + ai * HALF + m * 16) * FF + col0;
                float o[8];
#pragma unroll
                for (int n = 0; n < 2; ++n)
#pragma unroll
                    for (int i = 0; i < 4; i += 2) {
                        const f32x2 ag = {acc[ai][0][m][n][i], acc[ai][0][m][n][i + 1]}, au = {acc[ai][1][m][n][i], acc[ai][1][m][n][i + 1]};
                        const f32x2 e = ag * (-inv * LOG2E) + LOG2_RC;
                        f32x2 t; t.x = __builtin_amdgcn_exp2f(e.x); t.y = __builtin_amdgcn_exp2f(e.y);
                        t = t + RC;
                        f32x2 r; r.x = __builtin_amdgcn_rcpf(t.x); r.y = __builtin_amdgcn_rcpf(t.y);
                        const f32x2 q = (ag * au) * r;
                        o[n * 4 + i] = q.x; o[n * 4 + i + 1] = q.y; }
                u32x2 w; w.x = pk4_fp8(o[0], o[1], o[2], o[3]); w.y = pk4_fp8(o[4], o[5], o[6], o[7]);
                *(u32x2*)rowp = w; }
    }
};
struct EpiFfn2 {
    static constexpr bool PERM = true;
    unsigned char* YB8; const float* gsel;
    __device__ __forceinline__ void operator()(const Acc& acc, const Unit& u, int wr, int wc, int fr, int fq) const {
        const unsigned row0 = (unsigned)u.g * CAP + u.pm * BM + wr * 64 + fr; const unsigned col0 = u.pn * BM + wc * 32 + 8 * fq;
        float gsv[2][4];
#pragma unroll
        for (int ai = 0; ai < 2; ++ai)
#pragma unroll
            for (int m = 0; m < 4; ++m) gsv[ai][m] = gsel[row0 + ai * HALF + m * 16];
        asm volatile("" ::: "memory");
#pragma unroll
        for (int ai = 0; ai < 2; ++ai)
#pragma unroll
            for (int m = 0; m < 4; ++m) { const unsigned r = row0 + ai * HALF + m * 16; const float gs = gsv[ai][m] * (F8_SC_Y / (F8_SC_HMID * F8_SC_W)); unsigned char* rowp = YB8 + (r * (unsigned)DMODEL + col0);
#pragma unroll
                for (int bj = 0; bj < 2; ++bj) { const f32x4 v0 = acc[ai][bj][m][0] * gs, v1 = acc[ai][bj][m][1] * gs;
                    u32x2 w; w.x = pk4_fp8(v0[0], v0[1], v0[2], v0[3]); w.y = pk4_fp8(v1[0], v1[1], v1[2], v1[3]);
                    *(u32x2*)(rowp + bj * HALF) = w; } }
    }
};

template <bool F8> __device__ __forceinline__ f32x4 mma_step(bf16x8 b0, bf16x8 b1, bf16x8 a0, bf16x8 a1, f32x4 c) {
    if constexpr (F8) {
        const v8i b = __builtin_shufflevector(__builtin_bit_cast(v4i, b0), __builtin_bit_cast(v4i, b1), 0, 1, 2, 3, 4, 5, 6, 7);
        const v8i a = __builtin_shufflevector(__builtin_bit_cast(v4i, a0), __builtin_bit_cast(v4i, a1), 0, 1, 2, 3, 4, 5, 6, 7);
        asm volatile("v_mfma_f32_16x16x128_f8f6f4 %0, %1, %2, %0" : "+v"(c) : "v"(b), "v"(a));
        return c;
    } else {
        c = __builtin_amdgcn_mfma_f32_16x16x32_bf16(b0, a0, c, 0, 0, 0);
        return __builtin_amdgcn_mfma_f32_16x16x32_bf16(b1, a1, c, 0, 0, 0);
    }
}
__device__ __forceinline__ const char* uni_ptr(const char* p) {
    const unsigned long long v = (unsigned long long)p; const unsigned lo = __builtin_amdgcn_readfirstlane((unsigned)v), hi = __builtin_amdgcn_readfirstlane((unsigned)(v >> 32));
    return (const char*)(((unsigned long long)hi << 32) | lo); }
template <bool F8, class Epi, class Sched, bool SEG2 = false>
__device__ __forceinline__ void gemm_phase(LAS unsigned char* lds, const int nt, const Sched& S, const Epi& E) {
    const int tid = fresh_tid(), wid = __builtin_amdgcn_readfirstlane(tid >> 6), lane = tid & 63, wr = wid >> 2, wc = wid & 3, fr = lane & 15, fq = lane >> 4;
    constexpr bool GA = Sched::GATHER;
    int Rr[2], Cc[2];
#pragma unroll
    for (int i = 0; i < 2; ++i) stage_rc(tid * 16 + i * 8192, Rr[i], Cc[i]);
    unsigned voffB[2];
#pragma unroll
    for (int i = 0; i < 2; ++i) { const int Rb = Epi::PERM ? ((Rr[i] & ~31) + perm32(Rr[i] & 31)) : Rr[i]; voffB[i] = (unsigned)Rb * S.ldb + (unsigned)Cc[i] * 2u; }
    const size_t kstep = (size_t)(BK * 2);
    const size_t hstepB = (size_t)HALF * S.ldb;
    const size_t hstepA = GA ? (size_t)0 : (size_t)HALF * S.lda;
    const unsigned ldsw = (unsigned)wid * 1024u;
    const int aoff = lds_byte(wr * 64 + fr, fq * 8), boff = lds_byte(wc * 32 + fr, fq * 8);
#define PG8_SA(b, h) (((b) * 2 + (h)) * HTB)
#define PG8_SB(b, h) ((4 + (b) * 2 + (h)) * HTB)
#define PG8_STAGE(bufoff, gbase, voff) do { _Pragma("unroll") for (int _i = 0; _i < 2; ++_i) \
        __builtin_amdgcn_global_load_lds((GAS const unsigned*)((GAS const char*)(gbase) + (voff)[_i]), (LAS unsigned*)(lds + (bufoff) + ldsw + _i * 8192), 16, 0, 0); } while (0)
#define PG8_LDA(dst, b, h) do { _Pragma("unroll") for (int m = 0; m < 4; ++m) _Pragma("unroll") for (int k = 0; k < 2; ++k) dst[m][k] = *(const LAS bf16x8*)(lds + PG8_SA(b, h) + aoff + m * 2048 + k * 1024); } while (0)
#define PG8_LDB(dst, b, h) do { _Pragma("unroll") for (int n = 0; n < 2; ++n) _Pragma("unroll") for (int k = 0; k < 2; ++k) dst[n][k] = *(const LAS bf16x8*)(lds + PG8_SB(b, h) + boff + n * 2048 + k * 1024); } while (0)
#define PG8_MMA(ai, bj, At, Bt) do { __builtin_amdgcn_s_setprio(1); _Pragma("unroll") for (int m = 0; m < 4; ++m) _Pragma("unroll") for (int n = 0; n < 2; ++n) \
        acc[ai][bj][m][n] = mma_step<F8>(Bt[n][0], Bt[n][1], At[m][0], At[m][1], acc[ai][bj][m][n]); __builtin_amdgcn_s_setprio(0); } while (0)
#define PG8_WAIT_V(n) asm volatile("s_waitcnt vmcnt(" #n ")" ::: "memory")
#define PG8_WAIT_L(n) asm volatile("s_waitcnt lgkmcnt(" #n ")" ::: "memory")
#define PG8_BAR __builtin_amdgcn_s_barrier()
#define PG8_SCHED __builtin_amdgcn_sched_barrier(0)
#define PG8_ROWOFFS(dst, u_) do { if constexpr (GA) { const int* _rw = S.rows(u_); _Pragma("unroll") for (int _h = 0; _h < 2; ++_h) _Pragma("unroll") for (int _i = 0; _i < 2; ++_i) \
        dst[_h][_i] = (unsigned)_rw[_h * HALF + Rr[_i]] * S.lda + (unsigned)Cc[_i] * 2u; } } while (0)
    Unit cur, nxt; int ui = 0;
    if (!S.next(0, cur)) return;
    f32x4 acc[2][2][4][2];
#pragma unroll
    for (int a = 0; a < 2; ++a)
#pragma unroll
        for (int b = 0; b < 2; ++b)
#pragma unroll
            for (int m = 0; m < 4; ++m)
#pragma unroll
                for (int n = 0; n < 2; ++n) acc[a][b][m][n] = (f32x4){0.f, 0.f, 0.f, 0.f};
    bf16x8 At[4][2], B0[2][2], B1[2][2];
    unsigned voffP[2];
#pragma unroll
    for (int i = 0; i < 2; ++i) voffP[i] = (unsigned)Rr[i] * S.lda + (unsigned)Cc[i] * 2u;
    unsigned voffA[2][2], voffAn[2][2];
    PG8_ROWOFFS(voffA, cur);
#define PG8_VA(h) (GA ? voffA[h] : voffP)
#define PG8_VA2(h) (GA ? va2[h] : voffP)
    const char* cA = uni_ptr(S.a_ptr(cur)); const char* cB = uni_ptr(S.b_ptr(cur));
    const char* cA2 = cA; const char* cB2 = cB; int nt1 = nt;
    if constexpr (SEG2) { cA2 = uni_ptr(S.a_ptr2(cur)); cB2 = uni_ptr(S.b_ptr2(cur)); nt1 = S.nt1; }
#define PG8_KA(tau) ((!SEG2 || (tau) < nt1) ? cA + (size_t)(tau) * kstep : cA2 + (size_t)((tau) - nt1) * kstep)
#define PG8_KB(tau) ((!SEG2 || (tau) < nt1) ? cB + (size_t)(tau) * kstep : cB2 + (size_t)((tau) - nt1) * kstep)
    PG8_STAGE(PG8_SB(0, 0), cB, voffB); PG8_STAGE(PG8_SB(0, 1), cB + hstepB, voffB); PG8_STAGE(PG8_SA(0, 0), cA, PG8_VA(0)); PG8_STAGE(PG8_SA(0, 1), cA + hstepA, PG8_VA(1));
    if (wr == 1) PG8_BAR;
    PG8_WAIT_V(2); PG8_BAR;
    PG8_STAGE(PG8_SB(1, 0), cB + kstep, voffB); PG8_STAGE(PG8_SA(1, 0), cA + kstep, PG8_VA(0)); PG8_STAGE(PG8_SB(1, 1), cB + hstepB + kstep, voffB);
    PG8_WAIT_V(6); PG8_BAR;
    for (;;) {
        const bool has_next = S.next(ui + 1, nxt);
        const char* nA = has_next ? uni_ptr(S.a_ptr(nxt)) : cA; const char* nB = has_next ? uni_ptr(S.b_ptr(nxt)) : cB;
        if constexpr (GA) {
            if (has_next) { PG8_ROWOFFS(voffAn, nxt); } else {
#pragma unroll
                for (int h = 0; h < 2; ++h)
#pragma unroll
                    for (int i = 0; i < 2; ++i) voffAn[h][i] = voffA[h][i]; } }
        for (int t = 0; t < nt; t += 2) {
            const bool last = (t == nt - 2);
            const char* a1 = PG8_KA(t + 1);
            const char* a2 = last ? nA : PG8_KA(t + 2); const char* b2 = last ? nB : PG8_KB(t + 2);
            const char* a3 = a2 + kstep; const char* b3 = b2 + kstep;
            unsigned va2[2][2];
            if constexpr (GA) {
#pragma unroll
                for (int h = 0; h < 2; ++h)
#pragma unroll
                    for (int i = 0; i < 2; ++i) va2[h][i] = last ? voffAn[h][i] : voffA[h][i]; }
            PG8_LDB(B0, 0, 0); PG8_LDB(B1, 0, 1); PG8_SCHED; PG8_LDA(At, 0, 0); PG8_STAGE(PG8_SA(1, 1), a1 + hstepA, PG8_VA(1));
            PG8_WAIT_V(8); PG8_WAIT_L(0); PG8_BAR; PG8_MMA(0, 0, At, B0); PG8_MMA(0, 1, At, B1); PG8_BAR; PG8_SCHED;
            PG8_LDA(At, 0, 1); PG8_STAGE(PG8_SB(0, 0), b2, voffB); PG8_STAGE(PG8_SB(0, 1), b2 + hstepB, voffB); PG8_STAGE(PG8_SA(0, 0), a2, PG8_VA2(0));
            PG8_WAIT_V(8); PG8_WAIT_L(0); PG8_BAR; PG8_MMA(1, 0, At, B0); PG8_MMA(1, 1, At, B1); PG8_BAR; PG8_SCHED;
            PG8_LDB(B0, 1, 0); PG8_LDB(B1, 1, 1); PG8_SCHED; PG8_LDA(At, 1, 0); PG8_STAGE(PG8_SA(0, 1), a2 + hstepA, PG8_VA2(1));
            PG8_WAIT_V(8); PG8_WAIT_L(0); PG8_BAR; PG8_MMA(0, 0, At, B0); PG8_MMA(0, 1, At, B1); PG8_BAR; PG8_SCHED;
            PG8_LDA(At, 1, 1); PG8_STAGE(PG8_SB(1, 0), b3, voffB); PG8_STAGE(PG8_SB(1, 1), b3 + hstepB, voffB); PG8_STAGE(PG8_SA(1, 0), a3, PG8_VA2(0));
            PG8_WAIT_V(8); PG8_WAIT_L(0); PG8_BAR; PG8_MMA(1, 0, At, B0); PG8_MMA(1, 1, At, B1); PG8_BAR; PG8_SCHED;
            if constexpr (SEG2) { if (t + 2 == nt1) { E.mid(acc, cur, wr, wc, fr, fq); PG8_SCHED; } }
        }
        if (wr == 0) PG8_BAR;
        if constexpr (F8) asm volatile("s_nop 15\n\ts_nop 3" ::: "memory");
        E(acc, cur, wr, wc, fr, fq);
        if (!has_next) break;
#pragma unroll
        for (int a = 0; a < 2; ++a)
#pragma unroll
            for (int b = 0; b < 2; ++b)
#pragma unroll
                for (int m = 0; m < 4; ++m)
#pragma unroll
                    for (int n = 0; n < 2; ++n) acc[a][b][m][n] = (f32x4){0.f, 0.f, 0.f, 0.f};
        cur = nxt; cA = nA; cB = nB; ++ui;
        if constexpr (SEG2) { cA2 = uni_ptr(S.a_ptr2(cur)); cB2 = uni_ptr(S.b_ptr2(cur)); }
        if constexpr (GA) {
#pragma unroll
            for (int h = 0; h < 2; ++h)
#pragma unroll
                for (int i = 0; i < 2; ++i) voffA[h][i] = voffAn[h][i]; }
        if (wr == 1) PG8_BAR;
    }
    PG8_WAIT_V(0);
    PG8_BAR;
#undef PG8_SA
#undef PG8_SB
#undef PG8_STAGE
#undef PG8_LDA
#undef PG8_LDB
#undef PG8_MMA
#undef PG8_WAIT_V
#undef PG8_WAIT_L
#undef PG8_BAR
#undef PG8_SCHED
#undef PG8_ROWOFFS
#undef PG8_VA
#undef PG8_VA2
#undef PG8_KA
#undef PG8_KB
}
}

namespace attn_body {
using bf16 = __hip_bfloat16;
constexpr int D = 64, QP = NQKV, KP = NQKV, OP = DMODEL;
constexpr int NW = 8, QBLK = 32, QB = QBLK * NW, KVBLK = 64;
__device__ __forceinline__ int crow(int r, int hi) { return (r & 3) + 8 * (r >> 2) + 4 * hi; }
#define SBAR() __builtin_amdgcn_sched_barrier(0)
constexpr int NSLOT = 3, SLOTB = 8192;
constexpr int LDS_K = 0, LDS_V = NSLOT * SLOTB, LDS_WS = 2 * NSLOT * SLOTB, LDS_OST = LDS_WS + NW * 64 * 4, LDS_BYTES = LDS_OST + NW * 4096;
__device__ __forceinline__ void glds16(const void* gsrc, unsigned lds_dst) { unsigned keep;
    asm volatile("s_mov_b32 %0, m0\n\ts_mov_b32 m0, %2\n\ts_nop 0\n\tglobal_load_lds_dwordx4 %1, off\n\ts_mov_b32 m0, %0" : "=&s"(keep) : "v"(gsrc), "s"(lds_dst) : "memory"); }
__device__ __forceinline__ float max3f(float a, float b, float c) { float r; asm("v_max3_f32 %0, %1, %2, %3" : "=v"(r) : "v"(a), "v"(b), "v"(c)); return r; }
__device__ __forceinline__ float max2f(float a, float b) { float r; asm("v_max_f32_e32 %0, %1, %2" : "=v"(r) : "v"(a), "v"(b)); return r; }
__device__ __forceinline__ float fadd_s(float a, float b) { float r; asm("v_add_f32_e32 %0, %1, %2" : "=v"(r) : "v"(a), "v"(b)); return r; }
__device__ __forceinline__ float fsub_s(float a, float b) { float r; asm("v_sub_f32_e32 %0, %1, %2" : "=v"(r) : "v"(a), "v"(b)); return r; }
typedef float f32x2_t __attribute__((ext_vector_type(2))); typedef __bf16 bf16x2_t __attribute__((ext_vector_type(2)));
__device__ __forceinline__ unsigned cvtpk_s(float lo, float hi) { f32x2_t v = {lo, hi}; bf16x2_t b = __builtin_convertvector(v, bf16x2_t); return __builtin_bit_cast(unsigned, b); }
#define WAIT_BAR(N) asm volatile("s_waitcnt vmcnt(" #N ") lgkmcnt(0)\n\ts_barrier" ::: "memory")

__device__ __forceinline__ void qkt(f32x16& p0, f32x16& p1, const char* Kslot, const bf16x8* qr, const f32x16& negm, int r32, int hi) {
    const char* kb = Kslot + hi * 1024 + r32 * 16;
#pragma unroll
    for (int d0 = 0; d0 < 4; ++d0) {
        const bf16x8 b0 = *reinterpret_cast<const bf16x8*>(kb + d0 * 2048);
        const bf16x8 b1 = *reinterpret_cast<const bf16x8*>(kb + d0 * 2048 + 512);
        if (d0 == 0) { p0 = __builtin_amdgcn_mfma_f32_32x32x16_bf16(b0, qr[0], negm, 0, 0, 0); p1 = __builtin_amdgcn_mfma_f32_32x32x16_bf16(b1, qr[0], negm, 0, 0, 0); }
        else { p0 = __builtin_amdgcn_mfma_f32_32x32x16_bf16(b0, qr[d0], p0, 0, 0, 0); p1 = __builtin_amdgcn_mfma_f32_32x32x16_bf16(b1, qr[d0], p1, 0, 0, 0); } }
}
typedef LAS const char* lds_cptr;
typedef short v4i16_t __attribute__((ext_vector_type(4)));
__device__ __forceinline__ void kload8(bf16x8* kf, lds_cptr kp) {
    kf[0] = *(const LAS bf16x8*)(kp);        kf[1] = *(const LAS bf16x8*)(kp + 512);
    kf[2] = *(const LAS bf16x8*)(kp + 2048); kf[3] = *(const LAS bf16x8*)(kp + 2560);
    kf[4] = *(const LAS bf16x8*)(kp + 4096); kf[5] = *(const LAS bf16x8*)(kp + 4608);
    kf[6] = *(const LAS bf16x8*)(kp + 6144); kf[7] = *(const LAS bf16x8*)(kp + 6656);
}
__device__ __forceinline__ void kload2(bf16x8* kf, lds_cptr kp, int j) { kf[2 * j] = *(const LAS bf16x8*)(kp + j * 2048); kf[2 * j + 1] = *(const LAS bf16x8*)(kp + j * 2048 + 512); }
__device__ __forceinline__ s16x4 vtr(lds_cptr p) { return __builtin_bit_cast(s16x4, __builtin_amdgcn_ds_read_tr16_b64_v4i16((LAS v4i16_t*)p)); }
__device__ __forceinline__ float rowmax(const f32x16& p0, const f32x16& p1) {
    float a = max3f(p0[0], p0[1], p1[0]), b = max3f(p0[2], p0[3], p1[1]); a = max3f(a, p1[2], p1[3]);
#pragma unroll
    for (int r = 4; r < 16; r += 4) { a = max3f(a, p0[r], p0[r + 1]); b = max3f(b, p0[r + 2], p0[r + 3]); a = max3f(a, p1[r], p1[r + 1]); b = max3f(b, p1[r + 2], p1[r + 3]); }
    const float m = max2f(a, b);
    auto rr = __builtin_amdgcn_permlane32_swap(__float_as_uint(m), __float_as_uint(m), false, false);
    return max2f(__uint_as_float(rr[0]), __uint_as_float(rr[1]));
}
__device__ __forceinline__ void pv(f32x16* o, int vb, bf16x8 pa0, bf16x8 pa1, bf16x8 pa2, bf16x8 pa3) {
#pragma unroll
    for (int d0 = 0; d0 < 2; ++d0) { s16x4 lo[4], hi[4];
#pragma unroll
        for (int ks = 0; ks < 4; ++ks) {
            asm volatile("ds_read_b64_tr_b16 %0,%1 offset:%c2" : "=&v"(lo[ks]) : "v"(vb), "i"(d0 * 4096 + ks * 1024) : "memory");
            asm volatile("ds_read_b64_tr_b16 %0,%1 offset:%c2" : "=&v"(hi[ks]) : "v"(vb), "i"(d0 * 4096 + ks * 1024 + 512) : "memory"); }
        asm volatile("s_waitcnt lgkmcnt(0)" ::: "memory"); SBAR();
#define PK(k) (bf16x8){lo[k][0], lo[k][1], lo[k][2], lo[k][3], hi[k][0], hi[k][1], hi[k][2], hi[k][3]}
        o[d0] = __builtin_amdgcn_mfma_f32_32x32x16_bf16(pa0, PK(0), o[d0], 0, 0, 0);
        o[d0] = __builtin_amdgcn_mfma_f32_32x32x16_bf16(pa1, PK(1), o[d0], 0, 0, 0);
        o[d0] = __builtin_amdgcn_mfma_f32_32x32x16_bf16(pa2, PK(2), o[d0], 0, 0, 0);
        o[d0] = __builtin_amdgcn_mfma_f32_32x32x16_bf16(pa3, PK(3), o[d0], 0, 0, 0);
#undef PK
    }
}
#define ATTN_STORE16(p, v) (*(u32x4*)(p) = (v))
template <int THRL> __device__ __forceinline__ void attn_unit(int qb, const bf16* Qh, const bf16* __restrict__ Kh, const bf16* __restrict__ Vh, bf16* Oh, char* shm) {
    const int tid = fresh_tid(), lane = tid & 63, r32 = lane & 31, hi = lane >> 5; const int wid = __builtin_amdgcn_readfirstlane(tid >> 6);
    const int q0 = qb * QB;
    const bf16* Qw = Qh + (long)(q0 + wid * QBLK) * QP;
    const unsigned lds0 = (unsigned)(uintptr_t)shm;
    float* wsf = (float*)(shm + LDS_WS) + wid * 64;
    const bf16* ksrc = Kh + (long)lane * KP + wid * 8;
    const bf16* vsrc = Vh + (long)(16 * (wid & 3) + (lane >> 2)) * KP + (wid >> 2) * 32 + (lane & 3) * 8;
    const unsigned kdst = lds0 + LDS_K + wid * 1024, vdst = lds0 + LDS_V + wid * 1024;
#define DMA_K(t, slot) glds16(ksrc + (long)(t) * KVBLK * KP, (unsigned)__builtin_amdgcn_readfirstlane(kdst + (slot)))
#define DMA_V(t, slot) glds16(vsrc + (long)(t) * KVBLK * KP, (unsigned)__builtin_amdgcn_readfirstlane(vdst + (slot)))
    const int vb0 = (int)(lds0 + LDS_V) + ((lane >> 4) & 1) * 32 + (lane & 3) * 8 + (4 * hi + ((lane & 15) >> 2)) * 64;
    const char* Kbase = shm + LDS_K; bf16x8 kf[8];
    const lds_cptr shm3 = (lds_cptr)shm; const lds_cptr kp0 = shm3 + LDS_K + hi * 1024 + r32 * 16; const lds_cptr vp0 = shm3 + LDS_V + ((lane >> 4) & 1) * 32 + (lane & 3) * 8 + (4 * hi + ((lane & 15) >> 2)) * 64;
    constexpr int NT = SEQ / KVBLK;
    DMA_K(0, 0); DMA_V(0, 0); DMA_K(1, SLOTB);
    bf16x8 qr[4];
#pragma unroll
    for (int d0 = 0; d0 < 4; ++d0) qr[d0] = *reinterpret_cast<const bf16x8*>(&Qw[(long)r32 * QP + d0 * 16 + hi * 8]);
    float mhat = 0.f, l_reg = 0.f; f32x16 o[2]; o[0] = f32x16{}; o[1] = f32x16{}; f32x16 negm = f32x16{}; asm volatile("" : "+v"(negm));
    bool resc = false;
#define START(P0, P1) do { const float rm = rowmax(P0, P1); resc = false; \
    { const float dl = rm; mhat = fadd_s(mhat, dl); \
      _Pragma("unroll") for (int r = 0; r < 16; ++r) { P0[r] = fsub_s(P0[r], dl); P1[r] = fsub_s(P1[r], dl); } \
      _Pragma("unroll") for (int r = 0; r < 16; ++r) negm[r] = -mhat; asm volatile("" : "+v"(negm)); } \
    _Pragma("unroll") for (int r = 0; r < 16; ++r) P0[r] = __builtin_amdgcn_exp2f(P0[r]); } while (0)
#define RESC() do { if (resc) { asm volatile("s_waitcnt lgkmcnt(0)" ::: "memory"); \
      _Pragma("unroll") for (int d_ = 0; d_ < 2; ++d_) _Pragma("unroll") for (int r = 0; r < 16; ++r) o[d_][r] *= wsf[crow(r, hi)]; } } while (0)
    f32x16 pA0, pA1, pB0, pB1;
    int sl_prev = 0, sl_cur = 0, sl_next = SLOTB;
#define ROT() do { sl_prev = sl_cur; sl_cur = sl_next; sl_next = (sl_next == (NSLOT - 1) * SLOTB) ? 0 : sl_next + SLOTB; } while (0)
    DMA_K(2, 2 * SLOTB);
    WAIT_BAR(3);
    qkt(pA0, pA1, Kbase, qr, negm, r32, hi); asm volatile("s_nop 15\n\ts_nop 7" : "+v"(pA0), "+v"(pA1));
    START(pA0, pA1);
    _Pragma("unroll") for (int r = 0; r < 16; ++r) pA1[r] = __builtin_amdgcn_exp2f(pA1[r]);
    WAIT_BAR(0);
    DMA_K(3, 0); DMA_V(1, SLOTB);
    ROT();
    kload8(kf, kp0 + sl_cur);
    WAIT_BAR(2);
    s16x4 vlo[8], vhi[8]; u32x4 pw0, pw1, pw2, pw3;
#define PKW(P, B) cvtpk_s(P[B], P[B + 1])
#define PAF(k) __builtin_bit_cast(bf16x8, pw##k)
#define VFR(i) (bf16x8){vlo[i][0], vlo[i][1], vlo[i][2], vlo[i][3], vhi[i][0], vhi[i][1], vhi[i][2], vhi[i][3]}
#define PIN(x) asm volatile("" : "+v"(x))
#define MX3(a, b, c) __builtin_fmaxf(__builtin_fmaxf((a), (b)), (c))
#define GAPA(MF, A0, A1, A2, A3, W0, W1, PW) do { MF; sacc += A0; sacc += A1; sacc += A2; sacc += A3; PIN(sacc); W0; W1; PIN(PW); SBAR(); } while (0)
#define EX(v) __builtin_amdgcn_exp2f(v)
#define GAPB(MF, X, B) do { MF; X[B] = EX(X[B]); X[B + 1] = EX(X[B + 1]); X[B + 2] = EX(X[B + 2]); X[B + 3] = EX(X[B + 3]); PIN(X); SBAR(); } while (0)
#define VRD(i) do { vlo[i] = vtr(vp_ + (((i) >> 2) * 4096 + ((i) & 3) * 1024)); vhi[i] = vtr(vp_ + (((i) >> 2) * 4096 + ((i) & 3) * 1024 + 512)); } while (0)
#define KRD(G, j) do { if (G) { kload2(kf, kp0 + sl_next, j); SBAR(); } } while (0)
#define STEP(C0, C1, P0, P1, t, GK, GV, GL) do { SBAR(); \
    const lds_cptr vp_ = vp0 + sl_prev; \
    VRD(0); SBAR(); float sacc = (P0[0] + P0[1]); \
    GAPA(C0 = __builtin_amdgcn_mfma_f32_32x32x16_bf16(kf[0], qr[0], negm, 0, 0, 0), P0[2], P0[3], P0[4], P0[5],     pw0[0] = PKW(P0, 0), pw0[1] = PKW(P0, 2), pw0); \
    VRD(4); SBAR(); GAPA(C1 = __builtin_amdgcn_mfma_f32_32x32x16_bf16(kf[1], qr[0], negm, 0, 0, 0), P0[6], P0[7], P0[8], P0[9],     pw0[2] = PKW(P0, 4), pw0[3] = PKW(P0, 6), pw0); \
    VRD(1); SBAR(); GAPA(C0 = __builtin_amdgcn_mfma_f32_32x32x16_bf16(kf[2], qr[1], C0, 0, 0, 0),   P0[10], P0[11], P0[12], P0[13], pw1[0] = PKW(P0, 8), pw1[1] = PKW(P0, 10), pw1); \
    VRD(5); SBAR(); GAPA(C1 = __builtin_amdgcn_mfma_f32_32x32x16_bf16(kf[3], qr[1], C1, 0, 0, 0),   P0[14], P0[15], P1[0], P1[1],   pw1[2] = PKW(P0, 12), pw1[3] = PKW(P0, 14), pw1); \
    VRD(2); SBAR(); GAPA(C0 = __builtin_amdgcn_mfma_f32_32x32x16_bf16(kf[4], qr[2], C0, 0, 0, 0),   P1[2], P1[3], P1[4], P1[5],     pw2[0] = PKW(P1, 0), pw2[1] = PKW(P1, 2), pw2); \
    VRD(6); SBAR(); GAPA(C1 = __builtin_amdgcn_mfma_f32_32x32x16_bf16(kf[5], qr[2], C1, 0, 0, 0),   P1[6], P1[7], P1[8], P1[9],     pw2[2] = PKW(P1, 4), pw2[3] = PKW(P1, 6), pw2); \
    VRD(3); SBAR(); GAPA(C0 = __builtin_amdgcn_mfma_f32_32x32x16_bf16(kf[6], qr[3], C0, 0, 0, 0),   P1[10], P1[11], P1[12], P1[13], pw3[0] = PKW(P1, 8), pw3[1] = PKW(P1, 10), pw3); \
    VRD(7); SBAR(); GAPA(C1 = __builtin_amdgcn_mfma_f32_32x32x16_bf16(kf[7], qr[3], C1, 0, 0, 0),   P1[14], P1[15], 0.f, 0.f,       pw3[2] = PKW(P1, 12), pw3[3] = PKW(P1, 14), pw3); \
    l_reg += sacc; \
    if (GK) { DMA_K((t) + 3, sl_cur); } if (GV) { DMA_V((t) + 1, sl_next); } \
    { float a = MX3(C0[0], C0[1], C1[0]), b = MX3(C0[2], C0[3], C1[1]); a = MX3(a, C1[2], C1[3]); \
      _Pragma("unroll") for (int r = 4; r < 16; r += 4) { a = MX3(a, C0[r], C0[r + 1]); b = MX3(b, C0[r + 2], C0[r + 3]); a = MX3(a, C1[r], C1[r + 1]); b = MX3(b, C1[r + 2], C1[r + 3]); } \
      float rm = __builtin_fmaxf(a, b); { auto rr = __builtin_amdgcn_permlane32_swap(__float_as_uint(rm), __float_as_uint(rm), false, false); rm = __builtin_fmaxf(__uint_as_float(rr[0]), __uint_as_float(rr[1])); } \
      resc = false; \
      if (__builtin_expect(__any(rm > (float)THRL), 0)) { const float dl = __builtin_fmaxf(rm, 0.f); mhat += dl; \
        _Pragma("unroll") for (int r = 0; r < 16; ++r) { C0[r] -= dl; C1[r] -= dl; } \
        _Pragma("unroll") for (int r = 0; r < 16; ++r) negm[r] = -mhat; asm volatile("" : "+v"(negm)); \
        const float f = __builtin_amdgcn_exp2f(-dl); l_reg *= f; if (hi == 0) wsf[r32] = f; resc = true; } } \
    SBAR(); \
    GAPB(o[0] = __builtin_amdgcn_mfma_f32_32x32x16_bf16(PAF(0), VFR(0), o[0], 0, 0, 0), C0, 0); \
    GAPB(o[1] = __builtin_amdgcn_mfma_f32_32x32x16_bf16(PAF(0), VFR(4), o[1], 0, 0, 0), C0, 4); \
    KRD(GL, 0); GAPB(o[0] = __builtin_amdgcn_mfma_f32_32x32x16_bf16(PAF(1), VFR(1), o[0], 0, 0, 0), C0, 8); \
    KRD(GL, 1); GAPB(o[1] = __builtin_amdgcn_mfma_f32_32x32x16_bf16(PAF(1), VFR(5), o[1], 0, 0, 0), C0, 12); \
    KRD(GL, 2); GAPB(o[0] = __builtin_amdgcn_mfma_f32_32x32x16_bf16(PAF(2), VFR(2), o[0], 0, 0, 0), C1, 0); \
    KRD(GL, 3); GAPB(o[1] = __builtin_amdgcn_mfma_f32_32x32x16_bf16(PAF(2), VFR(6), o[1], 0, 0, 0), C1, 4); \
    GAPB(o[0] = __builtin_amdgcn_mfma_f32_32x32x16_bf16(PAF(3), VFR(3), o[0], 0, 0, 0), C1, 8); \
    GAPB(o[1] = __builtin_amdgcn_mfma_f32_32x32x16_bf16(PAF(3), VFR(7), o[1], 0, 0, 0), C1, 12); \
    } while (0)
    int t = 1;
    for (; t + 5 < NT; t += 2) {
        STEP(pB0, pB1, pA0, pA1, t, true, true, true);     WAIT_BAR(2); RESC(); ROT();
        STEP(pA0, pA1, pB0, pB1, t + 1, true, true, true); WAIT_BAR(2); RESC(); ROT();
    }
#define ENDW(tt) do { if ((tt) + 3 < NT) { WAIT_BAR(2); } else if ((tt) + 2 < NT) { WAIT_BAR(1); } else { WAIT_BAR(0); } } while (0)
    for (; t + 1 < NT; t += 2) {
        STEP(pB0, pB1, pA0, pA1, t, (t + 3 < NT), (t + 1 < NT), (t + 1 < NT));         ENDW(t);     RESC(); ROT();
        STEP(pA0, pA1, pB0, pB1, t + 1, (t + 4 < NT), (t + 2 < NT), (t + 2 < NT));     ENDW(t + 1); RESC(); ROT();
    }
    STEP(pB0, pB1, pA0, pA1, NT - 1, false, false, false); RESC();
    { float sacc = pB0[0] + pB0[1]; _Pragma("unroll") for (int r = 2; r < 16; ++r) sacc += pB0[r]; _Pragma("unroll") for (int r = 0; r < 16; ++r) sacc += pB1[r]; l_reg += sacc;
      pw0 = (u32x4){PKW(pB0, 0), PKW(pB0, 2), PKW(pB0, 4), PKW(pB0, 6)}; pw1 = (u32x4){PKW(pB0, 8), PKW(pB0, 10), PKW(pB0, 12), PKW(pB0, 14)}; pw2 = (u32x4){PKW(pB1, 0), PKW(pB1, 2), PKW(pB1, 4), PKW(pB1, 6)}; pw3 = (u32x4){PKW(pB1, 8), PKW(pB1, 10), PKW(pB1, 12), PKW(pB1, 14)};
      SBAR(); pv(o, vb0 + sl_cur, PAF(0), PAF(1), PAF(2), PAF(3)); }
#undef PKW
#undef PAF
#undef VFR
#undef PIN
#undef MX3
#undef GAPA
#undef GAPB
#undef EX
#undef VRD
#undef KRD
#undef STEP
#undef ENDW
    { auto rr = __builtin_amdgcn_permlane32_swap(__float_as_uint(l_reg), __float_as_uint(l_reg), false, false); l_reg = __uint_as_float(rr[0]) + __uint_as_float(rr[1]); }
    if (hi == 0) wsf[32 + r32] = l_reg; asm volatile("s_waitcnt lgkmcnt(0)" ::: "memory");
    float rli[16];
#pragma unroll
    for (int r = 0; r < 16; ++r) rli[r] = __builtin_amdgcn_rcpf(wsf[32 + crow(r, hi)]);
    bf16* Ow = Oh + (long)(q0 + wid * QBLK) * OP;
    { bf16* stg = (bf16*)(shm + LDS_OST) + wid * 2048;
#pragma unroll
      for (int r = 0; r < 16; ++r) { const int orow = crow(r, hi);
#pragma unroll
        for (int d0 = 0; d0 < 2; ++d0) stg[orow * 64 + d0 * 32 + r32] = __float2bfloat16(o[d0][r] * rli[r]); }
      asm volatile("s_waitcnt lgkmcnt(0)" ::: "memory");
#pragma unroll
      for (int i = 0; i < 4; ++i) { const int row = i * 8 + (lane >> 3), ch = lane & 7; const u32x4 v = *(const u32x4*)(stg + row * 64 + ch * 8); ATTN_STORE16(Ow + (long)row * OP + ch * 8, v); } }
    asm volatile("s_waitcnt lgkmcnt(0)\n\ts_barrier" ::: "memory");
#undef DMA_K
#undef DMA_V
#undef START
#undef RESC
#undef ROT
}

__device__ __forceinline__ void attn_unit_fast(int qb, const bf16* Qh, const bf16* __restrict__ Kh, const bf16* __restrict__ Vh, bf16* Oh, char* shm) {
    const int tid = fresh_tid(), lane = tid & 63, r32 = lane & 31, hi = lane >> 5; const int wid = __builtin_amdgcn_readfirstlane(tid >> 6);
    const int q0 = qb * QB;
    const bf16* Qw = Qh + (long)(q0 + wid * QBLK) * QP;
    const unsigned lds0 = (unsigned)(uintptr_t)shm;
    const bf16* ksrc = Kh + (long)lane * KP + wid * 8;
    const bf16* vsrc = Vh + (long)(16 * (wid & 3) + (lane >> 2)) * KP + (wid >> 2) * 32 + (lane & 3) * 8;
    const unsigned kdst = lds0 + LDS_K + wid * 1024, vdst = lds0 + LDS_V + wid * 1024;
#define DMA_K(t, slot) glds16(ksrc + (long)(t) * KVBLK * KP, (unsigned)__builtin_amdgcn_readfirstlane(kdst + (slot)))
#define DMA_V(t, slot) glds16(vsrc + (long)(t) * KVBLK * KP, (unsigned)__builtin_amdgcn_readfirstlane(vdst + (slot)))
    const int vb0 = (int)(lds0 + LDS_V) + ((lane >> 4) & 1) * 32 + (lane & 3) * 8 + (4 * hi + ((lane & 15) >> 2)) * 64;
    const char* Kbase = shm + LDS_K; bf16x8 kf[8];
    const lds_cptr shm3 = (lds_cptr)shm; const lds_cptr kp0 = shm3 + LDS_K + hi * 1024 + r32 * 16; const lds_cptr vp0 = shm3 + LDS_V + ((lane >> 4) & 1) * 32 + (lane & 3) * 8 + (4 * hi + ((lane & 15) >> 2)) * 64;
    constexpr int NT = SEQ / KVBLK;
    DMA_K(0, 0); DMA_V(0, 0); DMA_K(1, SLOTB);
    bf16x8 qr[4];
#pragma unroll
    for (int d0 = 0; d0 < 4; ++d0) qr[d0] = *reinterpret_cast<const bf16x8*>(&Qw[(long)r32 * QP + d0 * 16 + hi * 8]);
    f32x16 o[2]; o[0] = f32x16{}; o[1] = f32x16{}; f32x16 lsum = f32x16{};
    const f32x16 zero16 = f32x16{};
    bf16x8 ones; { const short one = (short)0x3F80; ones = (bf16x8){one, one, one, one, one, one, one, one}; asm volatile("" : "+v"(ones)); }
    f32x16 pA0, pA1, pB0, pB1;
    int sl_prev = 0, sl_cur = 0, sl_next = SLOTB;
#define ROT() do { sl_prev = sl_cur; sl_cur = sl_next; sl_next = (sl_next == (NSLOT - 1) * SLOTB) ? 0 : sl_next + SLOTB; } while (0)
    DMA_K(2, 2 * SLOTB);
    WAIT_BAR(3);
    qkt(pA0, pA1, Kbase, qr, zero16, r32, hi);
    _Pragma("unroll") for (int r = 0; r < 16; ++r) pA0[r] = __builtin_amdgcn_exp2f(pA0[r]);
    _Pragma("unroll") for (int r = 0; r < 16; ++r) pA1[r] = __builtin_amdgcn_exp2f(pA1[r]);
    WAIT_BAR(0);
    DMA_K(3, 0); DMA_V(1, SLOTB);
    ROT();
    kload8(kf, kp0 + sl_cur);
    WAIT_BAR(2);
    s16x4 vlo[8], vhi[8]; u32x4 pw0, pw1, pw2, pw3;
#define PKW(P, B) cvtpk_s(P[B], P[B + 1])
#define PAF(k) __builtin_bit_cast(bf16x8, pw##k)
#define VFR(i) (bf16x8){vlo[i][0], vlo[i][1], vlo[i][2], vlo[i][3], vhi[i][0], vhi[i][1], vhi[i][2], vhi[i][3]}
#define PIN(x) asm volatile("" : "+v"(x))
#define GAPA(MF, W0, W1, PW) do { MF; W0; W1; PIN(PW); SBAR(); } while (0)
#define EX(v) __builtin_amdgcn_exp2f(v)
#define GAPB(MF, X, B) do { MF; X[B] = EX(X[B]); X[B + 1] = EX(X[B + 1]); X[B + 2] = EX(X[B + 2]); PIN(X); SBAR(); } while (0)
#define GAPS(k, X, B) do { lsum = __builtin_amdgcn_mfma_f32_32x32x16_bf16(PAF(k), ones, lsum, 0, 0, 0); X[B] = EX(X[B]); X[B + 1] = EX(X[B + 1]); PIN(X); SBAR(); } while (0)
#define VRD(i) do { vlo[i] = vtr(vp_ + (((i) >> 2) * 4096 + ((i) & 3) * 1024)); vhi[i] = vtr(vp_ + (((i) >> 2) * 4096 + ((i) & 3) * 1024 + 512)); } while (0)
#define KRD(G, j) do { if (G) { kload2(kf, kp0 + sl_next, j); SBAR(); } } while (0)
#define STEP(C0, C1, P0, P1, t, GK, GV, GL) do { SBAR(); \
    const lds_cptr vp_ = vp0 + sl_prev; \
    VRD(0); SBAR(); \
    GAPA(C0 = __builtin_amdgcn_mfma_f32_32x32x16_bf16(kf[0], qr[0], zero16, 0, 0, 0), pw0[0] = PKW(P0, 0), pw0[1] = PKW(P0, 2), pw0); \
    VRD(4); SBAR(); GAPA(C1 = __builtin_amdgcn_mfma_f32_32x32x16_bf16(kf[1], qr[0], zero16, 0, 0, 0), pw0[2] = PKW(P0, 4), pw0[3] = PKW(P0, 6), pw0); \
    VRD(1); SBAR(); GAPA(C0 = __builtin_amdgcn_mfma_f32_32x32x16_bf16(kf[2], qr[1], C0, 0, 0, 0),   pw1[0] = PKW(P0, 8), pw1[1] = PKW(P0, 10), pw1); \
    VRD(5); SBAR(); GAPA(C1 = __builtin_amdgcn_mfma_f32_32x32x16_bf16(kf[3], qr[1], C1, 0, 0, 0),   pw1[2] = PKW(P0, 12), pw1[3] = PKW(P0, 14), pw1); \
    VRD(2); SBAR(); GAPA(C0 = __builtin_amdgcn_mfma_f32_32x32x16_bf16(kf[4], qr[2], C0, 0, 0, 0),   pw2[0] = PKW(P1, 0), pw2[1] = PKW(P1, 2), pw2); \
    VRD(6); SBAR(); GAPA(C1 = __builtin_amdgcn_mfma_f32_32x32x16_bf16(kf[5], qr[2], C1, 0, 0, 0),   pw2[2] = PKW(P1, 4), pw2[3] = PKW(P1, 6), pw2); \
    VRD(3); SBAR(); GAPA(C0 = __builtin_amdgcn_mfma_f32_32x32x16_bf16(kf[6], qr[3], C0, 0, 0, 0),   pw3[0] = PKW(P1, 8), pw3[1] = PKW(P1, 10), pw3); \
    VRD(7); SBAR(); GAPA(C1 = __builtin_amdgcn_mfma_f32_32x32x16_bf16(kf[7], qr[3], C1, 0, 0, 0),   pw3[2] = PKW(P1, 12), pw3[3] = PKW(P1, 14), pw3); \
    if (GK) { DMA_K((t) + 3, sl_cur); } if (GV) { DMA_V((t) + 1, sl_next); } \
    SBAR(); \
    GAPB(o[0] = __builtin_amdgcn_mfma_f32_32x32x16_bf16(PAF(0), VFR(0), o[0], 0, 0, 0), C0, 0); \
    GAPB(o[1] = __builtin_amdgcn_mfma_f32_32x32x16_bf16(PAF(0), VFR(4), o[1], 0, 0, 0), C0, 3); \
    KRD(GL, 0); GAPS(0, C0, 6); \
    GAPB(o[0] = __builtin_amdgcn_mfma_f32_32x32x16_bf16(PAF(1), VFR(1), o[0], 0, 0, 0), C0, 8); \
    KRD(GL, 1); GAPB(o[1] = __builtin_amdgcn_mfma_f32_32x32x16_bf16(PAF(1), VFR(5), o[1], 0, 0, 0), C0, 11); \
    GAPS(1, C0, 14); \
    KRD(GL, 2); GAPB(o[0] = __builtin_amdgcn_mfma_f32_32x32x16_bf16(PAF(2), VFR(2), o[0], 0, 0, 0), C1, 0); \
    KRD(GL, 3); GAPB(o[1] = __builtin_amdgcn_mfma_f32_32x32x16_bf16(PAF(2), VFR(6), o[1], 0, 0, 0), C1, 3); \
    GAPS(2, C1, 6); \
    GAPB(o[0] = __builtin_amdgcn_mfma_f32_32x32x16_bf16(PAF(3), VFR(3), o[0], 0, 0, 0), C1, 8); \
    GAPB(o[1] = __builtin_amdgcn_mfma_f32_32x32x16_bf16(PAF(3), VFR(7), o[1], 0, 0, 0), C1, 11); \
    GAPS(3, C1, 14); \
    } while (0)
    int t = 1;
    for (; t + 5 < NT; t += 2) {
        STEP(pB0, pB1, pA0, pA1, t, true, true, true);     WAIT_BAR(2); ROT();
        STEP(pA0, pA1, pB0, pB1, t + 1, true, true, true); WAIT_BAR(2); ROT();
    }
#define ENDW(tt) do { if ((tt) + 3 < NT) { WAIT_BAR(2); } else if ((tt) + 2 < NT) { WAIT_BAR(1); } else { WAIT_BAR(0); } } while (0)
    for (; t + 1 < NT; t += 2) {
        STEP(pB0, pB1, pA0, pA1, t, (t + 3 < NT), (t + 1 < NT), (t + 1 < NT));         ENDW(t);     ROT();
        STEP(pA0, pA1, pB0, pB1, t + 1, (t + 4 < NT), (t + 2 < NT), (t + 2 < NT));     ENDW(t + 1); ROT();
    }
    STEP(pB0, pB1, pA0, pA1, NT - 1, false, false, false);
    { pw0 = (u32x4){PKW(pB0, 0), PKW(pB0, 2), PKW(pB0, 4), PKW(pB0, 6)}; pw1 = (u32x4){PKW(pB0, 8), PKW(pB0, 10), PKW(pB0, 12), PKW(pB0, 14)}; pw2 = (u32x4){PKW(pB1, 0), PKW(pB1, 2), PKW(pB1, 4), PKW(pB1, 6)}; pw3 = (u32x4){PKW(pB1, 8), PKW(pB1, 10), PKW(pB1, 12), PKW(pB1, 14)};
      SBAR(); pv(o, vb0 + sl_cur, PAF(0), PAF(1), PAF(2), PAF(3));
      lsum = __builtin_amdgcn_mfma_f32_32x32x16_bf16(PAF(0), ones, lsum, 0, 0, 0); lsum = __builtin_amdgcn_mfma_f32_32x32x16_bf16(PAF(1), ones, lsum, 0, 0, 0);
      lsum = __builtin_amdgcn_mfma_f32_32x32x16_bf16(PAF(2), ones, lsum, 0, 0, 0); lsum = __builtin_amdgcn_mfma_f32_32x32x16_bf16(PAF(3), ones, lsum, 0, 0, 0); }
#undef PKW
#undef PAF
#undef VFR
#undef PIN
#undef GAPA
#undef GAPB
#undef GAPS
#undef EX
#undef VRD
#undef KRD
#undef STEP
#undef ENDW
    bf16* Ow = Oh + (long)(q0 + wid * QBLK) * OP;
    { bf16* stg = (bf16*)(shm + LDS_OST) + wid * 2048;
#pragma unroll
      for (int r = 0; r < 16; ++r) { const int orow = crow(r, hi); const float rl = __builtin_amdgcn_rcpf(lsum[r]);
#pragma unroll
        for (int d0 = 0; d0 < 2; ++d0) stg[orow * 64 + d0 * 32 + r32] = __float2bfloat16(o[d0][r] * rl); }
      asm volatile("s_waitcnt lgkmcnt(0)" ::: "memory");
#pragma unroll
      for (int i = 0; i < 4; ++i) { const int row = i * 8 + (lane >> 3), ch = lane & 7; const u32x4 v = *(const u32x4*)(stg + row * 64 + ch * 8); ATTN_STORE16(Ow + (long)row * OP + ch * 8, v); } }
    asm volatile("s_waitcnt lgkmcnt(0)\n\ts_barrier" ::: "memory");
#undef DMA_K
#undef DMA_V
#undef ROT
}
__device__ __forceinline__ void attn_unit_f8(int qb, const unsigned char* Q8h, const unsigned char* __restrict__ K8h, const unsigned char* __restrict__ V8Th, bf16* Oh, char* shm, float shift) {
    const int tid = fresh_tid(), lane = tid & 63, r32 = lane & 31, hi = lane >> 5; const int wid = __builtin_amdgcn_readfirstlane(tid >> 6);
    const int q0 = qb * QB;
    const unsigned lds0 = (unsigned)(uintptr_t)shm;
    constexpr int KSL = 4096;
    const int prow = 8 * wid + ((lane & 31) >> 2), pch = ((lane & 3) ^ ((prow >> 2) & 3)) * 16;
    const unsigned char* ksrc = K8h + (long)prow * 128 + pch;
    const unsigned char* vsrc = V8Th + (long)prow * 64 + pch;
    const unsigned kdst = lds0 + LDS_K + wid * 512, vdst = lds0 + LDS_V + wid * 512;
#define DMA_K(t, slot) do { if (lane < 32) glds16(ksrc + (long)(t) * KVBLK * 128, (unsigned)__builtin_amdgcn_readfirstlane(kdst + (slot))); } while (0)
#define DMA_V(t, slot) do { if (lane < 32) glds16(vsrc + (long)(t) * 4096, (unsigned)__builtin_amdgcn_readfirstlane(vdst + (slot))); } while (0)
    const lds_cptr shm3 = (lds_cptr)shm; const int ksw = (r32 >> 2) & 3;
    const int fo0 = r32 * 64 + (((2 * hi) ^ ksw) * 16), fo1 = r32 * 64 + (((2 * hi + 1) ^ ksw) * 16);
    const lds_cptr kp0 = shm3 + LDS_K, vp0 = shm3 + LDS_V;
    constexpr int NT = SEQ / KVBLK;
    DMA_K(0, 0); DMA_V(0, 0); DMA_K(1, KSL);
    v8i qf; { const unsigned char* qp = Q8h + (long)(q0 + wid * QBLK + r32) * 512 + hi * 32; qf = __builtin_shufflevector(*(const v4i*)qp, *(const v4i*)(qp + 16), 0, 1, 2, 3, 4, 5, 6, 7); }
    const int sc_k = 127 - 3, sc_q = 127 - 5, sc_v = 127 - 3, sc_1 = 127;
    v8i kf8[2], vf8[2], pa;
    v8i ones8; { const int o4 = 0x38383838; ones8 = (v8i){o4, o4, o4, o4, o4, o4, o4, o4}; asm volatile("" : "+v"(ones8)); }
    f32x16 cin; { const float ns = -shift; _Pragma("unroll") for (int r = 0; r < 16; ++r) cin[r] = ns; asm volatile("" : "+v"(cin)); }
#define LD8(dst, base, slotoff) do { _Pragma("unroll") for (int n_ = 0; n_ < 2; ++n_) dst[n_] = __builtin_shufflevector(*(const LAS v4i*)((base) + (slotoff) + n_ * 2048 + fo0), *(const LAS v4i*)((base) + (slotoff) + n_ * 2048 + fo1), 0, 1, 2, 3, 4, 5, 6, 7); } while (0)
#define QK8(n_) __builtin_amdgcn_mfma_scale_f32_32x32x64_f8f6f4(kf8[n_], qf, cin, 0, 0, 0, sc_k, 0, sc_q)
#define ACC8(acc, a_, b_, sb_) asm volatile("s_nop 1\n\tv_mfma_scale_f32_32x32x64_f8f6f4 %0, %1, %2, %0, %3, %4 op_sel_hi:[0,0,0]" : "+v"(acc) : "v"(a_), "v"(b_), "v"(sc_1), "v"(sb_))
#define PACK8(P0, P1) do { pa[0] = (int)pk4_fp8_nc(P0[0], P0[1], P0[2], P0[3]); pa[1] = (int)pk4_fp8_nc(P0[4], P0[5], P0[6], P0[7]); pa[2] = (int)pk4_fp8_nc(P0[8], P0[9], P0[10], P0[11]); pa[3] = (int)pk4_fp8_nc(P0[12], P0[13], P0[14], P0[15]); \
    pa[4] = (int)pk4_fp8_nc(P1[0], P1[1], P1[2], P1[3]); pa[5] = (int)pk4_fp8_nc(P1[4], P1[5], P1[6], P1[7]); pa[6] = (int)pk4_fp8_nc(P1[8], P1[9], P1[10], P1[11]); pa[7] = (int)pk4_fp8_nc(P1[12], P1[13], P1[14], P1[15]); } while (0)
    f32x16 o[2]; o[0] = f32x16{}; o[1] = f32x16{}; f32x16 lsum = f32x16{};
    f32x16 pA0, pA1, pB0, pB1;
    int sl_prev = 0, sl_cur = 0, sl_next = KSL;
#define ROT() do { sl_prev = sl_cur; sl_cur = sl_next; sl_next = (sl_next == (NSLOT - 1) * KSL) ? 0 : sl_next + KSL; } while (0)
    DMA_K(2, 2 * KSL);
    WAIT_BAR(3);
    LD8(kf8, kp0, 0); pA0 = QK8(0); pA1 = QK8(1);
    _Pragma("unroll") for (int r = 0; r < 16; ++r) pA0[r] = __builtin_amdgcn_exp2f(pA0[r]);
    _Pragma("unroll") for (int r = 0; r < 16; ++r) pA1[r] = __builtin_amdgcn_exp2f(pA1[r]);
    WAIT_BAR(0);
    DMA_K(3, 0); DMA_V(1, KSL);
    ROT();
    LD8(kf8, kp0, sl_cur);
    WAIT_BAR(2);
#define PIN(x) asm volatile("" : "+v"(x))
#define EX(v) __builtin_amdgcn_exp2f(v)
#define EX4(X, B) do { X[B] = EX(X[B]); X[B + 1] = EX(X[B + 1]); X[B + 2] = EX(X[B + 2]); X[B + 3] = EX(X[B + 3]); } while (0)
#define STEP(C0, C1, P0, P1, t, GK, GV, GL) do { SBAR(); \
    LD8(vf8, vp0, sl_prev); \
    C0 = QK8(0); PACK8(P0, P1); PIN(pa); \
    C1 = QK8(1); \
    if (GK) { DMA_K((t) + 3, sl_cur); } if (GV) { DMA_V((t) + 1, sl_next); } \
    \
    ACC8(o[0], pa, vf8[0], sc_v); EX4(C0, 0); EX4(C0, 4); EX4(C0, 8); PIN(C0); \
    ACC8(o[1], pa, vf8[1], sc_v); EX4(C0, 12); EX4(C1, 0); EX4(C1, 4); PIN(C0); PIN(C1); \
    if (GL) { LD8(kf8, kp0, sl_next); } \
    ACC8(lsum, pa, ones8, sc_1); EX4(C1, 8); EX4(C1, 12); PIN(C1); \
    } while (0)
    int t = 1;
    for (; t + 5 < NT; t += 2) {
        STEP(pB0, pB1, pA0, pA1, t, true, true, true);     WAIT_BAR(2); ROT();
        STEP(pA0, pA1, pB0, pB1, t + 1, true, true, true); WAIT_BAR(2); ROT();
    }
#define ENDW(tt) do { if ((tt) + 3 < NT) { WAIT_BAR(2); } else if ((tt) + 2 < NT) { WAIT_BAR(1); } else { WAIT_BAR(0); } } while (0)
    for (; t + 1 < NT; t += 2) {
        STEP(pB0, pB1, pA0, pA1, t, (t + 3 < NT), (t + 1 < NT), (t + 1 < NT));         ENDW(t);     ROT();
        STEP(pA0, pA1, pB0, pB1, t + 1, (t + 4 < NT), (t + 2 < NT), (t + 2 < NT));     ENDW(t + 1); ROT();
    }
    STEP(pB0, pB1, pA0, pA1, NT - 1, false, false, false);
    { PACK8(pB0, pB1); PIN(pa); SBAR(); LD8(vf8, vp0, sl_cur); SBAR();
      ACC8(o[0], pa, vf8[0], sc_v); ACC8(o[1], pa, vf8[1], sc_v); ACC8(lsum, pa, ones8, sc_1); }
    asm volatile("s_nop 15\n\ts_nop 15" : "+v"(o[0]), "+v"(o[1]), "+v"(lsum));
#undef PIN
#undef EX
#undef EX4
#undef STEP
#undef ENDW
    bf16* Ow = Oh + (long)(q0 + wid * QBLK) * OP;
    { bf16* stg = (bf16*)(shm + LDS_OST) + wid * 2048;
#pragma unroll
      for (int r = 0; r < 16; ++r) { const int orow = crow(r, hi); const float rl = lsum[r] > 0.f ? __builtin_amdgcn_rcpf(lsum[r]) : 0.f;
#pragma unroll
        for (int d0 = 0; d0 < 2; ++d0) stg[orow * 64 + d0 * 32 + r32] = __float2bfloat16(o[d0][r] * rl); }
      asm volatile("s_waitcnt lgkmcnt(0)" ::: "memory");
#pragma unroll
      for (int i = 0; i < 4; ++i) { const int row = i * 8 + (lane >> 3), ch = lane & 7; const u32x4 v = *(const u32x4*)(stg + row * 64 + ch * 8); ATTN_STORE16(Ow + (long)row * OP + ch * 8, v); } }
    asm volatile("s_waitcnt lgkmcnt(0)\n\ts_barrier" ::: "memory");
#undef DMA_K
#undef DMA_V
#undef ROT
#undef LD8
#undef QK8
#undef ACC8
#undef PACK8
}
constexpr int ATTN_LDS_BYTES = LDS_BYTES;
#undef SBAR
#undef WAIT_BAR
}

namespace na_body {
constexpr int NA_K = 0, NA_V = 65536;
typedef short v4i16_t __attribute__((ext_vector_type(4)));
__device__ __forceinline__ int clampi(int v, int lo, int hi) { return v < lo ? lo : (v > hi ? hi : v); }
__device__ __forceinline__ void na_phase(LAS unsigned char* lds, LAS float* biasL, LAS float* xch, const bf16_t* QKV, bf16_t* Y, const float* rpb, int vcu) {
    const int tid = fresh_tid(), lane = tid & 63, wid = __builtin_amdgcn_readfirstlane(tid >> 6);
    const int bh = vcu >> 3, b = bh >> 3, h = bh & 7, rbase = (vcu & 7) * 16;
    for (int i = tid; i < 15 * 31; i += 512) biasL[i] = rpb[h * 465 + i];
    const int lc = tid >> 3, lch = tid & 7;
    const unsigned kwoff = (unsigned)(lc * 128 + ((lch ^ (lc & 7)) * 16));
    const unsigned vwoff = (unsigned)(lc * 128 + (((lch >> 1) ^ ((lc >> 1) & 3)) * 32) + (lch & 1) * 16);
    const int q = lane & 15, g = lane >> 4;
    { const int rs0 = clampi(rbase - 4, 0, 120);
      u32x4 kv[8], vv[8];
#pragma unroll
      for (int i = 0; i < 8; ++i) { const size_t tok = (size_t)b * SEQ + (size_t)(rs0 + i) * 64 + lc;
          kv[i] = *(const u32x4*)(QKV + tok * NQKV + C_KNA + h * 64 + lch * 8); vv[i] = *(const u32x4*)(QKV + tok * NQKV + C_VNA + h * 64 + lch * 8); }
#pragma unroll
      for (int i = 0; i < 8; ++i) { const int row = rs0 + i;
          *(LAS u32x4*)(lds + NA_K + (row & 7) * 8192 + kwoff) = kv[i]; *(LAS u32x4*)(lds + NA_V + (row & 7) * 8192 + vwoff) = vv[i]; } }
    __syncthreads();
    const int tile_ = wid & 3, c0_ = tile_ * 16;
    bf16x8 qn[2];
#pragma unroll
    for (int ks = 0; ks < 2; ++ks) qn[ks] = *(const bf16x8*)(QKV + ((size_t)b * SEQ + (size_t)rbase * 64 + c0_ + q) * NQKV + C_QNA + h * 64 + ks * 32 + g * 8);
    for (int rr = 0; rr < 16; ++rr) {
        const int r = rbase + rr, rs = clampi(r - 4, 0, 120);
        const int rsn = (rr < 15) ? clampi(r + 1 - 4, 0, 120) : rs; const bool pf = rsn != rs;
        u32x4 pk = (u32x4){0u, 0u, 0u, 0u}, pv = (u32x4){0u, 0u, 0u, 0u};
        if (pf) { const size_t tok = (size_t)b * SEQ + (size_t)(rsn + 7) * 64 + lc;
            pk = *(const u32x4*)(QKV + tok * NQKV + C_KNA + h * 64 + lch * 8); pv = *(const u32x4*)(QKV + tok * NQKV + C_VNA + h * 64 + lch * 8); }
        {
            const int tile = wid & 3, kh = wid >> 2;
            const int c0 = tile * 16, u0 = clampi(c0 - 8, 0, 32);
            const size_t tq = (size_t)b * SEQ + (size_t)r * 64 + c0 + q;
            bf16x8 qf[2]; qf[0] = qn[0]; qf[1] = qn[1];
            { const int rn = (rr < 15) ? r + 1 : r; const size_t tqn = (size_t)b * SEQ + (size_t)rn * 64 + c0 + q;
#pragma unroll
              for (int ks = 0; ks < 2; ++ks) qn[ks] = *(const bf16x8*)(QKV + tqn * NQKV + C_QNA + h * 64 + ks * 32 + g * 8); }
            f32x4 s[4][2];
#pragma unroll
            for (int kk = 0; kk < 4; ++kk) { const int slot = (rs + 4 * kh + kk) & 7;
#pragma unroll
                for (int hf = 0; hf < 2; ++hf) { const int kc = u0 + hf * 16 + q;
                    f32x4 a = (f32x4){0.f, 0.f, 0.f, 0.f};
#pragma unroll
                    for (int ks = 0; ks < 2; ++ks) { const bf16x8 kfr = *(const LAS bf16x8*)(lds + NA_K + slot * 8192 + kc * 128 + (((ks * 4 + g) ^ (kc & 7)) * 16));
                        a = __builtin_amdgcn_mfma_f32_16x16x32_bf16(kfr, qf[ks], a, 0, 0, 0); }
                    s[kk][hf] = a; } }
            const int c = c0 + q, cs = clampi(c - 8, 0, 48), lo = cs - u0;
            const int dcb = u0 - c + 15 + 4 * g;
            float mx = -1e30f;
#pragma unroll
            for (int kk = 0; kk < 4; ++kk) { const int dr = rs + 4 * kh + kk - r + 7;
#pragma unroll
                for (int hf = 0; hf < 2; ++hf)
#pragma unroll
                    for (int i = 0; i < 4; ++i) { const int kcl = 16 * hf + 4 * g + i; const bool valid = (kcl >= lo) && (kcl < lo + 16);
                        const int dc = clampi(dcb + 16 * hf + i, 0, 30);
                        const float v = valid ? (s[kk][hf][i] + biasL[dr * 31 + dc]) * LOG2E : -1e30f;
                        s[kk][hf][i] = v; mx = fmaxf(mx, v); } }
            mx = swap16_max(mx); mx = swap32_max(mx);
            float l = 0.f;
#pragma unroll
            for (int kk = 0; kk < 4; ++kk)
#pragma unroll
                for (int hf = 0; hf < 2; ++hf)
#pragma unroll
                    for (int i = 0; i < 4; ++i) { const float p = __builtin_amdgcn_exp2f(s[kk][hf][i] - mx); s[kk][hf][i] = p; l += p; }
            l = swap16_sum(l, l); l = swap32_sum(l, l);
            f32x4 o[4];
#pragma unroll
            for (int nb = 0; nb < 4; ++nb) o[nb] = (f32x4){0.f, 0.f, 0.f, 0.f};
            const int qq = (lane & 15) >> 2, pp = lane & 3;
            const int kcA = u0 + 4 * g + qq, kcB = kcA + 16;
#pragma unroll
            for (int kk = 0; kk < 4; ++kk) { const int slot = (rs + 4 * kh + kk) & 7;
                u32x4 pw; pw.x = pk2(s[kk][0][0], s[kk][0][1]); pw.y = pk2(s[kk][0][2], s[kk][0][3]); pw.z = pk2(s[kk][1][0], s[kk][1][1]); pw.w = pk2(s[kk][1][2], s[kk][1][3]);
                const bf16x8 pf = __builtin_bit_cast(bf16x8, pw);
#pragma unroll
                for (int nb = 0; nb < 4; ++nb) {
                    const s16x4 va = __builtin_bit_cast(s16x4, __builtin_amdgcn_ds_read_tr16_b64_v4i16((LAS v4i16_t*)(lds + NA_V + slot * 8192 + kcA * 128 + ((nb ^ ((kcA >> 1) & 3)) * 32) + pp * 8)));
                    const s16x4 vb = __builtin_bit_cast(s16x4, __builtin_amdgcn_ds_read_tr16_b64_v4i16((LAS v4i16_t*)(lds + NA_V + slot * 8192 + kcB * 128 + ((nb ^ ((kcB >> 1) & 3)) * 32) + pp * 8)));
                    const bf16x8 vf = (bf16x8){va[0], va[1], va[2], va[3], vb[0], vb[1], vb[2], vb[3]};
                    o[nb] = __builtin_amdgcn_mfma_f32_16x16x32_bf16(vf, pf, o[nb], 0, 0, 0); } }
            LAS float* px = xch + (size_t)(tile * 64 + lane) * 18;
            if (kh == 1) { px[0] = mx; px[1] = l;
#pragma unroll
                for (int nb = 0; nb < 4; ++nb)
#pragma unroll
                    for (int i = 0; i < 4; ++i) px[2 + nb * 4 + i] = o[nb][i]; }
            __syncthreads();
            if (kh == 0) { const float mb = px[0], lb = px[1]; const float m = fmaxf(mx, mb), fa = __builtin_amdgcn_exp2f(mx - m), fb = __builtin_amdgcn_exp2f(mb - m);
                const float rl = 1.0f / (l * fa + lb * fb);
#pragma unroll
                for (int nb = 0; nb < 4; ++nb) { float t[4];
#pragma unroll
                    for (int i = 0; i < 4; ++i) t[i] = (o[nb][i] * fa + px[2 + nb * 4 + i] * fb) * rl;
                    u32x2 w; w.x = pk2(t[0], t[1]); w.y = pk2(t[2], t[3]);
                    *(u32x2*)(Y + tq * DMODEL + h * 64 + nb * 16 + 4 * g) = w; } }
        }
        if (pf) { *(LAS u32x4*)(lds + NA_K + ((rsn + 7) & 7) * 8192 + kwoff) = pk; *(LAS u32x4*)(lds + NA_V + ((rsn + 7) & 7) * 8192 + vwoff) = pv; }
        __syncthreads();
    }
}
}

constexpr size_t MiB = 1u << 20;
constexpr size_t WS_CTL = 0, CTL_ZERO_BYTES = 1 * MiB;
constexpr size_t WS_MOD = 1 * MiB;
constexpr size_t WS_IDX = 2 * MiB;
constexpr size_t WS_GSEL = 2 * MiB + 256 * 1024;
constexpr size_t WS_AFF = 3 * MiB;
constexpr size_t WS_SLOT = 5 * MiB;
constexpr size_t WS_WIN = 7 * MiB;
constexpr size_t WS_WG8 = 12 * MiB;
constexpr size_t WS_WA = 16 * MiB, WS_WB = 17 * MiB, WS_WOUT = 18 * MiB;
constexpr size_t WS_WGU = 20 * MiB;
constexpr size_t WS_WD = 148 * MiB;
constexpr size_t WS_H = 212 * MiB;
constexpr size_t WS_QKV = 276 * MiB;
constexpr size_t WS_GATES = 420 * MiB;
constexpr size_t WS_END = 548 * MiB;
constexpr size_t WS_YBUF = WS_WGU;
static_assert(WS_QKV + (size_t)65536 * 2048 * 2 <= WS_END, "HMID fits");
constexpr int CW_BAR = 4096;

constexpr int RING_OFF = 0, RING_BYTES = 131072;
constexpr int LDSCTL_OFF = RING_BYTES, MISC_OFF = LDSCTL_OFF + 320;
constexpr int NABIAS_OFF = RING_BYTES + 1024;
constexpr int NAXCH_OFF = RING_BYTES + 4096;
constexpr int LDS_BYTES = 163840;

#define XB_TMO      128
#define XB_XCNT(j)  (256  + 64 * (j))
#define XB_XSUB(j)  (1280 + 64 * (j))
#define XB_XGEN(j)  (2304 + 64 * (j))
#define XB_TOP      3328
#define XB_TOPGEN   3392
#define XCD_BAR_WORDS 3456
#define XB_SPIN_CAP (1u << 22)
__device__ __forceinline__ unsigned xb_ld(unsigned* p)              { return __hip_atomic_load(p, __ATOMIC_RELAXED, __HIP_MEMORY_SCOPE_AGENT); }
__device__ __forceinline__ unsigned xb_add(unsigned* p, unsigned v) { return __hip_atomic_fetch_add(p, v, __ATOMIC_RELAXED, __HIP_MEMORY_SCOPE_AGENT); }
__device__ __forceinline__ unsigned xb_xcc_id() { return (unsigned)__builtin_amdgcn_s_getreg((3 << 11) | 20) & 0xFu; }
#define XB_SPIN(cond, bar) do { unsigned _sp = 0; while (cond) { __builtin_amdgcn_s_sleep(1); \
    if ((++_sp & 255u) == 0u) { if (xb_ld(&(bar)[XB_TMO])) break; if (_sp > XB_SPIN_CAP) { atomicAdd(&(bar)[XB_TMO], 1u); break; } } } } while (0)
struct XcdBarrier { unsigned* bar; unsigned x; volatile LAS unsigned* st; };
__device__ __forceinline__ XcdBarrier xcd_barrier_post(unsigned* bar, volatile LAS unsigned* st) {
    XcdBarrier b; b.bar = bar; b.x = xb_xcc_id(); b.st = st;
    if (threadIdx.x == 0) (void)xb_add(&bar[XB_XCNT(b.x)], 1u);
    return b;
}
__device__ __forceinline__ void xcd_barrier_complete(unsigned* bar, unsigned x, unsigned& nloc, unsigned& nx) {
    const unsigned G = gridDim.x * gridDim.y * gridDim.z;
    unsigned sum, cnt, mine, sp = 0u;
    for (;;) {
        sum = 0u; cnt = 0u; mine = 0u;
#pragma unroll
        for (unsigned j = 0; j < 16; ++j) { const unsigned c = xb_ld(&bar[XB_XCNT(j)]); sum += c; cnt += (c > 0u) ? 1u : 0u; mine = (j == x) ? c : mine; }
        if (sum == G) break;
        __builtin_amdgcn_s_sleep(1);
        if ((++sp & 255u) == 0u) { if (xb_ld(&bar[XB_TMO])) break; if (sp > XB_SPIN_CAP) { atomicAdd(&bar[XB_TMO], 1u); break; } }
    }
    nloc = mine > 0u ? mine : 1u; nx = cnt > 0u ? cnt : 1u;
}
__device__ __forceinline__ void xcd_barrier(const XcdBarrier& b) {
    asm volatile("s_waitcnt vmcnt(0)" ::: "memory");
    __syncthreads();
    if (threadIdx.x == 0) {
        unsigned* bar = b.bar;
        __builtin_amdgcn_s_waitcnt(0);
        unsigned nloc = b.st[0], nx = b.st[1];
        if (nloc == 0u) { xcd_barrier_complete(bar, b.x, nloc, nx); b.st[0] = nloc; b.st[1] = nx; }
        const unsigned old = xb_add(&bar[XB_XSUB(b.x)], 1u);
        const unsigned gen = old / nloc;
        if (old + 1u == (gen + 1u) * nloc) {
            __builtin_amdgcn_fence(__ATOMIC_RELEASE, "agent");
            asm volatile("s_waitcnt vmcnt(0)" ::: "memory");
            const unsigned og = xb_add(&bar[XB_TOP], 1u);
            const unsigned tg = og / nx;
            if (og + 1u == (tg + 1u) * nx) xb_add(&bar[XB_TOPGEN], 1u);
            else XB_SPIN(xb_ld(&bar[XB_TOPGEN]) == tg, bar);
            __builtin_amdgcn_fence(__ATOMIC_ACQUIRE, "agent");
            xb_add(&bar[XB_XGEN(b.x)], 1u);
            asm volatile("s_waitcnt vmcnt(0)" ::: "memory");
        } else {
            XB_SPIN(xb_ld(&bar[XB_XGEN(b.x)]) == gen, bar);
            __builtin_amdgcn_fence(__ATOMIC_ACQUIRE, "agent");
            asm volatile("s_waitcnt vmcnt(0)" ::: "memory");
        }
    }
    __syncthreads();
}

#define LDS_WAIT() asm volatile("s_waitcnt lgkmcnt(0)" ::: "memory")
template <class RowMap>
__device__ __forceinline__ void p0_transpose_item(const float* W, int K, int N, bf16_t* WT, LAS float* scr, int item, int lane, const RowMap& rowmap) {
    const int nblk = N / 32, kb = item / nblk, nb = item % nblk, k0 = 64 * kb, n0 = 32 * nb;
    float ld_[32];
#pragma unroll
    for (int i = 0; i < 32; ++i) ld_[i] = __builtin_nontemporal_load(&W[(size_t)(k0 + 2 * i + (lane >> 5)) * N + n0 + (lane & 31)]);
#pragma unroll
    for (int i = 0; i < 32; ++i) scr[(2 * i + (lane >> 5)) * 33 + (lane & 31)] = ld_[i];
    LDS_WAIT(); asm volatile("" ::: "memory");
    const int c = lane & 7;
#pragma unroll
    for (int j = 0; j < 4; ++j) { const int n = (lane >> 3) + 8 * j; const LAS float* s = scr + (8 * c) * 33 + n;
        u32x4 o; o.x = pk2(s[0 * 33], s[1 * 33]); o.y = pk2(s[2 * 33], s[3 * 33]); o.z = pk2(s[4 * 33], s[5 * 33]); o.w = pk2(s[6 * 33], s[7 * 33]);
        *(u32x4*)(WT + (size_t)rowmap(n0 + n) * K + k0 + 8 * c) = o; }
    LDS_WAIT(); asm volatile("" ::: "memory");
}
template <class RowMap>
__device__ __forceinline__ void p0_transpose_item_f8(const float* W, int K, int N, unsigned char* WT, LAS float* scr, int item, int lane, const RowMap& rowmap, float scale) {
    const int nblk = N / 32, kb = item / nblk, nb = item % nblk, k0 = 64 * kb, n0 = 32 * nb;
    float ld_[32];
#pragma unroll
    for (int i = 0; i < 32; ++i) ld_[i] = __builtin_nontemporal_load(&W[(size_t)(k0 + 2 * i + (lane >> 5)) * N + n0 + (lane & 31)]);
#pragma unroll
    for (int i = 0; i < 32; ++i) scr[(2 * i + (lane >> 5)) * 33 + (lane & 31)] = ld_[i];
    LDS_WAIT(); asm volatile("" ::: "memory");
#pragma unroll
    for (int j = 0; j < 2; ++j) { const int p = lane + 64 * j, n = p >> 2, c = p & 3; const LAS float* s = scr + (16 * c) * 33 + n;
        u32x4 o;
        o.x = pk4_fp8(s[0 * 33] * scale, s[1 * 33] * scale, s[2 * 33] * scale, s[3 * 33] * scale);
        o.y = pk4_fp8(s[4 * 33] * scale, s[5 * 33] * scale, s[6 * 33] * scale, s[7 * 33] * scale);
        o.z = pk4_fp8(s[8 * 33] * scale, s[9 * 33] * scale, s[10 * 33] * scale, s[11 * 33] * scale);
        o.w = pk4_fp8(s[12 * 33] * scale, s[13 * 33] * scale, s[14 * 33] * scale, s[15 * 33] * scale);
        *(u32x4*)(WT + (size_t)rowmap(n0 + n) * K + k0 + 16 * c) = o; }
    LDS_WAIT(); asm volatile("" ::: "memory");
}
struct RowId { __device__ __forceinline__ int operator()(int n) const { return n; } };
struct RowIn { __device__ __forceinline__ int operator()(int n) const { if (n < 1536) return n; const int oc = n & 255; return (n & ~255) + 128 * ((oc >> 5) & 1) + 32 * (oc >> 6) + (oc & 31); } };
struct RowGate { __device__ __forceinline__ int operator()(int n) const { const int g = n - NQKV, c = g & 1023; return 768 + (c >> 7) * 256 + (g >> 10) * 128 + (c & 127); } };
struct RowAll8 { __device__ __forceinline__ int operator()(int n) const { if (n < NQKV) return RowIn{}(n); const int g = n - NQKV, c = g & 1023; return NQKV + (c >> 7) * 256 + (g >> 10) * 128 + (c & 127); } };
struct RowHead8 { __device__ __forceinline__ int operator()(int n) const { return RowIn{}(n) - 1536; } };
struct RowGU { int up; __device__ __forceinline__ int operator()(int f) const { return (f >> 7) * 256 + up * 128 + (f & 127); } };

struct CvDesc { const float* W; unsigned char* WT; int K, N, k0, n0, gu, up; };
__device__ __forceinline__ CvDesc cv_decode(int r, const float* w_eg, const float* w_eu, const float* w_ed, unsigned char* WGU, unsigned char* WD) {
    constexpr int I_GU = 16 * 64, I_D = 32 * 32;
    CvDesc d; const int e = r / (2 * I_GU + I_D); int q = r - e * (2 * I_GU + I_D);
    if (q < 2 * I_GU) { d.up = q >= I_GU; q -= d.up * I_GU; d.W = (d.up ? w_eu : w_eg) + (size_t)e * 1024 * 2048; d.WT = WGU + (size_t)e * 4096 * 1024; d.K = 1024; d.N = 2048; d.gu = 1; }
    else { q -= 2 * I_GU; d.W = w_ed + (size_t)e * 2048 * 1024; d.WT = WD + (size_t)e * 1024 * 2048; d.K = 2048; d.N = 1024; d.gu = 0; d.up = 0; }
    const int nblk = d.N / 32; d.k0 = 64 * (q / nblk); d.n0 = 32 * (q % nblk);
    return d;
}
#define CV_LOAD(ld_, d_) do { _Pragma("unroll") for (int i_ = 0; i_ < 32; ++i_) ld_[i_] = __builtin_nontemporal_load(&(d_).W[(size_t)((d_).k0 + 2 * i_ + (lane >> 5)) * (d_).N + (d_).n0 + (lane & 31)]); } while (0)
#define CV_FINISH(ld_, d_) do { _Pragma("unroll") for (int i_ = 0; i_ < 32; ++i_) scr[(2 * i_ + (lane >> 5)) * 33 + (lane & 31)] = ld_[i_]; \
        LDS_WAIT(); asm volatile("" ::: "memory"); \
        _Pragma("unroll") for (int j_ = 0; j_ < 2; ++j_) { const int p_ = lane + 64 * j_, n_ = p_ >> 2, c_ = p_ & 3; const LAS float* s_ = scr + (16 * c_) * 33 + n_; const int f_ = (d_).n0 + n_; \
            const int row_ = (d_).gu ? ((f_ >> 7) * 256 + (d_).up * 128 + (f_ & 127)) : f_; u32x4 o_; \
            o_.x = pk4_fp8(s_[0 * 33] * F8_SC_W, s_[1 * 33] * F8_SC_W, s_[2 * 33] * F8_SC_W, s_[3 * 33] * F8_SC_W); \
            o_.y = pk4_fp8(s_[4 * 33] * F8_SC_W, s_[5 * 33] * F8_SC_W, s_[6 * 33] * F8_SC_W, s_[7 * 33] * F8_SC_W); \
            o_.z = pk4_fp8(s_[8 * 33] * F8_SC_W, s_[9 * 33] * F8_SC_W, s_[10 * 33] * F8_SC_W, s_[11 * 33] * F8_SC_W); \
            o_.w = pk4_fp8(s_[12 * 33] * F8_SC_W, s_[13 * 33] * F8_SC_W, s_[14 * 33] * F8_SC_W, s_[15 * 33] * F8_SC_W); \
            *(u32x4*)((d_).WT + (size_t)row_ * (d_).K + (d_).k0 + 16 * c_) = o_; } \
        LDS_WAIT(); asm volatile("" ::: "memory"); } while (0)
__device__ __forceinline__ void conv_experts_pipelined(int first, int end, int step, int lane, LAS float* scr, const float* w_eg, const float* w_eu, const float* w_ed, unsigned char* WGU, unsigned char* WD) {
    float ldA[32], ldB[32]; CvDesc dA, dB; int itA = first, itB = first + step;
    if (itA < end) { dA = cv_decode(itA, w_eg, w_eu, w_ed, WGU, WD); CV_LOAD(ldA, dA); }
    if (itB < end) { dB = cv_decode(itB, w_eg, w_eu, w_ed, WGU, WD); CV_LOAD(ldB, dB); }
    for (;;) {
        if (itA >= end) break;
        CV_FINISH(ldA, dA); itA += 2 * step;
        if (itA < end) { dA = cv_decode(itA, w_eg, w_eu, w_ed, WGU, WD); CV_LOAD(ldA, dA); }
        if (itB >= end) break;
        CV_FINISH(ldB, dB); itB += 2 * step;
        if (itB < end) { dB = cv_decode(itB, w_eg, w_eu, w_ed, WGU, WD); CV_LOAD(ldB, dB); }
    }
}
#undef CV_LOAD
#undef CV_FINISH

__constant__ float INV_FREQ[16] = {1.0f, 0.5623413251903491f, 0.31622776601683794f, 0.1778279410038923f, 0.1f, 0.05623413251903491f, 0.03162277660168379f, 0.01778279410038923f,
                                   0.01f, 0.005623413251903491f, 0.0031622776601683794f, 0.001778279410038923f, 0.001f, 0.0005623413251903491f, 0.00031622776601683794f, 0.0001778279410038923f};

struct Args { const float* in[18]; float* out; unsigned char* ws; int ph_lo, ph_hi, li, pad; };
constexpr int NPHASE = 12;

__global__ void __launch_bounds__(512, 2) mk_fwd(Args args) {
    extern __shared__ __attribute__((aligned(16))) unsigned char lds_raw[];
    LAS unsigned char* lds = (LAS unsigned char*)lds_raw;
    volatile LAS unsigned* MISC = (volatile LAS unsigned*)(lds + MISC_OFF);
    const int G = gridDim.x; const int bx = blockIdx.x; const int vcu = (G % 8 == 0) ? (bx % 8) * (G / 8) + bx / 8 : bx;
    const int NGW = G * 8;
#define PH_IDS() const int tid = fresh_tid(), lane = tid & 63, wave = __builtin_amdgcn_readfirstlane(tid >> 6), gw = vcu * 8 + wave; (void)lane; (void)gw
    constexpr int I_IN = 16 * 136, I_BR = 8 * 32, I_OUT = 16 * 32, I_GU = 16 * 64, I_D = 32 * 32;
    constexpr int N_SMALL_ITEMS = I_IN + 2 * I_BR + I_OUT, N_EXP_ITEMS = 16 * (2 * I_GU + I_D);
#define CONV_ITEM(it_) do { LAS float* scr_ = (LAS float*)(lds + RING_OFF + wave * 16384); int r_ = (it_); \
        if (r_ < I_IN) { p0_transpose_item_f8(w_in, 1024, NIN, WG8, scr_, r_, lane, RowAll8{}, F8_SC_W); break; } r_ -= I_IN; \
        if (r_ < I_BR) { p0_transpose_item(w_bna, 512, 1024, WA, scr_, r_, lane, RowId{}); break; } r_ -= I_BR; \
        if (r_ < I_BR) { p0_transpose_item(w_bgqa, 512, 1024, WB, scr_, r_, lane, RowId{}); break; } r_ -= I_BR; \
        if (r_ < I_OUT) { p0_transpose_item(w_out, 1024, 1024, WOUT, scr_, r_, lane, RowId{}); break; } r_ -= I_OUT; \
        const int e_ = r_ / (2 * I_GU + I_D); r_ -= e_ * (2 * I_GU + I_D); \
        if (r_ < I_GU) { p0_transpose_item_f8(w_eg + (size_t)e_ * 1024 * 2048, 1024, 2048, (unsigned char*)WGU + (size_t)e_ * 4096 * 1024, scr_, r_, lane, RowGU{0}, F8_SC_W); break; } r_ -= I_GU; \
        if (r_ < I_GU) { p0_transpose_item_f8(w_eu + (size_t)e_ * 1024 * 2048, 1024, 2048, (unsigned char*)WGU + (size_t)e_ * 4096 * 1024, scr_, r_, lane, RowGU{1}, F8_SC_W); break; } r_ -= I_GU; \
        p0_transpose_item_f8(w_ed + (size_t)e_ * 2048 * 1024, 2048, 1024, (unsigned char*)WD + (size_t)e_ * 1024 * 2048, scr_, r_, lane, RowId{}, F8_SC_W); } while (0)
    unsigned char* ws = args.ws;
    const float* x = args.in[0]; const float* cvec = args.in[1]; const float* w_ada = args.in[2]; const float* b_ada = args.in[3]; const float* norm1_g = args.in[4];
    const float* w_in = args.in[5]; const float* q_norm_g = args.in[6]; const float* k_norm_g = args.in[7]; const float* na_rpb = args.in[8];
    const float* w_bna = args.in[9]; const float* w_bgqa = args.in[10]; const float* w_out = args.in[11]; const float* norm2_g = args.in[12]; const float* w_router = args.in[13];
    const float* w_eg = args.in[14]; const float* w_eu = args.in[15]; const float* w_ed = args.in[16]; const float* final_g = args.in[17];
    float* out = args.out;
    unsigned* ctl = (unsigned*)(ws + WS_CTL);
    float* MOD = (float*)(ws + WS_MOD); int* IDX = (int*)(ws + WS_IDX); float* GSEL = (float*)(ws + WS_GSEL); float* AFF = (float*)(ws + WS_AFF); int* SLOT = (int*)(ws + WS_SLOT);
    bf16_t* WIN = (bf16_t*)(ws + WS_WIN); bf16_t* WA = (bf16_t*)(ws + WS_WA); bf16_t* WB = (bf16_t*)(ws + WS_WB); bf16_t* WOUT = (bf16_t*)(ws + WS_WOUT);
    bf16_t* WGU = (bf16_t*)(ws + WS_WGU); bf16_t* WD = (bf16_t*)(ws + WS_WD);
    bf16_t* HB = (bf16_t*)(ws + WS_H); bf16_t* QKV = (bf16_t*)(ws + WS_QKV);
    bf16_t* GA = (bf16_t*)(ws + WS_GATES); unsigned char* R8 = ws + WS_GATES + 64 * MiB; unsigned char* H8 = ws + WS_GATES + 96 * MiB; unsigned char* WG8 = ws + WS_WIN;
    unsigned char* Q8 = ws + WS_WGU + 64 * MiB; unsigned char* K8 = ws + WS_WGU + 80 * MiB; unsigned char* V8T = ws + WS_WGU + 84 * MiB;
    bf16_t* DELTA = (bf16_t*)(ws + WS_GATES);
    bf16_t* MERGED = (bf16_t*)(ws + WS_QKV); bf16_t* HMID = (bf16_t*)(ws + WS_QKV); bf16_t* YBUF = (bf16_t*)(ws + WS_YBUF);

    { PH_IDS(); for (int u = tid; u < (LDS_BYTES - LDSCTL_OFF) / 4; u += 512) ((LAS unsigned*)(lds + LDSCTL_OFF))[u] = 0u; }
    __syncthreads();
    const bool use_bar = (MK_N_LAUNCHES != NPHASE);
    XcdBarrier bar; bar.bar = ctl + CW_BAR + args.li * XCD_BAR_WORDS; bar.x = 0; bar.st = nullptr;
    if (use_bar) bar = xcd_barrier_post(ctl + CW_BAR + args.li * XCD_BAR_WORDS, MISC + 8);
    const int lo = args.ph_lo, hi = args.ph_hi;
#ifndef PHASE_MASK
#define PHASE_MASK 0xFFF
#endif
#define IN(k) (((PHASE_MASK >> (k)) & 1) && lo <= (k) && (k) < hi)
#define SEAM(k) do { if (IN(k) && IN((k) + 1)) xcd_barrier(bar); } while (0)

    if (IN(0)) {
        PH_IDS();
        LAS float* scr = (LAS float*)(lds + RING_OFF + wave * 16384);
        if (vcu < 96) {
            LAS float* sl = (LAS float*)(lds + RING_OFF);
            for (int i = tid; i < 4096; i += 512) { const float cv = cvec[i]; sl[i] = cv * sigmoidf_fast(cv); }
            __syncthreads();
        }
        for (int it = vcu; it < 96; it += G) {
            const LAS float* sl = (const LAS float*)(lds + RING_OFF);
            const int col = it * 64 + lane; float a0 = 0.f, a1 = 0.f, a2 = 0.f, a3 = 0.f;
#pragma unroll 16
            for (int dd = 0; dd < 128; ++dd) { const int d = wave * 128 + dd; const float w = w_ada[(size_t)d * 6144 + col];
                a0 += sl[d] * w; a1 += sl[1024 + d] * w; a2 += sl[2048 + d] * w; a3 += sl[3072 + d] * w; }
            LAS float* part = (LAS float*)(lds + RING_OFF + 8 * 16384 - 8192);
            part[(wave * 4 + 0) * 64 + lane] = a0; part[(wave * 4 + 1) * 64 + lane] = a1; part[(wave * 4 + 2) * 64 + lane] = a2; part[(wave * 4 + 3) * 64 + lane] = a3;
            __syncthreads();
            if (tid < 256) { const int bb = tid >> 6, l = tid & 63; float s = 0.f;
#pragma unroll
                for (int w = 0; w < 8; ++w) s += part[(w * 4 + bb) * 64 + l];
                MOD[bb * 6144 + it * 64 + l] = s + b_ada[it * 64 + l]; }
            __syncthreads();
        }
        for (int it = gw; it < N_SMALL_ITEMS; it += NGW) { CONV_ITEM(it); }
    }
    SEAM(0);

    if (IN(1)) {
        PH_IDS();
        f32x4 gnv[4], nx[4];
#pragma unroll
        for (int j = 0; j < 4; ++j) { gnv[j] = *(const f32x4*)(norm1_g + 4 * lane + 256 * j); nx[j] = __builtin_nontemporal_load((const f32x4*)(x + (size_t)gw * DMODEL) + lane + 64 * j); }
        for (int m = gw; m < MT; m += NGW) { const int b = m >> 13; const float* mb = MOD + b * 6144;
            f32x4 v[4], scv[4], shv[4]; float s = 0.f;
#pragma unroll
            for (int j = 0; j < 4; ++j) { v[j] = nx[j]; scv[j] = *(const f32x4*)(mb + 1024 + 4 * lane + 256 * j); shv[j] = *(const f32x4*)(mb + 4 * lane + 256 * j); }
            const int mn = (m + NGW < MT) ? m + NGW : m;
#pragma unroll
            for (int j = 0; j < 4; ++j) nx[j] = __builtin_nontemporal_load((const f32x4*)(x + (size_t)mn * DMODEL) + lane + 64 * j);
#pragma unroll
            for (int j = 0; j < 4; ++j) s += (v[j].x * v[j].x + v[j].y * v[j].y) + (v[j].z * v[j].z + v[j].w * v[j].w);
            const float rinv = __builtin_amdgcn_rsqf(wave_sum(s) * (1.f / DMODEL) + EPS);
#pragma unroll
            for (int j = 0; j < 4; ++j) {
                const f32x4 hv = v[j] * rinv * gnv[j] * (scv[j] + 1.0f) + shv[j];
                ((unsigned*)(H8 + (size_t)m * DMODEL) + lane)[64 * j] = pk4_fp8(hv.x * F8_SC_H2, hv.y * F8_SC_H2, hv.z * F8_SC_H2, hv.w * F8_SC_H2); }
        }
    }
    SEAM(1);

#define ATTN_BOUND() float smaxp; { const int l_ = fresh_tid() & 63; float mq_ = fabsf(q_norm_g[l_]), mk_ = fabsf(k_norm_g[l_]); \
        _Pragma("unroll") for (int o_ = 1; o_ < 64; o_ <<= 1) { mq_ = fmaxf(mq_, __shfl_xor(mq_, o_)); mk_ = fmaxf(mk_, __shfl_xor(mk_, o_)); } smaxp = LOG2E * 8.0f * mq_ * mk_; } \
        const bool fast = __builtin_amdgcn_readfirstlane((int)(smaxp <= 24.0f)) != 0
    if (IN(2)) {
        ATTN_BOUND();
        { pg8::SchedPlain S; S.init(MT, NIN, G, bx, H8, DMODEL, WG8, DMODEL);
          pg8::EpiHeadGate E{pg8::EpiProj{QKV, Q8, K8, V8T, q_norm_g, k_norm_g, !fast}, pg8::EpiGate{GA, R8}};
          pg8::gemm_phase<true>(lds + RING_OFF, 8, S, E); }
    }
    SEAM(2);


    if (IN(4)) {
        PH_IDS();
#define CONV_EXPERTS() do { conv_experts_pipelined(gw, N_EXP_ITEMS, NGW, lane, (LAS float*)(lds + RING_OFF + wave * 16384), w_eg, w_eu, w_ed, (unsigned char*)WGU, (unsigned char*)WD); __syncthreads(); } while (0)
        const int cls = vcu & 3;
        if (cls == 0) CONV_EXPERTS();
        if (G == 256) na_body::na_phase(lds + RING_OFF, (LAS float*)(lds + NABIAS_OFF), (LAS float*)(lds + NAXCH_OFF), QKV, HB, na_rpb, vcu);
        if (cls == 1) CONV_EXPERTS();
        static_assert(attn_body::ATTN_LDS_BYTES <= RING_BYTES, "attention LDS");
        ATTN_BOUND(); const float shiftv = fmaxf(smaxp - 8.0f, 0.0f);
        for (int i = 0; i < 4; ++i) { const long L = (long)i * G + vcu; if (L >= 1024) break;
            if ((cls == 2 && i == 1) || (cls == 3 && i == 2)) { PH_IDS(); CONV_EXPERTS(); }
            const int ii = (int)(L >> 8), v = (int)(L & 255), bh = v >> 3, qb = (v & 7) * 4 + ii, b = bh >> 3, h = bh & 7;
            const attn_body::bf16* base = (const attn_body::bf16*)QKV + (size_t)b * SEQ * NQKV;
            if (fast) attn_body::attn_unit_f8(qb, Q8 + (size_t)b * SEQ * 512 + h * 64, K8 + (size_t)b * SEQ * 128 + (h >> 2) * 64, V8T + (size_t)(b * 2 + (h >> 2)) * 64 * SEQ,
                                    (attn_body::bf16*)HB + (size_t)b * SEQ * DMODEL + 512 + h * 64, (char*)lds_raw + RING_OFF, shiftv);
            else attn_body::attn_unit<8>(qb, base + C_QG + h * 64, base + C_KG + (h >> 2) * 64, base + C_VG + (h >> 2) * 64,
                                    (attn_body::bf16*)HB + (size_t)b * SEQ * DMODEL + 512 + h * 64, (char*)lds_raw + RING_OFF); }
#undef CONV_EXPERTS
    }
    SEAM(4);

    if (IN(5)) {
        pg8::SchedPlain S; S.init(MT, DMODEL, G, bx, HB + 512, DMODEL * 2, WB, 512 * 2); S.A2 = (const char*)HB; S.B2 = (const char*)WA; S.nt1 = 8;
        pg8::EpiMerge E{MERGED, GA, R8};
        pg8::gemm_phase<false, pg8::EpiMerge, pg8::SchedPlain, true>(lds + RING_OFF, 16, S, E);
    }
    SEAM(5);

    if (IN(6)) {
        pg8::SchedPlain S; S.init(MT, DMODEL, G, bx, MERGED, DMODEL * 2, WOUT, DMODEL * 2);
        pg8::EpiDelta E{DELTA, MOD};
        pg8::gemm_phase<false>(lds + RING_OFF, 16, S, E);
    }
    SEAM(6);

    if (IN(7)) {
        PH_IDS();
        LAS float* wr = (LAS float*)(lds + RING_OFF);
        for (int i = tid; i < 16384; i += 512) { const int d = i >> 4, e = i & 15; wr[e * 1024 + d] = w_router[i]; }
        __syncthreads();
        f32x4 nv[2][4]; u32x2 nd[2][4];
#define P7_LOADX(row_) do { const f32x4* p_ = (const f32x4*)(x + (size_t)(row_) * DMODEL) + lane; const u32x2* d_ = (const u32x2*)(DELTA + (size_t)(row_) * DMODEL) + lane; \
            _Pragma("unroll") for (int j_ = 0; j_ < 4; ++j_) { nv[0][j_] = __builtin_nontemporal_load(&p_[64 * j_]); nv[1][j_] = __builtin_nontemporal_load(&p_[256 + 64 * j_]); \
                nd[0][j_] = d_[64 * j_]; nd[1][j_] = d_[256 + 64 * j_]; } } while (0)
        P7_LOADX(gw * 2);
        for (int m = gw * 2; m < MT; m += NGW * 2) { const int b = m >> 13; const float* mb = MOD + b * 6144;
            f32x4 v[2][4], gnv[4], scv[4], shv[4]; float s0 = 0.f, s1 = 0.f;
            const int mn = (m + NGW * 2 < MT) ? m + NGW * 2 : m;
#pragma unroll
            for (int j = 0; j < 4; ++j) { const int col = 4 * lane + 256 * j;
#pragma unroll
                for (int r = 0; r < 2; ++r) { const u32x2 dd = nd[r][j]; v[r][j] = nv[r][j] + (f32x4){bf_lo(dd.x), bf_hi(dd.x), bf_lo(dd.y), bf_hi(dd.y)}; }
                gnv[j] = *(const f32x4*)(norm2_g + col); scv[j] = *(const f32x4*)(mb + 4096 + col); shv[j] = *(const f32x4*)(mb + 3072 + col); }
            P7_LOADX(mn);
            asm volatile("" ::: "memory");
#pragma unroll
            for (int j = 0; j < 4; ++j) {
                s0 += (v[0][j].x * v[0][j].x + v[0][j].y * v[0][j].y) + (v[0][j].z * v[0][j].z + v[0][j].w * v[0][j].w);
                s1 += (v[1][j].x * v[1][j].x + v[1][j].y * v[1][j].y) + (v[1][j].z * v[1][j].z + v[1][j].w * v[1][j].w); }
            s0 = wave_sum(s0); s1 = wave_sum(s1);
            const float rinv0 = __builtin_amdgcn_rsqf(s0 * (1.f / DMODEL) + EPS), rinv1 = __builtin_amdgcn_rsqf(s1 * (1.f / DMODEL) + EPS);
#pragma unroll
            for (int j = 0; j < 4; ++j) {
                const f32x4 a = gnv[j] * (scv[j] + 1.0f);
                v[0][j] = v[0][j] * rinv0 * a + shv[j]; v[1][j] = v[1][j] * rinv1 * a + shv[j];
                ((unsigned*)((unsigned char*)HB + (size_t)m * DMODEL) + lane)[64 * j] = pk4_fp8(v[0][j].x * F8_SC_H2, v[0][j].y * F8_SC_H2, v[0][j].z * F8_SC_H2, v[0][j].w * F8_SC_H2);
                ((unsigned*)((unsigned char*)HB + (size_t)(m + 1) * DMODEL) + lane)[64 * j] = pk4_fp8(v[1][j].x * F8_SC_H2, v[1][j].y * F8_SC_H2, v[1][j].z * F8_SC_H2, v[1][j].w * F8_SC_H2); }
            float pr[32];
#pragma unroll
            for (int e = 0; e < 16; ++e) { float a0 = 0.f, a1 = 0.f;
#pragma unroll
                for (int j = 0; j < 4; ++j) { const f32x4 w = *(const LAS f32x4*)(wr + e * 1024 + 4 * lane + 256 * j);
                    a0 += (v[0][j].x * w.x + v[0][j].y * w.y) + (v[0][j].z * w.z + v[0][j].w * w.w);
                    a1 += (v[1][j].x * w.x + v[1][j].y * w.y) + (v[1][j].z * w.z + v[1][j].w * w.w); }
                pr[e] = a0; pr[16 + e] = a1; if ((e & 3) == 3) asm volatile("" ::: "memory"); }
            float q16[16], q8[8];
#pragma unroll
            for (int i = 0; i < 16; ++i) q16[i] = swap32_sum(pr[i], pr[i + 16]);
#pragma unroll
            for (int i = 0; i < 8; ++i) q8[i] = swap16_sum(q16[i], q16[i + 8]);
            const bool up8 = (lane & 8) != 0, up4 = (lane & 4) != 0, up2 = (lane & 2) != 0;
            float q4[4], q2[2];
#pragma unroll
            for (int i = 0; i < 4; ++i) { float lo = q8[i], hi = q8[i + 4]; asm volatile("" : "+v"(lo), "+v"(hi)); q4[i] = (up8 ? hi : lo) + dppf<DPP_XOR8>(up8 ? lo : hi); }
#pragma unroll
            for (int i = 0; i < 2; ++i) { float lo = q4[i], hi = q4[i + 2]; asm volatile("" : "+v"(lo), "+v"(hi)); q2[i] = (up4 ? hi : lo) + lane_xor4(up4 ? lo : hi); }
            float mylog;
            { float lo = q2[0], hi = q2[1]; asm volatile("" : "+v"(lo), "+v"(hi)); mylog = (up2 ? hi : lo) + dppf<DPP_XOR2>(up2 ? lo : hi); }
            mylog += dppf<DPP_XOR1>(mylog);
            float mx = mylog;
            mx = fmaxf(mx, dppf<DPP_XOR2>(mx)); mx = fmaxf(mx, lane_xor4(mx)); mx = fmaxf(mx, dppf<DPP_XOR8>(mx)); mx = swap16_max(mx);
            const float ex = __expf(mylog - mx); float sum = ex;
            sum += dppf<DPP_XOR2>(sum); sum += lane_xor4(sum); sum += dppf<DPP_XOR8>(sum); sum = swap16_sum(sum, sum);
            if ((lane & 1) == 0) AFF[(unsigned)(m + (lane >> 5)) * 16u + (unsigned)((lane >> 1) & 15)] = ex * __builtin_amdgcn_rcpf(sum);
        }
#undef P7_LOADX
        __syncthreads();
    }
    SEAM(7);

    if (IN(8)) {
        PH_IDS();
        LAS unsigned* vals = (LAS unsigned*)(lds + RING_OFF);
        LAS unsigned* hist = (LAS unsigned*)(lds + RING_OFF + 32768);
        LAS unsigned* sel = (LAS unsigned*)(lds + RING_OFF + 32768 + 1024);
        LAS unsigned* wtot = (LAS unsigned*)(lds + RING_OFF + 32768 + 2048);
        for (int item = vcu; item < 64; item += G) { const int b = item >> 4, e = item & 15;
            __syncthreads();
            for (int k = 0; k < 16; ++k) { const int t = tid + 512 * k; vals[t] = __builtin_bit_cast(unsigned, AFF[((size_t)b * SEQ + t) * 16 + e]); }
            __syncthreads();
            unsigned mv[16];
#pragma unroll
            for (int k = 0; k < 16; ++k) mv[k] = vals[tid + 512 * k];
            unsigned T = 0u;
            for (int bit = 30; bit >= 0; --bit) { const unsigned cand = T | (1u << bit);
                unsigned c = 0u;
#pragma unroll
                for (int k = 0; k < 16; ++k) c += (unsigned)__popcll(__ballot(mv[k] >= cand));
                if (lane == 0) wtot[(bit & 1) * 8 + wave] = c;
                __syncthreads();
                unsigned tot = 0u;
#pragma unroll
                for (int w = 0; w < 8; ++w) tot += wtot[(bit & 1) * 8 + w];
                if (tot >= (unsigned)CAP) T = cand; }
            unsigned cgt = 0u;
#pragma unroll
            for (int k = 0; k < 16; ++k) cgt += (unsigned)__popcll(__ballot(mv[k] > T));
            __syncthreads();
            if (lane == 0) wtot[wave] = cgt;
            __syncthreads();
            unsigned ngt = 0u;
#pragma unroll
            for (int w = 0; w < 8; ++w) ngt += wtot[w];
            const unsigned need_eq = (unsigned)CAP - ngt;
            __syncthreads();
            unsigned cg = 0u, ce = 0u;
            for (int k = 0; k < 16; ++k) { const unsigned v = vals[16 * tid + k]; cg += (v > T) ? 1u : 0u; ce += (v == T) ? 1u : 0u; }
            unsigned packed = cg | (ce << 16), incl = packed;
#pragma unroll
            for (int o = 1; o < 64; o <<= 1) { const unsigned n = __shfl_up(incl, o); if (lane >= o) incl += n; }
            if (lane == 63) wtot[wave] = incl;
            __syncthreads();
            unsigned wbase = 0u;
            for (int w = 0; w < wave; ++w) wbase += wtot[w];
            const unsigned excl = wbase + incl - packed;
            unsigned g_before = excl & 0xffffu, e_before = excl >> 16;
            for (int k = 0; k < 16; ++k) { const int t = 16 * tid + k; const unsigned v = vals[t]; int slot = -1;
                if (v > T) { slot = (int)(g_before + (e_before < need_eq ? e_before : need_eq)); ++g_before; }
                else if (v == T) { if (e_before < need_eq) slot = (int)(g_before + e_before); ++e_before; }
                SLOT[((size_t)b * SEQ + t) * 16 + e] = slot;
                if (slot >= 0) { IDX[item * CAP + slot] = t; GSEL[item * CAP + slot] = __builtin_bit_cast(float, v); } }
        }
        __syncthreads();
    }
    SEAM(8);

    if (IN(9)) {
        pg8::SchedFfn1 S{G, vcu, (const char*)HB, (const char*)WGU, IDX, DMODEL, DMODEL};
        pg8::EpiFfn1 E{(unsigned char*)HMID};
        pg8::gemm_phase<true>(lds + RING_OFF, 8, S, E);
    }
    SEAM(9);

    if (IN(10)) {
        pg8::SchedFfn2 S{G, vcu, (const char*)HMID, (const char*)WD, FF, FF};
        pg8::EpiFfn2 E{(unsigned char*)YBUF, GSEL};
        pg8::gemm_phase<true>(lds + RING_OFF, 16, S, E);
    }
    SEAM(10);

    if (IN(11)) {
        PH_IDS();
        f32x4 fgv[4];
#pragma unroll
        for (int j = 0; j < 4; ++j) fgv[j] = *(const f32x4*)(final_g + 4 * lane + 256 * j);
        f32x4 nx[4]; u32x2 ndl[4]; int nsl;
#define P11_LOADX(row_) do { const f32x4* p_ = (const f32x4*)(x + (size_t)(row_) * DMODEL) + lane; const u32x2* d_ = (const u32x2*)(DELTA + (size_t)(row_) * DMODEL) + lane; \
            _Pragma("unroll") for (int j_ = 0; j_ < 4; ++j_) { nx[j_] = __builtin_nontemporal_load(&p_[64 * j_]); ndl[j_] = __builtin_nontemporal_load(&d_[64 * j_]); } \
            nsl = (lane < 16) ? SLOT[(size_t)(row_) * 16 + lane] : -1; } while (0)
#define P11_ISSUE() do { _Pragma("unroll") for (int k_ = 0; k_ < 4; ++k_) { if (mask) { const int e_ = __builtin_ctz(mask); mask &= mask - 1u; const int s_ = __builtin_amdgcn_readlane(sl, e_); \
                const unsigned* yr_ = (const unsigned*)((const unsigned char*)YBUF + ((size_t)(b * 16 + e_) * CAP + s_) * DMODEL) + lane; _Pragma("unroll") for (int j_ = 0; j_ < 4; ++j_) y[k_][j_] = __builtin_nontemporal_load(&yr_[64 * j_]); } \
            else { _Pragma("unroll") for (int j_ = 0; j_ < 4; ++j_) y[k_][j_] = 0u; } } } while (0)
#define P11_ACC() do { _Pragma("unroll") for (int k_ = 0; k_ < 4; ++k_) _Pragma("unroll") for (int j_ = 0; j_ < 4; ++j_) { const unsigned w_ = y[k_][j_]; \
            const auto lo_ = __builtin_amdgcn_cvt_pk_f32_fp8((int)w_, false), hi_ = __builtin_amdgcn_cvt_pk_f32_fp8((int)w_, true); a[j_].x += lo_[0]; a[j_].y += lo_[1]; a[j_].z += hi_[0]; a[j_].w += hi_[1]; } } while (0)
        P11_LOADX(gw);
        for (int m = gw; m < MT; m += NGW) { const int b = m >> 13; const float* g2 = MOD + b * 6144 + 5120;
            f32x4 v[4], a[4], g2v[4]; const int sl = nsl;
#pragma unroll
            for (int j = 0; j < 4; ++j) { const u32x2 dd = ndl[j]; v[j] = nx[j] + (f32x4){bf_lo(dd.x), bf_hi(dd.x), bf_lo(dd.y), bf_hi(dd.y)}; a[j] = (f32x4){0.f, 0.f, 0.f, 0.f}; g2v[j] = *(const f32x4*)(g2 + 4 * lane + 256 * j) * (1.0f / F8_SC_Y); }
            unsigned mask = (unsigned)__ballot(sl >= 0) & 0xFFFFu;
            const int mn = (m + NGW < MT) ? m + NGW : m;
            unsigned y[4][4];
            P11_ISSUE();
            P11_LOADX(mn);
            P11_ACC();
            while (mask) { P11_ISSUE(); P11_ACC(); }
            float s2 = 0.f;
#pragma unroll
            for (int j = 0; j < 4; ++j) { v[j] = v[j] + g2v[j] * a[j]; s2 += (v[j].x * v[j].x + v[j].y * v[j].y) + (v[j].z * v[j].z + v[j].w * v[j].w); }
            const float rinv = __builtin_amdgcn_rsqf(wave_sum(s2) * (1.f / DMODEL) + EPS);
            f32x4* xr = (f32x4*)(out + (size_t)m * DMODEL) + lane;
#pragma unroll
            for (int j = 0; j < 4; ++j) __builtin_nontemporal_store(v[j] * rinv * fgv[j], &xr[64 * j]);
        }
#undef P11_LOADX
#undef P11_ISSUE
#undef P11_ACC
    }
#undef IN
#undef SEAM
}

extern "C" void kernel_launch(void* const* d_in, const int* in_sizes, int n_in, void* d_out, int out_size, void* d_ws, size_t ws_size, hipStream_t stream) {
    static int grid = 0;
    if (grid == 0) {
        if (n_in != 18 || in_sizes[0] != MT * DMODEL || out_size != MT * DMODEL || ws_size < WS_END) {
            fprintf(stderr, "kernel_launch: unexpected shapes / workspace: n_in %d in0 %d out %d ws %zu (need %zu); nothing launched\n", n_in, n_in > 0 ? in_sizes[0] : -1, out_size, ws_size, (size_t)WS_END); grid = -1; return; }
        int dev = 0, cus = 0, per_cu = 0;
        if (hipGetDevice(&dev) != hipSuccess || hipDeviceGetAttribute(&cus, hipDeviceAttributeMultiprocessorCount, dev) != hipSuccess) { grid = -1; return; }
        if (hipFuncSetAttribute((const void*)mk_fwd, hipFuncAttributeMaxDynamicSharedMemorySize, LDS_BYTES) != hipSuccess) { fprintf(stderr, "kernel_launch: hipFuncSetAttribute failed\n"); grid = -1; return; }
        if (hipOccupancyMaxActiveBlocksPerMultiprocessor(&per_cu, (const void*)mk_fwd, 512, LDS_BYTES) != hipSuccess || per_cu < 1) fprintf(stderr, "kernel_launch: occupancy query reports %d\n", per_cu);
        (void)hipGetLastError();
        grid = cus;
        if (grid != 256) fprintf(stderr, "kernel_launch: %d CUs (expected 256)\n", grid);
    }
    if (grid < 0) return;
    if (hipMemsetAsync((char*)d_ws + WS_CTL, 0, CTL_ZERO_BYTES, stream) != hipSuccess) return;
    Args a{};
    for (int i = 0; i < 18; ++i) a.in[i] = (const float*)d_in[i];
    a.out = (float*)d_out; a.ws = (unsigned char*)d_ws;
#ifndef PROBE_DUP
#define PROBE_DUP -1
#endif
    constexpr int NL = (PROBE_DUP >= 0) ? 2 : MK_N_LAUNCHES;
    for (int li = 0; li < NL; ++li) {
        if (PROBE_DUP >= 0) { a.ph_lo = li == 0 ? 0 : PROBE_DUP; a.ph_hi = li == 0 ? PROBE_DUP + 1 : NPHASE; }
        else { a.ph_lo = (NL == NPHASE) ? li : (li * NPHASE) / NL; a.ph_hi = (NL == NPHASE) ? li + 1 : ((li + 1) * NPHASE) / NL; }
        a.li = li; a.pad = 0;
        hipLaunchKernelGGL(mk_fwd, dim3(grid), dim3(512), LDS_BYTES, stream, a);
        const hipError_t le = hipPeekAtLastError();
        if (le != hipSuccess) { fprintf(stderr, "kernel_launch: launch %d failed: %s\n", li, hipGetErrorName(le)); break; }
    }
}
```

```cpp
#include <hip/hip_runtime.h>
#include <hip/hip_bf16.h>
#include <cstdio>
#include <cstdint>

#ifndef MK_N_LAUNCHES
#define MK_N_LAUNCHES 1
#endif

#define LAS __attribute__((address_space(3)))
#define GAS __attribute__((address_space(1)))
typedef unsigned short bf16_t;
typedef short bf16x8 __attribute__((ext_vector_type(8)));
typedef short s16x4 __attribute__((ext_vector_type(4)));
typedef float f32x4 __attribute__((ext_vector_type(4)));
typedef float f32x2 __attribute__((ext_vector_type(2)));
typedef float f32x16 __attribute__((ext_vector_type(16)));
typedef unsigned u32x4 __attribute__((ext_vector_type(4)));
typedef unsigned u32x2 __attribute__((ext_vector_type(2)));
typedef int v8i __attribute__((ext_vector_type(8)));
typedef int v4i __attribute__((ext_vector_type(4)));

constexpr int BATCH = 4, SEQ = 8192, DMODEL = 1024, MT = BATCH * SEQ;
constexpr int NQKV = 2304, NGATE = 2048, NIN = 4352;
constexpr int C_QNA = 0, C_KNA = 512, C_VNA = 1024, C_QG = 1536, C_KG = 2048, C_VG = 2176;
constexpr int NEXP = 16, CAP = 1024, FF = 2048;
constexpr float EPS = 1e-6f;
constexpr float LOG2E = 1.4426950408889634f;
constexpr float C2 = 0.125f * LOG2E;

__device__ __forceinline__ unsigned f2bf(float f) { unsigned u = __builtin_bit_cast(unsigned, f); return (u + 0x7fffu + ((u >> 16) & 1u)) >> 16; }
__device__ __forceinline__ unsigned pk2(float lo, float hi) { return f2bf(lo) | (f2bf(hi) << 16); }
__device__ __forceinline__ float bf_lo(unsigned w) { return __builtin_bit_cast(float, w << 16); }
__device__ __forceinline__ float bf_hi(unsigned w) { return __builtin_bit_cast(float, w & 0xffff0000u); }
__device__ __forceinline__ unsigned cvt_pk_bf16(float lo, float hi) { unsigned r; asm volatile("v_cvt_pk_bf16_f32 %0, %1, %2" : "=v"(r) : "v"(lo), "v"(hi)); return r; }
__device__ __forceinline__ unsigned pk4_fp8(float a, float b, float c, float d) {
    a = __builtin_amdgcn_fmed3f(a, -448.f, 448.f); b = __builtin_amdgcn_fmed3f(b, -448.f, 448.f); c = __builtin_amdgcn_fmed3f(c, -448.f, 448.f); d = __builtin_amdgcn_fmed3f(d, -448.f, 448.f);
    int w = 0; w = __builtin_amdgcn_cvt_pk_fp8_f32(a, b, w, false); w = __builtin_amdgcn_cvt_pk_fp8_f32(c, d, w, true); return (unsigned)w; }
__device__ __forceinline__ unsigned pk4_fp8_nc(float a, float b, float c, float d) { int w = 0; w = __builtin_amdgcn_cvt_pk_fp8_f32(a, b, w, false); w = __builtin_amdgcn_cvt_pk_fp8_f32(c, d, w, true); return (unsigned)w; }
constexpr float F8_SC_H2 = 8.0f, F8_SC_W = 64.0f, F8_SC_HMID = 4.0f, F8_SC_GA = 256.0f, F8_SC_R = 2.0f, F8_SC_Y = 32.0f;
__device__ __forceinline__ float sigmoidf_fast(float v) { return __builtin_amdgcn_rcpf(1.0f + __builtin_amdgcn_exp2f(-v * LOG2E)); }
__device__ __forceinline__ int fresh_tid() { int t = threadIdx.x; asm volatile("" : "+v"(t)); return t; }
template <int CTRL> __device__ __forceinline__ float dppf(float x) { return __builtin_bit_cast(float, __builtin_amdgcn_mov_dpp(__builtin_bit_cast(int, x), CTRL, 0xf, 0xf, true)); }
constexpr int DPP_XOR1 = 0xB1, DPP_XOR2 = 0x4E, DPP_XOR3 = 0x1B, DPP_XOR7 = 0x141, DPP_XOR8 = 0x128;
__device__ __forceinline__ float lane_xor4(float x) { return dppf<DPP_XOR3>(dppf<DPP_XOR7>(x)); }
__device__ __forceinline__ float swap16_sum(float a, float b) { asm("s_nop 1\n\tv_permlane16_swap_b32 %0, %1" : "+v"(a), "+v"(b)); return a + b; }
__device__ __forceinline__ float swap32_sum(float a, float b) { asm("s_nop 1\n\tv_permlane32_swap_b32 %0, %1" : "+v"(a), "+v"(b)); return a + b; }
__device__ __forceinline__ float swap16_max(float a) { float b = a; asm("s_nop 1\n\tv_permlane16_swap_b32 %0, %1" : "+v"(a), "+v"(b)); return fmaxf(a, b); }
__device__ __forceinline__ float swap32_max(float a) { float b = a; asm("s_nop 1\n\tv_permlane32_swap_b32 %0, %1" : "+v"(a), "+v"(b)); return fmaxf(a, b); }
__device__ __forceinline__ float wave_sum(float v) {
    v += dppf<DPP_XOR1>(v); v += dppf<DPP_XOR2>(v); v += lane_xor4(v); v += dppf<DPP_XOR8>(v);
    v = swap16_sum(v, v); return swap32_sum(v, v);
}

__constant__ float INV_FREQ_D[16] = {1.0f, 0.5623413251903491f, 0.31622776601683794f, 0.1778279410038923f, 0.1f, 0.05623413251903491f, 0.03162277660168379f, 0.01778279410038923f,
                                     0.01f, 0.005623413251903491f, 0.0031622776601683794f, 0.001778279410038923f, 0.001f, 0.0005623413251903491f, 0.00031622776601683794f, 0.0001778279410038923f};
namespace pg8 {
constexpr int BM = 256, BK = 64, HALF = 128, HTB = HALF * BK * 2, STAGE_BYTES = 8 * HTB, NXCD = 8, WGM = 8;
__host__ __device__ __forceinline__ int lds_byte(int r, int c) { const int st = (r >> 4) * 2 + (c >> 5), rr = r & 15, cc = c & 31, ob = rr * 64 + cc * 2; return st * 1024 + (ob ^ (((ob >> 9) & 1) << 5)); }
__host__ __device__ __forceinline__ void stage_rc(int b, int& R, int& C) { const int st = b / 1024, sb = b % 1024, swz = sb ^ (((sb >> 9) & 1) << 5); R = (st >> 1) * 16 + swz / 64; C = (st & 1) * 32 + (swz % 64) / 2; }
__host__ __device__ __forceinline__ int perm32(int rho) { const int n = rho >> 4, i = rho & 15; return 8 * (i >> 2) + 4 * n + (i & 3); }

struct Unit { int pm, pn, g; };

struct SchedPlain {
    int nM, nN, nwg, G, c; const char* A; const char* B; unsigned lda, ldb;
    static constexpr bool GATHER = false;
    __device__ void init(int M, int N, int G_, int c_, const void* A_, unsigned lda_, const void* B_, unsigned ldb_) { nM = M / BM; nN = N / BM; nwg = nM * nN; G = G_; c = c_; A = (const char*)A_; B = (const char*)B_; lda = lda_; ldb = ldb_; }
    __device__ bool next(int i, Unit& u) const {
        const long L = (long)i * G + c; if (L >= nwg) return false;
        int wgid = (int)L; { const int q = nwg / NXCD, r = nwg % NXCD, xcd = wgid % NXCD, off = wgid / NXCD; wgid = (xcd < r ? xcd * (q + 1) : r * (q + 1) + (xcd - r) * q) + off; }
        const int nig = WGM * nN, gid = wgid / nig, fm = gid * WGM, gsz = (nM - fm) < WGM ? (nM - fm) : WGM;
        u.pm = fm + ((wgid % nig) % gsz); u.pn = (wgid % nig) / gsz; u.g = 0; return true;
    }
    __device__ __forceinline__ const char* a_ptr(const Unit& u) const { return A + (size_t)u.pm * BM * lda; }
    __device__ __forceinline__ const char* b_ptr(const Unit& u) const { return B + (size_t)u.pn * BM * ldb; }
    __device__ __forceinline__ const int* rows(const Unit&) const { return nullptr; }
    const char* A2 = nullptr; const char* B2 = nullptr; int nt1 = 0;
    __device__ __forceinline__ const char* a_ptr2(const Unit& u) const { return A2 + (size_t)u.pm * BM * lda; }
    __device__ __forceinline__ const char* b_ptr2(const Unit& u) const { return B2 + (size_t)u.pn * BM * ldb; }
};
struct SchedGate {
    int G, c; const char* A; const char* B; unsigned lda, ldb;
    static constexpr bool GATHER = false;
    __device__ bool next(int i, Unit& u) const {
        int id;
        if (G == 256) { if (c < 128) { if (i >= 3) return false; id = c * 3 + i; } else { if (i >= 5) return false; id = 384 + (c - 128) * 5 + i; } }
        else { const long L = (long)i * G + c; if (L >= 1024) return false; id = (int)L; }
        u.pm = id >> 3; u.pn = id & 7; u.g = 0; return true;
    }
    __device__ __forceinline__ const char* a_ptr(const Unit& u) const { return A + (size_t)u.pm * BM * lda; }
    __device__ __forceinline__ const char* b_ptr(const Unit& u) const { return B + (size_t)u.pn * BM * ldb; }
    __device__ __forceinline__ const int* rows(const Unit&) const { return nullptr; }
};
struct SchedFfn1 {
    int G, vcu; const char* A; const char* B; const int* idx; unsigned lda, ldb;
    static constexpr bool GATHER = true;
    __device__ bool next(int i, Unit& u) const {
        const long L = (long)i * G + vcu; if (L >= 4096) return false;
        const int ii = (int)(L >> 8), v = (int)(L & 255), x = v >> 5, c = v & 31;
        const int e = 2 * x + (ii >> 3), b = (ii & 7) >> 1, half = ii & 1;
        u.g = b * 16 + e; u.pm = c & 3; u.pn = half * 8 + (c >> 2); return true;
    }
    __device__ __forceinline__ const char* a_ptr(const Unit& u) const { return A + (size_t)(u.g >> 4) * SEQ * lda; }
    __device__ __forceinline__ const char* b_ptr(const Unit& u) const { return B + ((size_t)(u.g & 15) * 4096 + (size_t)u.pn * BM) * ldb; }
    __device__ __forceinline__ const int* rows(const Unit& u) const { return idx + u.g * CAP + u.pm * BM; }
};
struct SchedFfn2 {
    int G, vcu; const char* A; const char* B; unsigned lda, ldb;
    static constexpr bool GATHER = false;
    __device__ bool next(int i, Unit& u) const {
        const long L = (long)i * G + vcu; if (L >= 1024) return false;
        const int ii = (int)(L >> 8), v = (int)(L & 255), x = v >> 5, c = v & 31;
        const int e = 2 * x + (ii >> 1), b = 2 * (ii & 1) + (c >> 4);
        u.g = b * 16 + e; u.pm = (c & 15) >> 2; u.pn = c & 3; return true;
    }
    __device__ __forceinline__ const char* a_ptr(const Unit& u) const { return A + ((size_t)u.g * CAP + (size_t)u.pm * BM) * lda; }
    __device__ __forceinline__ const char* b_ptr(const Unit& u) const { return B + ((size_t)(u.g & 15) * 1024 + (size_t)u.pn * BM) * ldb; }
    __device__ __forceinline__ const int* rows(const Unit&) const { return nullptr; }
};

typedef f32x4 Acc[2][2][4][2];

struct EpiProj {
    static constexpr bool PERM = true;
    bf16_t* QKV; unsigned char* Q8; unsigned char* K8; unsigned char* V8T; const float* qg; const float* kg; bool gqa_bf16;
    __device__ __forceinline__ void operator()(const Acc& acc, const Unit& u, int wr, int wc, int fr_, int fq_) const { run<false>(acc, u, wr, wc, fr_, fq_); }
    template <bool ASC8> __device__ __forceinline__ void run(const Acc& acc, const Unit& u, int wr, int wc, int fr_, int fq_) const {
        constexpr float asc = ASC8 ? 1.0f / (F8_SC_H2 * F8_SC_W) : 1.0f;
        int fr = fr_, fq = fq_; asm volatile("" : "+v"(fr), "+v"(fq));
        const int row0 = u.pm * BM + wr * 64 + fr;
        if (u.pn < 6) {
            const int col0 = u.pn * BM + wc * 32 + 8 * fq;
            const float sc = ((u.pn < 2) ? 0.125f : 1.0f) * asc;
#pragma unroll
            for (int ai = 0; ai < 2; ++ai)
#pragma unroll
                for (int m = 0; m < 4; ++m) { bf16_t* rowp = QKV + (size_t)(row0 + ai * HALF + m * 16) * NQKV + col0;
#pragma unroll
                    for (int bj = 0; bj < 2; ++bj) { const f32x4 v0 = acc[ai][bj][m][0] * sc, v1 = acc[ai][bj][m][1] * sc;
                        u32x4 w; w.x = cvt_pk_bf16(v0[0], v0[1]); w.y = cvt_pk_bf16(v0[2], v0[3]); w.z = cvt_pk_bf16(v1[0], v1[1]); w.w = cvt_pk_bf16(v1[2], v1[3]);
                        *(u32x4*)(rowp + bj * HALF) = w; } }
            return;
        }
        const int colb = u.pn * BM + wc * 64 + 8 * fq;
        const bool isv = (u.pn == 8) && (wc >= 2), isq = u.pn < 8;
        if (isv) {
            const int kvh = wc - 2;
#pragma unroll
            for (int ai = 0; ai < 2; ++ai)
#pragma unroll
                for (int m = 0; m < 4; ++m) { const int tok = row0 + ai * HALF + m * 16; bf16_t* rowp = QKV + (size_t)tok * NQKV + colb;
                    const int b = tok >> 13, t = tok & (SEQ - 1), kap = t & 63;
                    const int pos = 32 * ((kap >> 2) & 1) + 16 * (kap >> 5) + (kap & 3) + 4 * ((kap & 31) >> 3);
                    unsigned char* vt = V8T + ((size_t)(b * 2 + kvh) * SEQ + (size_t)(t & ~63)) * 64 + (8 * fq) * 64 + pos;
#pragma unroll
                    for (int bj = 0; bj < 2; ++bj) { const f32x4 v0 = acc[ai][bj][m][0] * asc, v1 = acc[ai][bj][m][1] * asc;
                        if (gqa_bf16) { u32x4 w; w.x = cvt_pk_bf16(v0[0], v0[1]); w.y = cvt_pk_bf16(v0[2], v0[3]); w.z = cvt_pk_bf16(v1[0], v1[1]); w.w = cvt_pk_bf16(v1[2], v1[3]);
                            *(u32x4*)(rowp + bj * 32) = w; }
                        const unsigned p0 = pk4_fp8(v0[0] * 8.f, v0[1] * 8.f, v0[2] * 8.f, v0[3] * 8.f), p1 = pk4_fp8(v1[0] * 8.f, v1[1] * 8.f, v1[2] * 8.f, v1[3] * 8.f);
#pragma unroll
                        for (int i = 0; i < 4; ++i) { vt[(32 * bj + i) * 64] = (unsigned char)(p0 >> (8 * i)); vt[(32 * bj + 4 + i) * 64] = (unsigned char)(p1 >> (8 * i)); } } }
            return;
        }
        const float* gp = (isq ? qg : kg) + 8 * fq;
        float frq[2][2];
#pragma unroll
        for (int n = 0; n < 2; ++n)
#pragma unroll
            for (int k = 0; k < 2; ++k) frq[n][k] = INV_FREQ_D[4 * fq + 2 * n + k] * 0.15915494309189535f;
        f32x4 gn[2][2];
#pragma unroll
        for (int bj = 0; bj < 2; ++bj) { gn[bj][0] = *(const f32x4*)(gp + 32 * bj); gn[bj][1] = *(const f32x4*)(gp + 32 * bj + 4); }
        const float osc = isq ? C2 : 1.0f, f8s = isq ? 32.0f : 8.0f;
        const int head = isq ? (u.pn - 6) * 4 + wc : wc;
#pragma unroll
        for (int ai = 0; ai < 2; ++ai)
#pragma unroll
            for (int m = 0; m < 4; ++m) { const int tok = row0 + ai * HALF + m * 16; const int t = tok & (SEQ - 1);
                float ss = 0.f;
#pragma unroll
                for (int bj = 0; bj < 2; ++bj)
#pragma unroll
                    for (int n = 0; n < 2; ++n) { const f32x4 v = acc[ai][bj][m][n]; ss += (v[0] * v[0] + v[1] * v[1]) + (v[2] * v[2] + v[3] * v[3]); }
                ss += __shfl_xor(ss, 16); ss += __shfl_xor(ss, 32);
                const float rinv = asc * __builtin_amdgcn_rsqf(ss * (asc * asc / 64.f) + EPS);
                bf16_t* rowp = QKV + ((unsigned)tok * (unsigned)NQKV + (unsigned)colb);
#pragma unroll
                for (int bj = 0; bj < 2; ++bj) { const float pos = (float)(bj == 0 ? (t >> 6) : (t & 63));
                    float ov[8];
#pragma unroll
                    for (int n = 0; n < 2; ++n)
#pragma unroll
                        for (int k = 0; k < 2; ++k) { float rev = pos * frq[n][k]; rev = rev - floorf(rev);
                            const float sn = __builtin_amdgcn_sinf(rev), cs = __builtin_amdgcn_cosf(rev);
                            const float y0 = acc[ai][bj][m][n][2 * k] * rinv * gn[bj][n][2 * k], y1 = acc[ai][bj][m][n][2 * k + 1] * rinv * gn[bj][n][2 * k + 1];
                            ov[4 * n + 2 * k] = (y0 * cs - y1 * sn) * osc; ov[4 * n + 2 * k + 1] = (y0 * sn + y1 * cs) * osc; }
                    if (gqa_bf16) { u32x4 w; w.x = cvt_pk_bf16(ov[0], ov[1]); w.y = cvt_pk_bf16(ov[2], ov[3]); w.z = cvt_pk_bf16(ov[4], ov[5]); w.w = cvt_pk_bf16(ov[6], ov[7]);
                        *(u32x4*)(rowp + bj * 32) = w; }
                    u32x2 f8; f8.x = pk4_fp8(ov[0] * f8s, ov[1] * f8s, ov[2] * f8s, ov[3] * f8s); f8.y = pk4_fp8(ov[4] * f8s, ov[5] * f8s, ov[6] * f8s, ov[7] * f8s);
                    if (isq) *(u32x2*)(Q8 + ((unsigned)tok * 512u + (unsigned)(head * 64 + 32 * bj + 8 * fq))) = f8;
                    else     *(u32x2*)(K8 + ((unsigned)tok * 128u + (unsigned)(head * 64 + 32 * bj + 8 * fq))) = f8; }
                __builtin_amdgcn_sched_barrier(0); }
    }
};
struct EpiGate {
    static constexpr bool PERM = true;
    bf16_t* GA; unsigned char* R8;
    __device__ __forceinline__ void operator()(const Acc& acc, const Unit& u, int wr, int wc, int fr, int fq) const {
        const size_t row0 = (size_t)u.pm * BM + wr * 64 + fr; const int col0 = u.pn * HALF + wc * 32 + 8 * fq;
        constexpr float inv = -LOG2E / (F8_SC_H2 * F8_SC_W);
#pragma unroll
        for (int ai = 0; ai < 2; ++ai)
#pragma unroll
            for (int m = 0; m < 4; ++m) { const size_t off = (row0 + ai * HALF + m * 16) * DMODEL + col0;
                float ga[8], rr[8];
#pragma unroll
                for (int n = 0; n < 2; ++n)
#pragma unroll
                    for (int i = 0; i < 4; ++i) { const float ea = 1.0f + __builtin_amdgcn_exp2f(acc[ai][0][m][n][i] * inv), eb = 1.0f + __builtin_amdgcn_exp2f(acc[ai][1][m][n][i] * inv);
                        ga[n * 4 + i] = __builtin_amdgcn_rcpf(ea); rr[n * 4 + i] = ea * __builtin_amdgcn_rcpf(eb) * F8_SC_R; }
                u32x4 w; w.x = cvt_pk_bf16(ga[0], ga[1]); w.y = cvt_pk_bf16(ga[2], ga[3]); w.z = cvt_pk_bf16(ga[4], ga[5]); w.w = cvt_pk_bf16(ga[6], ga[7]); *(u32x4*)(GA + off) = w;
                u32x2 q; q.x = pk4_fp8(rr[0], rr[1], rr[2], rr[3]); q.y = pk4_fp8(rr[4], rr[5], rr[6], rr[7]); *(u32x2*)(R8 + off) = q; }
    }
};
struct EpiHeadGate {
    static constexpr bool PERM = true;
    EpiProj P; EpiGate Gt;
    __device__ __forceinline__ void operator()(const Acc& acc, const Unit& u, int wr, int wc, int fr, int fq) const {
        Unit v = u;
        if (u.pn < 9) { P.run<true>(acc, v, wr, wc, fr, fq); }
        else { v.pn = u.pn - 9; Gt(acc, v, wr, wc, fr, fq); }
    }
};
struct EpiMerge {
    static constexpr bool PERM = true;
    bf16_t* MERGED; const bf16_t* GA; const unsigned char* R8;
    __device__ __forceinline__ void mid(Acc& acc, const Unit& u, int wr, int wc, int fr, int fq) const {
        const int row0 = u.pm * BM + wr * 64 + fr, col0 = u.pn * BM + wc * 32 + 8 * fq;
        u32x2 rq[2][4][2];
#pragma unroll
        for (int ai = 0; ai < 2; ++ai)
#pragma unroll
            for (int m = 0; m < 4; ++m)
#pragma unroll
                for (int bj = 0; bj < 2; ++bj) rq[ai][m][bj] = *(const u32x2*)(R8 + (size_t)(row0 + ai * HALF + m * 16) * DMODEL + col0 + bj * HALF);
        asm volatile("" ::: "memory");
#pragma unroll
        for (int ai = 0; ai < 2; ++ai)
#pragma unroll
            for (int m = 0; m < 4; ++m) {
#pragma unroll
                for (int bj = 0; bj < 2; ++bj) { const u32x2 q = rq[ai][m][bj];
                    const auto a = __builtin_amdgcn_cvt_pk_f32_fp8((int)q.x, false), b = __builtin_amdgcn_cvt_pk_f32_fp8((int)q.x, true), c = __builtin_amdgcn_cvt_pk_f32_fp8((int)q.y, false), d = __builtin_amdgcn_cvt_pk_f32_fp8((int)q.y, true);
                    constexpr float k = 1.0f / F8_SC_R;
                    acc[ai][bj][m][0][0] *= a[0] * k; acc[ai][bj][m][0][1] *= a[1] * k; acc[ai][bj][m][0][2] *= b[0] * k; acc[ai][bj][m][0][3] *= b[1] * k;
                    acc[ai][bj][m][1][0] *= c[0] * k; acc[ai][bj][m][1][1] *= c[1] * k; acc[ai][bj][m][1][2] *= d[0] * k; acc[ai][bj][m][1][3] *= d[1] * k; } }
    }
    __device__ __forceinline__ void operator()(const Acc& acc, const Unit& u, int wr, int wc, int fr, int fq) const {
        const int row0 = u.pm * BM + wr * 64 + fr, col0 = u.pn * BM + wc * 32 + 8 * fq;
        u32x4 gq[2][4][2];
#pragma unroll
        for (int ai = 0; ai < 2; ++ai)
#pragma unroll
            for (int m = 0; m < 4; ++m)
#pragma unroll
                for (int bj = 0; bj < 2; ++bj) gq[ai][m][bj] = *(const u32x4*)(GA + (size_t)(row0 + ai * HALF + m * 16) * DMODEL + col0 + bj * HALF);
        asm volatile("" ::: "memory");
#pragma unroll
        for (int ai = 0; ai < 2; ++ai)
#pragma unroll
            for (int m = 0; m < 4; ++m) { const size_t r = (size_t)(row0 + ai * HALF + m * 16);
#pragma unroll
                for (int bj = 0; bj < 2; ++bj) { const u32x4 g = gq[ai][m][bj];
                    const f32x4 v0 = acc[ai][bj][m][0], v1 = acc[ai][bj][m][1];
                    u32x4 w; w.x = cvt_pk_bf16(bf_lo(g.x) * v0[0], bf_hi(g.x) * v0[1]); w.y = cvt_pk_bf16(bf_lo(g.y) * v0[2], bf_hi(g.y) * v0[3]);
                    w.z = cvt_pk_bf16(bf_lo(g.z) * v1[0], bf_hi(g.z) * v1[1]); w.w = cvt_pk_bf16(bf_lo(g.w) * v1[2], bf_hi(g.w) * v1[3]);
                    *(u32x4*)(MERGED + r * DMODEL + col0 + bj * HALF) = w; } }
    }
};
struct EpiOut {
    static constexpr bool PERM = false;
    const float* x; float* out; const float* mod;
    __device__ __forceinline__ void operator()(const Acc& acc, const Unit& u, int wr, int wc, int fr, int fq) const {
        const int row0 = u.pm * BM + wr * 64 + fr, col0 = u.pn * BM + wc * 32 + 4 * fq;
        const float* g1 = mod + (size_t)(u.pm >> 5) * 6144 + 2048;
        f32x4 gv[2][2];
#pragma unroll
        for (int bj = 0; bj < 2; ++bj)
#pragma unroll
            for (int n = 0; n < 2; ++n) gv[bj][n] = *(const f32x4*)(g1 + col0 + bj * HALF + n * 16);
#pragma unroll
        for (int ai = 0; ai < 2; ++ai)
#pragma unroll
            for (int m = 0; m < 4; ++m) { const size_t off = (size_t)(row0 + ai * HALF + m * 16) * DMODEL + col0;
#pragma unroll
                for (int bj = 0; bj < 2; ++bj)
#pragma unroll
                    for (int n = 0; n < 2; ++n) { const f32x4 xv = __builtin_nontemporal_load((const f32x4*)(x + off + bj * HALF + n * 16)); *(f32x4*)(out + off + bj * HALF + n * 16) = xv + gv[bj][n] * acc[ai][bj][m][n]; } }
    }
};
struct EpiDelta {
    static constexpr bool PERM = true;
    bf16_t* DELTA; const float* mod;
    __device__ __forceinline__ void operator()(const Acc& acc, const Unit& u, int wr, int wc, int fr, int fq) const {
        const unsigned row0 = u.pm * BM + wr * 64 + fr, col0 = u.pn * BM + wc * 32 + 8 * fq;
        const float* g1 = mod + (size_t)(u.pm >> 5) * 6144 + 2048 + col0;
        f32x4 gv[2][2];
#pragma unroll
        for (int bj = 0; bj < 2; ++bj)
#pragma unroll
            for (int n = 0; n < 2; ++n) gv[bj][n] = *(const f32x4*)(g1 + bj * HALF + n * 4);
#pragma unroll
        for (int ai = 0; ai < 2; ++ai)
#pragma unroll
            for (int m = 0; m < 4; ++m) { bf16_t* rowp = DELTA + ((row0 + ai * HALF + m * 16) * (unsigned)DMODEL + col0);
#pragma unroll
                for (int bj = 0; bj < 2; ++bj) { const f32x4 v0 = acc[ai][bj][m][0] * gv[bj][0], v1 = acc[ai][bj][m][1] * gv[bj][1];
                    u32x4 w; w.x = cvt_pk_bf16(v0[0], v0[1]); w.y = cvt_pk_bf16(v0[2], v0[3]); w.z = cvt_pk_bf16(v1[0], v1[1]); w.w = cvt_pk_bf16(v1[2], v1[3]);
                    *(u32x4*)(rowp + bj * HALF) = w; } }
    }
};
struct EpiFfn1 {
    static constexpr bool PERM = true;
    unsigned char* HMID;
    __device__ __forceinline__ void operator()(const Acc& acc, const Unit& u, int wr, int wc, int fr, int fq) const {
        const size_t row0 = (size_t)u.g * CAP + u.pm * BM + wr * 64 + fr; const int col0 = u.pn * HALF + wc * 32 + 8 * fq;
        constexpr float inv = 1.0f / (F8_SC_H2 * F8_SC_W);
        constexpr float RC = 1.0f / (inv * inv * F8_SC_HMID);
        static_assert(RC == 65536.0f, "LOG2_RC below assumes 2^16");
        constexpr float LOG2_RC = 16.0f;
#pragma unroll
        for (int ai = 0; ai < 2; ++ai)
#pragma unroll
            for (int m = 0; m < 4; ++m) { unsigned char* rowp = HMID + (row0 + ai * HALF + m * 16) * FF + col0;
                float o[8];
#pragma unroll
                for (int n = 0; n < 2; ++n)
#pragma unroll
                    for (int i = 0; i < 4; i += 2) {
                        const f32x2 ag = {acc[ai][0][m][n][i], acc[ai][0][m][n][i + 1]}, au = {acc[ai][1][m][n][i], acc[ai][1][m][n][i + 1]};
                        const f32x2 e = ag * (-inv * LOG2E) + LOG2_RC;
                        f32x2 t; t.x = __builtin_amdgcn_exp2f(e.x); t.y = __builtin_amdgcn_exp2f(e.y);
                        t = t + RC;
                        f32x2 r; r.x = __builtin_amdgcn_rcpf(t.x); r.y = __builtin_amdgcn_rcpf(t.y);
                        const f32x2 q = (ag * au) * r;
                        o[n * 4 + i] = q.x; o[n * 4 + i + 1] = q.y; }
                u32x2 w; w.x = pk4_fp8(o[0], o[1], o[2], o[3]); w.y = pk4_fp8(o[4], o[5], o[6], o[7]);
                *(u32x2*)rowp = w; }
    }
};
struct EpiFfn2 {
    static constexpr bool PERM = true;
    unsigned char* YB8; const float* gsel;
    __device__ __forceinline__ void operator()(const Acc& acc, const Unit& u, int wr, int wc, int fr, int fq) const {
        const unsigned row0 = (unsigned)u.g * CAP + u.pm * BM + wr * 64 + fr; const unsigned col0 = u.pn * BM + wc * 32 + 8 * fq;
        float gsv[2][4];
#pragma unroll
        for (int ai = 0; ai < 2; ++ai)
#pragma unroll
            for (int m = 0; m < 4; ++m) gsv[ai][m] = gsel[row0 + ai * HALF + m * 16];
        asm volatile("" ::: "memory");
#pragma unroll
        for (int ai = 0; ai < 2; ++ai)
#pragma unroll
            for (int m = 0; m < 4; ++m) { const unsigned r = row0 + ai * HALF + m * 16; const float gs = gsv[ai][m] * (F8_SC_Y / (F8_SC_HMID * F8_SC_W)); unsigned char* rowp = YB8 + (r * (unsigned)DMODEL + col0);
#pragma unroll
                for (int bj = 0; bj < 2; ++bj) { const f32x4 v0 = acc[ai][bj][m][0] * gs, v1 = acc[ai][bj][m][1] * gs;
                    u32x2 w; w.x = pk4_fp8(v0[0], v0[1], v0[2], v0[3]); w.y = pk4_fp8(v1[0], v1[1], v1[2], v1[3]);
                    *(u32x2*)(rowp + bj * HALF) = w; } }
    }
};

template <bool F8> __device__ __forceinline__ f32x4 mma_step(bf16x8 b0, bf16x8 b1, bf16x8 a0, bf16x8 a1, f32x4 c) {
    if constexpr (F8) {
        const v8i b = __builtin_shufflevector(__builtin_bit_cast(v4i, b0), __builtin_bit_cast(v4i, b1), 0, 1, 2, 3, 4, 5, 6, 7);
        const v8i a = __builtin_shufflevector(__builtin_bit_cast(v4i, a0), __builtin_bit_cast(v4i, a1), 0, 1, 2, 3, 4, 5, 6, 7);
        asm volatile("v_mfma_f32_16x16x128_f8f6f4 %0, %1, %2, %0" : "+v"(c) : "v"(b), "v"(a));
        return c;
    } else {
        c = __builtin_amdgcn_mfma_f32_16x16x32_bf16(b0, a0, c, 0, 0, 0);
        return __builtin_amdgcn_mfma_f32_16x16x32_bf16(b1, a1, c, 0, 0, 0);
    }
}
__device__ __forceinline__ const char* uni_ptr(const char* p) {
    const unsigned long long v = (unsigned long long)p; const unsigned lo = __builtin_amdgcn_readfirstlane((unsigned)v), hi = __builtin_amdgcn_readfirstlane((unsigned)(v >> 32));
    return (const char*)(((unsigned long long)hi << 32) | lo); }
template <bool F8, class Epi, class Sched, bool SEG2 = false>
__device__ __forceinline__ void gemm_phase(LAS unsigned char* lds, const int nt, const Sched& S, const Epi& E) {
    const int tid = fresh_tid(), wid = __builtin_amdgcn_readfirstlane(tid >> 6), lane = tid & 63, wr = wid >> 2, wc = wid & 3, fr = lane & 15, fq = lane >> 4;
    constexpr bool GA = Sched::GATHER;
    int Rr[2], Cc[2];
#pragma unroll
    for (int i = 0; i < 2; ++i) stage_rc(tid * 16 + i * 8192, Rr[i], Cc[i]);
    unsigned voffB[2];
#pragma unroll
    for (int i = 0; i < 2; ++i) { const int Rb = Epi::PERM ? ((Rr[i] & ~31) + perm32(Rr[i] & 31)) : Rr[i]; voffB[i] = (unsigned)Rb * S.ldb + (unsigned)Cc[i] * 2u; }
    const size_t kstep = (size_t)(BK * 2);
    const size_t hstepB = (size_t)HALF * S.ldb;
    const size_t hstepA = GA ? (size_t)0 : (size_t)HALF * S.lda;
    const unsigned ldsw = (unsigned)wid * 1024u;
    const int aoff = lds_byte(wr * 64 + fr, fq * 8), boff = lds_byte(wc * 32 + fr, fq * 8);
#define PG8_SA(b, h) (((b) * 2 + (h)) * HTB)
#define PG8_SB(b, h) ((4 + (b) * 2 + (h)) * HTB)
#define PG8_STAGE(bufoff, gbase, voff) do { _Pragma("unroll") for (int _i = 0; _i < 2; ++_i) \
        __builtin_amdgcn_global_load_lds((GAS const unsigned*)((GAS const char*)(gbase) + (voff)[_i]), (LAS unsigned*)(lds + (bufoff) + ldsw + _i * 8192), 16, 0, 0); } while (0)
#define PG8_LDA(dst, b, h) do { _Pragma("unroll") for (int m = 0; m < 4; ++m) _Pragma("unroll") for (int k = 0; k < 2; ++k) dst[m][k] = *(const LAS bf16x8*)(lds + PG8_SA(b, h) + aoff + m * 2048 + k * 1024); } while (0)
#define PG8_LDB(dst, b, h) do { _Pragma("unroll") for (int n = 0; n < 2; ++n) _Pragma("unroll") for (int k = 0; k < 2; ++k) dst[n][k] = *(const LAS bf16x8*)(lds + PG8_SB(b, h) + boff + n * 2048 + k * 1024); } while (0)
#define PG8_MMA(ai, bj, At, Bt) do { __builtin_amdgcn_s_setprio(1); _Pragma("unroll") for (int m = 0; m < 4; ++m) _Pragma("unroll") for (int n = 0; n < 2; ++n) \
        acc[ai][bj][m][n] = mma_step<F8>(Bt[n][0], Bt[n][1], At[m][0], At[m][1], acc[ai][bj][m][n]); __builtin_amdgcn_s_setprio(0); } while (0)
#define PG8_WAIT_V(n) asm volatile("s_waitcnt vmcnt(" #n ")" ::: "memory")
#define PG8_WAIT_L(n) asm volatile("s_waitcnt lgkmcnt(" #n ")" ::: "memory")
#define PG8_BAR __builtin_amdgcn_s_barrier()
#define PG8_SCHED __builtin_amdgcn_sched_barrier(0)
#define PG8_ROWOFFS(dst, u_) do { if constexpr (GA) { const int* _rw = S.rows(u_); _Pragma("unroll") for (int _h = 0; _h < 2; ++_h) _Pragma("unroll") for (int _i = 0; _i < 2; ++_i) \
        dst[_h][_i] = (unsigned)_rw[_h * HALF + Rr[_i]] * S.lda + (unsigned)Cc[_i] * 2u; } } while (0)
    Unit cur, nxt; int ui = 0;
    if (!S.next(0, cur)) return;
    f32x4 acc[2][2][4][2];
#pragma unroll
    for (int a = 0; a < 2; ++a)
#pragma unroll
        for (int b = 0; b < 2; ++b)
#pragma unroll
            for (int m = 0; m < 4; ++m)
#pragma unroll
                for (int n = 0; n < 2; ++n) acc[a][b][m][n] = (f32x4){0.f, 0.f, 0.f, 0.f};
    bf16x8 At[4][2], B0[2][2], B1[2][2];
    unsigned voffP[2];
#pragma unroll
    for (int i = 0; i < 2; ++i) voffP[i] = (unsigned)Rr[i] * S.lda + (unsigned)Cc[i] * 2u;
    unsigned voffA[2][2], voffAn[2][2];
    PG8_ROWOFFS(voffA, cur);
#define PG8_VA(h) (GA ? voffA[h] : voffP)
#define PG8_VA2(h) (GA ? va2[h] : voffP)
    const char* cA = uni_ptr(S.a_ptr(cur)); const char* cB = uni_ptr(S.b_ptr(cur));
    const char* cA2 = cA; const char* cB2 = cB; int nt1 = nt;
    if constexpr (SEG2) { cA2 = uni_ptr(S.a_ptr2(cur)); cB2 = uni_ptr(S.b_ptr2(cur)); nt1 = S.nt1; }
#define PG8_KA(tau) ((!SEG2 || (tau) < nt1) ? cA + (size_t)(tau) * kstep : cA2 + (size_t)((tau) - nt1) * kstep)
#define PG8_KB(tau) ((!SEG2 || (tau) < nt1) ? cB + (size_t)(tau) * kstep : cB2 + (size_t)((tau) - nt1) * kstep)
    PG8_STAGE(PG8_SB(0, 0), cB, voffB); PG8_STAGE(PG8_SB(0, 1), cB + hstepB, voffB); PG8_STAGE(PG8_SA(0, 0), cA, PG8_VA(0)); PG8_STAGE(PG8_SA(0, 1), cA + hstepA, PG8_VA(1));
    if (wr == 1) PG8_BAR;
    PG8_WAIT_V(2); PG8_BAR;
    PG8_STAGE(PG8_SB(1, 0), cB + kstep, voffB); PG8_STAGE(PG8_SA(1, 0), cA + kstep, PG8_VA(0)); PG8_STAGE(PG8_SB(1, 1), cB + hstepB + kstep, voffB);
    PG8_WAIT_V(6); PG8_BAR;
    for (;;) {
        const bool has_next = S.next(ui + 1, nxt);
        const char* nA = has_next ? uni_ptr(S.a_ptr(nxt)) : cA; const char* nB = has_next ? uni_ptr(S.b_ptr(nxt)) : cB;
        if constexpr (GA) {
            if (has_next) { PG8_ROWOFFS(voffAn, nxt); } else {
#pragma unroll
                for (int h = 0; h < 2; ++h)
#pragma unroll
                    for (int i = 0; i < 2; ++i) voffAn[h][i] = voffA[h][i]; } }
        for (int t = 0; t < nt; t += 2) {
            const bool last = (t == nt - 2);
            const char* a1 = PG8_KA(t + 1);
            const char* a2 = last ? nA : PG8_KA(t + 2); const char* b2 = last ? nB : PG8_KB(t + 2);
            const char* a3 = a2 + kstep; const char* b3 = b2 + kstep;
            unsigned va2[2][2];
            if constexpr (GA) {
#pragma unroll
                for (int h = 0; h < 2; ++h)
#pragma unroll
                    for (int i = 0; i < 2; ++i) va2[h][i] = last ? voffAn[h][i] : voffA[h][i]; }
            PG8_LDB(B0, 0, 0); PG8_LDB(B1, 0, 1); PG8_SCHED; PG8_LDA(At, 0, 0); PG8_STAGE(PG8_SA(1, 1), a1 + hstepA, PG8_VA(1));
            PG8_WAIT_V(8); PG8_WAIT_L(0); PG8_BAR; PG8_MMA(0, 0, At, B0); PG8_MMA(0, 1, At, B1); PG8_BAR; PG8_SCHED;
            PG8_LDA(At, 0, 1); PG8_STAGE(PG8_SB(0, 0), b2, voffB); PG8_STAGE(PG8_SB(0, 1), b2 + hstepB, voffB); PG8_STAGE(PG8_SA(0, 0), a2, PG8_VA2(0));
            PG8_WAIT_V(8); PG8_WAIT_L(0); PG8_BAR; PG8_MMA(1, 0, At, B0); PG8_MMA(1, 1, At, B1); PG8_BAR; PG8_SCHED;
            PG8_LDB(B0, 1, 0); PG8_LDB(B1, 1, 1); PG8_SCHED; PG8_LDA(At, 1, 0); PG8_STAGE(PG8_SA(0, 1), a2 + hstepA, PG8_VA2(1));
            PG8_WAIT_V(8); PG8_WAIT_L(0); PG8_BAR; PG8_MMA(0, 0, At, B0); PG8_MMA(0, 1, At, B1); PG8_BAR; PG8_SCHED;
            PG8_LDA(At, 1, 1); PG8_STAGE(PG8_SB(1, 0), b3, voffB); PG8_STAGE(PG8_SB(1, 1), b3 + hstepB, voffB); PG8_STAGE(PG8_SA(1, 0), a3, PG8_VA2(0));
            PG8_WAIT_V(8); PG8_WAIT_L(0); PG8_BAR; PG8_MMA(1, 0, At, B0); PG8_MMA(1, 1, At, B1); PG8_BAR; PG8_SCHED;
            if constexpr (SEG2) { if (t + 2 == nt1) { E.mid(acc, cur, wr, wc, fr, fq); PG8_SCHED; } }
        }
        if (wr == 0) PG8_BAR;
        if constexpr (F8) asm volatile("s_nop 15\n\ts_nop 3" ::: "memory");
        E(acc, cur, wr, wc, fr, fq);
        if (!has_next) break;
#pragma unroll
        for (int a = 0; a < 2; ++a)
#pragma unroll
            for (int b = 0; b < 2; ++b)
#pragma unroll
                for (int m = 0; m < 4; ++m)
#pragma unroll
                    for (int n = 0; n < 2; ++n) acc[a][b][m][n] = (f32x4){0.f, 0.f, 0.f, 0.f};
        cur = nxt; cA = nA; cB = nB; ++ui;
        if constexpr (SEG2) { cA2 = uni_ptr(S.a_ptr2(cur)); cB2 = uni_ptr(S.b_ptr2(cur)); }
        if constexpr (GA) {
#pragma unroll
            for (int h = 0; h < 2; ++h)
#pragma unroll
                for (int i = 0; i < 2; ++i) voffA[h][i] = voffAn[h][i]; }
        if (wr == 1) PG8_BAR;
    }
    PG8_WAIT_V(0);
    PG8_BAR;
#undef PG8_SA
#undef PG8_SB
#undef PG8_STAGE
#undef PG8_LDA
#undef PG8_LDB
#undef PG8_MMA
#undef PG8_WAIT_V
#undef PG8_WAIT_L
#undef PG8_BAR
#undef PG8_SCHED
#undef PG8_ROWOFFS
#undef PG8_VA
#undef PG8_VA2
#undef PG8_KA
#undef PG8_KB
}
}

namespace attn_body {
using bf16 = __hip_bfloat16;
constexpr int D = 64, QP = NQKV, KP = NQKV, OP = DMODEL;
constexpr int NW = 8, QBLK = 32, QB = QBLK * NW, KVBLK = 64;
__device__ __forceinline__ int crow(int r, int hi) { return (r & 3) + 8 * (r >> 2) + 4 * hi; }
#define SBAR() __builtin_amdgcn_sched_barrier(0)
constexpr int NSLOT = 3, SLOTB = 8192;
constexpr int LDS_K = 0, LDS_V = NSLOT * SLOTB, LDS_WS = 2 * NSLOT * SLOTB, LDS_OST = LDS_WS + NW * 64 * 4, LDS_BYTES = LDS_OST + NW * 4096;
__device__ __forceinline__ void glds16(const void* gsrc, unsigned lds_dst) { unsigned keep;
    asm volatile("s_mov_b32 %0, m0\n\ts_mov_b32 m0, %2\n\ts_nop 0\n\tglobal_load_lds_dwordx4 %1, off\n\ts_mov_b32 m0, %0" : "=&s"(keep) : "v"(gsrc), "s"(lds_dst) : "memory"); }
__device__ __forceinline__ float max3f(float a, float b, float c) { float r; asm("v_max3_f32 %0, %1, %2, %3" : "=v"(r) : "v"(a), "v"(b), "v"(c)); return r; }
__device__ __forceinline__ float max2f(float a, float b) { float r; asm("v_max_f32_e32 %0, %1, %2" : "=v"(r) : "v"(a), "v"(b)); return r; }
__device__ __forceinline__ float fadd_s(float a, float b) { float r; asm("v_add_f32_e32 %0, %1, %2" : "=v"(r) : "v"(a), "v"(b)); return r; }
__device__ __forceinline__ float fsub_s(float a, float b) { float r; asm("v_sub_f32_e32 %0, %1, %2" : "=v"(r) : "v"(a), "v"(b)); return r; }
typedef float f32x2_t __attribute__((ext_vector_type(2))); typedef __bf16 bf16x2_t __attribute__((ext_vector_type(2)));
__device__ __forceinline__ unsigned cvtpk_s(float lo, float hi) { f32x2_t v = {lo, hi}; bf16x2_t b = __builtin_convertvector(v, bf16x2_t); return __builtin_bit_cast(unsigned, b); }
#define WAIT_BAR(N) asm volatile("s_waitcnt vmcnt(" #N ") lgkmcnt(0)\n\ts_barrier" ::: "memory")

__device__ __forceinline__ void qkt(f32x16& p0, f32x16& p1, const char* Kslot, const bf16x8* qr, const f32x16& negm, int r32, int hi) {
    const char* kb = Kslot + hi * 1024 + r32 * 16;
#pragma unroll
    for (int d0 = 0; d0 < 4; ++d0) {
        const bf16x8 b0 = *reinterpret_cast<const bf16x8*>(kb + d0 * 2048);
        const bf16x8 b1 = *reinterpret_cast<const bf16x8*>(kb + d0 * 2048 + 512);
        if (d0 == 0) { p0 = __builtin_amdgcn_mfma_f32_32x32x16_bf16(b0, qr[0], negm, 0, 0, 0); p1 = __builtin_amdgcn_mfma_f32_32x32x16_bf16(b1, qr[0], negm, 0, 0, 0); }
        else { p0 = __builtin_amdgcn_mfma_f32_32x32x16_bf16(b0, qr[d0], p0, 0, 0, 0); p1 = __builtin_amdgcn_mfma_f32_32x32x16_bf16(b1, qr[d0], p1, 0, 0, 0); } }
}
typedef LAS const char* lds_cptr;
typedef short v4i16_t __attribute__((ext_vector_type(4)));
__device__ __forceinline__ void kload8(bf16x8* kf, lds_cptr kp) {
    kf[0] = *(const LAS bf16x8*)(kp);        kf[1] = *(const LAS bf16x8*)(kp + 512);
    kf[2] = *(const LAS bf16x8*)(kp + 2048); kf[3] = *(const LAS bf16x8*)(kp + 2560);
    kf[4] = *(const LAS bf16x8*)(kp + 4096); kf[5] = *(const LAS bf16x8*)(kp + 4608);
    kf[6] = *(const LAS bf16x8*)(kp + 6144); kf[7] = *(const LAS bf16x8*)(kp + 6656);
}
__device__ __forceinline__ void kload2(bf16x8* kf, lds_cptr kp, int j) { kf[2 * j] = *(const LAS bf16x8*)(kp + j * 2048); kf[2 * j + 1] = *(const LAS bf16x8*)(kp + j * 2048 + 512); }
__device__ __forceinline__ s16x4 vtr(lds_cptr p) { return __builtin_bit_cast(s16x4, __builtin_amdgcn_ds_read_tr16_b64_v4i16((LAS v4i16_t*)p)); }
__device__ __forceinline__ float rowmax(const f32x16& p0, const f32x16& p1) {
    float a = max3f(p0[0], p0[1], p1[0]), b = max3f(p0[2], p0[3], p1[1]); a = max3f(a, p1[2], p1[3]);
#pragma unroll
    for (int r = 4; r < 16; r += 4) { a = max3f(a, p0[r], p0[r + 1]); b = max3f(b, p0[r + 2], p0[r + 3]); a = max3f(a, p1[r], p1[r + 1]); b = max3f(b, p1[r + 2], p1[r + 3]); }
    const float m = max2f(a, b);
    auto rr = __builtin_amdgcn_permlane32_swap(__float_as_uint(m), __float_as_uint(m), false, false);
    return max2f(__uint_as_float(rr[0]), __uint_as_float(rr[1]));
}
__device__ __forceinline__ void pv(f32x16* o, int vb, bf16x8 pa0, bf16x8 pa1, bf16x8 pa2, bf16x8 pa3) {
#pragma unroll
    for (int d0 = 0; d0 < 2; ++d0) { s16x4 lo[4], hi[4];
#pragma unroll
        for (int ks = 0; ks < 4; ++ks) {
            asm volatile("ds_read_b64_tr_b16 %0,%1 offset:%c2" : "=&v"(lo[ks]) : "v"(vb), "i"(d0 * 4096 + ks * 1024) : "memory");
            asm volatile("ds_read_b64_tr_b16 %0,%1 offset:%c2" : "=&v"(hi[ks]) : "v"(vb), "i"(d0 * 4096 + ks * 1024 + 512) : "memory"); }
        asm volatile("s_waitcnt lgkmcnt(0)" ::: "memory"); SBAR();
#define PK(k) (bf16x8){lo[k][0], lo[k][1], lo[k][2], lo[k][3], hi[k][0], hi[k][1], hi[k][2], hi[k][3]}
        o[d0] = __builtin_amdgcn_mfma_f32_32x32x16_bf16(pa0, PK(0), o[d0], 0, 0, 0);
        o[d0] = __builtin_amdgcn_mfma_f32_32x32x16_bf16(pa1, PK(1), o[d0], 0, 0, 0);
        o[d0] = __builtin_amdgcn_mfma_f32_32x32x16_bf16(pa2, PK(2), o[d0], 0, 0, 0);
        o[d0] = __builtin_amdgcn_mfma_f32_32x32x16_bf16(pa3, PK(3), o[d0], 0, 0, 0);
#undef PK
    }
}
#define ATTN_STORE16(p, v) (*(u32x4*)(p) = (v))
template <int THRL> __device__ __forceinline__ void attn_unit(int qb, const bf16* Qh, const bf16* __restrict__ Kh, const bf16* __restrict__ Vh, bf16* Oh, char* shm) {
    const int tid = fresh_tid(), lane = tid & 63, r32 = lane & 31, hi = lane >> 5; const int wid = __builtin_amdgcn_readfirstlane(tid >> 6);
    const int q0 = qb * QB;
    const bf16* Qw = Qh + (long)(q0 + wid * QBLK) * QP;
    const unsigned lds0 = (unsigned)(uintptr_t)shm;
    float* wsf = (float*)(shm + LDS_WS) + wid * 64;
    const bf16* ksrc = Kh + (long)lane * KP + wid * 8;
    const bf16* vsrc = Vh + (long)(16 * (wid & 3) + (lane >> 2)) * KP + (wid >> 2) * 32 + (lane & 3) * 8;
    const unsigned kdst = lds0 + LDS_K + wid * 1024, vdst = lds0 + LDS_V + wid * 1024;
#define DMA_K(t, slot) glds16(ksrc + (long)(t) * KVBLK * KP, (unsigned)__builtin_amdgcn_readfirstlane(kdst + (slot)))
#define DMA_V(t, slot) glds16(vsrc + (long)(t) * KVBLK * KP, (unsigned)__builtin_amdgcn_readfirstlane(vdst + (slot)))
    const int vb0 = (int)(lds0 + LDS_V) + ((lane >> 4) & 1) * 32 + (lane & 3) * 8 + (4 * hi + ((lane & 15) >> 2)) * 64;
    const char* Kbase = shm + LDS_K; bf16x8 kf[8];
    const lds_cptr shm3 = (lds_cptr)shm; const lds_cptr kp0 = shm3 + LDS_K + hi * 1024 + r32 * 16; const lds_cptr vp0 = shm3 + LDS_V + ((lane >> 4) & 1) * 32 + (lane & 3) * 8 + (4 * hi + ((lane & 15) >> 2)) * 64;
    constexpr int NT = SEQ / KVBLK;
    DMA_K(0, 0); DMA_V(0, 0); DMA_K(1, SLOTB);
    bf16x8 qr[4];
#pragma unroll
    for (int d0 = 0; d0 < 4; ++d0) qr[d0] = *reinterpret_cast<const bf16x8*>(&Qw[(long)r32 * QP + d0 * 16 + hi * 8]);
    float mhat = 0.f, l_reg = 0.f; f32x16 o[2]; o[0] = f32x16{}; o[1] = f32x16{}; f32x16 negm = f32x16{}; asm volatile("" : "+v"(negm));
    bool resc = false;
#define START(P0, P1) do { const float rm = rowmax(P0, P1); resc = false; \
    { const float dl = rm; mhat = fadd_s(mhat, dl); \
      _Pragma("unroll") for (int r = 0; r < 16; ++r) { P0[r] = fsub_s(P0[r], dl); P1[r] = fsub_s(P1[r], dl); } \
      _Pragma("unroll") for (int r = 0; r < 16; ++r) negm[r] = -mhat; asm volatile("" : "+v"(negm)); } \
    _Pragma("unroll") for (int r = 0; r < 16; ++r) P0[r] = __builtin_amdgcn_exp2f(P0[r]); } while (0)
#define RESC() do { if (resc) { asm volatile("s_waitcnt lgkmcnt(0)" ::: "memory"); \
      _Pragma("unroll") for (int d_ = 0; d_ < 2; ++d_) _Pragma("unroll") for (int r = 0; r < 16; ++r) o[d_][r] *= wsf[crow(r, hi)]; } } while (0)
    f32x16 pA0, pA1, pB0, pB1;
    int sl_prev = 0, sl_cur = 0, sl_next = SLOTB;
#define ROT() do { sl_prev = sl_cur; sl_cur = sl_next; sl_next = (sl_next == (NSLOT - 1) * SLOTB) ? 0 : sl_next + SLOTB; } while (0)
    DMA_K(2, 2 * SLOTB);
    WAIT_BAR(3);
    qkt(pA0, pA1, Kbase, qr, negm, r32, hi); asm volatile("s_nop 15\n\ts_nop 7" : "+v"(pA0), "+v"(pA1));
    START(pA0, pA1);
    _Pragma("unroll") for (int r = 0; r < 16; ++r) pA1[r] = __builtin_amdgcn_exp2f(pA1[r]);
    WAIT_BAR(0);
    DMA_K(3, 0); DMA_V(1, SLOTB);
    ROT();
    kload8(kf, kp0 + sl_cur);
    WAIT_BAR(2);
    s16x4 vlo[8], vhi[8]; u32x4 pw0, pw1, pw2, pw3;
#define PKW(P, B) cvtpk_s(P[B], P[B + 1])
#define PAF(k) __builtin_bit_cast(bf16x8, pw##k)
#define VFR(i) (bf16x8){vlo[i][0], vlo[i][1], vlo[i][2], vlo[i][3], vhi[i][0], vhi[i][1], vhi[i][2], vhi[i][3]}
#define PIN(x) asm volatile("" : "+v"(x))
#define MX3(a, b, c) __builtin_fmaxf(__builtin_fmaxf((a), (b)), (c))
#define GAPA(MF, A0, A1, A2, A3, W0, W1, PW) do { MF; sacc += A0; sacc += A1; sacc += A2; sacc += A3; PIN(sacc); W0; W1; PIN(PW); SBAR(); } while (0)
#define EX(v) __builtin_amdgcn_exp2f(v)
#define GAPB(MF, X, B) do { MF; X[B] = EX(X[B]); X[B + 1] = EX(X[B + 1]); X[B + 2] = EX(X[B + 2]); X[B + 3] = EX(X[B + 3]); PIN(X); SBAR(); } while (0)
#define VRD(i) do { vlo[i] = vtr(vp_ + (((i) >> 2) * 4096 + ((i) & 3) * 1024)); vhi[i] = vtr(vp_ + (((i) >> 2) * 4096 + ((i) & 3) * 1024 + 512)); } while (0)
#define KRD(G, j) do { if (G) { kload2(kf, kp0 + sl_next, j); SBAR(); } } while (0)
#define STEP(C0, C1, P0, P1, t, GK, GV, GL) do { SBAR(); \
    const lds_cptr vp_ = vp0 + sl_prev; \
    VRD(0); SBAR(); float sacc = (P0[0] + P0[1]); \
    GAPA(C0 = __builtin_amdgcn_mfma_f32_32x32x16_bf16(kf[0], qr[0], negm, 0, 0, 0), P0[2], P0[3], P0[4], P0[5],     pw0[0] = PKW(P0, 0), pw0[1] = PKW(P0, 2), pw0); \
    VRD(4); SBAR(); GAPA(C1 = __builtin_amdgcn_mfma_f32_32x32x16_bf16(kf[1], qr[0], negm, 0, 0, 0), P0[6], P0[7], P0[8], P0[9],     pw0[2] = PKW(P0, 4), pw0[3] = PKW(P0, 6), pw0); \
    VRD(1); SBAR(); GAPA(C0 = __builtin_amdgcn_mfma_f32_32x32x16_bf16(kf[2], qr[1], C0, 0, 0, 0),   P0[10], P0[11], P0[12], P0[13], pw1[0] = PKW(P0, 8), pw1[1] = PKW(P0, 10), pw1); \
    VRD(5); SBAR(); GAPA(C1 = __builtin_amdgcn_mfma_f32_32x32x16_bf16(kf[3], qr[1], C1, 0, 0, 0),   P0[14], P0[15], P1[0], P1[1],   pw1[2] = PKW(P0, 12), pw1[3] = PKW(P0, 14), pw1); \
    VRD(2); SBAR(); GAPA(C0 = __builtin_amdgcn_mfma_f32_32x32x16_bf16(kf[4], qr[2], C0, 0, 0, 0),   P1[2], P1[3], P1[4], P1[5],     pw2[0] = PKW(P1, 0), pw2[1] = PKW(P1, 2), pw2); \
    VRD(6); SBAR(); GAPA(C1 = __builtin_amdgcn_mfma_f32_32x32x16_bf16(kf[5], qr[2], C1, 0, 0, 0),   P1[6], P1[7], P1[8], P1[9],     pw2[2] = PKW(P1, 4), pw2[3] = PKW(P1, 6), pw2); \
    VRD(3); SBAR(); GAPA(C0 = __builtin_amdgcn_mfma_f32_32x32x16_bf16(kf[6], qr[3], C0, 0, 0, 0),   P1[10], P1[11], P1[12], P1[13], pw3[0] = PKW(P1, 8), pw3[1] = PKW(P1, 10), pw3); \
    VRD(7); SBAR(); GAPA(C1 = __builtin_amdgcn_mfma_f32_32x32x16_bf16(kf[7], qr[3], C1, 0, 0, 0),   P1[14], P1[15], 0.f, 0.f,       pw3[2] = PKW(P1, 12), pw3[3] = PKW(P1, 14), pw3); \
    l_reg += sacc; \
    if (GK) { DMA_K((t) + 3, sl_cur); } if (GV) { DMA_V((t) + 1, sl_next); } \
    { float a = MX3(C0[0], C0[1], C1[0]), b = MX3(C0[2], C0[3], C1[1]); a = MX3(a, C1[2], C1[3]); \
      _Pragma("unroll") for (int r = 4; r < 16; r += 4) { a = MX3(a, C0[r], C0[r + 1]); b = MX3(b, C0[r + 2], C0[r + 3]); a = MX3(a, C1[r], C1[r + 1]); b = MX3(b, C1[r + 2], C1[r + 3]); } \
      float rm = __builtin_fmaxf(a, b); { auto rr = __builtin_amdgcn_permlane32_swap(__float_as_uint(rm), __float_as_uint(rm), false, false); rm = __builtin_fmaxf(__uint_as_float(rr[0]), __uint_as_float(rr[1])); } \
      resc = false; \
      if (__builtin_expect(__any(rm > (float)THRL), 0)) { const float dl = __builtin_fmaxf(rm, 0.f); mhat += dl; \
        _Pragma("unroll") for (int r = 0; r < 16; ++r) { C0[r] -= dl; C1[r] -= dl; } \
        _Pragma("unroll") for (int r = 0; r < 16; ++r) negm[r] = -mhat; asm volatile("" : "+v"(negm)); \
        const float f = __builtin_amdgcn_exp2f(-dl); l_reg *= f; if (hi == 0) wsf[r32] = f; resc = true; } } \
    SBAR(); \
    GAPB(o[0] = __builtin_amdgcn_mfma_f32_32x32x16_bf16(PAF(0), VFR(0), o[0], 0, 0, 0), C0, 0); \
    GAPB(o[1] = __builtin_amdgcn_mfma_f32_32x32x16_bf16(PAF(0), VFR(4), o[1], 0, 0, 0), C0, 4); \
    KRD(GL, 0); GAPB(o[0] = __builtin_amdgcn_mfma_f32_32x32x16_bf16(PAF(1), VFR(1), o[0], 0, 0, 0), C0, 8); \
    KRD(GL, 1); GAPB(o[1] = __builtin_amdgcn_mfma_f32_32x32x16_bf16(PAF(1), VFR(5), o[1], 0, 0, 0), C0, 12); \
    KRD(GL, 2); GAPB(o[0] = __builtin_amdgcn_mfma_f32_32x32x16_bf16(PAF(2), VFR(2), o[0], 0, 0, 0), C1, 0); \
    KRD(GL, 3); GAPB(o[1] = __builtin_amdgcn_mfma_f32_32x32x16_bf16(PAF(2), VFR(6), o[1], 0, 0, 0), C1, 4); \
    GAPB(o[0] = __builtin_amdgcn_mfma_f32_32x32x16_bf16(PAF(3), VFR(3), o[0], 0, 0, 0), C1, 8); \
    GAPB(o[1] = __builtin_amdgcn_mfma_f32_32x32x16_bf16(PAF(3), VFR(7), o[1], 0, 0, 0), C1, 12); \
    } while (0)
    int t = 1;
    for (; t + 5 < NT; t += 2) {
        STEP(pB0, pB1, pA0, pA1, t, true, true, true);     WAIT_BAR(2); RESC(); ROT();
        STEP(pA0, pA1, pB0, pB1, t + 1, true, true, true); WAIT_BAR(2); RESC(); ROT();
    }
#define ENDW(tt) do { if ((tt) + 3 < NT) { WAIT_BAR(2); } else if ((tt) + 2 < NT) { WAIT_BAR(1); } else { WAIT_BAR(0); } } while (0)
    for (; t + 1 < NT; t += 2) {
        STEP(pB0, pB1, pA0, pA1, t, (t + 3 < NT), (t + 1 < NT), (t + 1 < NT));         ENDW(t);     RESC(); ROT();
        STEP(pA0, pA1, pB0, pB1, t + 1, (t + 4 < NT), (t + 2 < NT), (t + 2 < NT));     ENDW(t + 1); RESC(); ROT();
    }
    STEP(pB0, pB1, pA0, pA1, NT - 1, false, false, false); RESC();
    { float sacc = pB0[0] + pB0[1]; _Pragma("unroll") for (int r = 2; r < 16; ++r) sacc += pB0[r]; _Pragma("unroll") for (int r = 0; r < 16; ++r) sacc += pB1[r]; l_reg += sacc;
      pw0 = (u32x4){PKW(pB0, 0), PKW(pB0, 2), PKW(pB0, 4), PKW(pB0, 6)}; pw1 = (u32x4){PKW(pB0, 8), PKW(pB0, 10), PKW(pB0, 12), PKW(pB0, 14)}; pw2 = (u32x4){PKW(pB1, 0), PKW(pB1, 2), PKW(pB1, 4), PKW(pB1, 6)}; pw3 = (u32x4){PKW(pB1, 8), PKW(pB1, 10), PKW(pB1, 12), PKW(pB1, 14)};
      SBAR(); pv(o, vb0 + sl_cur, PAF(0), PAF(1), PAF(2), PAF(3)); }
#undef PKW
#undef PAF
#undef VFR
#undef PIN
#undef MX3
#undef GAPA
#undef GAPB
#undef EX
#undef VRD
#undef KRD
#undef STEP
#undef ENDW
    { auto rr = __builtin_amdgcn_permlane32_swap(__float_as_uint(l_reg), __float_as_uint(l_reg), false, false); l_reg = __uint_as_float(rr[0]) + __uint_as_float(rr[1]); }
    if (hi == 0) wsf[32 + r32] = l_reg; asm volatile("s_waitcnt lgkmcnt(0)" ::: "memory");
    float rli[16];
#pragma unroll
    for (int r = 0; r < 16; ++r) rli[r] = __builtin_amdgcn_rcpf(wsf[32 + crow(r, hi)]);
    bf16* Ow = Oh + (long)(q0 + wid * QBLK) * OP;
    { bf16* stg = (bf16*)(shm + LDS_OST) + wid * 2048;
#pragma unroll
      for (int r = 0; r < 16; ++r) { const int orow = crow(r, hi);
#pragma unroll
        for (int d0 = 0; d0 < 2; ++d0) stg[orow * 64 + d0 * 32 + r32] = __float2bfloat16(o[d0][r] * rli[r]); }
      asm volatile("s_waitcnt lgkmcnt(0)" ::: "memory");
#pragma unroll
      for (int i = 0; i < 4; ++i) { const int row = i * 8 + (lane >> 3), ch = lane & 7; const u32x4 v = *(const u32x4*)(stg + row * 64 + ch * 8); ATTN_STORE16(Ow + (long)row * OP + ch * 8, v); } }
    asm volatile("s_waitcnt lgkmcnt(0)\n\ts_barrier" ::: "memory");
#undef DMA_K
#undef DMA_V
#undef START
#undef RESC
#undef ROT
}

__device__ __forceinline__ void attn_unit_fast(int qb, const bf16* Qh, const bf16* __restrict__ Kh, const bf16* __restrict__ Vh, bf16* Oh, char* shm) {
    const int tid = fresh_tid(), lane = tid & 63, r32 = lane & 31, hi = lane >> 5; const int wid = __builtin_amdgcn_readfirstlane(tid >> 6);
    const int q0 = qb * QB;
    const bf16* Qw = Qh + (long)(q0 + wid * QBLK) * QP;
    const unsigned lds0 = (unsigned)(uintptr_t)shm;
    const bf16* ksrc = Kh + (long)lane * KP + wid * 8;
    const bf16* vsrc = Vh + (long)(16 * (wid & 3) + (lane >> 2)) * KP + (wid >> 2) * 32 + (lane & 3) * 8;
    const unsigned kdst = lds0 + LDS_K + wid * 1024, vdst = lds0 + LDS_V + wid * 1024;
#define DMA_K(t, slot) glds16(ksrc + (long)(t) * KVBLK * KP, (unsigned)__builtin_amdgcn_readfirstlane(kdst + (slot)))
#define DMA_V(t, slot) glds16(vsrc + (long)(t) * KVBLK * KP, (unsigned)__builtin_amdgcn_readfirstlane(vdst + (slot)))
    const int vb0 = (int)(lds0 + LDS_V) + ((lane >> 4) & 1) * 32 + (lane & 3) * 8 + (4 * hi + ((lane & 15) >> 2)) * 64;
    const char* Kbase = shm + LDS_K; bf16x8 kf[8];
    const lds_cptr shm3 = (lds_cptr)shm; const lds_cptr kp0 = shm3 + LDS_K + hi * 1024 + r32 * 16; const lds_cptr vp0 = shm3 + LDS_V + ((lane >> 4) & 1) * 32 + (lane & 3) * 8 + (4 * hi + ((lane & 15) >> 2)) * 64;
    constexpr int NT = SEQ / KVBLK;
    DMA_K(0, 0); DMA_V(0, 0); DMA_K(1, SLOTB);
    bf16x8 qr[4];
#pragma unroll
    for (int d0 = 0; d0 < 4; ++d0) qr[d0] = *reinterpret_cast<const bf16x8*>(&Qw[(long)r32 * QP + d0 * 16 + hi * 8]);
    f32x16 o[2]; o[0] = f32x16{}; o[1] = f32x16{}; f32x16 lsum = f32x16{};
    const f32x16 zero16 = f32x16{};
    bf16x8 ones; { const short one = (short)0x3F80; ones = (bf16x8){one, one, one, one, one, one, one, one}; asm volatile("" : "+v"(ones)); }
    f32x16 pA0, pA1, pB0, pB1;
    int sl_prev = 0, sl_cur = 0, sl_next = SLOTB;
#define ROT() do { sl_prev = sl_cur; sl_cur = sl_next; sl_next = (sl_next == (NSLOT - 1) * SLOTB) ? 0 : sl_next + SLOTB; } while (0)
    DMA_K(2, 2 * SLOTB);
    WAIT_BAR(3);
    qkt(pA0, pA1, Kbase, qr, zero16, r32, hi);
    _Pragma("unroll") for (int r = 0; r < 16; ++r) pA0[r] = __builtin_amdgcn_exp2f(pA0[r]);
    _Pragma("unroll") for (int r = 0; r < 16; ++r) pA1[r] = __builtin_amdgcn_exp2f(pA1[r]);
    WAIT_BAR(0);
    DMA_K(3, 0); DMA_V(1, SLOTB);
    ROT();
    kload8(kf, kp0 + sl_cur);
    WAIT_BAR(2);
    s16x4 vlo[8], vhi[8]; u32x4 pw0, pw1, pw2, pw3;
#define PKW(P, B) cvtpk_s(P[B], P[B + 1])
#define PAF(k) __builtin_bit_cast(bf16x8, pw##k)
#define VFR(i) (bf16x8){vlo[i][0], vlo[i][1], vlo[i][2], vlo[i][3], vhi[i][0], vhi[i][1], vhi[i][2], vhi[i][3]}
#define PIN(x) asm volatile("" : "+v"(x))
#define GAPA(MF, W0, W1, PW) do { MF; W0; W1; PIN(PW); SBAR(); } while (0)
#define EX(v) __builtin_amdgcn_exp2f(v)
#define GAPB(MF, X, B) do { MF; X[B] = EX(X[B]); X[B + 1] = EX(X[B + 1]); X[B + 2] = EX(X[B + 2]); PIN(X); SBAR(); } while (0)
#define GAPS(k, X, B) do { lsum = __builtin_amdgcn_mfma_f32_32x32x16_bf16(PAF(k), ones, lsum, 0, 0, 0); X[B] = EX(X[B]); X[B + 1] = EX(X[B + 1]); PIN(X); SBAR(); } while (0)
#define VRD(i) do { vlo[i] = vtr(vp_ + (((i) >> 2) * 4096 + ((i) & 3) * 1024)); vhi[i] = vtr(vp_ + (((i) >> 2) * 4096 + ((i) & 3) * 1024 + 512)); } while (0)
#define KRD(G, j) do { if (G) { kload2(kf, kp0 + sl_next, j); SBAR(); } } while (0)
#define STEP(C0, C1, P0, P1, t, GK, GV, GL) do { SBAR(); \
    const lds_cptr vp_ = vp0 + sl_prev; \
    VRD(0); SBAR(); \
    GAPA(C0 = __builtin_amdgcn_mfma_f32_32x32x16_bf16(kf[0], qr[0], zero16, 0, 0, 0), pw0[0] = PKW(P0, 0), pw0[1] = PKW(P0, 2), pw0); \
    VRD(4); SBAR(); GAPA(C1 = __builtin_amdgcn_mfma_f32_32x32x16_bf16(kf[1], qr[0], zero16, 0, 0, 0), pw0[2] = PKW(P0, 4), pw0[3] = PKW(P0, 6), pw0); \
    VRD(1); SBAR(); GAPA(C0 = __builtin_amdgcn_mfma_f32_32x32x16_bf16(kf[2], qr[1], C0, 0, 0, 0),   pw1[0] = PKW(P0, 8), pw1[1] = PKW(P0, 10), pw1); \
    VRD(5); SBAR(); GAPA(C1 = __builtin_amdgcn_mfma_f32_32x32x16_bf16(kf[3], qr[1], C1, 0, 0, 0),   pw1[2] = PKW(P0, 12), pw1[3] = PKW(P0, 14), pw1); \
    VRD(2); SBAR(); GAPA(C0 = __builtin_amdgcn_mfma_f32_32x32x16_bf16(kf[4], qr[2], C0, 0, 0, 0),   pw2[0] = PKW(P1, 0), pw2[1] = PKW(P1, 2), pw2); \
    VRD(6); SBAR(); GAPA(C1 = __builtin_amdgcn_mfma_f32_32x32x16_bf16(kf[5], qr[2], C1, 0, 0, 0),   pw2[2] = PKW(P1, 4), pw2[3] = PKW(P1, 6), pw2); \
    VRD(3); SBAR(); GAPA(C0 = __builtin_amdgcn_mfma_f32_32x32x16_bf16(kf[6], qr[3], C0, 0, 0, 0),   pw3[0] = PKW(P1, 8), pw3[1] = PKW(P1, 10), pw3); \
    VRD(7); SBAR(); GAPA(C1 = __builtin_amdgcn_mfma_f32_32x32x16_bf16(kf[7], qr[3], C1, 0, 0, 0),   pw3[2] = PKW(P1, 12), pw3[3] = PKW(P1, 14), pw3); \
    if (GK) { DMA_K((t) + 3, sl_cur); } if (GV) { DMA_V((t) + 1, sl_next); } \
    SBAR(); \
    GAPB(o[0] = __builtin_amdgcn_mfma_f32_32x32x16_bf16(PAF(0), VFR(0), o[0], 0, 0, 0), C0, 0); \
    GAPB(o[1] = __builtin_amdgcn_mfma_f32_32x32x16_bf16(PAF(0), VFR(4), o[1], 0, 0, 0), C0, 3); \
    KRD(GL, 0); GAPS(0, C0, 6); \
    GAPB(o[0] = __builtin_amdgcn_mfma_f32_32x32x16_bf16(PAF(1), VFR(1), o[0], 0, 0, 0), C0, 8); \
    KRD(GL, 1); GAPB(o[1] = __builtin_amdgcn_mfma_f32_32x32x16_bf16(PAF(1), VFR(5), o[1], 0, 0, 0), C0, 11); \
    GAPS(1, C0, 14); \
    KRD(GL, 2); GAPB(o[0] = __builtin_amdgcn_mfma_f32_32x32x16_bf16(PAF(2), VFR(2), o[0], 0, 0, 0), C1, 0); \
    KRD(GL, 3); GAPB(o[1] = __builtin_amdgcn_mfma_f32_32x32x16_bf16(PAF(2), VFR(6), o[1], 0, 0, 0), C1, 3); \
    GAPS(2, C1, 6); \
    GAPB(o[0] = __builtin_amdgcn_mfma_f32_32x32x16_bf16(PAF(3), VFR(3), o[0], 0, 0, 0), C1, 8); \
    GAPB(o[1] = __builtin_amdgcn_mfma_f32_32x32x16_bf16(PAF(3), VFR(7), o[1], 0, 0, 0), C1, 11); \
    GAPS(3, C1, 14); \
    } while (0)
    int t = 1;
    for (; t + 5 < NT; t += 2) {
        STEP(pB0, pB1, pA0, pA1, t, true, true, true);     WAIT_BAR(2); ROT();
        STEP(pA0, pA1, pB0, pB1, t + 1, true, true, true); WAIT_BAR(2); ROT();
    }
#define ENDW(tt) do { if ((tt) + 3 < NT) { WAIT_BAR(2); } else if ((tt) + 2 < NT) { WAIT_BAR(1); } else { WAIT_BAR(0); } } while (0)
    for (; t + 1 < NT; t += 2) {
        STEP(pB0, pB1, pA0, pA1, t, (t + 3 < NT), (t + 1 < NT), (t + 1 < NT));         ENDW(t);     ROT();
        STEP(pA0, pA1, pB0, pB1, t + 1, (t + 4 < NT), (t + 2 < NT), (t + 2 < NT));     ENDW(t + 1); ROT();
    }
    STEP(pB0, pB1, pA0, pA1, NT - 1, false, false, false);
    { pw0 = (u32x4){PKW(pB0, 0), PKW(pB0, 2), PKW(pB0, 4), PKW(pB0, 6)}; pw1 = (u32x4){PKW(pB0, 8), PKW(pB0, 10), PKW(pB0, 12), PKW(pB0, 14)}; pw2 = (u32x4){PKW(pB1, 0), PKW(pB1, 2), PKW(pB1, 4), PKW(pB1, 6)}; pw3 = (u32x4){PKW(pB1, 8), PKW(pB1, 10), PKW(pB1, 12), PKW(pB1, 14)};
      SBAR(); pv(o, vb0 + sl_cur, PAF(0), PAF(1), PAF(2), PAF(3));
      lsum = __builtin_amdgcn_mfma_f32_32x32x16_bf16(PAF(0), ones, lsum, 0, 0, 0); lsum = __builtin_amdgcn_mfma_f32_32x32x16_bf16(PAF(1), ones, lsum, 0, 0, 0);
      lsum = __builtin_amdgcn_mfma_f32_32x32x16_bf16(PAF(2), ones, lsum, 0, 0, 0); lsum = __builtin_amdgcn_mfma_f32_32x32x16_bf16(PAF(3), ones, lsum, 0, 0, 0); }
#undef PKW
#undef PAF
#undef VFR
#undef PIN
#undef GAPA
#undef GAPB
#undef GAPS
#undef EX
#undef VRD
#undef KRD
#undef STEP
#undef ENDW
    bf16* Ow = Oh + (long)(q0 + wid * QBLK) * OP;
    { bf16* stg = (bf16*)(shm + LDS_OST) + wid * 2048;
#pragma unroll
      for (int r = 0; r < 16; ++r) { const int orow = crow(r, hi); const float rl = __builtin_amdgcn_rcpf(lsum[r]);
#pragma unroll
        for (int d0 = 0; d0 < 2; ++d0) stg[orow * 64 + d0 * 32 + r32] = __float2bfloat16(o[d0][r] * rl); }
      asm volatile("s_waitcnt lgkmcnt(0)" ::: "memory");
#pragma unroll
      for (int i = 0; i < 4; ++i) { const int row = i * 8 + (lane >> 3), ch = lane & 7; const u32x4 v = *(const u32x4*)(stg + row * 64 + ch * 8); ATTN_STORE16(Ow + (long)row * OP + ch * 8, v); } }
    asm volatile("s_waitcnt lgkmcnt(0)\n\ts_barrier" ::: "memory");
#undef DMA_K
#undef DMA_V
#undef ROT
}
__device__ __forceinline__ void attn_unit_f8(int qb, const unsigned char* Q8h, const unsigned char* __restrict__ K8h, const unsigned char* __restrict__ V8Th, bf16* Oh, char* shm, float shift) {
    const int tid = fresh_tid(), lane = tid & 63, r32 = lane & 31, hi = lane >> 5; const int wid = __builtin_amdgcn_readfirstlane(tid >> 6);
    const int q0 = qb * QB;
    const unsigned lds0 = (unsigned)(uintptr_t)shm;
    constexpr int KSL = 4096;
    const int prow = 8 * wid + ((lane & 31) >> 2), pch = ((lane & 3) ^ ((prow >> 2) & 3)) * 16;
    const unsigned char* ksrc = K8h + (long)prow * 128 + pch;
    const unsigned char* vsrc = V8Th + (long)prow * 64 + pch;
    const unsigned kdst = lds0 + LDS_K + wid * 512, vdst = lds0 + LDS_V + wid * 512;
#define DMA_K(t, slot) do { if (lane < 32) glds16(ksrc + (long)(t) * KVBLK * 128, (unsigned)__builtin_amdgcn_readfirstlane(kdst + (slot))); } while (0)
#define DMA_V(t, slot) do { if (lane < 32) glds16(vsrc + (long)(t) * 4096, (unsigned)__builtin_amdgcn_readfirstlane(vdst + (slot))); } while (0)
    const lds_cptr shm3 = (lds_cptr)shm; const int ksw = (r32 >> 2) & 3;
    const int fo0 = r32 * 64 + (((2 * hi) ^ ksw) * 16), fo1 = r32 * 64 + (((2 * hi + 1) ^ ksw) * 16);
    const lds_cptr kp0 = shm3 + LDS_K, vp0 = shm3 + LDS_V;
    constexpr int NT = SEQ / KVBLK;
    DMA_K(0, 0); DMA_V(0, 0); DMA_K(1, KSL);
    v8i qf; { const unsigned char* qp = Q8h + (long)(q0 + wid * QBLK + r32) * 512 + hi * 32; qf = __builtin_shufflevector(*(const v4i*)qp, *(const v4i*)(qp + 16), 0, 1, 2, 3, 4, 5, 6, 7); }
    const int sc_k = 127 - 3, sc_q = 127 - 5, sc_v = 127 - 3, sc_1 = 127;
    v8i kf8[2], vf8[2], pa;
    v8i ones8; { const int o4 = 0x38383838; ones8 = (v8i){o4, o4, o4, o4, o4, o4, o4, o4}; asm volatile("" : "+v"(ones8)); }
    f32x16 cin; { const float ns = -shift; _Pragma("unroll") for (int r = 0; r < 16; ++r) cin[r] = ns; asm volatile("" : "+v"(cin)); }
#define LD8(dst, base, slotoff) do { _Pragma("unroll") for (int n_ = 0; n_ < 2; ++n_) dst[n_] = __builtin_shufflevector(*(const LAS v4i*)((base) + (slotoff) + n_ * 2048 + fo0), *(const LAS v4i*)((base) + (slotoff) + n_ * 2048 + fo1), 0, 1, 2, 3, 4, 5, 6, 7); } while (0)
#define QK8(n_) __builtin_amdgcn_mfma_scale_f32_32x32x64_f8f6f4(kf8[n_], qf, cin, 0, 0, 0, sc_k, 0, sc_q)
#define ACC8(acc, a_, b_, sb_) asm volatile("s_nop 1\n\tv_mfma_scale_f32_32x32x64_f8f6f4 %0, %1, %2, %0, %3, %4 op_sel_hi:[0,0,0]" : "+v"(acc) : "v"(a_), "v"(b_), "v"(sc_1), "v"(sb_))
#define PACK8(P0, P1) do { pa[0] = (int)pk4_fp8_nc(P0[0], P0[1], P0[2], P0[3]); pa[1] = (int)pk4_fp8_nc(P0[4], P0[5], P0[6], P0[7]); pa[2] = (int)pk4_fp8_nc(P0[8], P0[9], P0[10], P0[11]); pa[3] = (int)pk4_fp8_nc(P0[12], P0[13], P0[14], P0[15]); \
    pa[4] = (int)pk4_fp8_nc(P1[0], P1[1], P1[2], P1[3]); pa[5] = (int)pk4_fp8_nc(P1[4], P1[5], P1[6], P1[7]); pa[6] = (int)pk4_fp8_nc(P1[8], P1[9], P1[10], P1[11]); pa[7] = (int)pk4_fp8_nc(P1[12], P1[13], P1[14], P1[15]); } while (0)
    f32x16 o[2]; o[0] = f32x16{}; o[1] = f32x16{}; f32x16 lsum = f32x16{};
    f32x16 pA0, pA1, pB0, pB1;
    int sl_prev = 0, sl_cur = 0, sl_next = KSL;
#define ROT() do { sl_prev = sl_cur; sl_cur = sl_next; sl_next = (sl_next == (NSLOT - 1) * KSL) ? 0 : sl_next + KSL; } while (0)
    DMA_K(2, 2 * KSL);
    WAIT_BAR(3);
    LD8(kf8, kp0, 0); pA0 = QK8(0); pA1 = QK8(1);
    _Pragma("unroll") for (int r = 0; r < 16; ++r) pA0[r] = __builtin_amdgcn_exp2f(pA0[r]);
    _Pragma("unroll") for (int r = 0; r < 16; ++r) pA1[r] = __builtin_amdgcn_exp2f(pA1[r]);
    WAIT_BAR(0);
    DMA_K(3, 0); DMA_V(1, KSL);
    ROT();
    LD8(kf8, kp0, sl_cur);
    WAIT_BAR(2);
#define PIN(x) asm volatile("" : "+v"(x))
#define EX(v) __builtin_amdgcn_exp2f(v)
#define EX4(X, B) do { X[B] = EX(X[B]); X[B + 1] = EX(X[B + 1]); X[B + 2] = EX(X[B + 2]); X[B + 3] = EX(X[B + 3]); } while (0)
#define STEP(C0, C1, P0, P1, t, GK, GV, GL) do { SBAR(); \
    LD8(vf8, vp0, sl_prev); \
    C0 = QK8(0); PACK8(P0, P1); PIN(pa); \
    C1 = QK8(1); \
    if (GK) { DMA_K((t) + 3, sl_cur); } if (GV) { DMA_V((t) + 1, sl_next); } \
    \
    ACC8(o[0], pa, vf8[0], sc_v); EX4(C0, 0); EX4(C0, 4); EX4(C0, 8); PIN(C0); \
    ACC8(o[1], pa, vf8[1], sc_v); EX4(C0, 12); EX4(C1, 0); EX4(C1, 4); PIN(C0); PIN(C1); \
    if (GL) { LD8(kf8, kp0, sl_next); } \
    ACC8(lsum, pa, ones8, sc_1); EX4(C1, 8); EX4(C1, 12); PIN(C1); \
    } while (0)
    int t = 1;
    for (; t + 5 < NT; t += 2) {
        STEP(pB0, pB1, pA0, pA1, t, true, true, true);     WAIT_BAR(2); ROT();
        STEP(pA0, pA1, pB0, pB1, t + 1, true, true, true); WAIT_BAR(2); ROT();
    }
#define ENDW(tt) do { if ((tt) + 3 < NT) { WAIT_BAR(2); } else if ((tt) + 2 < NT) { WAIT_BAR(1); } else { WAIT_BAR(0); } } while (0)
    for (; t + 1 < NT; t += 2) {
        STEP(pB0, pB1, pA0, pA1, t, (t + 3 < NT), (t + 1 < NT), (t + 1 < NT));         ENDW(t);     ROT();
        STEP(pA0, pA1, pB0, pB1, t + 1, (t + 4 < NT), (t + 2 < NT), (t + 2 < NT));     ENDW(t + 1); ROT();
    }
    STEP(pB0, pB1, pA0, pA1, NT - 1, false, false, false);
    { PACK8(pB0, pB1); PIN(pa); SBAR(); LD8(vf8, vp0, sl_cur); SBAR();
      ACC8(o[0], pa, vf8[0], sc_v); ACC8(o[1], pa, vf8[1], sc_v); ACC8(lsum, pa, ones8, sc_1); }
    asm volatile("s_nop 15\n\ts_nop 15" : "+v"(o[0]), "+v"(o[1]), "+v"(lsum));
#undef PIN
#undef EX
#undef EX4
#undef STEP
#undef ENDW
    bf16* Ow = Oh + (long)(q0 + wid * QBLK) * OP;
    { bf16* stg = (bf16*)(shm + LDS_OST) + wid * 2048;
#pragma unroll
      for (int r = 0; r < 16; ++r) { const int orow = crow(r, hi); const float rl = lsum[r] > 0.f ? __builtin_amdgcn_rcpf(lsum[r]) : 0.f;
#pragma unroll
        for (int d0 = 0; d0 < 2; ++d0) stg[orow * 64 + d0 * 32 + r32] = __float2bfloat16(o[d0][r] * rl); }
      asm volatile("s_waitcnt lgkmcnt(0)" ::: "memory");
#pragma unroll
      for (int i = 0; i < 4; ++i) { const int row = i * 8 + (lane >> 3), ch = lane & 7; const u32x4 v = *(const u32x4*)(stg + row * 64 + ch * 8); ATTN_STORE16(Ow + (long)row * OP + ch * 8, v); } }
    asm volatile("s_waitcnt lgkmcnt(0)\n\ts_barrier" ::: "memory");
#undef DMA_K
#undef DMA_V
#undef ROT
#undef LD8
#undef QK8
#undef ACC8
#undef PACK8
}
constexpr int ATTN_LDS_BYTES = LDS_BYTES;
#undef SBAR
#undef WAIT_BAR
}

namespace na_body {
constexpr int NA_K = 0, NA_V = 65536;
typedef short v4i16_t __attribute__((ext_vector_type(4)));
__device__ __forceinline__ int clampi(int v, int lo, int hi) { return v < lo ? lo : (v > hi ? hi : v); }
__device__ __forceinline__ void na_phase(LAS unsigned char* lds, LAS float* biasL, LAS float* xch, const bf16_t* QKV, bf16_t* Y, const float* rpb, int vcu) {
    const int tid = fresh_tid(), lane = tid & 63, wid = __builtin_amdgcn_readfirstlane(tid >> 6);
    const int bh = vcu >> 3, b = bh >> 3, h = bh & 7, rbase = (vcu & 7) * 16;
    for (int i = tid; i < 15 * 31; i += 512) biasL[i] = rpb[h * 465 + i];
    const int lc = tid >> 3, lch = tid & 7;
    const unsigned kwoff = (unsigned)(lc * 128 + ((lch ^ (lc & 7)) * 16));
    const unsigned vwoff = (unsigned)(lc * 128 + (((lch >> 1) ^ ((lc >> 1) & 3)) * 32) + (lch & 1) * 16);
    const int q = lane & 15, g = lane >> 4;
    { const int rs0 = clampi(rbase - 4, 0, 120);
      u32x4 kv[8], vv[8];
#pragma unroll
      for (int i = 0; i < 8; ++i) { const size_t tok = (size_t)b * SEQ + (size_t)(rs0 + i) * 64 + lc;
          kv[i] = *(const u32x4*)(QKV + tok * NQKV + C_KNA + h * 64 + lch * 8); vv[i] = *(const u32x4*)(QKV + tok * NQKV + C_VNA + h * 64 + lch * 8); }
#pragma unroll
      for (int i = 0; i < 8; ++i) { const int row = rs0 + i;
          *(LAS u32x4*)(lds + NA_K + (row & 7) * 8192 + kwoff) = kv[i]; *(LAS u32x4*)(lds + NA_V + (row & 7) * 8192 + vwoff) = vv[i]; } }
    __syncthreads();
    const int tile_ = wid & 3, c0_ = tile_ * 16;
    bf16x8 qn[2];
#pragma unroll
    for (int ks = 0; ks < 2; ++ks) qn[ks] = *(const bf16x8*)(QKV + ((size_t)b * SEQ + (size_t)rbase * 64 + c0_ + q) * NQKV + C_QNA + h * 64 + ks * 32 + g * 8);
    for (int rr = 0; rr < 16; ++rr) {
        const int r = rbase + rr, rs = clampi(r - 4, 0, 120);
        const int rsn = (rr < 15) ? clampi(r + 1 - 4, 0, 120) : rs; const bool pf = rsn != rs;
        u32x4 pk = (u32x4){0u, 0u, 0u, 0u}, pv = (u32x4){0u, 0u, 0u, 0u};
        if (pf) { const size_t tok = (size_t)b * SEQ + (size_t)(rsn + 7) * 64 + lc;
            pk = *(const u32x4*)(QKV + tok * NQKV + C_KNA + h * 64 + lch * 8); pv = *(const u32x4*)(QKV + tok * NQKV + C_VNA + h * 64 + lch * 8); }
        {
            const int tile = wid & 3, kh = wid >> 2;
            const int c0 = tile * 16, u0 = clampi(c0 - 8, 0, 32);
            const size_t tq = (size_t)b * SEQ + (size_t)r * 64 + c0 + q;
            bf16x8 qf[2]; qf[0] = qn[0]; qf[1] = qn[1];
            { const int rn = (rr < 15) ? r + 1 : r; const size_t tqn = (size_t)b * SEQ + (size_t)rn * 64 + c0 + q;
#pragma unroll
              for (int ks = 0; ks < 2; ++ks) qn[ks] = *(const bf16x8*)(QKV + tqn * NQKV + C_QNA + h * 64 + ks * 32 + g * 8); }
            f32x4 s[4][2];
#pragma unroll
            for (int kk = 0; kk < 4; ++kk) { const int slot = (rs + 4 * kh + kk) & 7;
#pragma unroll
                for (int hf = 0; hf < 2; ++hf) { const int kc = u0 + hf * 16 + q;
                    f32x4 a = (f32x4){0.f, 0.f, 0.f, 0.f};
#pragma unroll
                    for (int ks = 0; ks < 2; ++ks) { const bf16x8 kfr = *(const LAS bf16x8*)(lds + NA_K + slot * 8192 + kc * 128 + (((ks * 4 + g) ^ (kc & 7)) * 16));
                        a = __builtin_amdgcn_mfma_f32_16x16x32_bf16(kfr, qf[ks], a, 0, 0, 0); }
                    s[kk][hf] = a; } }
            const int c = c0 + q, cs = clampi(c - 8, 0, 48), lo = cs - u0;
            const int dcb = u0 - c + 15 + 4 * g;
            float mx = -1e30f;
#pragma unroll
            for (int kk = 0; kk < 4; ++kk) { const int dr = rs + 4 * kh + kk - r + 7;
#pragma unroll
                for (int hf = 0; hf < 2; ++hf)
#pragma unroll
                    for (int i = 0; i < 4; ++i) { const int kcl = 16 * hf + 4 * g + i; const bool valid = (kcl >= lo) && (kcl < lo + 16);
                        const int dc = clampi(dcb + 16 * hf + i, 0, 30);
                        const float v = valid ? (s[kk][hf][i] + biasL[dr * 31 + dc]) * LOG2E : -1e30f;
                        s[kk][hf][i] = v; mx = fmaxf(mx, v); } }
            mx = swap16_max(mx); mx = swap32_max(mx);
            float l = 0.f;
#pragma unroll
            for (int kk = 0; kk < 4; ++kk)
#pragma unroll
                for (int hf = 0; hf < 2; ++hf)
#pragma unroll
                    for (int i = 0; i < 4; ++i) { const float p = __builtin_amdgcn_exp2f(s[kk][hf][i] - mx); s[kk][hf][i] = p; l += p; }
            l = swap16_sum(l, l); l = swap32_sum(l, l);
            f32x4 o[4];
#pragma unroll
            for (int nb = 0; nb < 4; ++nb) o[nb] = (f32x4){0.f, 0.f, 0.f, 0.f};
            const int qq = (lane & 15) >> 2, pp = lane & 3;
            const int kcA = u0 + 4 * g + qq, kcB = kcA + 16;
#pragma unroll
            for (int kk = 0; kk < 4; ++kk) { const int slot = (rs + 4 * kh + kk) & 7;
                u32x4 pw; pw.x = pk2(s[kk][0][0], s[kk][0][1]); pw.y = pk2(s[kk][0][2], s[kk][0][3]); pw.z = pk2(s[kk][1][0], s[kk][1][1]); pw.w = pk2(s[kk][1][2], s[kk][1][3]);
                const bf16x8 pf = __builtin_bit_cast(bf16x8, pw);
#pragma unroll
                for (int nb = 0; nb < 4; ++nb) {
                    const s16x4 va = __builtin_bit_cast(s16x4, __builtin_amdgcn_ds_read_tr16_b64_v4i16((LAS v4i16_t*)(lds + NA_V + slot * 8192 + kcA * 128 + ((nb ^ ((kcA >> 1) & 3)) * 32) + pp * 8)));
                    const s16x4 vb = __builtin_bit_cast(s16x4, __builtin_amdgcn_ds_read_tr16_b64_v4i16((LAS v4i16_t*)(lds + NA_V + slot * 8192 + kcB * 128 + ((nb ^ ((kcB >> 1) & 3)) * 32) + pp * 8)));
                    const bf16x8 vf = (bf16x8){va[0], va[1], va[2], va[3], vb[0], vb[1], vb[2], vb[3]};
                    o[nb] = __builtin_amdgcn_mfma_f32_16x16x32_bf16(vf, pf, o[nb], 0, 0, 0); } }
            LAS float* px = xch + (size_t)(tile * 64 + lane) * 18;
            if (kh == 1) { px[0] = mx; px[1] = l;
#pragma unroll
                for (int nb = 0; nb < 4; ++nb)
#pragma unroll
                    for (int i = 0; i < 4; ++i) px[2 + nb * 4 + i] = o[nb][i]; }
            __syncthreads();
            if (kh == 0) { const float mb = px[0], lb = px[1]; const float m = fmaxf(mx, mb), fa = __builtin_amdgcn_exp2f(mx - m), fb = __builtin_amdgcn_exp2f(mb - m);
                const float rl = 1.0f / (l * fa + lb * fb);
#pragma unroll
                for (int nb = 0; nb < 4; ++nb) { float t[4];
#pragma unroll
                    for (int i = 0; i < 4; ++i) t[i] = (o[nb][i] * fa + px[2 + nb * 4 + i] * fb) * rl;
                    u32x2 w; w.x = pk2(t[0], t[1]); w.y = pk2(t[2], t[3]);
                    *(u32x2*)(Y + tq * DMODEL + h * 64 + nb * 16 + 4 * g) = w; } }
        }
        if (pf) { *(LAS u32x4*)(lds + NA_K + ((rsn + 7) & 7) * 8192 + kwoff) = pk; *(LAS u32x4*)(lds + NA_V + ((rsn + 7) & 7) * 8192 + vwoff) = pv; }
        __syncthreads();
    }
}
}

constexpr size_t MiB = 1u << 20;
constexpr size_t WS_CTL = 0, CTL_ZERO_BYTES = 1 * MiB;
constexpr size_t WS_MOD = 1 * MiB;
constexpr size_t WS_IDX = 2 * MiB;
constexpr size_t WS_GSEL = 2 * MiB + 256 * 1024;
constexpr size_t WS_AFF = 3 * MiB;
constexpr size_t WS_SLOT = 5 * MiB;
constexpr size_t WS_WIN = 7 * MiB;
constexpr size_t WS_WG8 = 12 * MiB;
constexpr size_t WS_WA = 16 * MiB, WS_WB = 17 * MiB, WS_WOUT = 18 * MiB;
constexpr size_t WS_WGU = 20 * MiB;
constexpr size_t WS_WD = 148 * MiB;
constexpr size_t WS_H = 212 * MiB;
constexpr size_t WS_QKV = 276 * MiB;
constexpr size_t WS_GATES = 420 * MiB;
constexpr size_t WS_END = 548 * MiB;
constexpr size_t WS_YBUF = WS_WGU;
static_assert(WS_QKV + (size_t)65536 * 2048 * 2 <= WS_END, "HMID fits");
constexpr int CW_BAR = 4096;

constexpr int RING_OFF = 0, RING_BYTES = 131072;
constexpr int LDSCTL_OFF = RING_BYTES, MISC_OFF = LDSCTL_OFF + 320;
constexpr int NABIAS_OFF = RING_BYTES + 1024;
constexpr int NAXCH_OFF = RING_BYTES + 4096;
constexpr int LDS_BYTES = 163840;

#define XB_TMO      128
#define XB_XCNT(j)  (256  + 64 * (j))
#define XB_XSUB(j)  (1280 + 64 * (j))
#define XB_XGEN(j)  (2304 + 64 * (j))
#define XB_TOP      3328
#define XB_TOPGEN   3392
#define XCD_BAR_WORDS 3456
#define XB_SPIN_CAP (1u << 22)
__device__ __forceinline__ unsigned xb_ld(unsigned* p)              { return __hip_atomic_load(p, __ATOMIC_RELAXED, __HIP_MEMORY_SCOPE_AGENT); }
__device__ __forceinline__ unsigned xb_add(unsigned* p, unsigned v) { return __hip_atomic_fetch_add(p, v, __ATOMIC_RELAXED, __HIP_MEMORY_SCOPE_AGENT); }
__device__ __forceinline__ unsigned xb_xcc_id() { return (unsigned)__builtin_amdgcn_s_getreg((3 << 11) | 20) & 0xFu; }
#define XB_SPIN(cond, bar) do { unsigned _sp = 0; while (cond) { __builtin_amdgcn_s_sleep(1); \
    if ((++_sp & 255u) == 0u) { if (xb_ld(&(bar)[XB_TMO])) break; if (_sp > XB_SPIN_CAP) { atomicAdd(&(bar)[XB_TMO], 1u); break; } } } } while (0)
struct XcdBarrier { unsigned* bar; unsigned x; volatile LAS unsigned* st; };
__device__ __forceinline__ XcdBarrier xcd_barrier_post(unsigned* bar, volatile LAS unsigned* st) {
    XcdBarrier b; b.bar = bar; b.x = xb_xcc_id(); b.st = st;
    if (threadIdx.x == 0) (void)xb_add(&bar[XB_XCNT(b.x)], 1u);
    return b;
}
__device__ __forceinline__ void xcd_barrier_complete(unsigned* bar, unsigned x, unsigned& nloc, unsigned& nx) {
    const unsigned G = gridDim.x * gridDim.y * gridDim.z;
    unsigned sum, cnt, mine, sp = 0u;
    for (;;) {
        sum = 0u; cnt = 0u; mine = 0u;
#pragma unroll
        for (unsigned j = 0; j < 16; ++j) { const unsigned c = xb_ld(&bar[XB_XCNT(j)]); sum += c; cnt += (c > 0u) ? 1u : 0u; mine = (j == x) ? c : mine; }
        if (sum == G) break;
        __builtin_amdgcn_s_sleep(1);
        if ((++sp & 255u) == 0u) { if (xb_ld(&bar[XB_TMO])) break; if (sp > XB_SPIN_CAP) { atomicAdd(&bar[XB_TMO], 1u); break; } }
    }
    nloc = mine > 0u ? mine : 1u; nx = cnt > 0u ? cnt : 1u;
}
__device__ __forceinline__ void xcd_barrier(const XcdBarrier& b) {
    asm volatile("s_waitcnt vmcnt(0)" ::: "memory");
    __syncthreads();
    if (threadIdx.x == 0) {
        unsigned* bar = b.bar;
        __builtin_amdgcn_s_waitcnt(0);
        unsigned nloc = b.st[0], nx = b.st[1];
        if (nloc == 0u) { xcd_barrier_complete(bar, b.x, nloc, nx); b.st[0] = nloc; b.st[1] = nx; }
        const unsigned old = xb_add(&bar[XB_XSUB(b.x)], 1u);
        const unsigned gen = old / nloc;
        if (old + 1u == (gen + 1u) * nloc) {
            __builtin_amdgcn_fence(__ATOMIC_RELEASE, "agent");
            asm volatile("s_waitcnt vmcnt(0)" ::: "memory");
            const unsigned og = xb_add(&bar[XB_TOP], 1u);
            const unsigned tg = og / nx;
            if (og + 1u == (tg + 1u) * nx) xb_add(&bar[XB_TOPGEN], 1u);
            else XB_SPIN(xb_ld(&bar[XB_TOPGEN]) == tg, bar);
            __builtin_amdgcn_fence(__ATOMIC_ACQUIRE, "agent");
            xb_add(&bar[XB_XGEN(b.x)], 1u);
            asm volatile("s_waitcnt vmcnt(0)" ::: "memory");
        } else {
            XB_SPIN(xb_ld(&bar[XB_XGEN(b.x)]) == gen, bar);
            __builtin_amdgcn_fence(__ATOMIC_ACQUIRE, "agent");
            asm volatile("s_waitcnt vmcnt(0)" ::: "memory");
        }
    }
    __syncthreads();
}

#define LDS_WAIT() asm volatile("s_waitcnt lgkmcnt(0)" ::: "memory")
template <class RowMap>
__device__ __forceinline__ void p0_transpose_item(const float* W, int K, int N, bf16_t* WT, LAS float* scr, int item, int lane, const RowMap& rowmap) {
    const int nblk = N / 32, kb = item / nblk, nb = item % nblk, k0 = 64 * kb, n0 = 32 * nb;
    float ld_[32];
#pragma unroll
    for (int i = 0; i < 32; ++i) ld_[i] = __builtin_nontemporal_load(&W[(size_t)(k0 + 2 * i + (lane >> 5)) * N + n0 + (lane & 31)]);
#pragma unroll
    for (int i = 0; i < 32; ++i) scr[(2 * i + (lane >> 5)) * 33 + (lane & 31)] = ld_[i];
    LDS_WAIT(); asm volatile("" ::: "memory");
    const int c = lane & 7;
#pragma unroll
    for (int j = 0; j < 4; ++j) { const int n = (lane >> 3) + 8 * j; const LAS float* s = scr + (8 * c) * 33 + n;
        u32x4 o; o.x = pk2(s[0 * 33], s[1 * 33]); o.y = pk2(s[2 * 33], s[3 * 33]); o.z = pk2(s[4 * 33], s[5 * 33]); o.w = pk2(s[6 * 33], s[7 * 33]);
        *(u32x4*)(WT + (size_t)rowmap(n0 + n) * K + k0 + 8 * c) = o; }
    LDS_WAIT(); asm volatile("" ::: "memory");
}
template <class RowMap>
__device__ __forceinline__ void p0_transpose_item_f8(const float* W, int K, int N, unsigned char* WT, LAS float* scr, int item, int lane, const RowMap& rowmap, float scale) {
    const int nblk = N / 32, kb = item / nblk, nb = item % nblk, k0 = 64 * kb, n0 = 32 * nb;
    float ld_[32];
#pragma unroll
    for (int i = 0; i < 32; ++i) ld_[i] = __builtin_nontemporal_load(&W[(size_t)(k0 + 2 * i + (lane >> 5)) * N + n0 + (lane & 31)]);
#pragma unroll
    for (int i = 0; i < 32; ++i) scr[(2 * i + (lane >> 5)) * 33 + (lane & 31)] = ld_[i];
    LDS_WAIT(); asm volatile("" ::: "memory");
#pragma unroll
    for (int j = 0; j < 2; ++j) { const int p = lane + 64 * j, n = p >> 2, c = p & 3; const LAS float* s = scr + (16 * c) * 33 + n;
        u32x4 o;
        o.x = pk4_fp8(s[0 * 33] * scale, s[1 * 33] * scale, s[2 * 33] * scale, s[3 * 33] * scale);
        o.y = pk4_fp8(s[4 * 33] * scale, s[5 * 33] * scale, s[6 * 33] * scale, s[7 * 33] * scale);
        o.z = pk4_fp8(s[8 * 33] * scale, s[9 * 33] * scale, s[10 * 33] * scale, s[11 * 33] * scale);
        o.w = pk4_fp8(s[12 * 33] * scale, s[13 * 33] * scale, s[14 * 33] * scale, s[15 * 33] * scale);
        *(u32x4*)(WT + (size_t)rowmap(n0 + n) * K + k0 + 16 * c) = o; }
    LDS_WAIT(); asm volatile("" ::: "memory");
}
struct RowId { __device__ __forceinline__ int operator()(int n) const { return n; } };
struct RowIn { __device__ __forceinline__ int operator()(int n) const { if (n < 1536) return n; const int oc = n & 255; return (n & ~255) + 128 * ((oc >> 5) & 1) + 32 * (oc >> 6) + (oc & 31); } };
struct RowGate { __device__ __forceinline__ int operator()(int n) const { const int g = n - NQKV, c = g & 1023; return 768 + (c >> 7) * 256 + (g >> 10) * 128 + (c & 127); } };
struct RowAll8 { __device__ __forceinline__ int operator()(int n) const { if (n < NQKV) return RowIn{}(n); const int g = n - NQKV, c = g & 1023; return NQKV + (c >> 7) * 256 + (g >> 10) * 128 + (c & 127); } };
struct RowHead8 { __device__ __forceinline__ int operator()(int n) const { return RowIn{}(n) - 1536; } };
struct RowGU { int up; __device__ __forceinline__ int operator()(int f) const { return (f >> 7) * 256 + up * 128 + (f & 127); } };

struct CvDesc { const float* W; unsigned char* WT; int K, N, k0, n0, gu, up; };
__device__ __forceinline__ CvDesc cv_decode(int r, const float* w_eg, const float* w_eu, const float* w_ed, unsigned char* WGU, unsigned char* WD) {
    constexpr int I_GU = 16 * 64, I_D = 32 * 32;
    CvDesc d; const int e = r / (2 * I_GU + I_D); int q = r - e * (2 * I_GU + I_D);
    if (q < 2 * I_GU) { d.up = q >= I_GU; q -= d.up * I_GU; d.W = (d.up ? w_eu : w_eg) + (size_t)e * 1024 * 2048; d.WT = WGU + (size_t)e * 4096 * 1024; d.K = 1024; d.N = 2048; d.gu = 1; }
    else { q -= 2 * I_GU; d.W = w_ed + (size_t)e * 2048 * 1024; d.WT = WD + (size_t)e * 1024 * 2048; d.K = 2048; d.N = 1024; d.gu = 0; d.up = 0; }
    const int nblk = d.N / 32; d.k0 = 64 * (q / nblk); d.n0 = 32 * (q % nblk);
    return d;
}
#define CV_LOAD(ld_, d_) do { _Pragma("unroll") for (int i_ = 0; i_ < 32; ++i_) ld_[i_] = __builtin_nontemporal_load(&(d_).W[(size_t)((d_).k0 + 2 * i_ + (lane >> 5)) * (d_).N + (d_).n0 + (lane & 31)]); } while (0)
#define CV_FINISH(ld_, d_) do { _Pragma("unroll") for (int i_ = 0; i_ < 32; ++i_) scr[(2 * i_ + (lane >> 5)) * 33 + (lane & 31)] = ld_[i_]; \
        LDS_WAIT(); asm volatile("" ::: "memory"); \
        _Pragma("unroll") for (int j_ = 0; j_ < 2; ++j_) { const int p_ = lane + 64 * j_, n_ = p_ >> 2, c_ = p_ & 3; const LAS float* s_ = scr + (16 * c_) * 33 + n_; const int f_ = (d_).n0 + n_; \
            const int row_ = (d_).gu ? ((f_ >> 7) * 256 + (d_).up * 128 + (f_ & 127)) : f_; u32x4 o_; \
            o_.x = pk4_fp8(s_[0 * 33] * F8_SC_W, s_[1 * 33] * F8_SC_W, s_[2 * 33] * F8_SC_W, s_[3 * 33] * F8_SC_W); \
            o_.y = pk4_fp8(s_[4 * 33] * F8_SC_W, s_[5 * 33] * F8_SC_W, s_[6 * 33] * F8_SC_W, s_[7 * 33] * F8_SC_W); \
            o_.z = pk4_fp8(s_[8 * 33] * F8_SC_W, s_[9 * 33] * F8_SC_W, s_[10 * 33] * F8_SC_W, s_[11 * 33] * F8_SC_W); \
            o_.w = pk4_fp8(s_[12 * 33] * F8_SC_W, s_[13 * 33] * F8_SC_W, s_[14 * 33] * F8_SC_W, s_[15 * 33] * F8_SC_W); \
            *(u32x4*)((d_).WT + (size_t)row_ * (d_).K + (d_).k0 + 16 * c_) = o_; } \
        LDS_WAIT(); asm volatile("" ::: "memory"); } while (0)
__device__ __forceinline__ void conv_experts_pipelined(int first, int end, int step, int lane, LAS float* scr, const float* w_eg, const float* w_eu, const float* w_ed, unsigned char* WGU, unsigned char* WD) {
    float ldA[32], ldB[32]; CvDesc dA, dB; int itA = first, itB = first + step;
    if (itA < end) { dA = cv_decode(itA, w_eg, w_eu, w_ed, WGU, WD); CV_LOAD(ldA, dA); }
    if (itB < end) { dB = cv_decode(itB, w_eg, w_eu, w_ed, WGU, WD); CV_LOAD(ldB, dB); }
    for (;;) {
        if (itA >= end) break;
        CV_FINISH(ldA, dA); itA += 2 * step;
        if (itA < end) { dA = cv_decode(itA, w_eg, w_eu, w_ed, WGU, WD); CV_LOAD(ldA, dA); }
        if (itB >= end) break;
        CV_FINISH(ldB, dB); itB += 2 * step;
        if (itB < end) { dB = cv_decode(itB, w_eg, w_eu, w_ed, WGU, WD); CV_LOAD(ldB, dB); }
    }
}
#undef CV_LOAD
#undef CV_FINISH

__constant__ float INV_FREQ[16] = {1.0f, 0.5623413251903491f, 0.31622776601683794f, 0.1778279410038923f, 0.1f, 0.05623413251903491f, 0.03162277660168379f, 0.01778279410038923f,
                                   0.01f, 0.005623413251903491f, 0.0031622776601683794f, 0.001778279410038923f, 0.001f, 0.0005623413251903491f, 0.00031622776601683794f, 0.0001778279410038923f};

struct Args { const float* in[18]; float* out; unsigned char* ws; int ph_lo, ph_hi, li, pad; };
constexpr int NPHASE = 12;

__global__ void __launch_bounds__(512, 2) mk_fwd(Args args) {
    extern __shared__ __attribute__((aligned(16))) unsigned char lds_raw[];
    LAS unsigned char* lds = (LAS unsigned char*)lds_raw;
    volatile LAS unsigned* MISC = (volatile LAS unsigned*)(lds + MISC_OFF);
    const int G = gridDim.x; const int bx = blockIdx.x; const int vcu = (G % 8 == 0) ? (bx % 8) * (G / 8) + bx / 8 : bx;
    const int NGW = G * 8;
#define PH_IDS() const int tid = fresh_tid(), lane = tid & 63, wave = __builtin_amdgcn_readfirstlane(tid >> 6), gw = vcu * 8 + wave; (void)lane; (void)gw
    constexpr int I_IN = 16 * 136, I_BR = 8 * 32, I_OUT = 16 * 32, I_GU = 16 * 64, I_D = 32 * 32;
    constexpr int N_SMALL_ITEMS = I_IN + 2 * I_BR + I_OUT, N_EXP_ITEMS = 16 * (2 * I_GU + I_D);
#define CONV_ITEM(it_) do { LAS float* scr_ = (LAS float*)(lds + RING_OFF + wave * 16384); int r_ = (it_); \
        if (r_ < I_IN) { p0_transpose_item_f8(w_in, 1024, NIN, WG8, scr_, r_, lane, RowAll8{}, F8_SC_W); break; } r_ -= I_IN; \
        if (r_ < I_BR) { p0_transpose_item(w_bna, 512, 1024, WA, scr_, r_, lane, RowId{}); break; } r_ -= I_BR; \
        if (r_ < I_BR) { p0_transpose_item(w_bgqa, 512, 1024, WB, scr_, r_, lane, RowId{}); break; } r_ -= I_BR; \
        if (r_ < I_OUT) { p0_transpose_item(w_out, 1024, 1024, WOUT, scr_, r_, lane, RowId{}); break; } r_ -= I_OUT; \
        const int e_ = r_ / (2 * I_GU + I_D); r_ -= e_ * (2 * I_GU + I_D); \
        if (r_ < I_GU) { p0_transpose_item_f8(w_eg + (size_t)e_ * 1024 * 2048, 1024, 2048, (unsigned char*)WGU + (size_t)e_ * 4096 * 1024, scr_, r_, lane, RowGU{0}, F8_SC_W); break; } r_ -= I_GU; \
        if (r_ < I_GU) { p0_transpose_item_f8(w_eu + (size_t)e_ * 1024 * 2048, 1024, 2048, (unsigned char*)WGU + (size_t)e_ * 4096 * 1024, scr_, r_, lane, RowGU{1}, F8_SC_W); break; } r_ -= I_GU; \
        p0_transpose_item_f8(w_ed + (size_t)e_ * 2048 * 1024, 2048, 1024, (unsigned char*)WD + (size_t)e_ * 1024 * 2048, scr_, r_, lane, RowId{}, F8_SC_W); } while (0)
    unsigned char* ws = args.ws;
    const float* x = args.in[0]; const float* cvec = args.in[1]; const float* w_ada = args.in[2]; const float* b_ada = args.in[3]; const float* norm1_g = args.in[4];
    const float* w_in = args.in[5]; const float* q_norm_g = args.in[6]; const float* k_norm_g = args.in[7]; const float* na_rpb = args.in[8];
    const float* w_bna = args.in[9]; const float* w_bgqa = args.in[10]; const float* w_out = args.in[11]; const float* norm2_g = args.in[12]; const float* w_router = args.in[13];
    const float* w_eg = args.in[14]; const float* w_eu = args.in[15]; const float* w_ed = args.in[16]; const float* final_g = args.in[17];
    float* out = args.out;
    unsigned* ctl = (unsigned*)(ws + WS_CTL);
    float* MOD = (float*)(ws + WS_MOD); int* IDX = (int*)(ws + WS_IDX); float* GSEL = (float*)(ws + WS_GSEL); float* AFF = (float*)(ws + WS_AFF); int* SLOT = (int*)(ws + WS_SLOT);
    bf16_t* WIN = (bf16_t*)(ws + WS_WIN); bf16_t* WA = (bf16_t*)(ws + WS_WA); bf16_t* WB = (bf16_t*)(ws + WS_WB); bf16_t* WOUT = (bf16_t*)(ws + WS_WOUT);
    bf16_t* WGU = (bf16_t*)(ws + WS_WGU); bf16_t* WD = (bf16_t*)(ws + WS_WD);
    bf16_t* HB = (bf16_t*)(ws + WS_H); bf16_t* QKV = (bf16_t*)(ws + WS_QKV);
    bf16_t* GA = (bf16_t*)(ws + WS_GATES); unsigned char* R8 = ws + WS_GATES + 64 * MiB; unsigned char* H8 = ws + WS_GATES + 96 * MiB; unsigned char* WG8 = ws + WS_WIN;
    unsigned char* Q8 = ws + WS_WGU + 64 * MiB; unsigned char* K8 = ws + WS_WGU + 80 * MiB; unsigned char* V8T = ws + WS_WGU + 84 * MiB;
    bf16_t* DELTA = (bf16_t*)(ws + WS_GATES);
    bf16_t* MERGED = (bf16_t*)(ws + WS_QKV); bf16_t* HMID = (bf16_t*)(ws + WS_QKV); bf16_t* YBUF = (bf16_t*)(ws + WS_YBUF);

    { PH_IDS(); for (int u = tid; u < (LDS_BYTES - LDSCTL_OFF) / 4; u += 512) ((LAS unsigned*)(lds + LDSCTL_OFF))[u] = 0u; }
    __syncthreads();
    const bool use_bar = (MK_N_LAUNCHES != NPHASE);
    XcdBarrier bar; bar.bar = ctl + CW_BAR + args.li * XCD_BAR_WORDS; bar.x = 0; bar.st = nullptr;
    if (use_bar) bar = xcd_barrier_post(ctl + CW_BAR + args.li * XCD_BAR_WORDS, MISC + 8);
    const int lo = args.ph_lo, hi = args.ph_hi;
#ifndef PHASE_MASK
#define PHASE_MASK 0xFFF
#endif
#define IN(k) (((PHASE_MASK >> (k)) & 1) && lo <= (k) && (k) < hi)
#define SEAM(k) do { if (IN(k) && IN((k) + 1)) xcd_barrier(bar); } while (0)

    if (IN(0)) {
        PH_IDS();
        LAS float* scr = (LAS float*)(lds + RING_OFF + wave * 16384);
        if (vcu < 96) {
            LAS float* sl = (LAS float*)(lds + RING_OFF);
            for (int i = tid; i < 4096; i += 512) { const float cv = cvec[i]; sl[i] = cv * sigmoidf_fast(cv); }
            __syncthreads();
        }
        for (int it = vcu; it < 96; it += G) {
            const LAS float* sl = (const LAS float*)(lds + RING_OFF);
            const int col = it * 64 + lane; float a0 = 0.f, a1 = 0.f, a2 = 0.f, a3 = 0.f;
#pragma unroll 16
            for (int dd = 0; dd < 128; ++dd) { const int d = wave * 128 + dd; const float w = w_ada[(size_t)d * 6144 + col];
                a0 += sl[d] * w; a1 += sl[1024 + d] * w; a2 += sl[2048 + d] * w; a3 += sl[3072 + d] * w; }
            LAS float* part = (LAS float*)(lds + RING_OFF + 8 * 16384 - 8192);
            part[(wave * 4 + 0) * 64 + lane] = a0; part[(wave * 4 + 1) * 64 + lane] = a1; part[(wave * 4 + 2) * 64 + lane] = a2; part[(wave * 4 + 3) * 64 + lane] = a3;
            __syncthreads();
            if (tid < 256) { const int bb = tid >> 6, l = tid & 63; float s = 0.f;
#pragma unroll
                for (int w = 0; w < 8; ++w) s += part[(w * 4 + bb) * 64 + l];
                MOD[bb * 6144 + it * 64 + l] = s + b_ada[it * 64 + l]; }
            __syncthreads();
        }
        for (int it = gw; it < N_SMALL_ITEMS; it += NGW) { CONV_ITEM(it); }
    }
    SEAM(0);

    if (IN(1)) {
        PH_IDS();
        f32x4 gnv[4], nx[4];
#pragma unroll
        for (int j = 0; j < 4; ++j) { gnv[j] = *(const f32x4*)(norm1_g + 4 * lane + 256 * j); nx[j] = __builtin_nontemporal_load((const f32x4*)(x + (size_t)gw * DMODEL) + lane + 64 * j); }
        for (int m = gw; m < MT; m += NGW) { const int b = m >> 13; const float* mb = MOD + b * 6144;
            f32x4 v[4], scv[4], shv[4]; float s = 0.f;
#pragma unroll
            for (int j = 0; j < 4; ++j) { v[j] = nx[j]; scv[j] = *(const f32x4*)(mb + 1024 + 4 * lane + 256 * j); shv[j] = *(const f32x4*)(mb + 4 * lane + 256 * j); }
            const int mn = (m + NGW < MT) ? m + NGW : m;
#pragma unroll
            for (int j = 0; j < 4; ++j) nx[j] = __builtin_nontemporal_load((const f32x4*)(x + (size_t)mn * DMODEL) + lane + 64 * j);
#pragma unroll
            for (int j = 0; j < 4; ++j) s += (v[j].x * v[j].x + v[j].y * v[j].y) + (v[j].z * v[j].z + v[j].w * v[j].w);
            const float rinv = __builtin_amdgcn_rsqf(wave_sum(s) * (1.f / DMODEL) + EPS);
#pragma unroll
            for (int j = 0; j < 4; ++j) {
                const f32x4 hv = v[j] * rinv * gnv[j] * (scv[j] + 1.0f) + shv[j];
                ((unsigned*)(H8 + (size_t)m * DMODEL) + lane)[64 * j] = pk4_fp8(hv.x * F8_SC_H2, hv.y * F8_SC_H2, hv.z * F8_SC_H2, hv.w * F8_SC_H2); }
        }
    }
    SEAM(1);

#define ATTN_BOUND() float smaxp; { const int l_ = fresh_tid() & 63; float mq_ = fabsf(q_norm_g[l_]), mk_ = fabsf(k_norm_g[l_]); \
        _Pragma("unroll") for (int o_ = 1; o_ < 64; o_ <<= 1) { mq_ = fmaxf(mq_, __shfl_xor(mq_, o_)); mk_ = fmaxf(mk_, __shfl_xor(mk_, o_)); } smaxp = LOG2E * 8.0f * mq_ * mk_; } \
        const bool fast = __builtin_amdgcn_readfirstlane((int)(smaxp <= 24.0f)) != 0
    if (IN(2)) {
        ATTN_BOUND();
        { pg8::SchedPlain S; S.init(MT, NIN, G, bx, H8, DMODEL, WG8, DMODEL);
          pg8::EpiHeadGate E{pg8::EpiProj{QKV, Q8, K8, V8T, q_norm_g, k_norm_g, !fast}, pg8::EpiGate{GA, R8}};
          pg8::gemm_phase<true>(lds + RING_OFF, 8, S, E); }
    }
    SEAM(2);


    if (IN(4)) {
        PH_IDS();
#define CONV_EXPERTS() do { conv_experts_pipelined(gw, N_EXP_ITEMS, NGW, lane, (LAS float*)(lds + RING_OFF + wave * 16384), w_eg, w_eu, w_ed, (unsigned char*)WGU, (unsigned char*)WD); __syncthreads(); } while (0)
        const int cls = vcu & 3;
        if (cls == 0) CONV_EXPERTS();
        if (G == 256) na_body::na_phase(lds + RING_OFF, (LAS float*)(lds + NABIAS_OFF), (LAS float*)(lds + NAXCH_OFF), QKV, HB, na_rpb, vcu);
        if (cls == 1) CONV_EXPERTS();
        static_assert(attn_body::ATTN_LDS_BYTES <= RING_BYTES, "attention LDS");
        ATTN_BOUND(); const float shiftv = fmaxf(smaxp - 8.0f, 0.0f);
        for (int i = 0; i < 4; ++i) { const long L = (long)i * G + vcu; if (L >= 1024) break;
            if ((cls == 2 && i == 1) || (cls == 3 && i == 2)) { PH_IDS(); CONV_EXPERTS(); }
            const int ii = (int)(L >> 8), v = (int)(L & 255), bh = v >> 3, qb = (v & 7) * 4 + ii, b = bh >> 3, h = bh & 7;
            const attn_body::bf16* base = (const attn_body::bf16*)QKV + (size_t)b * SEQ * NQKV;
            if (fast) attn_body::attn_unit_f8(qb, Q8 + (size_t)b * SEQ * 512 + h * 64, K8 + (size_t)b * SEQ * 128 + (h >> 2) * 64, V8T + (size_t)(b * 2 + (h >> 2)) * 64 * SEQ,
                                    (attn_body::bf16*)HB + (size_t)b * SEQ * DMODEL + 512 + h * 64, (char*)lds_raw + RING_OFF, shiftv);
            else attn_body::attn_unit<8>(qb, base + C_QG + h * 64, base + C_KG + (h >> 2) * 64, base + C_VG + (h >> 2) * 64,
                                    (attn_body::bf16*)HB + (size_t)b * SEQ * DMODEL + 512 + h * 64, (char*)lds_raw + RING_OFF); }
#undef CONV_EXPERTS
    }
    SEAM(4);

    if (IN(5)) {
        pg8::SchedPlain S; S.init(MT, DMODEL, G, bx, HB + 512, DMODEL * 2, WB, 512 * 2); S.A2 = (const char*)HB; S.B2 = (const char*)WA; S.nt1 = 8;
        pg8::EpiMerge E{MERGED, GA, R8};
        pg8::gemm_phase<false, pg8::EpiMerge, pg8::SchedPlain, true>(lds + RING_OFF, 16, S, E);
    }
    SEAM(5);

    if (IN(6)) {
        pg8::SchedPlain S; S.init(MT, DMODEL, G, bx, MERGED, DMODEL * 2, WOUT, DMODEL * 2);
        pg8::EpiDelta E{DELTA, MOD};
        pg8::gemm_phase<false>(lds + RING_OFF, 16, S, E);
    }
    SEAM(6);

    if (IN(7)) {
        PH_IDS();
        LAS float* wr = (LAS float*)(lds + RING_OFF);
        for (int i = tid; i < 16384; i += 512) { const int d = i >> 4, e = i & 15; wr[e * 1024 + d] = w_router[i]; }
        __syncthreads();
        f32x4 nv[2][4]; u32x2 nd[2][4];
#define P7_LOADX(row_) do { const f32x4* p_ = (const f32x4*)(x + (size_t)(row_) * DMODEL) + lane; const u32x2* d_ = (const u32x2*)(DELTA + (size_t)(row_) * DMODEL) + lane; \
            _Pragma("unroll") for (int j_ = 0; j_ < 4; ++j_) { nv[0][j_] = __builtin_nontemporal_load(&p_[64 * j_]); nv[1][j_] = __builtin_nontemporal_load(&p_[256 + 64 * j_]); \
                nd[0][j_] = d_[64 * j_]; nd[1][j_] = d_[256 + 64 * j_]; } } while (0)
        P7_LOADX(gw * 2);
        for (int m = gw * 2; m < MT; m += NGW * 2) { const int b = m >> 13; const float* mb = MOD + b * 6144;
            f32x4 v[2][4], gnv[4], scv[4], shv[4]; float s0 = 0.f, s1 = 0.f;
            const int mn = (m + NGW * 2 < MT) ? m + NGW * 2 : m;
#pragma unroll
            for (int j = 0; j < 4; ++j) { const int col = 4 * lane + 256 * j;
#pragma unroll
                for (int r = 0; r < 2; ++r) { const u32x2 dd = nd[r][j]; v[r][j] = nv[r][j] + (f32x4){bf_lo(dd.x), bf_hi(dd.x), bf_lo(dd.y), bf_hi(dd.y)}; }
                gnv[j] = *(const f32x4*)(norm2_g + col); scv[j] = *(const f32x4*)(mb + 4096 + col); shv[j] = *(const f32x4*)(mb + 3072 + col); }
            P7_LOADX(mn);
            asm volatile("" ::: "memory");
#pragma unroll
            for (int j = 0; j < 4; ++j) {
                s0 += (v[0][j].x * v[0][j].x + v[0][j].y * v[0][j].y) + (v[0][j].z * v[0][j].z + v[0][j].w * v[0][j].w);
                s1 += (v[1][j].x * v[1][j].x + v[1][j].y * v[1][j].y) + (v[1][j].z * v[1][j].z + v[1][j].w * v[1][j].w); }
            s0 = wave_sum(s0); s1 = wave_sum(s1);
            const float rinv0 = __builtin_amdgcn_rsqf(s0 * (1.f / DMODEL) + EPS), rinv1 = __builtin_amdgcn_rsqf(s1 * (1.f / DMODEL) + EPS);
#pragma unroll
            for (int j = 0; j < 4; ++j) {
                const f32x4 a = gnv[j] * (scv[j] + 1.0f);
                v[0][j] = v[0][j] * rinv0 * a + shv[j]; v[1][j] = v[1][j] * rinv1 * a + shv[j];
                ((unsigned*)((unsigned char*)HB + (size_t)m * DMODEL) + lane)[64 * j] = pk4_fp8(v[0][j].x * F8_SC_H2, v[0][j].y * F8_SC_H2, v[0][j].z * F8_SC_H2, v[0][j].w * F8_SC_H2);
                ((unsigned*)((unsigned char*)HB + (size_t)(m + 1) * DMODEL) + lane)[64 * j] = pk4_fp8(v[1][j].x * F8_SC_H2, v[1][j].y * F8_SC_H2, v[1][j].z * F8_SC_H2, v[1][j].w * F8_SC_H2); }
            float pr[32];
#pragma unroll
            for (int e = 0; e < 16; ++e) { float a0 = 0.f, a1 = 0.f;
#pragma unroll
                for (int j = 0; j < 4; ++j) { const f32x4 w = *(const LAS f32x4*)(wr + e * 1024 + 4 * lane + 256 * j);
                    a0 += (v[0][j].x * w.x + v[0][j].y * w.y) + (v[0][j].z * w.z + v[0][j].w * w.w);
                    a1 += (v[1][j].x * w.x + v[1][j].y * w.y) + (v[1][j].z * w.z + v[1][j].w * w.w); }
                pr[e] = a0; pr[16 + e] = a1; if ((e & 3) == 3) asm volatile("" ::: "memory"); }
            float q16[16], q8[8];
#pragma unroll
            for (int i = 0; i < 16; ++i) q16[i] = swap32_sum(pr[i], pr[i + 16]);
#pragma unroll
            for (int i = 0; i < 8; ++i) q8[i] = swap16_sum(q16[i], q16[i + 8]);
            const bool up8 = (lane & 8) != 0, up4 = (lane & 4) != 0, up2 = (lane & 2) != 0;
            float q4[4], q2[2];
#pragma unroll
            for (int i = 0; i < 4; ++i) { float lo = q8[i], hi = q8[i + 4]; asm volatile("" : "+v"(lo), "+v"(hi)); q4[i] = (up8 ? hi : lo) + dppf<DPP_XOR8>(up8 ? lo : hi); }
#pragma unroll
            for (int i = 0; i < 2; ++i) { float lo = q4[i], hi = q4[i + 2]; asm volatile("" : "+v"(lo), "+v"(hi)); q2[i] = (up4 ? hi : lo) + lane_xor4(up4 ? lo : hi); }
            float mylog;
            { float lo = q2[0], hi = q2[1]; asm volatile("" : "+v"(lo), "+v"(hi)); mylog = (up2 ? hi : lo) + dppf<DPP_XOR2>(up2 ? lo : hi); }
            mylog += dppf<DPP_XOR1>(mylog);
            float mx = mylog;
            mx = fmaxf(mx, dppf<DPP_XOR2>(mx)); mx = fmaxf(mx, lane_xor4(mx)); mx = fmaxf(mx, dppf<DPP_XOR8>(mx)); mx = swap16_max(mx);
            const float ex = __expf(mylog - mx); float sum = ex;
            sum += dppf<DPP_XOR2>(sum); sum += lane_xor4(sum); sum += dppf<DPP_XOR8>(sum); sum = swap16_sum(sum, sum);
            if ((lane & 1) == 0) AFF[(unsigned)(m + (lane >> 5)) * 16u + (unsigned)((lane >> 1) & 15)] = ex * __builtin_amdgcn_rcpf(sum);
        }
#undef P7_LOADX
        __syncthreads();
    }
    SEAM(7);

    if (IN(8)) {
        PH_IDS();
        LAS unsigned* vals = (LAS unsigned*)(lds + RING_OFF);
        LAS unsigned* hist = (LAS unsigned*)(lds + RING_OFF + 32768);
        LAS unsigned* sel = (LAS unsigned*)(lds + RING_OFF + 32768 + 1024);
        LAS unsigned* wtot = (LAS unsigned*)(lds + RING_OFF + 32768 + 2048);
        for (int item = vcu; item < 64; item += G) { const int b = item >> 4, e = item & 15;
            __syncthreads();
            for (int k = 0; k < 16; ++k) { const int t = tid + 512 * k; vals[t] = __builtin_bit_cast(unsigned, AFF[((size_t)b * SEQ + t) * 16 + e]); }
            __syncthreads();
            unsigned mv[16];
#pragma unroll
            for (int k = 0; k < 16; ++k) mv[k] = vals[tid + 512 * k];
            unsigned T = 0u;
            for (int bit = 30; bit >= 0; --bit) { const unsigned cand = T | (1u << bit);
                unsigned c = 0u;
#pragma unroll
                for (int k = 0; k < 16; ++k) c += (unsigned)__popcll(__ballot(mv[k] >= cand));
                if (lane == 0) wtot[(bit & 1) * 8 + wave] = c;
                __syncthreads();
                unsigned tot = 0u;
#pragma unroll
                for (int w = 0; w < 8; ++w) tot += wtot[(bit & 1) * 8 + w];
                if (tot >= (unsigned)CAP) T = cand; }
            unsigned cgt = 0u;
#pragma unroll
            for (int k = 0; k < 16; ++k) cgt += (unsigned)__popcll(__ballot(mv[k] > T));
            __syncthreads();
            if (lane == 0) wtot[wave] = cgt;
            __syncthreads();
            unsigned ngt = 0u;
#pragma unroll
            for (int w = 0; w < 8; ++w) ngt += wtot[w];
            const unsigned need_eq = (unsigned)CAP - ngt;
            __syncthreads();
            unsigned cg = 0u, ce = 0u;
            for (int k = 0; k < 16; ++k) { const unsigned v = vals[16 * tid + k]; cg += (v > T) ? 1u : 0u; ce += (v == T) ? 1u : 0u; }
            unsigned packed = cg | (ce << 16), incl = packed;
#pragma unroll
            for (int o = 1; o < 64; o <<= 1) { const unsigned n = __shfl_up(incl, o); if (lane >= o) incl += n; }
            if (lane == 63) wtot[wave] = incl;
            __syncthreads();
            unsigned wbase = 0u;
            for (int w = 0; w < wave; ++w) wbase += wtot[w];
            const unsigned excl = wbase + incl - packed;
            unsigned g_before = excl & 0xffffu, e_before = excl >> 16;
            for (int k = 0; k < 16; ++k) { const int t = 16 * tid + k; const unsigned v = vals[t]; int slot = -1;
                if (v > T) { slot = (int)(g_before + (e_before < need_eq ? e_before : need_eq)); ++g_before; }
                else if (v == T) { if (e_before < need_eq) slot = (int)(g_before + e_before); ++e_before; }
                SLOT[((size_t)b * SEQ + t) * 16 + e] = slot;
                if (slot >= 0) { IDX[item * CAP + slot] = t; GSEL[item * CAP + slot] = __builtin_bit_cast(float, v); } }
        }
        __syncthreads();
    }
    SEAM(8);

    if (IN(9)) {
        pg8::SchedFfn1 S{G, vcu, (const char*)HB, (const char*)WGU, IDX, DMODEL, DMODEL};
        pg8::EpiFfn1 E{(unsigned char*)HMID};
        pg8::gemm_phase<true>(lds + RING_OFF, 8, S, E);
    }
    SEAM(9);

    if (IN(10)) {
        pg8::SchedFfn2 S{G, vcu, (const char*)HMID, (const char*)WD, FF, FF};
        pg8::EpiFfn2 E{(unsigned char*)YBUF, GSEL};
        pg8::gemm_phase<true>(lds + RING_OFF, 16, S, E);
    }
    SEAM(10);

    if (IN(11)) {
        PH_IDS();
        f32x4 fgv[4];
#pragma unroll
        for (int j = 0; j < 4; ++j) fgv[j] = *(const f32x4*)(final_g + 4 * lane + 256 * j);
        f32x4 nx[4]; u32x2 ndl[4]; int nsl;
#define P11_LOADX(row_) do { const f32x4* p_ = (const f32x4*)(x + (size_t)(row_) * DMODEL) + lane; const u32x2* d_ = (const u32x2*)(DELTA + (size_t)(row_) * DMODEL) + lane; \
            _Pragma("unroll") for (int j_ = 0; j_ < 4; ++j_) { nx[j_] = __builtin_nontemporal_load(&p_[64 * j_]); ndl[j_] = __builtin_nontemporal_load(&d_[64 * j_]); } \
            nsl = (lane < 16) ? SLOT[(size_t)(row_) * 16 + lane] : -1; } while (0)
#define P11_ISSUE() do { _Pragma("unroll") for (int k_ = 0; k_ < 4; ++k_) { if (mask) { const int e_ = __builtin_ctz(mask); mask &= mask - 1u; const int s_ = __builtin_amdgcn_readlane(sl, e_); \
                const unsigned* yr_ = (const unsigned*)((const unsigned char*)YBUF + ((size_t)(b * 16 + e_) * CAP + s_) * DMODEL) + lane; _Pragma("unroll") for (int j_ = 0; j_ < 4; ++j_) y[k_][j_] = __builtin_nontemporal_load(&yr_[64 * j_]); } \
            else { _Pragma("unroll") for (int j_ = 0; j_ < 4; ++j_) y[k_][j_] = 0u; } } } while (0)
#define P11_ACC() do { _Pragma("unroll") for (int k_ = 0; k_ < 4; ++k_) _Pragma("unroll") for (int j_ = 0; j_ < 4; ++j_) { const unsigned w_ = y[k_][j_]; \
            const auto lo_ = __builtin_amdgcn_cvt_pk_f32_fp8((int)w_, false), hi_ = __builtin_amdgcn_cvt_pk_f32_fp8((int)w_, true); a[j_].x += lo_[0]; a[j_].y += lo_[1]; a[j_].z += hi_[0]; a[j_].w += hi_[1]; } } while (0)
        P11_LOADX(gw);
        for (int m = gw; m < MT; m += NGW) { const int b = m >> 13; const float* g2 = MOD + b * 6144 + 5120;
            f32x4 v[4], a[4], g2v[4]; const int sl = nsl;
#pragma unroll
            for (int j = 0; j < 4; ++j) { const u32x2 dd = ndl[j]; v[j] = nx[j] + (f32x4){bf_lo(dd.x), bf_hi(dd.x), bf_lo(dd.y), bf_hi(dd.y)}; a[j] = (f32x4){0.f, 0.f, 0.f, 0.f}; g2v[j] = *(const f32x4*)(g2 + 4 * lane + 256 * j) * (1.0f / F8_SC_Y); }
            unsigned mask = (unsigned)__ballot(sl >= 0) & 0xFFFFu;
            const int mn = (m + NGW < MT) ? m + NGW : m;
            unsigned y[4][4];
            P11_ISSUE();
            P11_LOADX(mn);
            P11_ACC();
            while (mask) { P11_ISSUE(); P11_ACC(); }
            float s2 = 0.f;
#pragma unroll
            for (int j = 0; j < 4; ++j) { v[j] = v[j] + g2v[j] * a[j]; s2 += (v[j].x * v[j].x + v[j].y * v[j].y) + (v[j].z * v[j].z + v[j].w * v[j].w); }
            const float rinv = __builtin_amdgcn_rsqf(wave_sum(s2) * (1.f / DMODEL) + EPS);
            f32x4* xr = (f32x4*)(out + (size_t)m * DMODEL) + lane;
#pragma unroll
            for (int j = 0; j < 4; ++j) __builtin_nontemporal_store(v[j] * rinv * fgv[j], &xr[64 * j]);
        }
#undef P11_LOADX
#undef P11_ISSUE
#undef P11_ACC
    }
#undef IN
#undef SEAM
}

extern "C" void kernel_launch(void* const* d_in, const int* in_sizes, int n_in, void* d_out, int out_size, void* d_ws, size_t ws_size, hipStream_t stream) {
    static int grid = 0;
    if (grid == 0) {
        if (n_in != 18 || in_sizes[0] != MT * DMODEL || out_size != MT * DMODEL || ws_size < WS_END) {
            fprintf(stderr, "kernel_launch: unexpected shapes / workspace: n_in %d in0 %d out %d ws %zu (need %zu); nothing launched\n", n_in, n_in > 0 ? in_sizes[0] : -1, out_size, ws_size, (size_t)WS_END); grid = -1; return; }
        int dev = 0, cus = 0, per_cu = 0;
        if (hipGetDevice(&dev) != hipSuccess || hipDeviceGetAttribute(&cus, hipDeviceAttributeMultiprocessorCount, dev) != hipSuccess) { grid = -1; return; }
        if (hipFuncSetAttribute((const void*)mk_fwd, hipFuncAttributeMaxDynamicSharedMemorySize, LDS_BYTES) != hipSuccess) { fprintf(stderr, "kernel_launch: hipFuncSetAttribute failed\n"); grid = -1; return; }
        if (hipOccupancyMaxActiveBlocksPerMultiprocessor(&per_cu, (const void*)mk_fwd, 512, LDS_BYTES) != hipSuccess || per_cu < 1) fprintf(stderr, "kernel_launch: occupancy query reports %d\n", per_cu);
        (void)hipGetLastError();
        grid = cus;
        if (grid != 256) fprintf(stderr, "kernel_launch: %d CUs (expected 256)\n", grid);
    }
    if (grid < 0) return;
    if (hipMemsetAsync((char*)d_ws + WS_CTL, 0, CTL_ZERO_BYTES, stream) != hipSuccess) return;
    Args a{};
    for (int i = 0; i < 18; ++i) a.in[i] = (const float*)d_in[i];
    a.out = (float*)d_out; a.ws = (unsigned char*)d_ws;
#ifndef PROBE_DUP
#define PROBE_DUP -1
#endif
    constexpr int NL = (PROBE_DUP >= 0) ? 2 : MK_N_LAUNCHES;
    for (int li = 0; li < NL; ++li) {
        if (PROBE_DUP >= 0) { a.ph_lo = li == 0 ? 0 : PROBE_DUP; a.ph_hi = li == 0 ? PROBE_DUP + 1 : NPHASE; }
        else { a.ph_lo = (NL == NPHASE) ? li : (li * NPHASE) / NL; a.ph_hi = (NL == NPHASE) ? li + 1 : ((li + 1) * NPHASE) / NL; }
        a.li = li; a.pad = 0;
        hipLaunchKernelGGL(mk_fwd, dim3(grid), dim3(512), LDS_BYTES, stream, a);
        const hipError_t le = hipPeekAtLastError();
        if (le != hipSuccess) { fprintf(stderr, "kernel_launch: launch %d failed: %s\n", li, hipGetErrorName(le)); break; }
    }
}
```

```cpp
#include <hip/hip_runtime.h>
#include <hip/hip_bf16.h>
#include <cstdio>
#include <cstdint>

#ifndef MK_N_LAUNCHES
#define MK_N_LAUNCHES 1
#endif

#define LAS __attribute__((address_space(3)))
#define GAS __attribute__((address_space(1)))
typedef unsigned short bf16_t;
typedef short bf16x8 __attribute__((ext_vector_type(8)));
typedef short s16x4 __attribute__((ext_vector_type(4)));
typedef float f32x4 __attribute__((ext_vector_type(4)));
typedef float f32x2 __attribute__((ext_vector_type(2)));
typedef float f32x16 __attribute__((ext_vector_type(16)));
typedef unsigned u32x4 __attribute__((ext_vector_type(4)));
typedef unsigned u32x2 __attribute__((ext_vector_type(2)));
typedef int v8i __attribute__((ext_vector_type(8)));
typedef int v4i __attribute__((ext_vector_type(4)));

constexpr int BATCH = 4, SEQ = 8192, DMODEL = 1024, MT = BATCH * SEQ;
constexpr int NQKV = 2304, NGATE = 2048, NIN = 4352;
constexpr int C_QNA = 0, C_KNA = 512, C_VNA = 1024, C_QG = 1536, C_KG = 2048, C_VG = 2176;
constexpr int NEXP = 16, CAP = 1024, FF = 2048;
constexpr float EPS = 1e-6f;
constexpr float LOG2E = 1.4426950408889634f;
constexpr float C2 = 0.125f * LOG2E;

__device__ __forceinline__ unsigned f2bf(float f) { unsigned u = __builtin_bit_cast(unsigned, f); return (u + 0x7fffu + ((u >> 16) & 1u)) >> 16; }
__device__ __forceinline__ unsigned pk2(float lo, float hi) { return f2bf(lo) | (f2bf(hi) << 16); }
__device__ __forceinline__ float bf_lo(unsigned w) { return __builtin_bit_cast(float, w << 16); }
__device__ __forceinline__ float bf_hi(unsigned w) { return __builtin_bit_cast(float, w & 0xffff0000u); }
__device__ __forceinline__ unsigned cvt_pk_bf16(float lo, float hi) { unsigned r; asm volatile("v_cvt_pk_bf16_f32 %0, %1, %2" : "=v"(r) : "v"(lo), "v"(hi)); return r; }
__device__ __forceinline__ unsigned pk4_fp8(float a, float b, float c, float d) {
    a = __builtin_amdgcn_fmed3f(a, -448.f, 448.f); b = __builtin_amdgcn_fmed3f(b, -448.f, 448.f); c = __builtin_amdgcn_fmed3f(c, -448.f, 448.f); d = __builtin_amdgcn_fmed3f(d, -448.f, 448.f);
    int w = 0; w = __builtin_amdgcn_cvt_pk_fp8_f32(a, b, w, false); w = __builtin_amdgcn_cvt_pk_fp8_f32(c, d, w, true); return (unsigned)w; }
__device__ __forceinline__ unsigned pk4_fp8_nc(float a, float b, float c, float d) { int w = 0; w = __builtin_amdgcn_cvt_pk_fp8_f32(a, b, w, false); w = __builtin_amdgcn_cvt_pk_fp8_f32(c, d, w, true); return (unsigned)w; }
constexpr float F8_SC_H2 = 8.0f, F8_SC_W = 64.0f, F8_SC_HMID = 4.0f, F8_SC_GA = 256.0f, F8_SC_R = 2.0f, F8_SC_Y = 32.0f;
__device__ __forceinline__ float sigmoidf_fast(float v) { return __builtin_amdgcn_rcpf(1.0f + __builtin_amdgcn_exp2f(-v * LOG2E)); }
__device__ __forceinline__ int fresh_tid() { int t = threadIdx.x; asm volatile("" : "+v"(t)); return t; }
template <int CTRL> __device__ __forceinline__ float dppf(float x) { return __builtin_bit_cast(float, __builtin_amdgcn_mov_dpp(__builtin_bit_cast(int, x), CTRL, 0xf, 0xf, true)); }
constexpr int DPP_XOR1 = 0xB1, DPP_XOR2 = 0x4E, DPP_XOR3 = 0x1B, DPP_XOR7 = 0x141, DPP_XOR8 = 0x128;
__device__ __forceinline__ float lane_xor4(float x) { return dppf<DPP_XOR3>(dppf<DPP_XOR7>(x)); }
__device__ __forceinline__ float swap16_sum(float a, float b) { asm("s_nop 1\n\tv_permlane16_swap_b32 %0, %1" : "+v"(a), "+v"(b)); return a + b; }
__device__ __forceinline__ float swap32_sum(float a, float b) { asm("s_nop 1\n\tv_permlane32_swap_b32 %0, %1" : "+v"(a), "+v"(b)); return a + b; }
__device__ __forceinline__ float swap16_max(float a) { float b = a; asm("s_nop 1\n\tv_permlane16_swap_b32 %0, %1" : "+v"(a), "+v"(b)); return fmaxf(a, b); }
__device__ __forceinline__ float swap32_max(float a) { float b = a; asm("s_nop 1\n\tv_permlane32_swap_b32 %0, %1" : "+v"(a), "+v"(b)); return fmaxf(a, b); }
__device__ __forceinline__ float wave_sum(float v) {
    v += dppf<DPP_XOR1>(v); v += dppf<DPP_XOR2>(v); v += lane_xor4(v); v += dppf<DPP_XOR8>(v);
    v = swap16_sum(v, v); return swap32_sum(v, v);
}

__constant__ float INV_FREQ_D[16] = {1.0f, 0.5623413251903491f, 0.31622776601683794f, 0.1778279410038923f, 0.1f, 0.05623413251903491f, 0.03162277660168379f, 0.01778279410038923f,
                                     0.01f, 0.005623413251903491f, 0.0031622776601683794f, 0.001778279410038923f, 0.001f, 0.0005623413251903491f, 0.00031622776601683794f, 0.0001778279410038923f};
namespace pg8 {
constexpr int BM = 256, BK = 64, HALF = 128, HTB = HALF * BK * 2, STAGE_BYTES = 8 * HTB, NXCD = 8, WGM = 8;
__host__ __device__ __forceinline__ int lds_byte(int r, int c) { const int st = (r >> 4) * 2 + (c >> 5), rr = r & 15, cc = c & 31, ob = rr * 64 + cc * 2; return st * 1024 + (ob ^ (((ob >> 9) & 1) << 5)); }
__host__ __device__ __forceinline__ void stage_rc(int b, int& R, int& C) { const int st = b / 1024, sb = b % 1024, swz = sb ^ (((sb >> 9) & 1) << 5); R = (st >> 1) * 16 + swz / 64; C = (st & 1) * 32 + (swz % 64) / 2; }
__host__ __device__ __forceinline__ int perm32(int rho) { const int n = rho >> 4, i = rho & 15; return 8 * (i >> 2) + 4 * n + (i & 3); }

struct Unit { int pm, pn, g; };

struct SchedPlain {
    int nM, nN, nwg, G, c; const char* A; const char* B; unsigned lda, ldb;
    static constexpr bool GATHER = false;
    __device__ void init(int M, int N, int G_, int c_, const void* A_, unsigned lda_, const void* B_, unsigned ldb_) { nM = M / BM; nN = N / BM; nwg = nM * nN; G = G_; c = c_; A = (const char*)A_; B = (const char*)B_; lda = lda_; ldb = ldb_; }
    __device__ bool next(int i, Unit& u) const {
        const long L = (long)i * G + c; if (L >= nwg) return false;
        int wgid = (int)L; { const int q = nwg / NXCD, r = nwg % NXCD, xcd = wgid % NXCD, off = wgid / NXCD; wgid = (xcd < r ? xcd * (q + 1) : r * (q + 1) + (xcd - r) * q) + off; }
        const int nig = WGM * nN, gid = wgid / nig, fm = gid * WGM, gsz = (nM - fm) < WGM ? (nM - fm) : WGM;
        u.pm = fm + ((wgid % nig) % gsz); u.pn = (wgid % nig) / gsz; u.g = 0; return true;
    }
    __device__ __forceinline__ const char* a_ptr(const Unit& u) const { return A + (size_t)u.pm * BM * lda; }
    __device__ __forceinline__ const char* b_ptr(const Unit& u) const { return B + (size_t)u.pn * BM * ldb; }
    __device__ __forceinline__ const int* rows(const Unit&) const { return nullptr; }
    const char* A2 = nullptr; const char* B2 = nullptr; int nt1 = 0;
    __device__ __forceinline__ const char* a_ptr2(const Unit& u) const { return A2 + (size_t)u.pm * BM * lda; }
    __device__ __forceinline__ const char* b_ptr2(const Unit& u) const { return B2 + (size_t)u.pn * BM * ldb; }
};
struct SchedGate {
    int G, c; const char* A; const char* B; unsigned lda, ldb;
    static constexpr bool GATHER = false;
    __device__ bool next(int i, Unit& u) const {
        int id;
        if (G == 256) { if (c < 128) { if (i >= 3) return false; id = c * 3 + i; } else { if (i >= 5) return false; id = 384 + (c - 128) * 5 + i; } }
        else { const long L = (long)i * G + c; if (L >= 1024) return false; id = (int)L; }
        u.pm = id >> 3; u.pn = id & 7; u.g = 0; return true;
    }
    __device__ __forceinline__ const char* a_ptr(const Unit& u) const { return A + (size_t)u.pm * BM * lda; }
    __device__ __forceinline__ const char* b_ptr(const Unit& u) const { return B + (size_t)u.pn * BM * ldb; }
    __device__ __forceinline__ const int* rows(const Unit&) const { return nullptr; }
};
struct SchedFfn1 {
    int G, vcu; const char* A; const char* B; const int* idx; unsigned lda, ldb;
    static constexpr bool GATHER = true;
    __device__ bool next(int i, Unit& u) const {
        const long L = (long)i * G + vcu; if (L >= 4096) return false;
        const int ii = (int)(L >> 8), v = (int)(L & 255), x = v >> 5, c = v & 31;
        const int e = 2 * x + (ii >> 3), b = (ii & 7) >> 1, half = ii & 1;
        u.g = b * 16 + e; u.pm = c & 3; u.pn = half * 8 + (c >> 2); return true;
    }
    __device__ __forceinline__ const char* a_ptr(const Unit& u) const { return A + (size_t)(u.g >> 4) * SEQ * lda; }
    __device__ __forceinline__ const char* b_ptr(const Unit& u) const { return B + ((size_t)(u.g & 15) * 4096 + (size_t)u.pn * BM) * ldb; }
    __device__ __forceinline__ const int* rows(const Unit& u) const { return idx + u.g * CAP + u.pm * BM; }
};
struct SchedFfn2 {
    int G, vcu; const char* A; const char* B; unsigned lda, ldb;
    static constexpr bool GATHER = false;
    __device__ bool next(int i, Unit& u) const {
        const long L = (long)i * G + vcu; if (L >= 1024) return false;
        const int ii = (int)(L >> 8), v = (int)(L & 255), x = v >> 5, c = v & 31;
        const int e = 2 * x + (ii >> 1), b = 2 * (ii & 1) + (c >> 4);
        u.g = b * 16 + e; u.pm = (c & 15) >> 2; u.pn = c & 3; return true;
    }
    __device__ __forceinline__ const char* a_ptr(const Unit& u) const { return A + ((size_t)u.g * CAP + (size_t)u.pm * BM) * lda; }
    __device__ __forceinline__ const char* b_ptr(const Unit& u) const { return B + ((size_t)(u.g & 15) * 1024 + (size_t)u.pn * BM) * ldb; }
    __device__ __forceinline__ const int* rows(const Unit&) const { return nullptr; }
};

typedef f32x4 Acc[2][2][4][2];

struct EpiProj {
    static constexpr bool PERM = true;
    bf16_t* QKV; unsigned char* Q8; unsigned char* K8; unsigned char* V8T; const float* qg; const float* kg; bool gqa_bf16;
    __device__ __forceinline__ void operator()(const Acc& acc, const Unit& u, int wr, int wc, int fr_, int fq_) const { run<false>(acc, u, wr, wc, fr_, fq_); }
    template <bool ASC8> __device__ __forceinline__ void run(const Acc& acc, const Unit& u, int wr, int wc, int fr_, int fq_) const {
        constexpr float asc = ASC8 ? 1.0f / (F8_SC_H2 * F8_SC_W) : 1.0f;
        int fr = fr_, fq = fq_; asm volatile("" : "+v"(fr), "+v"(fq));
        const int row0 = u.pm * BM + wr * 64 + fr;
        if (u.pn < 6) {
            const int col0 = u.pn * BM + wc * 32 + 8 * fq;
            const float sc = ((u.pn < 2) ? 0.125f : 1.0f) * asc;
#pragma unroll
            for (int ai = 0; ai < 2; ++ai)
#pragma unroll
                for (int m = 0; m < 4; ++m) { bf16_t* rowp = QKV + (size_t)(row0 + ai * HALF + m * 16) * NQKV + col0;
#pragma unroll
                    for (int bj = 0; bj < 2; ++bj) { const f32x4 v0 = acc[ai][bj][m][0] * sc, v1 = acc[ai][bj][m][1] * sc;
                        u32x4 w; w.x = cvt_pk_bf16(v0[0], v0[1]); w.y = cvt_pk_bf16(v0[2], v0[3]); w.z = cvt_pk_bf16(v1[0], v1[1]); w.w = cvt_pk_bf16(v1[2], v1[3]);
                        *(u32x4*)(rowp + bj * HALF) = w; } }
            return;
        }
        const int colb = u.pn * BM + wc * 64 + 8 * fq;
        const bool isv = (u.pn == 8) && (wc >= 2), isq = u.pn < 8;
        if (isv) {
            const int kvh = wc - 2;
#pragma unroll
            for (int ai = 0; ai < 2; ++ai)
#pragma unroll
                for (int m = 0; m < 4; ++m) { const int tok = row0 + ai * HALF + m * 16; bf16_t* rowp = QKV + (size_t)tok * NQKV + colb;
                    const int b = tok >> 13, t = tok & (SEQ - 1), kap = t & 63;
                    const int pos = 32 * ((kap >> 2) & 1) + 16 * (kap >> 5) + (kap & 3) + 4 * ((kap & 31) >> 3);
                    unsigned char* vt = V8T + ((size_t)(b * 2 + kvh) * SEQ + (size_t)(t & ~63)) * 64 + (8 * fq) * 64 + pos;
#pragma unroll
                    for (int bj = 0; bj < 2; ++bj) { const f32x4 v0 = acc[ai][bj][m][0] * asc, v1 = acc[ai][bj][m][1] * asc;
                        if (gqa_bf16) { u32x4 w; w.x = cvt_pk_bf16(v0[0], v0[1]); w.y = cvt_pk_bf16(v0[2], v0[3]); w.z = cvt_pk_bf16(v1[0], v1[1]); w.w = cvt_pk_bf16(v1[2], v1[3]);
                            *(u32x4*)(rowp + bj * 32) = w; }
                        const unsigned p0 = pk4_fp8(v0[0] * 8.f, v0[1] * 8.f, v0[2] * 8.f, v0[3] * 8.f), p1 = pk4_fp8(v1[0] * 8.f, v1[1] * 8.f, v1[2] * 8.f, v1[3] * 8.f);
#pragma unroll
                        for (int i = 0; i < 4; ++i) { vt[(32 * bj + i) * 64] = (unsigned char)(p0 >> (8 * i)); vt[(32 * bj + 4 + i) * 64] = (unsigned char)(p1 >> (8 * i)); } } }
            return;
        }
        const float* gp = (isq ? qg : kg) + 8 * fq;
        float frq[2][2];
#pragma unroll
        for (int n = 0; n < 2; ++n)
#pragma unroll
            for (int k = 0; k < 2; ++k) frq[n][k] = INV_FREQ_D[4 * fq + 2 * n + k] * 0.15915494309189535f;
        f32x4 gn[2][2];
#pragma unroll
        for (int bj = 0; bj < 2; ++bj) { gn[bj][0] = *(const f32x4*)(gp + 32 * bj); gn[bj][1] = *(const f32x4*)(gp + 32 * bj + 4); }
        const float osc = isq ? C2 : 1.0f, f8s = isq ? 32.0f : 8.0f;
        const int head = isq ? (u.pn - 6) * 4 + wc : wc;
#pragma unroll
        for (int ai = 0; ai < 2; ++ai)
#pragma unroll
            for (int m = 0; m < 4; ++m) { const int tok = row0 + ai * HALF + m * 16; const int t = tok & (SEQ - 1);
                float ss = 0.f;
#pragma unroll
                for (int bj = 0; bj < 2; ++bj)
#pragma unroll
                    for (int n = 0; n < 2; ++n) { const f32x4 v = acc[ai][bj][m][n]; ss += (v[0] * v[0] + v[1] * v[1]) + (v[2] * v[2] + v[3] * v[3]); }
                ss += __shfl_xor(ss, 16); ss += __shfl_xor(ss, 32);
                const float rinv = asc * __builtin_amdgcn_rsqf(ss * (asc * asc / 64.f) + EPS);
                bf16_t* rowp = QKV + ((unsigned)tok * (unsigned)NQKV + (unsigned)colb);
#pragma unroll
                for (int bj = 0; bj < 2; ++bj) { const float pos = (float)(bj == 0 ? (t >> 6) : (t & 63));
                    float ov[8];
#pragma unroll
                    for (int n = 0; n < 2; ++n)
#pragma unroll
                        for (int k = 0; k < 2; ++k) { float rev = pos * frq[n][k]; rev = rev - floorf(rev);
                            const float sn = __builtin_amdgcn_sinf(rev), cs = __builtin_amdgcn_cosf(rev);
                            const float y0 = acc[ai][bj][m][n][2 * k] * rinv * gn[bj][n][2 * k], y1 = acc[ai][bj][m][n][2 * k + 1] * rinv * gn[bj][n][2 * k + 1];
                            ov[4 * n + 2 * k] = (y0 * cs - y1 * sn) * osc; ov[4 * n + 2 * k + 1] = (y0 * sn + y1 * cs) * osc; }
                    if (gqa_bf16) { u32x4 w; w.x = cvt_pk_bf16(ov[0], ov[1]); w.y = cvt_pk_bf16(ov[2], ov[3]); w.z = cvt_pk_bf16(ov[4], ov[5]); w.w = cvt_pk_bf16(ov[6], ov[7]);
                        *(u32x4*)(rowp + bj * 32) = w; }
                    u32x2 f8; f8.x = pk4_fp8(ov[0] * f8s, ov[1] * f8s, ov[2] * f8s, ov[3] * f8s); f8.y = pk4_fp8(ov[4] * f8s, ov[5] * f8s, ov[6] * f8s, ov[7] * f8s);
                    if (isq) *(u32x2*)(Q8 + ((unsigned)tok * 512u + (unsigned)(head * 64 + 32 * bj + 8 * fq))) = f8;
                    else     *(u32x2*)(K8 + ((unsigned)tok * 128u + (unsigned)(head * 64 + 32 * bj + 8 * fq))) = f8; }
                __builtin_amdgcn_sched_barrier(0); }
    }
};
struct EpiGate {
    static constexpr bool PERM = true;
    bf16_t* GA; unsigned char* R8;
    __device__ __forceinline__ void operator()(const Acc& acc, const Unit& u, int wr, int wc, int fr, int fq) const {
        const size_t row0 = (size_t)u.pm * BM + wr * 64 + fr; const int col0 = u.pn * HALF + wc * 32 + 8 * fq;
        constexpr float inv = -LOG2E / (F8_SC_H2 * F8_SC_W);
#pragma unroll
        for (int ai = 0; ai < 2; ++ai)
#pragma unroll
            for (int m = 0; m < 4; ++m) { const size_t off = (row0 + ai * HALF + m * 16) * DMODEL + col0;
                float ga[8], rr[8];
#pragma unroll
                for (int n = 0; n < 2; ++n)
#pragma unroll
                    for (int i = 0; i < 4; ++i) { const float ea = 1.0f + __builtin_amdgcn_exp2f(acc[ai][0][m][n][i] * inv), eb = 1.0f + __builtin_amdgcn_exp2f(acc[ai][1][m][n][i] * inv);
                        ga[n * 4 + i] = __builtin_amdgcn_rcpf(ea); rr[n * 4 + i] = ea * __builtin_amdgcn_rcpf(eb) * F8_SC_R; }
                u32x4 w; w.x = cvt_pk_bf16(ga[0], ga[1]); w.y = cvt_pk_bf16(ga[2], ga[3]); w.z = cvt_pk_bf16(ga[4], ga[5]); w.w = cvt_pk_bf16(ga[6], ga[7]); *(u32x4*)(GA + off) = w;
                u32x2 q; q.x = pk4_fp8(rr[0], rr[1], rr[2], rr[3]); q.y = pk4_fp8(rr[4], rr[5], rr[6], rr[7]); *(u32x2*)(R8 + off) = q; }
    }
};
struct EpiHeadGate {
    static constexpr bool PERM = true;
    EpiProj P; EpiGate Gt;
    __device__ __forceinline__ void operator()(const Acc& acc, const Unit& u, int wr, int wc, int fr, int fq) const {
        Unit v = u;
        if (u.pn < 9) { P.run<true>(acc, v, wr, wc, fr, fq); }
        else { v.pn = u.pn - 9; Gt(acc, v, wr, wc, fr, fq); }
    }
};
struct EpiMerge {
    static constexpr bool PERM = true;
    bf16_t* MERGED; const bf16_t* GA; const unsigned char* R8;
    __device__ __forceinline__ void mid(Acc& acc, const Unit& u, int wr, int wc, int fr, int fq) const {
        const int row0 = u.pm * BM + wr * 64 + fr, col0 = u.pn * BM + wc * 32 + 8 * fq;
        u32x2 rq[2][4][2];
#pragma unroll
        for (int ai = 0; ai < 2; ++ai)
#pragma unroll
            for (int m = 0; m < 4; ++m)
#pragma unroll
                for (int bj = 0; bj < 2; ++bj) rq[ai][m][bj] = *(const u32x2*)(R8 + (size_t)(row0 + ai * HALF + m * 16) * DMODEL + col0 + bj * HALF);
        asm volatile("" ::: "memory");
#pragma unroll
        for (int ai = 0; ai < 2; ++ai)
#pragma unroll
            for (int m = 0; m < 4; ++m) {
#pragma unroll
                for (int bj = 0; bj < 2; ++bj) { const u32x2 q = rq[ai][m][bj];
                    const auto a = __builtin_amdgcn_cvt_pk_f32_fp8((int)q.x, false), b = __builtin_amdgcn_cvt_pk_f32_fp8((int)q.x, true), c = __builtin_amdgcn_cvt_pk_f32_fp8((int)q.y, false), d = __builtin_amdgcn_cvt_pk_f32_fp8((int)q.y, true);
                    constexpr float k = 1.0f / F8_SC_R;
                    acc[ai][bj][m][0][0] *= a[0] * k; acc[ai][bj][m][0][1] *= a[1] * k; acc[ai][bj][m][0][2] *= b[0] * k; acc[ai][bj][m][0][3] *= b[1] * k;
                    acc[ai][bj][m][1][0] *= c[0] * k; acc[ai][bj][m][1][1] *= c[1] * k; acc[ai][bj][m][1][2] *= d[0] * k; acc[ai][bj][m][1][3] *= d[1] * k; } }
    }
    __device__ __forceinline__ void operator()(const Acc& acc, const Unit& u, int wr, int wc, int fr, int fq) const {
        const int row0 = u.pm * BM + wr * 64 + fr, col0 = u.pn * BM + wc * 32 + 8 * fq;
        u32x4 gq[2][4][2];
#pragma unroll
        for (int ai = 0; ai < 2; ++ai)
#pragma unroll
            for (int m = 0; m < 4; ++m)
#pragma unroll
                for (int bj = 0; bj < 2; ++bj) gq[ai][m][bj] = *(const u32x4*)(GA + (size_t)(row0 + ai * HALF + m * 16) * DMODEL + col0 + bj * HALF);
        asm volatile("" ::: "memory");
#pragma unroll
        for (int ai = 0; ai < 2; ++ai)
#pragma unroll
            for (int m = 0; m < 4; ++m) { const size_t r = (size_t)(row0 + ai * HALF + m * 16);
#pragma unroll
                for (int bj = 0; bj < 2; ++bj) { const u32x4 g = gq[ai][m][bj];
                    const f32x4 v0 = acc[ai][bj][m][0], v1 = acc[ai][bj][m][1];
                    u32x4 w; w.x = cvt_pk_bf16(bf_lo(g.x) * v0[0], bf_hi(g.x) * v0[1]); w.y = cvt_pk_bf16(bf_lo(g.y) * v0[2], bf_hi(g.y) * v0[3]);
                    w.z = cvt_pk_bf16(bf_lo(g.z) * v1[0], bf_hi(g.z) * v1[1]); w.w = cvt_pk_bf16(bf_lo(g.w) * v1[2], bf_hi(g.w) * v1[3]);
                    *(u32x4*)(MERGED + r * DMODEL + col0 + bj * HALF) = w; } }
    }
};
struct EpiOut {
    static constexpr bool PERM = false;
    const float* x; float* out; const float* mod;
    __device__ __forceinline__ void operator()(const Acc& acc, const Unit& u, int wr, int wc, int fr, int fq) const {
        const int row0 = u.pm * BM + wr * 64 + fr, col0 = u.pn * BM + wc * 32 + 4 * fq;
        const float* g1 = mod + (size_t)(u.pm >> 5) * 6144 + 2048;
        f32x4 gv[2][2];
#pragma unroll
        for (int bj = 0; bj < 2; ++bj)
#pragma unroll
            for (int n = 0; n < 2; ++n) gv[bj][n] = *(const f32x4*)(g1 + col0 + bj * HALF + n * 16);
#pragma unroll
        for (int ai = 0; ai < 2; ++ai)
#pragma unroll
            for (int m = 0; m < 4; ++m) { const size_t off = (size_t)(row0 + ai * HALF + m * 16) * DMODEL + col0;
#pragma unroll
                for (int bj = 0; bj < 2; ++bj)
#pragma unroll
                    for (int n = 0; n < 2; ++n) { const f32x4 xv = __builtin_nontemporal_load((const f32x4*)(x + off + bj * HALF + n * 16)); *(f32x4*)(out + off + bj * HALF + n * 16) = xv + gv[bj][n] * acc[ai][bj][m][n]; } }
    }
};
struct EpiDelta {
    static constexpr bool PERM = true;
    bf16_t* DELTA; const float* mod;
    __device__ __forceinline__ void operator()(const Acc& acc, const Unit& u, int wr, int wc, int fr, int fq) const {
        const unsigned row0 = u.pm * BM + wr * 64 + fr, col0 = u.pn * BM + wc * 32 + 8 * fq;
        const float* g1 = mod + (size_t)(u.pm >> 5) * 6144 + 2048 + col0;
        f32x4 gv[2][2];
#pragma unroll
        for (int bj = 0; bj < 2; ++bj)
#pragma unroll
            for (int n = 0; n < 2; ++n) gv[bj][n] = *(const f32x4*)(g1 + bj * HALF + n * 4);
#pragma unroll
        for (int ai = 0; ai < 2; ++ai)
#pragma unroll
            for (int m = 0; m < 4; ++m) { bf16_t* rowp = DELTA + ((row0 + ai * HALF + m * 16) * (unsigned)DMODEL + col0);
#pragma unroll
                for (int bj = 0; bj < 2; ++bj) { const f32x4 v0 = acc[ai][bj][m][0] * gv[bj][0], v1 = acc[ai][bj][m][1] * gv[bj][1];
                    u32x4 w; w.x = cvt_pk_bf16(v0[0], v0[1]); w.y = cvt_pk_bf16(v0[2], v0[3]); w.z = cvt_pk_bf16(v1[0], v1[1]); w.w = cvt_pk_bf16(v1[2], v1[3]);
                    *(u32x4*)(rowp + bj * HALF) = w; } }
    }
};
struct EpiFfn1 {
    static constexpr bool PERM = true;
    unsigned char* HMID;
    __device__ __forceinline__ void operator()(const Acc& acc, const Unit& u, int wr, int wc, int fr, int fq) const {
        const size_t row0 = (size_t)u.g * CAP + u.pm * BM + wr * 64 + fr; const int col0 = u.pn * HALF + wc * 32 + 8 * fq;
        constexpr float inv = 1.0f / (F8_SC_H2 * F8_SC_W);
        constexpr float RC = 1.0f / (inv * inv * F8_SC_HMID);
        static_assert(RC == 65536.0f, "LOG2_RC below assumes 2^16");
        constexpr float LOG2_RC = 16.0f;
#pragma unroll
        for (int ai = 0; ai < 2; ++ai)
#pragma unroll
            for (int m = 0; m < 4; ++m) { unsigned char* rowp = HMID + (row0 + ai * HALF + m * 16) * FF + col0;
                float o[8];
#pragma unroll
                for (int n = 0; n < 2; ++n)
#pragma unroll
                    for (int i = 0; i < 4; i += 2) {
                        const f32x2 ag = {acc[ai][0][m][n][i], acc[ai][0][m][n][i + 1]}, au = {acc[ai][1][m][n][i], acc[ai][1][m][n][i + 1]};
                        const f32x2 e = ag * (-inv * LOG2E) + LOG2_RC;
                        f32x2 t; t.x = __builtin_amdgcn_exp2f(e.x); t.y = __builtin_amdgcn_exp2f(e.y);
                        t = t + RC;
                        f32x2 r; r.x = __builtin_amdgcn_rcpf(t.x); r.y = __builtin_amdgcn_rcpf(t.y);
                        const f32x2 q = (ag * au) * r;
                        o[n * 4 + i] = q.x; o[n * 4 + i + 1] = q.y; }
                u32x2 w; w.x = pk4_fp8(o[0], o[1], o[2], o[3]); w.y = pk4_fp8(o[4], o[5], o[6], o[7]);
                *(u32x2*)rowp = w; }
    }
};
struct EpiFfn2 {
    static constexpr bool PERM = true;
    unsigned char* YB8; const float* gsel;
    __device__ __forceinline__ void operator()(const Acc& acc, const Unit& u, int wr, int wc, int fr, int fq) const {
        const unsigned row0 = (unsigned)u.g * CAP + u.pm * BM + wr * 64 + fr; const unsigned col0 = u.pn * BM + wc * 32 + 8 * fq;
        float gsv[2][4];
#pragma unroll
        for (int ai = 0; ai < 2; ++ai)
#pragma unroll
            for (int m = 0; m < 4; ++m) gsv[ai][m] = gsel[row0 + ai * HALF + m * 16];
        asm volatile("" ::: "memory");
#pragma unroll
        for (int ai = 0; ai < 2; ++ai)
#pragma unroll
            for (int m = 0; m < 4; ++m) { const unsigned r = row0 + ai * HALF + m * 16; const float gs = gsv[ai][m] * (F8_SC_Y / (F8_SC_HMID * F8_SC_W)); unsigned char* rowp = YB8 + (r * (unsigned)DMODEL + col0);
#pragma unroll
                for (int bj = 0; bj < 2; ++bj) { const f32x4 v0 = acc[ai][bj][m][0] * gs, v1 = acc[ai][bj][m][1] * gs;
                    u32x2 w; w.x = pk4_fp8(v0[0], v0[1], v0[2], v0[3]); w.y = pk4_fp8(v1[0], v1[1], v1[2], v1[3]);
                    *(u32x2*)(rowp + bj * HALF) = w; } }
    }
};

template <bool F8> __device__ __forceinline__ f32x4 mma_step(bf16x8 b0, bf16x8 b1, bf16x8 a0, bf16x8 a1, f32x4 c) {
    if constexpr (F8) {
        const v8i b = __builtin_shufflevector(__builtin_bit_cast(v4i, b0), __builtin_bit_cast(v4i, b1), 0, 1, 2, 3, 4, 5, 6, 7);
        const v8i a = __builtin_shufflevector(__builtin_bit_cast(v4i, a0), __builtin_bit_cast(v4i, a1), 0, 1, 2, 3, 4, 5, 6, 7);
        asm volatile("v_mfma_f32_16x16x128_f8f6f4 %0, %1, %2, %0" : "+v"(c) : "v"(b), "v"(a));
        return c;
    } else {
        c = __builtin_amdgcn_mfma_f32_16x16x32_bf16(b0, a0, c, 0, 0, 0);
        return __builtin_amdgcn_mfma_f32_16x16x32_bf16(b1, a1, c, 0, 0, 0);
    }
}
__device__ __forceinline__ const char* uni_ptr(const char* p) {
    const unsigned long long v = (unsigned long long)p; const unsigned lo = __builtin_amdgcn_readfirstlane((unsigned)v), hi = __builtin_amdgcn_readfirstlane((unsigned)(v >> 32));
    return (const char*)(((unsigned long long)hi << 32) | lo); }
template <bool F8, class Epi, class Sched, bool SEG2 = false>
__device__ __forceinline__ void gemm_phase(LAS unsigned char* lds, const int nt, const Sched& S, const Epi& E) {
    const int tid = fresh_tid(), wid = __builtin_amdgcn_readfirstlane(tid >> 6), lane = tid & 63, wr = wid >> 2, wc = wid & 3, fr = lane & 15, fq = lane >> 4;
    constexpr bool GA = Sched::GATHER;
    int Rr[2], Cc[2];
#pragma unroll
    for (int i = 0; i < 2; ++i) stage_rc(tid * 16 + i * 8192, Rr[i], Cc[i]);
    unsigned voffB[2];
#pragma unroll
    for (int i = 0; i < 2; ++i) { const int Rb = Epi::PERM ? ((Rr[i] & ~31) + perm32(Rr[i] & 31)) : Rr[i]; voffB[i] = (unsigned)Rb * S.ldb + (unsigned)Cc[i] * 2u; }
    const size_t kstep = (size_t)(BK * 2);
    const size_t hstepB = (size_t)HALF * S.ldb;
    const size_t hstepA = GA ? (size_t)0 : (size_t)HALF * S.lda;
    const unsigned ldsw = (unsigned)wid * 1024u;
    const int aoff = lds_byte(wr * 64 + fr, fq * 8), boff = lds_byte(wc * 32 + fr, fq * 8);
#define PG8_SA(b, h) (((b) * 2 + (h)) * HTB)
#define PG8_SB(b, h) ((4 + (b) * 2 + (h)) * HTB)
#define PG8_STAGE(bufoff, gbase, voff) do { _Pragma("unroll") for (int _i = 0; _i < 2; ++_i) \
        __builtin_amdgcn_global_load_lds((GAS const unsigned*)((GAS const char*)(gbase) + (voff)[_i]), (LAS unsigned*)(lds + (bufoff) + ldsw + _i * 8192), 16, 0, 0); } while (0)
#define PG8_LDA(dst, b, h) do { _Pragma("unroll") for (int m = 0; m < 4; ++m) _Pragma("unroll") for (int k = 0; k < 2; ++k) dst[m][k] = *(const LAS bf16x8*)(lds + PG8_SA(b, h) + aoff + m * 2048 + k * 1024); } while (0)
#define PG8_LDB(dst, b, h) do { _Pragma("unroll") for (int n = 0; n < 2; ++n) _Pragma("unroll") for (int k = 0; k < 2; ++k) dst[n][k] = *(const LAS bf16x8*)(lds + PG8_SB(b, h) + boff + n * 2048 + k * 1024); } while (0)
#define PG8_MMA(ai, bj, At, Bt) do { __builtin_amdgcn_s_setprio(1); _Pragma("unroll") for (int m = 0; m < 4; ++m) _Pragma("unroll") for (int n = 0; n < 2; ++n) \
        acc[ai][bj][m][n] = mma_step<F8>(Bt[n][0], Bt[n][1], At[m][0], At[m][1], acc[ai][bj][m][n]); __builtin_amdgcn_s_setprio(0); } while (0)
#define PG8_WAIT_V(n) asm volatile("s_waitcnt vmcnt(" #n ")" ::: "memory")
#define PG8_WAIT_L(n) asm volatile("s_waitcnt lgkmcnt(" #n ")" ::: "memory")
#define PG8_BAR __builtin_amdgcn_s_barrier()
#define PG8_SCHED __builtin_amdgcn_sched_barrier(0)
#define PG8_ROWOFFS(dst, u_) do { if constexpr (GA) { const int* _rw = S.rows(u_); _Pragma("unroll") for (int _h = 0; _h < 2; ++_h) _Pragma("unroll") for (int _i = 0; _i < 2; ++_i) \
        dst[_h][_i] = (unsigned)_rw[_h * HALF + Rr[_i]] * S.lda + (unsigned)Cc[_i] * 2u; } } while (0)
    Unit cur, nxt; int ui = 0;
    if (!S.next(0, cur)) return;
    f32x4 acc[2][2][4][2];
#pragma unroll
    for (int a = 0; a < 2; ++a)
#pragma unroll
        for (int b = 0; b < 2; ++b)
#pragma unroll
            for (int m = 0; m < 4; ++m)
#pragma unroll
                for (int n = 0; n < 2; ++n) acc[a][b][m][n] = (f32x4){0.f, 0.f, 0.f, 0.f};
    bf16x8 At[4][2], B0[2][2], B1[2][2];
    unsigned voffP[2];
#pragma unroll
    for (int i = 0; i < 2; ++i) voffP[i] = (unsigned)Rr[i] * S.lda + (unsigned)Cc[i] * 2u;
    unsigned voffA[2][2], voffAn[2][2];
    PG8_ROWOFFS(voffA, cur);
#define PG8_VA(h) (GA ? voffA[h] : voffP)
#define PG8_VA2(h) (GA ? va2[h] : voffP)
    const char* cA = uni_ptr(S.a_ptr(cur)); const char* cB = uni_ptr(S.b_ptr(cur));
    const char* cA2 = cA; const char* cB2 = cB; int nt1 = nt;
    if constexpr (SEG2) { cA2 = uni_ptr(S.a_ptr2(cur)); cB2 = uni_ptr(S.b_ptr2(cur)); nt1 = S.nt1; }
#define PG8_KA(tau) ((!SEG2 || (tau) < nt1) ? cA + (size_t)(tau) * kstep : cA2 + (size_t)((tau) - nt1) * kstep)
#define PG8_KB(tau) ((!SEG2 || (tau) < nt1) ? cB + (size_t)(tau) * kstep : cB2 + (size_t)((tau) - nt1) * kstep)
    PG8_STAGE(PG8_SB(0, 0), cB, voffB); PG8_STAGE(PG8_SB(0, 1), cB + hstepB, voffB); PG8_STAGE(PG8_SA(0, 0), cA, PG8_VA(0)); PG8_STAGE(PG8_SA(0, 1), cA + hstepA, PG8_VA(1));
    if (wr == 1) PG8_BAR;
    PG8_WAIT_V(2); PG8_BAR;
    PG8_STAGE(PG8_SB(1, 0), cB + kstep, voffB); PG8_STAGE(PG8_SA(1, 0), cA + kstep, PG8_VA(0)); PG8_STAGE(PG8_SB(1, 1), cB + hstepB + kstep, voffB);
    PG8_WAIT_V(6); PG8_BAR;
    for (;;) {
        const bool has_next = S.next(ui + 1, nxt);
        const char* nA = has_next ? uni_ptr(S.a_ptr(nxt)) : cA; const char* nB = has_next ? uni_ptr(S.b_ptr(nxt)) : cB;
        if constexpr (GA) {
            if (has_next) { PG8_ROWOFFS(voffAn, nxt); } else {
#pragma unroll
                for (int h = 0; h < 2; ++h)
#pragma unroll
                    for (int i = 0; i < 2; ++i) voffAn[h][i] = voffA[h][i]; } }
        for (int t = 0; t < nt; t += 2) {
            const bool last = (t == nt - 2);
            const char* a1 = PG8_KA(t + 1);
            const char* a2 = last ? nA : PG8_KA(t + 2); const char* b2 = last ? nB : PG8_KB(t + 2);
            const char* a3 = a2 + kstep; const char* b3 = b2 + kstep;
            unsigned va2[2][2];
            if constexpr (GA) {
#pragma unroll
                for (int h = 0; h < 2; ++h)
#pragma unroll
                    for (int i = 0; i < 2; ++i) va2[h][i] = last ? voffAn[h][i] : voffA[h][i]; }
            PG8_LDB(B0, 0, 0); PG8_LDB(B1, 0, 1); PG8_SCHED; PG8_LDA(At, 0, 0); PG8_STAGE(PG8_SA(1, 1), a1 + hstepA, PG8_VA(1));
            PG8_WAIT_V(8); PG8_WAIT_L(0); PG8_BAR; PG8_MMA(0, 0, At, B0); PG8_MMA(0, 1, At, B1); PG8_BAR; PG8_SCHED;
            PG8_LDA(At, 0, 1); PG8_STAGE(PG8_SB(0, 0), b2, voffB); PG8_STAGE(PG8_SB(0, 1), b2 + hstepB, voffB); PG8_STAGE(PG8_SA(0, 0), a2, PG8_VA2(0));
            PG8_WAIT_V(8); PG8_WAIT_L(0); PG8_BAR; PG8_MMA(1, 0, At, B0); PG8_MMA(1, 1, At, B1); PG8_BAR; PG8_SCHED;
            PG8_LDB(B0, 1, 0); PG8_LDB(B1, 1, 1); PG8_SCHED; PG8_LDA(At, 1, 0); PG8_STAGE(PG8_SA(0, 1), a2 + hstepA, PG8_VA2(1));
            PG8_WAIT_V(8); PG8_WAIT_L(0); PG8_BAR; PG8_MMA(0, 0, At, B0); PG8_MMA(0, 1, At, B1); PG8_BAR; PG8_SCHED;
            PG8_LDA(At, 1, 1); PG8_STAGE(PG8_SB(1, 0), b3, voffB); PG8_STAGE(PG8_SB(1, 1), b3 + hstepB, voffB); PG8_STAGE(PG8_SA(1, 0), a3, PG8_VA2(0));
            PG8_WAIT_V(8); PG8_WAIT_L(0); PG8_BAR; PG8_MMA(1, 0, At, B0); PG8_MMA(1, 1, At, B1); PG8_BAR; PG8_SCHED;
            if constexpr (SEG2) { if (t + 2 == nt1) { E.mid(acc, cur, wr, wc, fr, fq); PG8_SCHED; } }
        }
        if (wr == 0) PG8_BAR;
        if constexpr (F8) asm volatile("s_nop 15\n\ts_nop 3" ::: "memory");
        E(acc, cur, wr, wc, fr, fq);
        if (!has_next) break;
#pragma unroll
        for (int a = 0; a < 2; ++a)
#pragma unroll
            for (int b = 0; b < 2; ++b)
#pragma unroll
                for (int m = 0; m < 4; ++m)
#pragma unroll
                    for (int n = 0; n < 2; ++n) acc[a][b][m][n] = (f32x4){0.f, 0.f, 0.f, 0.f};
        cur = nxt; cA = nA; cB = nB; ++ui;
        if constexpr (SEG2) { cA2 = uni_ptr(S.a_ptr2(cur)); cB2 = uni_ptr(S.b_ptr2(cur)); }
        if constexpr (GA) {
#pragma unroll
            for (int h = 0; h < 2; ++h)
#pragma unroll
                for (int i = 0; i < 2; ++i) voffA[h][i] = voffAn[h][i]; }
        if (wr == 1) PG8_BAR;
    }
    PG8_WAIT_V(0);
    PG8_BAR;
#undef PG8_SA
#undef PG8_SB
#undef PG8_STAGE
#undef PG8_LDA
#undef PG8_LDB
#undef PG8_MMA
#undef PG8_WAIT_V
#undef PG8_WAIT_L
#undef PG8_BAR
#undef PG8_SCHED
#undef PG8_ROWOFFS
#undef PG8_VA
#undef PG8_VA2
#undef PG8_KA
#undef PG8_KB
}
}

namespace attn_body {
using bf16 = __hip_bfloat16;
constexpr int D = 64, QP = NQKV, KP = NQKV, OP = DMODEL;
constexpr int NW = 8, QBLK = 32, QB = QBLK * NW, KVBLK = 64;
__device__ __forceinline__ int crow(int r, int hi) { return (r & 3) + 8 * (r >> 2) + 4 * hi; }
#define SBAR() __builtin_amdgcn_sched_barrier(0)
constexpr int NSLOT = 3, SLOTB = 8192;
constexpr int LDS_K = 0, LDS_V = NSLOT * SLOTB, LDS_WS = 2 * NSLOT * SLOTB, LDS_OST = LDS_WS + NW * 64 * 4, LDS_BYTES = LDS_OST + NW * 4096;
__device__ __forceinline__ void glds16(const void* gsrc, unsigned lds_dst) { unsigned keep;
    asm volatile("s_mov_b32 %0, m0\n\ts_mov_b32 m0, %2\n\ts_nop 0\n\tglobal_load_lds_dwordx4 %1, off\n\ts_mov_b32 m0, %0" : "=&s"(keep) : "v"(gsrc), "s"(lds_dst) : "memory"); }
__device__ __forceinline__ float max3f(float a, float b, float c) { float r; asm("v_max3_f32 %0, %1, %2, %3" : "=v"(r) : "v"(a), "v"(b), "v"(c)); return r; }
__device__ __forceinline__ float max2f(float a, float b) { float r; asm("v_max_f32_e32 %0, %1, %2" : "=v"(r) : "v"(a), "v"(b)); return r; }
__device__ __forceinline__ float fadd_s(float a, float b) { float r; asm("v_add_f32_e32 %0, %1, %2" : "=v"(r) : "v"(a), "v"(b)); return r; }
__device__ __forceinline__ float fsub_s(float a, float b) { float r; asm("v_sub_f32_e32 %0, %1, %2" : "=v"(r) : "v"(a), "v"(b)); return r; }
typedef float f32x2_t __attribute__((ext_vector_type(2))); typedef __bf16 bf16x2_t __attribute__((ext_vector_type(2)));
__device__ __forceinline__ unsigned cvtpk_s(float lo, float hi) { f32x2_t v = {lo, hi}; bf16x2_t b = __builtin_convertvector(v, bf16x2_t); return __builtin_bit_cast(unsigned, b); }
#define WAIT_BAR(N) asm volatile("s_waitcnt vmcnt(" #N ") lgkmcnt(0)\n\ts_barrier" ::: "memory")

__device__ __forceinline__ void qkt(f32x16& p0, f32x16& p1, const char* Kslot, const bf16x8* qr, const f32x16& negm, int r32, int hi) {
    const char* kb = Kslot + hi * 1024 + r32 * 16;
#pragma unroll
    for (int d0 = 0; d0 < 4; ++d0) {
        const bf16x8 b0 = *reinterpret_cast<const bf16x8*>(kb + d0 * 2048);
        const bf16x8 b1 = *reinterpret_cast<const bf16x8*>(kb + d0 * 2048 + 512);
        if (d0 == 0) { p0 = __builtin_amdgcn_mfma_f32_32x32x16_bf16(b0, qr[0], negm, 0, 0, 0); p1 = __builtin_amdgcn_mfma_f32_32x32x16_bf16(b1, qr[0], negm, 0, 0, 0); }
        else { p0 = __builtin_amdgcn_mfma_f32_32x32x16_bf16(b0, qr[d0], p0, 0, 0, 0); p1 = __builtin_amdgcn_mfma_f32_32x32x16_bf16(b1, qr[d0], p1, 0, 0, 0); } }
}
typedef LAS const char* lds_cptr;
typedef short v4i16_t __attribute__((ext_vector_type(4)));
__device__ __forceinline__ void kload8(bf16x8* kf, lds_cptr kp) {
    kf[0] = *(const LAS bf16x8*)(kp);        kf[1] = *(const LAS bf16x8*)(kp + 512);
    kf[2] = *(const LAS bf16x8*)(kp + 2048); kf[3] = *(const LAS bf16x8*)(kp + 2560);
    kf[4] = *(const LAS bf16x8*)(kp + 4096); kf[5] = *(const LAS bf16x8*)(kp + 4608);
    kf[6] = *(const LAS bf16x8*)(kp + 6144); kf[7] = *(const LAS bf16x8*)(kp + 6656);
}
__device__ __forceinline__ void kload2(bf16x8* kf, lds_cptr kp, int j) { kf[2 * j] = *(const LAS bf16x8*)(kp + j * 2048); kf[2 * j + 1] = *(const LAS bf16x8*)(kp + j * 2048 + 512); }
__device__ __forceinline__ s16x4 vtr(lds_cptr p) { return __builtin_bit_cast(s16x4, __builtin_amdgcn_ds_read_tr16_b64_v4i16((LAS v4i16_t*)p)); }
__device__ __forceinline__ float rowmax(const f32x16& p0, const f32x16& p1) {
    float a = max3f(p0[0], p0[1], p1[0]), b = max3f(p0[2], p0[3], p1[1]); a = max3f(a, p1[2], p1[3]);
#pragma unroll
    for (int r = 4; r < 16; r += 4) { a = max3f(a, p0[r], p0[r + 1]); b = max3f(b, p0[r + 2], p0[r + 3]); a = max3f(a, p1[r], p1[r + 1]); b = max3f(b, p1[r + 2], p1[r + 3]); }
    const float m = max2f(a, b);
    auto rr = __builtin_amdgcn_permlane32_swap(__float_as_uint(m), __float_as_uint(m), false, false);
    return max2f(__uint_as_float(rr[0]), __uint_as_float(rr[1]));
}
__device__ __forceinline__ void pv(f32x16* o, int vb, bf16x8 pa0, bf16x8 pa1, bf16x8 pa2, bf16x8 pa3) {
#pragma unroll
    for (int d0 = 0; d0 < 2; ++d0) { s16x4 lo[4], hi[4];
#pragma unroll
        for (int ks = 0; ks < 4; ++ks) {
            asm volatile("ds_read_b64_tr_b16 %0,%1 offset:%c2" : "=&v"(lo[ks]) : "v"(vb), "i"(d0 * 4096 + ks * 1024) : "memory");
            asm volatile("ds_read_b64_tr_b16 %0,%1 offset:%c2" : "=&v"(hi[ks]) : "v"(vb), "i"(d0 * 4096 + ks * 1024 + 512) : "memory"); }
        asm volatile("s_waitcnt lgkmcnt(0)" ::: "memory"); SBAR();
#define PK(k) (bf16x8){lo[k][0], lo[k][1], lo[k][2], lo[k][3], hi[k][0], hi[k][1], hi[k][2], hi[k][3]}
        o[d0] = __builtin_amdgcn_mfma_f32_32x32x16_bf16(pa0, PK(0), o[d0], 0, 0, 0);
        o[d0] = __builtin_amdgcn_mfma_f32_32x32x16_bf16(pa1, PK(1), o[d0], 0, 0, 0);
        o[d0] = __builtin_amdgcn_mfma_f32_32x32x16_bf16(pa2, PK(2), o[d0], 0, 0, 0);
        o[d0] = __builtin_amdgcn_mfma_f32_32x32x16_bf16(pa3, PK(3), o[d0], 0, 0, 0);
#undef PK
    }
}
#define ATTN_STORE16(p, v) (*(u32x4*)(p) = (v))
template <int THRL> __device__ __forceinline__ void attn_unit(int qb, const bf16* Qh, const bf16* __restrict__ Kh, const bf16* __restrict__ Vh, bf16* Oh, char* shm) {
    const int tid = fresh_tid(), lane = tid & 63, r32 = lane & 31, hi = lane >> 5; const int wid = __builtin_amdgcn_readfirstlane(tid >> 6);
    const int q0 = qb * QB;
    const bf16* Qw = Qh + (long)(q0 + wid * QBLK) * QP;
    const unsigned lds0 = (unsigned)(uintptr_t)shm;
    float* wsf = (float*)(shm + LDS_WS) + wid * 64;
    const bf16* ksrc = Kh + (long)lane * KP + wid * 8;
    const bf16* vsrc = Vh + (long)(16 * (wid & 3) + (lane >> 2)) * KP + (wid >> 2) * 32 + (lane & 3) * 8;
    const unsigned kdst = lds0 + LDS_K + wid * 1024, vdst = lds0 + LDS_V + wid * 1024;
#define DMA_K(t, slot) glds16(ksrc + (long)(t) * KVBLK * KP, (unsigned)__builtin_amdgcn_readfirstlane(kdst + (slot)))
#define DMA_V(t, slot) glds16(vsrc + (long)(t) * KVBLK * KP, (unsigned)__builtin_amdgcn_readfirstlane(vdst + (slot)))
    const int vb0 = (int)(lds0 + LDS_V) + ((lane >> 4) & 1) * 32 + (lane & 3) * 8 + (4 * hi + ((lane & 15) >> 2)) * 64;
    const char* Kbase = shm + LDS_K; bf16x8 kf[8];
    const lds_cptr shm3 = (lds_cptr)shm; const lds_cptr kp0 = shm3 + LDS_K + hi * 1024 + r32 * 16; const lds_cptr vp0 = shm3 + LDS_V + ((lane >> 4) & 1) * 32 + (lane & 3) * 8 + (4 * hi + ((lane & 15) >> 2)) * 64;
    constexpr int NT = SEQ / KVBLK;
    DMA_K(0, 0); DMA_V(0, 0); DMA_K(1, SLOTB);
    bf16x8 qr[4];
#pragma unroll
    for (int d0 = 0; d0 < 4; ++d0) qr[d0] = *reinterpret_cast<const bf16x8*>(&Qw[(long)r32 * QP + d0 * 16 + hi * 8]);
    float mhat = 0.f, l_reg = 0.f; f32x16 o[2]; o[0] = f32x16{}; o[1] = f32x16{}; f32x16 negm = f32x16{}; asm volatile("" : "+v"(negm));
    bool resc = false;
#define START(P0, P1) do { const float rm = rowmax(P0, P1); resc = false; \
    { const float dl = rm; mhat = fadd_s(mhat, dl); \
      _Pragma("unroll") for (int r = 0; r < 16; ++r) { P0[r] = fsub_s(P0[r], dl); P1[r] = fsub_s(P1[r], dl); } \
      _Pragma("unroll") for (int r = 0; r < 16; ++r) negm[r] = -mhat; asm volatile("" : "+v"(negm)); } \
    _Pragma("unroll") for (int r = 0; r < 16; ++r) P0[r] = __builtin_amdgcn_exp2f(P0[r]); } while (0)
#define RESC() do { if (resc) { asm volatile("s_waitcnt lgkmcnt(0)" ::: "memory"); \
      _Pragma("unroll") for (int d_ = 0; d_ < 2; ++d_) _Pragma("unroll") for (int r = 0; r < 16; ++r) o[d_][r] *= wsf[crow(r, hi)]; } } while (0)
    f32x16 pA0, pA1, pB0, pB1;
    int sl_prev = 0, sl_cur = 0, sl_next = SLOTB;
#define ROT() do { sl_prev = sl_cur; sl_cur = sl_next; sl_next = (sl_next == (NSLOT - 1) * SLOTB) ? 0 : sl_next + SLOTB; } while (0)
    DMA_K(2, 2 * SLOTB);
    WAIT_BAR(3);
    qkt(pA0, pA1, Kbase, qr, negm, r32, hi); asm volatile("s_nop 15\n\ts_nop 7" : "+v"(pA0), "+v"(pA1));
    START(pA0, pA1);
    _Pragma("unroll") for (int r = 0; r < 16; ++r) pA1[r] = __builtin_amdgcn_exp2f(pA1[r]);
    WAIT_BAR(0);
    DMA_K(3, 0); DMA_V(1, SLOTB);
    ROT();
    kload8(kf, kp0 + sl_cur);
    WAIT_BAR(2);
    s16x4 vlo[8], vhi[8]; u32x4 pw0, pw1, pw2, pw3;
#define PKW(P, B) cvtpk_s(P[B], P[B + 1])
#define PAF(k) __builtin_bit_cast(bf16x8, pw##k)
#define VFR(i) (bf16x8){vlo[i][0], vlo[i][1], vlo[i][2], vlo[i][3], vhi[i][0], vhi[i][1], vhi[i][2], vhi[i][3]}
#define PIN(x) asm volatile("" : "+v"(x))
#define MX3(a, b, c) __builtin_fmaxf(__builtin_fmaxf((a), (b)), (c))
#define GAPA(MF, A0, A1, A2, A3, W0, W1, PW) do { MF; sacc += A0; sacc += A1; sacc += A2; sacc += A3; PIN(sacc); W0; W1; PIN(PW); SBAR(); } while (0)
#define EX(v) __builtin_amdgcn_exp2f(v)
#define GAPB(MF, X, B) do { MF; X[B] = EX(X[B]); X[B + 1] = EX(X[B + 1]); X[B + 2] = EX(X[B + 2]); X[B + 3] = EX(X[B + 3]); PIN(X); SBAR(); } while (0)
#define VRD(i) do { vlo[i] = vtr(vp_ + (((i) >> 2) * 4096 + ((i) & 3) * 1024)); vhi[i] = vtr(vp_ + (((i) >> 2) * 4096 + ((i) & 3) * 1024 + 512)); } while (0)
#define KRD(G, j) do { if (G) { kload2(kf, kp0 + sl_next, j); SBAR(); } } while (0)
#define STEP(C0, C1, P0, P1, t, GK, GV, GL) do { SBAR(); \
    const lds_cptr vp_ = vp0 + sl_prev; \
    VRD(0); SBAR(); float sacc = (P0[0] + P0[1]); \
    GAPA(C0 = __builtin_amdgcn_mfma_f32_32x32x16_bf16(kf[0], qr[0], negm, 0, 0, 0), P0[2], P0[3], P0[4], P0[5],     pw0[0] = PKW(P0, 0), pw0[1] = PKW(P0, 2), pw0); \
    VRD(4); SBAR(); GAPA(C1 = __builtin_amdgcn_mfma_f32_32x32x16_bf16(kf[1], qr[0], negm, 0, 0, 0), P0[6], P0[7], P0[8], P0[9],     pw0[2] = PKW(P0, 4), pw0[3] = PKW(P0, 6), pw0); \
    VRD(1); SBAR(); GAPA(C0 = __builtin_amdgcn_mfma_f32_32x32x16_bf16(kf[2], qr[1], C0, 0, 0, 0),   P0[10], P0[11], P0[12], P0[13], pw1[0] = PKW(P0, 8), pw1[1] = PKW(P0, 10), pw1); \
    VRD(5); SBAR(); GAPA(C1 = __builtin_amdgcn_mfma_f32_32x32x16_bf16(kf[3], qr[1], C1, 0, 0, 0),   P0[14], P0[15], P1[0], P1[1],   pw1[2] = PKW(P0, 12), pw1[3] = PKW(P0, 14), pw1); \
    VRD(2); SBAR(); GAPA(C0 = __builtin_amdgcn_mfma_f32_32x32x16_bf16(kf[4], qr[2], C0, 0, 0, 0),   P1[2], P1[3], P1[4], P1[5],     pw2[0] = PKW(P1, 0), pw2[1] = PKW(P1, 2), pw2); \
    VRD(6); SBAR(); GAPA(C1 = __builtin_amdgcn_mfma_f32_32x32x16_bf16(kf[5], qr[2], C1, 0, 0, 0),   P1[6], P1[7], P1[8], P1[9],     pw2[2] = PKW(P1, 4), pw2[3] = PKW(P1, 6), pw2); \
    VRD(3); SBAR(); GAPA(C0 = __builtin_amdgcn_mfma_f32_32x32x16_bf16(kf[6], qr[3], C0, 0, 0, 0),   P1[10], P1[11], P1[12], P1[13], pw3[0] = PKW(P1, 8), pw3[1] = PKW(P1, 10), pw3); \
    VRD(7); SBAR(); GAPA(C1 = __builtin_amdgcn_mfma_f32_32x32x16_bf16(kf[7], qr[3], C1, 0, 0, 0),   P1[14], P1[15], 0.f, 0.f,       pw3[2] = PKW(P1, 12), pw3[3] = PKW(P1, 14), pw3); \
    l_reg += sacc; \
    if (GK) { DMA_K((t) + 3, sl_cur); } if (GV) { DMA_V((t) + 1, sl_next); } \
    { float a = MX3(C0[0], C0[1], C1[0]), b = MX3(C0[2], C0[3], C1[1]); a = MX3(a, C1[2], C1[3]); \
      _Pragma("unroll") for (int r = 4; r < 16; r += 4) { a = MX3(a, C0[r], C0[r + 1]); b = MX3(b, C0[r + 2], C0[r + 3]); a = MX3(a, C1[r], C1[r + 1]); b = MX3(b, C1[r + 2], C1[r + 3]); } \
      float rm = __builtin_fmaxf(a, b); { auto rr = __builtin_amdgcn_permlane32_swap(__float_as_uint(rm), __float_as_uint(rm), false, false); rm = __builtin_fmaxf(__uint_as_float(rr[0]), __uint_as_float(rr[1])); } \
      resc = false; \
      if (__builtin_expect(__any(rm > (float)THRL), 0)) { const float dl = __builtin_fmaxf(rm, 0.f); mhat += dl; \
        _Pragma("unroll") for (int r = 0; r < 16; ++r) { C0[r] -= dl; C1[r] -= dl; } \
        _Pragma("unroll") for (int r = 0; r < 16; ++r) negm[r] = -mhat; asm volatile("" : "+v"(negm)); \
        const float f = __builtin_amdgcn_exp2f(-dl); l_reg *= f; if (hi == 0) wsf[r32] = f; resc = true; } } \
    SBAR(); \
    GAPB(o[0] = __builtin_amdgcn_mfma_f32_32x32x16_bf16(PAF(0), VFR(0), o[0], 0, 0, 0), C0, 0); \
    GAPB(o[1] = __builtin_amdgcn_mfma_f32_32x32x16_bf16(PAF(0), VFR(4), o[1], 0, 0, 0), C0, 4); \
    KRD(GL, 0); GAPB(o[0] = __builtin_amdgcn_mfma_f32_32x32x16_bf16(PAF(1), VFR(1), o[0], 0, 0, 0), C0, 8); \
    KRD(GL, 1); GAPB(o[1] = __builtin_amdgcn_mfma_f32_32x32x16_bf16(PAF(1), VFR(5), o[1], 0, 0, 0), C0, 12); \
    KRD(GL, 2); GAPB(o[0] = __builtin_amdgcn_mfma_f32_32x32x16_bf16(PAF(2), VFR(2), o[0], 0, 0, 0), C1, 0); \
    KRD(GL, 3); GAPB(o[1] = __builtin_amdgcn_mfma_f32_32x32x16_bf16(PAF(2), VFR(6), o[1], 0, 0, 0), C1, 4); \
    GAPB(o[0] = __builtin_amdgcn_mfma_f32_32x32x16_bf16(PAF(3), VFR(3), o[0], 0, 0, 0), C1, 8); \
    GAPB(o[1] = __builtin_amdgcn_mfma_f32_32x32x16_bf16(PAF(3), VFR(7), o[1], 0, 0, 0), C1, 12); \
    } while (0)
    int t = 1;
    for (; t + 5 < NT; t += 2) {
        STEP(pB0, pB1, pA0, pA1, t, true, true, true);     WAIT_BAR(2); RESC(); ROT();
        STEP(pA0, pA1, pB0, pB1, t + 1, true, true, true); WAIT_BAR(2); RESC(); ROT();
    }
#define ENDW(tt) do { if ((tt) + 3 < NT) { WAIT_BAR(2); } else if ((tt) + 2 < NT) { WAIT_BAR(1); } else { WAIT_BAR(0); } } while (0)
    for (; t + 1 < NT; t += 2) {
        STEP(pB0, pB1, pA0, pA1, t, (t + 3 < NT), (t + 1 < NT), (t + 1 < NT));         ENDW(t);     RESC(); ROT();
        STEP(pA0, pA1, pB0, pB1, t + 1, (t + 4 < NT), (t + 2 < NT), (t + 2 < NT));     ENDW(t + 1); RESC(); ROT();
    }
    STEP(pB0, pB1, pA0, pA1, NT - 1, false, false, false); RESC();
    { float sacc = pB0[0] + pB0[1]; _Pragma("unroll") for (int r = 2; r < 16; ++r) sacc += pB0[r]; _Pragma("unroll") for (int r = 0; r < 16; ++r) sacc += pB1[r]; l_reg += sacc;
      pw0 = (u32x4){PKW(pB0, 0), PKW(pB0, 2), PKW(pB0, 4), PKW(pB0, 6)}; pw1 = (u32x4){PKW(pB0, 8), PKW(pB0, 10), PKW(pB0, 12), PKW(pB0, 14)}; pw2 = (u32x4){PKW(pB1, 0), PKW(pB1, 2), PKW(pB1, 4), PKW(pB1, 6)}; pw3 = (u32x4){PKW(pB1, 8), PKW(pB1, 10), PKW(pB1, 12), PKW(pB1, 14)};
      SBAR(); pv(o, vb0 + sl_cur, PAF(0), PAF(1), PAF(2), PAF(3)); }
#undef PKW
#undef PAF
#undef VFR
#undef PIN
#undef MX3
#undef GAPA
#undef GAPB
#undef EX
#undef VRD
#undef KRD
#undef STEP
#undef ENDW
    { auto rr = __builtin_amdgcn_permlane32_swap(__float_as_uint(l_reg), __float_as_uint(l_reg), false, false); l_reg = __uint_as_float(rr[0]) + __uint_as_float(rr[1]); }
    if (hi == 0) wsf[32 + r32] = l_reg; asm volatile("s_waitcnt lgkmcnt(0)" ::: "memory");
    float rli[16];
#pragma unroll
    for (int r = 0; r < 16; ++r) rli[r] = __builtin_amdgcn_rcpf(wsf[32 + crow(r, hi)]);
    bf16* Ow = Oh + (long)(q0 + wid * QBLK) * OP;
    { bf16* stg = (bf16*)(shm + LDS_OST) + wid * 2048;
#pragma unroll
      for (int r = 0; r < 16; ++r) { const int orow = crow(r, hi);
#pragma unroll
        for (int d0 = 0; d0 < 2; ++d0) stg[orow * 64 + d0 * 32 + r32] = __float2bfloat16(o[d0][r] * rli[r]); }
      asm volatile("s_waitcnt lgkmcnt(0)" ::: "memory");
#pragma unroll
      for (int i = 0; i < 4; ++i) { const int row = i * 8 + (lane >> 3), ch = lane & 7; const u32x4 v = *(const u32x4*)(stg + row * 64 + ch * 8); ATTN_STORE16(Ow + (long)row * OP + ch * 8, v); } }
    asm volatile("s_waitcnt lgkmcnt(0)\n\ts_barrier" ::: "memory");
#undef DMA_K
#undef DMA_V
#undef START
#undef RESC
#undef ROT
}

__device__ __forceinline__ void attn_unit_fast(int qb, const bf16* Qh, const bf16* __restrict__ Kh, const bf16* __restrict__ Vh, bf16* Oh, char* shm) {
    const int tid = fresh_tid(), lane = tid & 63, r32 = lane & 31, hi = lane >> 5; const int wid = __builtin_amdgcn_readfirstlane(tid >> 6);
    const int q0 = qb * QB;
    const bf16* Qw = Qh + (long)(q0 + wid * QBLK) * QP;
    const unsigned lds0 = (unsigned)(uintptr_t)shm;
    const bf16* ksrc = Kh + (long)lane * KP + wid * 8;
    const bf16* vsrc = Vh + (long)(16 * (wid & 3) + (lane >> 2)) * KP + (wid >> 2) * 32 + (lane & 3) * 8;
    const unsigned kdst = lds0 + LDS_K + wid * 1024, vdst = lds0 + LDS_V + wid * 1024;
#define DMA_K(t, slot) glds16(ksrc + (long)(t) * KVBLK * KP, (unsigned)__builtin_amdgcn_readfirstlane(kdst + (slot)))
#define DMA_V(t, slot) glds16(vsrc + (long)(t) * KVBLK * KP, (unsigned)__builtin_amdgcn_readfirstlane(vdst + (slot)))
    const int vb0 = (int)(lds0 + LDS_V) + ((lane >> 4) & 1) * 32 + (lane & 3) * 8 + (4 * hi + ((lane & 15) >> 2)) * 64;
    const char* Kbase = shm + LDS_K; bf16x8 kf[8];
    const lds_cptr shm3 = (lds_cptr)shm; const lds_cptr kp0 = shm3 + LDS_K + hi * 1024 + r32 * 16; const lds_cptr vp0 = shm3 + LDS_V + ((lane >> 4) & 1) * 32 + (lane & 3) * 8 + (4 * hi + ((lane & 15) >> 2)) * 64;
    constexpr int NT = SEQ / KVBLK;
    DMA_K(0, 0); DMA_V(0, 0); DMA_K(1, SLOTB);
    bf16x8 qr[4];
#pragma unroll
    for (int d0 = 0; d0 < 4; ++d0) qr[d0] = *reinterpret_cast<const bf16x8*>(&Qw[(long)r32 * QP + d0 * 16 + hi * 8]);
    f32x16 o[2]; o[0] = f32x16{}; o[1] = f32x16{}; f32x16 lsum = f32x16{};
    const f32x16 zero16 = f32x16{};
    bf16x8 ones; { const short one = (short)0x3F80; ones = (bf16x8){one, one, one, one, one, one, one, one}; asm volatile("" : "+v"(ones)); }
    f32x16 pA0, pA1, pB0, pB1;
    int sl_prev = 0, sl_cur = 0, sl_next = SLOTB;
#define ROT() do { sl_prev = sl_cur; sl_cur = sl_next; sl_next = (sl_next == (NSLOT - 1) * SLOTB) ? 0 : sl_next + SLOTB; } while (0)
    DMA_K(2, 2 * SLOTB);
    WAIT_BAR(3);
    qkt(pA0, pA1, Kbase, qr, zero16, r32, hi);
    _Pragma("unroll") for (int r = 0; r < 16; ++r) pA0[r] = __builtin_amdgcn_exp2f(pA0[r]);
    _Pragma("unroll") for (int r = 0; r < 16; ++r) pA1[r] = __builtin_amdgcn_exp2f(pA1[r]);
    WAIT_BAR(0);
    DMA_K(3, 0); DMA_V(1, SLOTB);
    ROT();
    kload8(kf, kp0 + sl_cur);
    WAIT_BAR(2);
    s16x4 vlo[8], vhi[8]; u32x4 pw0, pw1, pw2, pw3;
#define PKW(P, B) cvtpk_s(P[B], P[B + 1])
#define PAF(k) __builtin_bit_cast(bf16x8, pw##k)
#define VFR(i) (bf16x8){vlo[i][0], vlo[i][1], vlo[i][2], vlo[i][3], vhi[i][0], vhi[i][1], vhi[i][2], vhi[i][3]}
#define PIN(x) asm volatile("" : "+v"(x))
#define GAPA(MF, W0, W1, PW) do { MF; W0; W1; PIN(PW); SBAR(); } while (0)
#define EX(v) __builtin_amdgcn_exp2f(v)
#define GAPB(MF, X, B) do { MF; X[B] = EX(X[B]); X[B + 1] = EX(X[B + 1]); X[B + 2] = EX(X[B + 2]); PIN(X); SBAR(); } while (0)
#define GAPS(k, X, B) do { lsum = __builtin_amdgcn_mfma_f32_32x32x16_bf16(PAF(k), ones, lsum, 0, 0, 0); X[B] = EX(X[B]); X[B + 1] = EX(X[B + 1]); PIN(X); SBAR(); } while (0)
#define VRD(i) do { vlo[i] = vtr(vp_ + (((i) >> 2) * 4096 + ((i) & 3) * 1024)); vhi[i] = vtr(vp_ + (((i) >> 2) * 4096 + ((i) & 3) * 1024 + 512)); } while (0)
#define KRD(G, j) do { if (G) { kload2(kf, kp0 + sl_next, j); SBAR(); } } while (0)
#define STEP(C0, C1, P0, P1, t, GK, GV, GL) do { SBAR(); \
    const lds_cptr vp_ = vp0 + sl_prev; \
    VRD(0); SBAR(); \
    GAPA(C0 = __builtin_amdgcn_mfma_f32_32x32x16_bf16(kf[0], qr[0], zero16, 0, 0, 0), pw0[0] = PKW(P0, 0), pw0[1] = PKW(P0, 2), pw0); \
    VRD(4); SBAR(); GAPA(C1 = __builtin_amdgcn_mfma_f32_32x32x16_bf16(kf[1], qr[0], zero16, 0, 0, 0), pw0[2] = PKW(P0, 4), pw0[3] = PKW(P0, 6), pw0); \
    VRD(1); SBAR(); GAPA(C0 = __builtin_amdgcn_mfma_f32_32x32x16_bf16(kf[2], qr[1], C0, 0, 0, 0),   pw1[0] = PKW(P0, 8), pw1[1] = PKW(P0, 10), pw1); \
    VRD(5); SBAR(); GAPA(C1 = __builtin_amdgcn_mfma_f32_32x32x16_bf16(kf[3], qr[1], C1, 0, 0, 0),   pw1[2] = PKW(P0, 12), pw1[3] = PKW(P0, 14), pw1); \
    VRD(2); SBAR(); GAPA(C0 = __builtin_amdgcn_mfma_f32_32x32x16_bf16(kf[4], qr[2], C0, 0, 0, 0),   pw2[0] = PKW(P1, 0), pw2[1] = PKW(P1, 2), pw2); \
    VRD(6); SBAR(); GAPA(C1 = __builtin_amdgcn_mfma_f32_32x32x16_bf16(kf[5], qr[2], C1, 0, 0, 0),   pw2[2] = PKW(P1, 4), pw2[3] = PKW(P1, 6), pw2); \
    VRD(3); SBAR(); GAPA(C0 = __builtin_amdgcn_mfma_f32_32x32x16_bf16(kf[6], qr[3], C0, 0, 0, 0),   pw3[0] = PKW(P1, 8), pw3[1] = PKW(P1, 10), pw3); \
    VRD(7); SBAR(); GAPA(C1 = __builtin_amdgcn_mfma_f32_32x32x16_bf16(kf[7], qr[3], C1, 0, 0, 0),   pw3[2] = PKW(P1, 12), pw3[3] = PKW(P1, 14), pw3); \
    if (GK) { DMA_K((t) + 3, sl_cur); } if (GV) { DMA_V((t) + 1, sl_next); } \
    SBAR(); \
    GAPB(o[0] = __builtin_amdgcn_mfma_f32_32x32x16_bf16(PAF(0), VFR(0), o[0], 0, 0, 0), C0, 0); \
    GAPB(o[1] = __builtin_amdgcn_mfma_f32_32x32x16_bf16(PAF(0), VFR(4), o[1], 0, 0, 0), C0, 3); \
    KRD(GL, 0); GAPS(0, C0, 6); \
    GAPB(o[0] = __builtin_amdgcn_mfma_f32_32x32x16_bf16(PAF(1), VFR(1), o[0], 0, 0, 0), C0, 8); \
    KRD(GL, 1); GAPB(o[1] = __builtin_amdgcn_mfma_f32_32x32x16_bf16(PAF(1), VFR(5), o[1], 0, 0, 0), C0, 11); \
    GAPS(1, C0, 14); \
    KRD(GL, 2); GAPB(o[0] = __builtin_amdgcn_mfma_f32_32x32x16_bf16(PAF(2), VFR(2), o[0], 0, 0, 0), C1, 0); \
    KRD(GL, 3); GAPB(o[1] = __builtin_amdgcn_mfma_f32_32x32x16_bf16(PAF(2), VFR(6), o[1], 0, 0, 0), C1, 3); \
    GAPS(2, C1, 6); \
    GAPB(o[0] = __builtin_amdgcn_mfma_f32_32x32x16_bf16(PAF(3), VFR(3), o[0], 0, 0, 0), C1, 8); \
    GAPB(o[1] = __builtin_amdgcn_mfma_f32_32x32x16_bf16(PAF(3), VFR(7), o[1], 0, 0, 0), C1, 11); \
    GAPS(3, C1, 14); \
    } while (0)
    int t = 1;
    for (; t + 5 < NT; t += 2) {
        STEP(pB0, pB1, pA0, pA1, t, true, true, true);     WAIT_BAR(2); ROT();
        STEP(pA0, pA1, pB0, pB1, t + 1, true, true, true); WAIT_BAR(2); ROT();
    }
#define ENDW(tt) do { if ((tt) + 3 < NT) { WAIT_BAR(2); } else if ((tt) + 2 < NT) { WAIT_BAR(1); } else { WAIT_BAR(0); } } while (0)
    for (; t + 1 < NT; t += 2) {
        STEP(pB0, pB1, pA0, pA1, t, (t + 3 < NT), (t + 1 < NT), (t + 1 < NT));         ENDW(t);     ROT();
        STEP(pA0, pA1, pB0, pB1, t + 1, (t + 4 < NT), (t + 2 < NT), (t + 2 < NT));     ENDW(t + 1); ROT();
    }
    STEP(pB0, pB1, pA0, pA1, NT - 1, false, false, false);
    { pw0 = (u32x4){PKW(pB0, 0), PKW(pB0, 2), PKW(pB0, 4), PKW(pB0, 6)}; pw1 = (u32x4){PKW(pB0, 8), PKW(pB0, 10), PKW(pB0, 12), PKW(pB0, 14)}; pw2 = (u32x4){PKW(pB1, 0), PKW(pB1, 2), PKW(pB1, 4), PKW(pB1, 6)}; pw3 = (u32x4){PKW(pB1, 8), PKW(pB1, 10), PKW(pB1, 12), PKW(pB1, 14)};
      SBAR(); pv(o, vb0 + sl_cur, PAF(0), PAF(1), PAF(2), PAF(3));
      lsum = __builtin_amdgcn_mfma_f32_32x32x16_bf16(PAF(0), ones, lsum, 0, 0, 0); lsum = __builtin_amdgcn_mfma_f32_32x32x16_bf16(PAF(1), ones, lsum, 0, 0, 0);
      lsum = __builtin_amdgcn_mfma_f32_32x32x16_bf16(PAF(2), ones, lsum, 0, 0, 0); lsum = __builtin_amdgcn_mfma_f32_32x32x16_bf16(PAF(3), ones, lsum, 0, 0, 0); }
#undef PKW
#undef PAF
#undef VFR
#undef PIN
#undef GAPA
#undef GAPB
#undef GAPS
#undef EX
#undef VRD
#undef KRD
#undef STEP
#undef ENDW
    bf16* Ow = Oh + (long)(q0 + wid * QBLK) * OP;
    { bf16* stg = (bf16*)(shm + LDS_OST) + wid * 2048;
#pragma unroll
      for (int r = 0; r < 16; ++r) { const int orow = crow(r, hi); const float rl = __builtin_amdgcn_rcpf(lsum[r]);
#pragma unroll
        for (int d0 = 0; d0 < 2; ++d0) stg[orow * 64 + d0 * 32 + r32] = __float2bfloat16(o[d0][r] * rl); }
      asm volatile("s_waitcnt lgkmcnt(0)" ::: "memory");
#pragma unroll
      for (int i = 0; i < 4; ++i) { const int row = i * 8 + (lane >> 3), ch = lane & 7; const u32x4 v = *(const u32x4*)(stg + row * 64 + ch * 8); ATTN_STORE16(Ow + (long)row * OP + ch * 8, v); } }
    asm volatile("s_waitcnt lgkmcnt(0)\n\ts_barrier" ::: "memory");
#undef DMA_K
#undef DMA_V
#undef ROT
}
__device__ __forceinline__ void attn_unit_f8(int qb, const unsigned char* Q8h, const unsigned char* __restrict__ K8h, const unsigned char* __restrict__ V8Th, bf16* Oh, char* shm, float shift) {
    const int tid = fresh_tid(), lane = tid & 63, r32 = lane & 31, hi = lane >> 5; const int wid = __builtin_amdgcn_readfirstlane(tid >> 6);
    const int q0 = qb * QB;
    const unsigned lds0 = (unsigned)(uintptr_t)shm;
    constexpr int KSL = 4096;
    const int prow = 8 * wid + ((lane & 31) >> 2), pch = ((lane & 3) ^ ((prow >> 2) & 3)) * 16;
    const unsigned char* ksrc = K8h + (long)prow * 128 + pch;
    const unsigned char* vsrc = V8Th + (long)prow * 64 + pch;
    const unsigned kdst = lds0 + LDS_K + wid * 512, vdst = lds0 + LDS_V + wid * 512;
#define DMA_K(t, slot) do { if (lane < 32) glds16(ksrc + (long)(t) * KVBLK * 128, (unsigned)__builtin_amdgcn_readfirstlane(kdst + (slot))); } while (0)
#define DMA_V(t, slot) do { if (lane < 32) glds16(vsrc + (long)(t) * 4096, (unsigned)__builtin_amdgcn_readfirstlane(vdst + (slot))); } while (0)
    const lds_cptr shm3 = (lds_cptr)shm; const int ksw = (r32 >> 2) & 3;
    const int fo0 = r32 * 64 + (((2 * hi) ^ ksw) * 16), fo1 = r32 * 64 + (((2 * hi + 1) ^ ksw) * 16);
    const lds_cptr kp0 = shm3 + LDS_K, vp0 = shm3 + LDS_V;
    constexpr int NT = SEQ / KVBLK;
    DMA_K(0, 0); DMA_V(0, 0); DMA_K(1, KSL);
    v8i qf; { const unsigned char* qp = Q8h + (long)(q0 + wid * QBLK + r32) * 512 + hi * 32; qf = __builtin_shufflevector(*(const v4i*)qp, *(const v4i*)(qp + 16), 0, 1, 2, 3, 4, 5, 6, 7); }
    const int sc_k = 127 - 3, sc_q = 127 - 5, sc_v = 127 - 3, sc_1 = 127;
    v8i kf8[2], vf8[2], pa;
    v8i ones8; { const int o4 = 0x38383838; ones8 = (v8i){o4, o4, o4, o4, o4, o4, o4, o4}; asm volatile("" : "+v"(ones8)); }
    f32x16 cin; { const float ns = -shift; _Pragma("unroll") for (int r = 0; r < 16; ++r) cin[r] = ns; asm volatile("" : "+v"(cin)); }
#define LD8(dst, base, slotoff) do { _Pragma("unroll") for (int n_ = 0; n_ < 2; ++n_) dst[n_] = __builtin_shufflevector(*(const LAS v4i*)((base) + (slotoff) + n_ * 2048 + fo0), *(const LAS v4i*)((base) + (slotoff) + n_ * 2048 + fo1), 0, 1, 2, 3, 4, 5, 6, 7); } while (0)
#define QK8(n_) __builtin_amdgcn_mfma_scale_f32_32x32x64_f8f6f4(kf8[n_], qf, cin, 0, 0, 0, sc_k, 0, sc_q)
#define ACC8(acc, a_, b_, sb_) asm volatile("s_nop 1\n\tv_mfma_scale_f32_32x32x64_f8f6f4 %0, %1, %2, %0, %3, %4 op_sel_hi:[0,0,0]" : "+v"(acc) : "v"(a_), "v"(b_), "v"(sc_1), "v"(sb_))
#define PACK8(P0, P1) do { pa[0] = (int)pk4_fp8_nc(P0[0], P0[1], P0[2], P0[3]); pa[1] = (int)pk4_fp8_nc(P0[4], P0[5], P0[6], P0[7]); pa[2] = (int)pk4_fp8_nc(P0[8], P0[9], P0[10], P0[11]); pa[3] = (int)pk4_fp8_nc(P0[12], P0[13], P0[14], P0[15]); \
    pa[4] = (int)pk4_fp8_nc(P1[0], P1[1], P1[2], P1[3]); pa[5] = (int)pk4_fp8_nc(P1[4], P1[5], P1[6], P1[7]); pa[6] = (int)pk4_fp8_nc(P1[8], P1[9], P1[10], P1[11]); pa[7] = (int)pk4_fp8_nc(P1[12], P1[13], P1[14], P1[15]); } while (0)
    f32x16 o[2]; o[0] = f32x16{}; o[1] = f32x16{}; f32x16 lsum = f32x16{};
    f32x16 pA0, pA1, pB0, pB1;
    int sl_prev = 0, sl_cur = 0, sl_next = KSL;
#define ROT() do { sl_prev = sl_cur; sl_cur = sl_next; sl_next = (sl_next == (NSLOT - 1) * KSL) ? 0 : sl_next + KSL; } while (0)
    DMA_K(2, 2 * KSL);
    WAIT_BAR(3);
    LD8(kf8, kp0, 0); pA0 = QK8(0); pA1 = QK8(1);
    _Pragma("unroll") for (int r = 0; r < 16; ++r) pA0[r] = __builtin_amdgcn_exp2f(pA0[r]);
    _Pragma("unroll") for (int r = 0; r < 16; ++r) pA1[r] = __builtin_amdgcn_exp2f(pA1[r]);
    WAIT_BAR(0);
    DMA_K(3, 0); DMA_V(1, KSL);
    ROT();
    LD8(kf8, kp0, sl_cur);
    WAIT_BAR(2);
#define PIN(x) asm volatile("" : "+v"(x))
#define EX(v) __builtin_amdgcn_exp2f(v)
#define EX4(X, B) do { X[B] = EX(X[B]); X[B + 1] = EX(X[B + 1]); X[B + 2] = EX(X[B + 2]); X[B + 3] = EX(X[B + 3]); } while (0)
#define STEP(C0, C1, P0, P1, t, GK, GV, GL) do { SBAR(); \
    LD8(vf8, vp0, sl_prev); \
    C0 = QK8(0); PACK8(P0, P1); PIN(pa); \
    C1 = QK8(1); \
    if (GK) { DMA_K((t) + 3, sl_cur); } if (GV) { DMA_V((t) + 1, sl_next); } \
    \
    ACC8(o[0], pa, vf8[0], sc_v); EX4(C0, 0); EX4(C0, 4); EX4(C0, 8); PIN(C0); \
    ACC8(o[1], pa, vf8[1], sc_v); EX4(C0, 12); EX4(C1, 0); EX4(C1, 4); PIN(C0); PIN(C1); \
    if (GL) { LD8(kf8, kp0, sl_next); } \
    ACC8(lsum, pa, ones8, sc_1); EX4(C1, 8); EX4(C1, 12); PIN(C1); \
    } while (0)
    int t = 1;
    for (; t + 5 < NT; t += 2) {
        STEP(pB0, pB1, pA0, pA1, t, true, true, true);     WAIT_BAR(2); ROT();
        STEP(pA0, pA1, pB0, pB1, t + 1, true, true, true); WAIT_BAR(2); ROT();
    }
#define ENDW(tt) do { if ((tt) + 3 < NT) { WAIT_BAR(2); } else if ((tt) + 2 < NT) { WAIT_BAR(1); } else { WAIT_BAR(0); } } while (0)
    for (; t + 1 < NT; t += 2) {
        STEP(pB0, pB1, pA0, pA1, t, (t + 3 < NT), (t + 1 < NT), (t + 1 < NT));         ENDW(t);     ROT();
        STEP(pA0, pA1, pB0, pB1, t + 1, (t + 4 < NT), (t + 2 < NT), (t + 2 < NT));     ENDW(t + 1); ROT();
    }
    STEP(pB0, pB1, pA0, pA1, NT - 1, false, false, false);
    { PACK8(pB0, pB1); PIN(pa); SBAR(); LD8(vf8, vp0, sl_cur); SBAR();
      ACC8(o[0], pa, vf8[0], sc_v); ACC8(o[1], pa, vf8[1], sc_v); ACC8(lsum, pa, ones8, sc_1); }
    asm volatile("s_nop 15\n\ts_nop 15" : "+v"(o[0]), "+v"(o[1]), "+v"(lsum));
#undef PIN
#undef EX
#undef EX4
#undef STEP
#undef ENDW
    bf16* Ow = Oh + (long)(q0 + wid * QBLK) * OP;
    { bf16* stg = (bf16*)(shm + LDS_OST) + wid * 2048;
#pragma unroll
      for (int r = 0; r < 16; ++r) { const int orow = crow(r, hi); const float rl = lsum[r] > 0.f ? __builtin_amdgcn_rcpf(lsum[r]) : 0.f;
#pragma unroll
        for (int d0 = 0; d0 < 2; ++d0) stg[orow * 64 + d0 * 32 + r32] = __float2bfloat16(o[d0][r] * rl); }
      asm volatile("s_waitcnt lgkmcnt(0)" ::: "memory");
#pragma unroll
      for (int i = 0; i < 4; ++i) { const int row = i * 8 + (lane >> 3), ch = lane & 7; const u32x4 v = *(const u32x4*)(stg + row * 64 + ch * 8); ATTN_STORE16(Ow + (long)row * OP + ch * 8, v); } }
    asm volatile("s_waitcnt lgkmcnt(0)\n\ts_barrier" ::: "memory");
#undef DMA_K
#undef DMA_V
#undef ROT
#undef LD8
#undef QK8
#undef ACC8
#undef PACK8
}
constexpr int ATTN_LDS_BYTES = LDS_BYTES;
#undef SBAR
#undef WAIT_BAR
}

namespace na_body {
constexpr int NA_K = 0, NA_V = 65536;
typedef short v4i16_t __attribute__((ext_vector_type(4)));
__device__ __forceinline__ int clampi(int v, int lo, int hi) { return v < lo ? lo : (v > hi ? hi : v); }
__device__ __forceinline__ void na_phase(LAS unsigned char* lds, LAS float* biasL, LAS float* xch, const bf16_t* QKV, bf16_t* Y, const float* rpb, int vcu) {
    const int tid = fresh_tid(), lane = tid & 63, wid = __builtin_amdgcn_readfirstlane(tid >> 6);
    const int bh = vcu >> 3, b = bh >> 3, h = bh & 7, rbase = (vcu & 7) * 16;
    for (int i = tid; i < 15 * 31; i += 512) biasL[i] = rpb[h * 465 + i];
    const int lc = tid >> 3, lch = tid & 7;
    const unsigned kwoff = (unsigned)(lc * 128 + ((lch ^ (lc & 7)) * 16));
    const unsigned vwoff = (unsigned)(lc * 128 + (((lch >> 1) ^ ((lc >> 1) & 3)) * 32) + (lch & 1) * 16);
    const int q = lane & 15, g = lane >> 4;
    { const int rs0 = clampi(rbase - 4, 0, 120);
      u32x4 kv[8], vv[8];
#pragma unroll
      for (int i = 0; i < 8; ++i) { const size_t tok = (size_t)b * SEQ + (size_t)(rs0 + i) * 64 + lc;
          kv[i] = *(const u32x4*)(QKV + tok * NQKV + C_KNA + h * 64 + lch * 8); vv[i] = *(const u32x4*)(QKV + tok * NQKV + C_VNA + h * 64 + lch * 8); }
#pragma unroll
      for (int i = 0; i < 8; ++i) { const int row = rs0 + i;
          *(LAS u32x4*)(lds + NA_K + (row & 7) * 8192 + kwoff) = kv[i]; *(LAS u32x4*)(lds + NA_V + (row & 7) * 8192 + vwoff) = vv[i]; } }
    __syncthreads();
    const int tile_ = wid & 3, c0_ = tile_ * 16;
    bf16x8 qn[2];
#pragma unroll
    for (int ks = 0; ks < 2; ++ks) qn[ks] = *(const bf16x8*)(QKV + ((size_t)b * SEQ + (size_t)rbase * 64 + c0_ + q) * NQKV + C_QNA + h * 64 + ks * 32 + g * 8);
    for (int rr = 0; rr < 16; ++rr) {
        const int r = rbase + rr, rs = clampi(r - 4, 0, 120);
        const int rsn = (rr < 15) ? clampi(r + 1 - 4, 0, 120) : rs; const bool pf = rsn != rs;
        u32x4 pk = (u32x4){0u, 0u, 0u, 0u}, pv = (u32x4){0u, 0u, 0u, 0u};
        if (pf) { const size_t tok = (size_t)b * SEQ + (size_t)(rsn + 7) * 64 + lc;
            pk = *(const u32x4*)(QKV + tok * NQKV + C_KNA + h * 64 + lch * 8); pv = *(const u32x4*)(QKV + tok * NQKV + C_VNA + h * 64 + lch * 8); }
        {
            const int tile = wid & 3, kh = wid >> 2;
            const int c0 = tile * 16, u0 = clampi(c0 - 8, 0, 32);
            const size_t tq = (size_t)b * SEQ + (size_t)r * 64 + c0 + q;
            bf16x8 qf[2]; qf[0] = qn[0]; qf[1] = qn[1];
            { const int rn = (rr < 15) ? r + 1 : r; const size_t tqn = (size_t)b * SEQ + (size_t)rn * 64 + c0 + q;
#pragma unroll
              for (int ks = 0; ks < 2; ++ks) qn[ks] = *(const bf16x8*)(QKV + tqn * NQKV + C_QNA + h * 64 + ks * 32 + g * 8); }
            f32x4 s[4][2];
#pragma unroll
            for (int kk = 0; kk < 4; ++kk) { const int slot = (rs + 4 * kh + kk) & 7;
#pragma unroll
                for (int hf = 0; hf < 2; ++hf) { const int kc = u0 + hf * 16 + q;
                    f32x4 a = (f32x4){0.f, 0.f, 0.f, 0.f};
#pragma unroll
                    for (int ks = 0; ks < 2; ++ks) { const bf16x8 kfr = *(const LAS bf16x8*)(lds + NA_K + slot * 8192 + kc * 128 + (((ks * 4 + g) ^ (kc & 7)) * 16));
                        a = __builtin_amdgcn_mfma_f32_16x16x32_bf16(kfr, qf[ks], a, 0, 0, 0); }
                    s[kk][hf] = a; } }
            const int c = c0 + q, cs = clampi(c - 8, 0, 48), lo = cs - u0;
            const int dcb = u0 - c + 15 + 4 * g;
            float mx = -1e30f;
#pragma unroll
            for (int kk = 0; kk < 4; ++kk) { const int dr = rs + 4 * kh + kk - r + 7;
#pragma unroll
                for (int hf = 0; hf < 2; ++hf)
#pragma unroll
                    for (int i = 0; i < 4; ++i) { const int kcl = 16 * hf + 4 * g + i; const bool valid = (kcl >= lo) && (kcl < lo + 16);
                        const int dc = clampi(dcb + 16 * hf + i, 0, 30);
                        const float v = valid ? (s[kk][hf][i] + biasL[dr * 31 + dc]) * LOG2E : -1e30f;
                        s[kk][hf][i] = v; mx = fmaxf(mx, v); } }
            mx = swap16_max(mx); mx = swap32_max(mx);
            float l = 0.f;
#pragma unroll
            for (int kk = 0; kk < 4; ++kk)
#pragma unroll
                for (int hf = 0; hf < 2; ++hf)
#pragma unroll
                    for (int i = 0; i < 4; ++i) { const float p = __builtin_amdgcn_exp2f(s[kk][hf][i] - mx); s[kk][hf][i] = p; l += p; }
            l = swap16_sum(l, l); l = swap32_sum(l, l);
            f32x4 o[4];
#pragma unroll
            for (int nb = 0; nb < 4; ++nb) o[nb] = (f32x4){0.f, 0.f, 0.f, 0.f};
            const int qq = (lane & 15) >> 2, pp = lane & 3;
            const int kcA = u0 + 4 * g + qq, kcB = kcA + 16;
#pragma unroll
            for (int kk = 0; kk < 4; ++kk) { const int slot = (rs + 4 * kh + kk) & 7;
                u32x4 pw; pw.x = pk2(s[kk][0][0], s[kk][0][1]); pw.y = pk2(s[kk][0][2], s[kk][0][3]); pw.z = pk2(s[kk][1][0], s[kk][1][1]); pw.w = pk2(s[kk][1][2], s[kk][1][3]);
                const bf16x8 pf = __builtin_bit_cast(bf16x8, pw);
#pragma unroll
                for (int nb = 0; nb < 4; ++nb) {
                    const s16x4 va = __builtin_bit_cast(s16x4, __builtin_amdgcn_ds_read_tr16_b64_v4i16((LAS v4i16_t*)(lds + NA_V + slot * 8192 + kcA * 128 + ((nb ^ ((kcA >> 1) & 3)) * 32) + pp * 8)));
                    const s16x4 vb = __builtin_bit_cast(s16x4, __builtin_amdgcn_ds_read_tr16_b64_v4i16((LAS v4i16_t*)(lds + NA_V + slot * 8192 + kcB * 128 + ((nb ^ ((kcB >> 1) & 3)) * 32) + pp * 8)));
                    const bf16x8 vf = (bf16x8){va[0], va[1], va[2], va[3], vb[0], vb[1], vb[2], vb[3]};
                    o[nb] = __builtin_amdgcn_mfma_f32_16x16x32_bf16(vf, pf, o[nb], 0, 0, 0); } }
            LAS float* px = xch + (size_t)(tile * 64 + lane) * 18;
            if (kh == 1) { px[0] = mx; px[1] = l;
#pragma unroll
                for (int nb = 0; nb < 4; ++nb)
#pragma unroll
                    for (int i = 0; i < 4; ++i) px[2 + nb * 4 + i] = o[nb][i]; }
            __syncthreads();
            if (kh == 0) { const float mb = px[0], lb = px[1]; const float m = fmaxf(mx, mb), fa = __builtin_amdgcn_exp2f(mx - m), fb = __builtin_amdgcn_exp2f(mb - m);
                const float rl = 1.0f / (l * fa + lb * fb);
#pragma unroll
                for (int nb = 0; nb < 4; ++nb) { float t[4];
#pragma unroll
                    for (int i = 0; i < 4; ++i) t[i] = (o[nb][i] * fa + px[2 + nb * 4 + i] * fb) * rl;
                    u32x2 w; w.x = pk2(t[0], t[1]); w.y = pk2(t[2], t[3]);
                    *(u32x2*)(Y + tq * DMODEL + h * 64 + nb * 16 + 4 * g) = w; } }
        }
        if (pf) { *(LAS u32x4*)(lds + NA_K + ((rsn + 7) & 7) * 8192 + kwoff) = pk; *(LAS u32x4*)(lds + NA_V + ((rsn + 7) & 7) * 8192 + vwoff) = pv; }
        __syncthreads();
    }
}
}

constexpr size_t MiB = 1u << 20;
constexpr size_t WS_CTL = 0, CTL_ZERO_BYTES = 1 * MiB;
constexpr size_t WS_MOD = 1 * MiB;
constexpr size_t WS_IDX = 2 * MiB;
constexpr size_t WS_GSEL = 2 * MiB + 256 * 1024;
constexpr size_t WS_AFF = 3 * MiB;
constexpr size_t WS_SLOT = 5 * MiB;
constexpr size_t WS_WIN = 7 * MiB;
constexpr size_t WS_WG8 = 12 * MiB;
constexpr size_t WS_WA = 16 * MiB, WS_WB = 17 * MiB, WS_WOUT = 18 * MiB;
constexpr size_t WS_WGU = 20 * MiB;
constexpr size_t WS_WD = 148 * MiB;
constexpr size_t WS_H = 212 * MiB;
constexpr size_t WS_QKV = 276 * MiB;
constexpr size_t WS_GATES = 420 * MiB;
constexpr size_t WS_END = 548 * MiB;
constexpr size_t WS_YBUF = WS_WGU;
static_assert(WS_QKV + (size_t)65536 * 2048 * 2 <= WS_END, "HMID fits");
constexpr int CW_BAR = 4096;

constexpr int RING_OFF = 0, RING_BYTES = 131072;
constexpr int LDSCTL_OFF = RING_BYTES, MISC_OFF = LDSCTL_OFF + 320;
constexpr int NABIAS_OFF = RING_BYTES + 1024;
constexpr int NAXCH_OFF = RING_BYTES + 4096;
constexpr int LDS_BYTES = 163840;

#define XB_TMO      128
#define XB_XCNT(j)  (256  + 64 * (j))
#define XB_XSUB(j)  (1280 + 64 * (j))
#define XB_XGEN(j)  (2304 + 64 * (j))
#define XB_TOP      3328
#define XB_TOPGEN   3392
#define XCD_BAR_WORDS 3456
#define XB_SPIN_CAP (1u << 22)
__device__ __forceinline__ unsigned xb_ld(unsigned* p)              { return __hip_atomic_load(p, __ATOMIC_RELAXED, __HIP_MEMORY_SCOPE_AGENT); }
__device__ __forceinline__ unsigned xb_add(unsigned* p, unsigned v) { return __hip_atomic_fetch_add(p, v, __ATOMIC_RELAXED, __HIP_MEMORY_SCOPE_AGENT); }
__device__ __forceinline__ unsigned xb_xcc_id() { return (unsigned)__builtin_amdgcn_s_getreg((3 << 11) | 20) & 0xFu; }
#define XB_SPIN(cond, bar) do { unsigned _sp = 0; while (cond) { __builtin_amdgcn_s_sleep(1); \
    if ((++_sp & 255u) == 0u) { if (xb_ld(&(bar)[XB_TMO])) break; if (_sp > XB_SPIN_CAP) { atomicAdd(&(bar)[XB_TMO], 1u); break; } } } } while (0)
struct XcdBarrier { unsigned* bar; unsigned x; volatile LAS unsigned* st; };
__device__ __forceinline__ XcdBarrier xcd_barrier_post(unsigned* bar, volatile LAS unsigned* st) {
    XcdBarrier b; b.bar = bar; b.x = xb_xcc_id(); b.st = st;
    if (threadIdx.x == 0) (void)xb_add(&bar[XB_XCNT(b.x)], 1u);
    return b;
}
__device__ __forceinline__ void xcd_barrier_complete(unsigned* bar, unsigned x, unsigned& nloc, unsigned& nx) {
    const unsigned G = gridDim.x * gridDim.y * gridDim.z;
    unsigned sum, cnt, mine, sp = 0u;
    for (;;) {
        sum = 0u; cnt = 0u; mine = 0u;
#pragma unroll
        for (unsigned j = 0; j < 16; ++j) { const unsigned c = xb_ld(&bar[XB_XCNT(j)]); sum += c; cnt += (c > 0u) ? 1u : 0u; mine = (j == x) ? c : mine; }
        if (sum == G) break;
        __builtin_amdgcn_s_sleep(1);
        if ((++sp & 255u) == 0u) { if (xb_ld(&bar[XB_TMO])) break; if (sp > XB_SPIN_CAP) { atomicAdd(&bar[XB_TMO], 1u); break; } }
    }
    nloc = mine > 0u ? mine : 1u; nx = cnt > 0u ? cnt : 1u;
}
__device__ __forceinline__ void xcd_barrier(const XcdBarrier& b) {
    asm volatile("s_waitcnt vmcnt(0)" ::: "memory");
    __syncthreads();
    if (threadIdx.x == 0) {
        unsigned* bar = b.bar;
        __builtin_amdgcn_s_waitcnt(0);
        unsigned nloc = b.st[0], nx = b.st[1];
        if (nloc == 0u) { xcd_barrier_complete(bar, b.x, nloc, nx); b.st[0] = nloc; b.st[1] = nx; }
        const unsigned old = xb_add(&bar[XB_XSUB(b.x)], 1u);
        const unsigned gen = old / nloc;
        if (old + 1u == (gen + 1u) * nloc) {
            __builtin_amdgcn_fence(__ATOMIC_RELEASE, "agent");
            asm volatile("s_waitcnt vmcnt(0)" ::: "memory");
            const unsigned og = xb_add(&bar[XB_TOP], 1u);
            const unsigned tg = og / nx;
            if (og + 1u == (tg + 1u) * nx) xb_add(&bar[XB_TOPGEN], 1u);
            else XB_SPIN(xb_ld(&bar[XB_TOPGEN]) == tg, bar);
            __builtin_amdgcn_fence(__ATOMIC_ACQUIRE, "agent");
            xb_add(&bar[XB_XGEN(b.x)], 1u);
            asm volatile("s_waitcnt vmcnt(0)" ::: "memory");
        } else {
            XB_SPIN(xb_ld(&bar[XB_XGEN(b.x)]) == gen, bar);
            __builtin_amdgcn_fence(__ATOMIC_ACQUIRE, "agent");
            asm volatile("s_waitcnt vmcnt(0)" ::: "memory");
        }
    }
    __syncthreads();
}

#define LDS_WAIT() asm volatile("s_waitcnt lgkmcnt(0)" ::: "memory")
template <class RowMap>
__device__ __forceinline__ void p0_transpose_item(const float* W, int K, int N, bf16_t* WT, LAS float* scr, int item, int lane, const RowMap& rowmap) {
    const int nblk = N / 32, kb = item / nblk, nb = item % nblk, k0 = 64 * kb, n0 = 32 * nb;
    float ld_[32];
#pragma unroll
    for (int i = 0; i < 32; ++i) ld_[i] = __builtin_nontemporal_load(&W[(size_t)(k0 + 2 * i + (lane >> 5)) * N + n0 + (lane & 31)]);
#pragma unroll
    for (int i = 0; i < 32; ++i) scr[(2 * i + (lane >> 5)) * 33 + (lane & 31)] = ld_[i];
    LDS_WAIT(); asm volatile("" ::: "memory");
    const int c = lane & 7;
#pragma unroll
    for (int j = 0; j < 4; ++j) { const int n = (lane >> 3) + 8 * j; const LAS float* s = scr + (8 * c) * 33 + n;
        u32x4 o; o.x = pk2(s[0 * 33], s[1 * 33]); o.y = pk2(s[2 * 33], s[3 * 33]); o.z = pk2(s[4 * 33], s[5 * 33]); o.w = pk2(s[6 * 33], s[7 * 33]);
        *(u32x4*)(WT + (size_t)rowmap(n0 + n) * K + k0 + 8 * c) = o; }
    LDS_WAIT(); asm volatile("" ::: "memory");
}
template <class RowMap>
__device__ __forceinline__ void p0_transpose_item_f8(const float* W, int K, int N, unsigned char* WT, LAS float* scr, int item, int lane, const RowMap& rowmap, float scale) {
    const int nblk = N / 32, kb = item / nblk, nb = item % nblk, k0 = 64 * kb, n0 = 32 * nb;
    float ld_[32];
#pragma unroll
    for (int i = 0; i < 32; ++i) ld_[i] = __builtin_nontemporal_load(&W[(size_t)(k0 + 2 * i + (lane >> 5)) * N + n0 + (lane & 31)]);
#pragma unroll
    for (int i = 0; i < 32; ++i) scr[(2 * i + (lane >> 5)) * 33 + (lane & 31)] = ld_[i];
    LDS_WAIT(); asm volatile("" ::: "memory");
#pragma unroll
    for (int j = 0; j < 2; ++j) { const int p = lane + 64 * j, n = p >> 2, c = p & 3; const LAS float* s = scr + (16 * c) * 33 + n;
        u32x4 o;
        o.x = pk4_fp8(s[0 * 33] * scale, s[1 * 33] * scale, s[2 * 33] * scale, s[3 * 33] * scale);
        o.y = pk4_fp8(s[4 * 33] * scale, s[5 * 33] * scale, s[6 * 33] * scale, s[7 * 33] * scale);
        o.z = pk4_fp8(s[8 * 33] * scale, s[9 * 33] * scale, s[10 * 33] * scale, s[11 * 33] * scale);
        o.w = pk4_fp8(s[12 * 33] * scale, s[13 * 33] * scale, s[14 * 33] * scale, s[15 * 33] * scale);
        *(u32x4*)(WT + (size_t)rowmap(n0 + n) * K + k0 + 16 * c) = o; }
    LDS_WAIT(); asm volatile("" ::: "memory");
}
struct RowId { __device__ __forceinline__ int operator()(int n) const { return n; } };
struct RowIn { __device__ __forceinline__ int operator()(int n) const { if (n < 1536) return n; const int oc = n & 255; return (n & ~255) + 128 * ((oc >> 5) & 1) + 32 * (oc >> 6) + (oc & 31); } };
struct RowGate { __device__ __forceinline__ int operator()(int n) const { const int g = n - NQKV, c = g & 1023; return 768 + (c >> 7) * 256 + (g >> 10) * 128 + (c & 127); } };
struct RowAll8 { __device__ __forceinline__ int operator()(int n) const { if (n < NQKV) return RowIn{}(n); const int g = n - NQKV, c = g & 1023; return NQKV + (c >> 7) * 256 + (g >> 10) * 128 + (c & 127); } };
struct RowHead8 { __device__ __forceinline__ int operator()(int n) const { return RowIn{}(n) - 1536; } };
struct RowGU { int up; __device__ __forceinline__ int operator()(int f) const { return (f >> 7) * 256 + up * 128 + (f & 127); } };

struct CvDesc { const float* W; unsigned char* WT; int K, N, k0, n0, gu, up; };
__device__ __forceinline__ CvDesc cv_decode(int r, const float* w_eg, const float* w_eu, const float* w_ed, unsigned char* WGU, unsigned char* WD) {
    constexpr int I_GU = 16 * 64, I_D = 32 * 32;
    CvDesc d; const int e = r / (2 * I_GU + I_D); int q = r - e * (2 * I_GU + I_D);
    if (q < 2 * I_GU) { d.up = q >= I_GU; q -= d.up * I_GU; d.W = (d.up ? w_eu : w_eg) + (size_t)e * 1024 * 2048; d.WT = WGU + (size_t)e * 4096 * 1024; d.K = 1024; d.N = 2048; d.gu = 1; }
    else { q -= 2 * I_GU; d.W = w_ed + (size_t)e * 2048 * 1024; d.WT = WD + (size_t)e * 1024 * 2048; d.K = 2048; d.N = 1024; d.gu = 0; d.up = 0; }
    const int nblk = d.N / 32; d.k0 = 64 * (q / nblk); d.n0 = 32 * (q % nblk);
    return d;
}
#define CV_LOAD(ld_, d_) do { _Pragma("unroll") for (int i_ = 0; i_ < 32; ++i_) ld_[i_] = __builtin_nontemporal_load(&(d_).W[(size_t)((d_).k0 + 2 * i_ + (lane >> 5)) * (d_).N + (d_).n0 + (lane & 31)]); } while (0)
#define CV_FINISH(ld_, d_) do { _Pragma("unroll") for (int i_ = 0; i_ < 32; ++i_) scr[(2 * i_ + (lane >> 5)) * 33 + (lane & 31)] = ld_[i_]; \
        LDS_WAIT(); asm volatile("" ::: "memory"); \
        _Pragma("unroll") for (int j_ = 0; j_ < 2; ++j_) { const int p_ = lane + 64 * j_, n_ = p_ >> 2, c_ = p_ & 3; const LAS float* s_ = scr + (16 * c_) * 33 + n_; const int f_ = (d_).n0 + n_; \
            const int row_ = (d_).gu ? ((f_ >> 7) * 256 + (d_).up * 128 + (f_ & 127)) : f_; u32x4 o_; \
            o_.x = pk4_fp8(s_[0 * 33] * F8_SC_W, s_[1 * 33] * F8_SC_W, s_[2 * 33] * F8_SC_W, s_[3 * 33] * F8_SC_W); \
            o_.y = pk4_fp8(s_[4 * 33] * F8_SC_W, s_[5 * 33] * F8_SC_W, s_[6 * 33] * F8_SC_W, s_[7 * 33] * F8_SC_W); \
            o_.z = pk4_fp8(s_[8 * 33] * F8_SC_W, s_[9 * 33] * F8_SC_W, s_[10 * 33] * F8_SC_W, s_[11 * 33] * F8_SC_W); \
            o_.w = pk4_fp8(s_[12 * 33] * F8_SC_W, s_[13 * 33] * F8_SC_W, s_[14 * 33] * F8_SC_W, s_[15 * 33] * F8_SC_W); \
            *(u32x4*)((d_).WT + (size_t)row_ * (d_).K + (d_).k0 + 16 * c_) = o_; } \
        LDS_WAIT(); asm volatile("" ::: "memory"); } while (0)
__device__ __forceinline__ void conv_experts_pipelined(int first, int end, int step, int lane, LAS float* scr, const float* w_eg, const float* w_eu, const float* w_ed, unsigned char* WGU, unsigned char* WD) {
    float ldA[32], ldB[32]; CvDesc dA, dB; int itA = first, itB = first + step;
    if (itA < end) { dA = cv_decode(itA, w_eg, w_eu, w_ed, WGU, WD); CV_LOAD(ldA, dA); }
    if (itB < end) { dB = cv_decode(itB, w_eg, w_eu, w_ed, WGU, WD); CV_LOAD(ldB, dB); }
    for (;;) {
        if (itA >= end) break;
        CV_FINISH(ldA, dA); itA += 2 * step;
        if (itA < end) { dA = cv_decode(itA, w_eg, w_eu, w_ed, WGU, WD); CV_LOAD(ldA, dA); }
        if (itB >= end) break;
        CV_FINISH(ldB, dB); itB += 2 * step;
        if (itB < end) { dB = cv_decode(itB, w_eg, w_eu, w_ed, WGU, WD); CV_LOAD(ldB, dB); }
    }
}
#undef CV_LOAD
#undef CV_FINISH

__constant__ float INV_FREQ[16] = {1.0f, 0.5623413251903491f, 0.31622776601683794f, 0.1778279410038923f, 0.1f, 0.05623413251903491f, 0.03162277660168379f, 0.01778279410038923f,
                                   0.01f, 0.005623413251903491f, 0.0031622776601683794f, 0.001778279410038923f, 0.001f, 0.0005623413251903491f, 0.00031622776601683794f, 0.0001778279410038923f};

struct Args { const float* in[18]; float* out; unsigned char* ws; int ph_lo, ph_hi, li, pad; };
constexpr int NPHASE = 12;

__global__ void __launch_bounds__(512, 2) mk_fwd(Args args) {
    extern __shared__ __attribute__((aligned(16))) unsigned char lds_raw[];
    LAS unsigned char* lds = (LAS unsigned char*)lds_raw;
    volatile LAS unsigned* MISC = (volatile LAS unsigned*)(lds + MISC_OFF);
    const int G = gridDim.x; const int bx = blockIdx.x; const int vcu = (G % 8 == 0) ? (bx % 8) * (G / 8) + bx / 8 : bx;
    const int NGW = G * 8;
#define PH_IDS() const int tid = fresh_tid(), lane = tid & 63, wave = __builtin_amdgcn_readfirstlane(tid >> 6), gw = vcu * 8 + wave; (void)lane; (void)gw
    constexpr int I_IN = 16 * 136, I_BR = 8 * 32, I_OUT = 16 * 32, I_GU = 16 * 64, I_D = 32 * 32;
    constexpr int N_SMALL_ITEMS = I_IN + 2 * I_BR + I_OUT, N_EXP_ITEMS = 16 * (2 * I_GU + I_D);
#define CONV_ITEM(it_) do { LAS float* scr_ = (LAS float*)(lds + RING_OFF + wave * 16384); int r_ = (it_); \
        if (r_ < I_IN) { p0_transpose_item_f8(w_in, 1024, NIN, WG8, scr_, r_, lane, RowAll8{}, F8_SC_W); break; } r_ -= I_IN; \
        if (r_ < I_BR) { p0_transpose_item(w_bna, 512, 1024, WA, scr_, r_, lane, RowId{}); break; } r_ -= I_BR; \
        if (r_ < I_BR) { p0_transpose_item(w_bgqa, 512, 1024, WB, scr_, r_, lane, RowId{}); break; } r_ -= I_BR; \
        if (r_ < I_OUT) { p0_transpose_item(w_out, 1024, 1024, WOUT, scr_, r_, lane, RowId{}); break; } r_ -= I_OUT; \
        const int e_ = r_ / (2 * I_GU + I_D); r_ -= e_ * (2 * I_GU + I_D); \
        if (r_ < I_GU) { p0_transpose_item_f8(w_eg + (size_t)e_ * 1024 * 2048, 1024, 2048, (unsigned char*)WGU + (size_t)e_ * 4096 * 1024, scr_, r_, lane, RowGU{0}, F8_SC_W); break; } r_ -= I_GU; \
        if (r_ < I_GU) { p0_transpose_item_f8(w_eu + (size_t)e_ * 1024 * 2048, 1024, 2048, (unsigned char*)WGU + (size_t)e_ * 4096 * 1024, scr_, r_, lane, RowGU{1}, F8_SC_W); break; } r_ -= I_GU; \
        p0_transpose_item_f8(w_ed + (size_t)e_ * 2048 * 1024, 2048, 1024, (unsigned char*)WD + (size_t)e_ * 1024 * 2048, scr_, r_, lane, RowId{}, F8_SC_W); } while (0)
    unsigned char* ws = args.ws;
    const float* x = args.in[0]; const float* cvec = args.in[1]; const float* w_ada = args.in[2]; const float* b_ada = args.in[3]; const float* norm1_g = args.in[4];
    const float* w_in = args.in[5]; const float* q_norm_g = args.in[6]; const float* k_norm_g = args.in[7]; const float* na_rpb = args.in[8];
    const float* w_bna = args.in[9]; const float* w_bgqa = args.in[10]; const float* w_out = args.in[11]; const float* norm2_g = args.in[12]; const float* w_router = args.in[13];
    const float* w_eg = args.in[14]; const float* w_eu = args.in[15]; const float* w_ed = args.in[16]; const float* final_g = args.in[17];
    float* out = args.out;
    unsigned* ctl = (unsigned*)(ws + WS_CTL);
    float* MOD = (float*)(ws + WS_MOD); int* IDX = (int*)(ws + WS_IDX); float* GSEL = (float*)(ws + WS_GSEL); float* AFF = (float*)(ws + WS_AFF); int* SLOT = (int*)(ws + WS_SLOT);
    bf16_t* WIN = (bf16_t*)(ws + WS_WIN); bf16_t* WA = (bf16_t*)(ws + WS_WA); bf16_t* WB = (bf16_t*)(ws + WS_WB); bf16_t* WOUT = (bf16_t*)(ws + WS_WOUT);
    bf16_t* WGU = (bf16_t*)(ws + WS_WGU); bf16_t* WD = (bf16_t*)(ws + WS_WD);
    bf16_t* HB = (bf16_t*)(ws + WS_H); bf16_t* QKV = (bf16_t*)(ws + WS_QKV);
    bf16_t* GA = (bf16_t*)(ws + WS_GATES); unsigned char* R8 = ws + WS_GATES + 64 * MiB; unsigned char* H8 = ws + WS_GATES + 96 * MiB; unsigned char* WG8 = ws + WS_WIN;
    unsigned char* Q8 = ws + WS_WGU + 64 * MiB; unsigned char* K8 = ws + WS_WGU + 80 * MiB; unsigned char* V8T = ws + WS_WGU + 84 * MiB;
    bf16_t* DELTA = (bf16_t*)(ws + WS_GATES);
    bf16_t* MERGED = (bf16_t*)(ws + WS_QKV); bf16_t* HMID = (bf16_t*)(ws + WS_QKV); bf16_t* YBUF = (bf16_t*)(ws + WS_YBUF);

    { PH_IDS(); for (int u = tid; u < (LDS_BYTES - LDSCTL_OFF) / 4; u += 512) ((LAS unsigned*)(lds + LDSCTL_OFF))[u] = 0u; }
    __syncthreads();
    const bool use_bar = (MK_N_LAUNCHES != NPHASE);
    XcdBarrier bar; bar.bar = ctl + CW_BAR + args.li * XCD_BAR_WORDS; bar.x = 0; bar.st = nullptr;
    if (use_bar) bar = xcd_barrier_post(ctl + CW_BAR + args.li * XCD_BAR_WORDS, MISC + 8);
    const int lo = args.ph_lo, hi = args.ph_hi;
#ifndef PHASE_MASK
#define PHASE_MASK 0xFFF
#endif
#define IN(k) (((PHASE_MASK >> (k)) & 1) && lo <= (k) && (k) < hi)
#define SEAM(k) do { if (IN(k) && IN((k) + 1)) xcd_barrier(bar); } while (0)

    if (IN(0)) {
        PH_IDS();
        LAS float* scr = (LAS float*)(lds + RING_OFF + wave * 16384);
        if (vcu < 96) {
            LAS float* sl = (LAS float*)(lds + RING_OFF);
            for (int i = tid; i < 4096; i += 512) { const float cv = cvec[i]; sl[i] = cv * sigmoidf_fast(cv); }
            __syncthreads();
        }
        for (int it = vcu; it < 96; it += G) {
            const LAS float* sl = (const LAS float*)(lds + RING_OFF);
            const int col = it * 64 + lane; float a0 = 0.f, a1 = 0.f, a2 = 0.f, a3 = 0.f;
#pragma unroll 16
            for (int dd = 0; dd < 128; ++dd) { const int d = wave * 128 + dd; const float w = w_ada[(size_t)d * 6144 + col];
                a0 += sl[d] * w; a1 += sl[1024 + d] * w; a2 += sl[2048 + d] * w; a3 += sl[3072 + d] * w; }
            LAS float* part = (LAS float*)(lds + RING_OFF + 8 * 16384 - 8192);
            part[(wave * 4 + 0) * 64 + lane] = a0; part[(wave * 4 + 1) * 64 + lane] = a1; part[(wave * 4 + 2) * 64 + lane] = a2; part[(wave * 4 + 3) * 64 + lane] = a3;
            __syncthreads();
            if (tid < 256) { const int bb = tid >> 6, l = tid & 63; float s = 0.f;
#pragma unroll
                for (int w = 0; w < 8; ++w) s += part[(w * 4 + bb) * 64 + l];
                MOD[bb * 6144 + it * 64 + l] = s + b_ada[it * 64 + l]; }
            __syncthreads();
        }
        for (int it = gw; it < N_SMALL_ITEMS; it += NGW) { CONV_ITEM(it); }
    }
    SEAM(0);

    if (IN(1)) {
        PH_IDS();
        f32x4 gnv[4], nx[4];
#pragma unroll
        for (int j = 0; j < 4; ++j) { gnv[j] = *(const f32x4*)(norm1_g + 4 * lane + 256 * j); nx[j] = __builtin_nontemporal_load((const f32x4*)(x + (size_t)gw * DMODEL) + lane + 64 * j); }
        for (int m = gw; m < MT; m += NGW) { const int b = m >> 13; const float* mb = MOD + b * 6144;
            f32x4 v[4], scv[4], shv[4]; float s = 0.f;
#pragma unroll
            for (int j = 0; j < 4; ++j) { v[j] = nx[j]; scv[j] = *(const f32x4*)(mb + 1024 + 4 * lane + 256 * j); shv[j] = *(const f32x4*)(mb + 4 * lane + 256 * j); }
            const int mn = (m + NGW < MT) ? m + NGW : m;
#pragma unroll
            for (int j = 0; j < 4; ++j) nx[j] = __builtin_nontemporal_load((const f32x4*)(x + (size_t)mn * DMODEL) + lane + 64 * j);
#pragma unroll
            for (int j = 0; j < 4; ++j) s += (v[j].x * v[j].x + v[j].y * v[j].y) + (v[j].z * v[j].z + v[j].w * v[j].w);
            const float rinv = __builtin_amdgcn_rsqf(wave_sum(s) * (1.f / DMODEL) + EPS);
#pragma unroll
            for (int j = 0; j < 4; ++j) {
                const f32x4 hv = v[j] * rinv * gnv[j] * (scv[j] + 1.0f) + shv[j];
                ((unsigned*)(H8 + (size_t)m * DMODEL) + lane)[64 * j] = pk4_fp8(hv.x * F8_SC_H2, hv.y * F8_SC_H2, hv.z * F8_SC_H2, hv.w * F8_SC_H2); }
        }
    }
    SEAM(1);

#define ATTN_BOUND() float smaxp; { const int l_ = fresh_tid() & 63; float mq_ = fabsf(q_norm_g[l_]), mk_ = fabsf(k_norm_g[l_]); \
        _Pragma("unroll") for (int o_ = 1; o_ < 64; o_ <<= 1) { mq_ = fmaxf(mq_, __shfl_xor(mq_, o_)); mk_ = fmaxf(mk_, __shfl_xor(mk_, o_)); } smaxp = LOG2E * 8.0f * mq_ * mk_; } \
        const bool fast = __builtin_amdgcn_readfirstlane((int)(smaxp <= 24.0f)) != 0
    if (IN(2)) {
        ATTN_BOUND();
        { pg8::SchedPlain S; S.init(MT, NIN, G, bx, H8, DMODEL, WG8, DMODEL);
          pg8::EpiHeadGate E{pg8::EpiProj{QKV, Q8, K8, V8T, q_norm_g, k_norm_g, !fast}, pg8::EpiGate{GA, R8}};
          pg8::gemm_phase<true>(lds + RING_OFF, 8, S, E); }
    }
    SEAM(2);


    if (IN(4)) {
        PH_IDS();
#define CONV_EXPERTS() do { conv_experts_pipelined(gw, N_EXP_ITEMS, NGW, lane, (LAS float*)(lds + RING_OFF + wave * 16384), w_eg, w_eu, w_ed, (unsigned char*)WGU, (unsigned char*)WD); __syncthreads(); } while (0)
        const int cls = vcu & 3;
        if (cls == 0) CONV_EXPERTS();
        if (G == 256) na_body::na_phase(lds + RING_OFF, (LAS float*)(lds + NABIAS_OFF), (LAS float*)(lds + NAXCH_OFF), QKV, HB, na_rpb, vcu);
        if (cls == 1) CONV_EXPERTS();
        static_assert(attn_body::ATTN_LDS_BYTES <= RING_BYTES, "attention LDS");
        ATTN_BOUND(); const float shiftv = fmaxf(smaxp - 8.0f, 0.0f);
        for (int i = 0; i < 4; ++i) { const long L = (long)i * G + vcu; if (L >= 1024) break;
            if ((cls == 2 && i == 1) || (cls == 3 && i == 2)) { PH_IDS(); CONV_EXPERTS(); }
            const int ii = (int)(L >> 8), v = (int)(L & 255), bh = v >> 3, qb = (v & 7) * 4 + ii, b = bh >> 3, h = bh & 7;
            const attn_body::bf16* base = (const attn_body::bf16*)QKV + (size_t)b * SEQ * NQKV;
            if (fast) attn_body::attn_unit_f8(qb, Q8 + (size_t)b * SEQ * 512 + h * 64, K8 + (size_t)b * SEQ * 128 + (h >> 2) * 64, V8T + (size_t)(b * 2 + (h >> 2)) * 64 * SEQ,
                                    (attn_body::bf16*)HB + (size_t)b * SEQ * DMODEL + 512 + h * 64, (char*)lds_raw + RING_OFF, shiftv);
            else attn_body::attn_unit<8>(qb, base + C_QG + h * 64, base + C_KG + (h >> 2) * 64, base + C_VG + (h >> 2) * 64,
                                    (attn_body::bf16*)HB + (size_t)b * SEQ * DMODEL + 512 + h * 64, (char*)lds_raw + RING_OFF); }
#undef CONV_EXPERTS
    }
    SEAM(4);

    if (IN(5)) {
        pg8::SchedPlain S; S.init(MT, DMODEL, G, bx, HB + 512, DMODEL * 2, WB, 512 * 2); S.A2 = (const char*)HB; S.B2 = (const char*)WA; S.nt1 = 8;
        pg8::EpiMerge E{MERGED, GA, R8};
        pg8::gemm_phase<false, pg8::EpiMerge, pg8::SchedPlain, true>(lds + RING_OFF, 16, S, E);
    }
    SEAM(5);

    if (IN(6)) {
        pg8::SchedPlain S; S.init(MT, DMODEL, G, bx, MERGED, DMODEL * 2, WOUT, DMODEL * 2);
        pg8::EpiDelta E{DELTA, MOD};
        pg8::gemm_phase<false>(lds + RING_OFF, 16, S, E);
    }
    SEAM(6);

    if (IN(7)) {
        PH_IDS();
        f32x4 nv[2][4]; u32x2 nd[2][4];
#define P7_LOADX(row_) do { const f32x4* p_ = (const f32x4*)(x + (size_t)(row_) * DMODEL) + lane; const u32x2* d_ = (const u32x2*)(DELTA + (size_t)(row_) * DMODEL) + lane; \
            _Pragma("unroll") for (int j_ = 0; j_ < 4; ++j_) { nv[0][j_] = __builtin_nontemporal_load(&p_[64 * j_]); nv[1][j_] = __builtin_nontemporal_load(&p_[256 + 64 * j_]); \
                nd[0][j_] = d_[64 * j_]; nd[1][j_] = d_[256 + 64 * j_]; } } while (0)
        P7_LOADX(gw * 2);
        LAS float* wr = (LAS float*)(lds + RING_OFF);
        for (int i = tid; i < 16384; i += 512) { const int d = i >> 4, e = i & 15; wr[e * 1024 + d] = w_router[i]; }
        __syncthreads();
        for (int m = gw * 2; m < MT; m += NGW * 2) { const int b = m >> 13; const float* mb = MOD + b * 6144;
            f32x4 v[2][4], gnv[4], scv[4], shv[4]; float s0 = 0.f, s1 = 0.f;
            const int mn = (m + NGW * 2 < MT) ? m + NGW * 2 : m;
#pragma unroll
            for (int j = 0; j < 4; ++j) { const int col = 4 * lane + 256 * j;
#pragma unroll
                for (int r = 0; r < 2; ++r) { const u32x2 dd = nd[r][j]; v[r][j] = nv[r][j] + (f32x4){bf_lo(dd.x), bf_hi(dd.x), bf_lo(dd.y), bf_hi(dd.y)}; }
                gnv[j] = *(const f32x4*)(norm2_g + col); scv[j] = *(const f32x4*)(mb + 4096 + col); shv[j] = *(const f32x4*)(mb + 3072 + col); }
            P7_LOADX(mn);
            asm volatile("" ::: "memory");
#pragma unroll
            for (int j = 0; j < 4; ++j) {
                s0 += (v[0][j].x * v[0][j].x + v[0][j].y * v[0][j].y) + (v[0][j].z * v[0][j].z + v[0][j].w * v[0][j].w);
                s1 += (v[1][j].x * v[1][j].x + v[1][j].y * v[1][j].y) + (v[1][j].z * v[1][j].z + v[1][j].w * v[1][j].w); }
            s0 = wave_sum(s0); s1 = wave_sum(s1);
            const float rinv0 = __builtin_amdgcn_rsqf(s0 * (1.f / DMODEL) + EPS), rinv1 = __builtin_amdgcn_rsqf(s1 * (1.f / DMODEL) + EPS);
#pragma unroll
            for (int j = 0; j < 4; ++j) {
                const f32x4 a = gnv[j] * (scv[j] + 1.0f);
                v[0][j] = v[0][j] * rinv0 * a + shv[j]; v[1][j] = v[1][j] * rinv1 * a + shv[j];
                ((unsigned*)((unsigned char*)HB + (size_t)m * DMODEL) + lane)[64 * j] = pk4_fp8(v[0][j].x * F8_SC_H2, v[0][j].y * F8_SC_H2, v[0][j].z * F8_SC_H2, v[0][j].w * F8_SC_H2);
                ((unsigned*)((unsigned char*)HB + (size_t)(m + 1) * DMODEL) + lane)[64 * j] = pk4_fp8(v[1][j].x * F8_SC_H2, v[1][j].y * F8_SC_H2, v[1][j].z * F8_SC_H2, v[1][j].w * F8_SC_H2); }
            float pr[32];
#pragma unroll
            for (int e = 0; e < 16; ++e) { float a0 = 0.f, a1 = 0.f;
#pragma unroll
                for (int j = 0; j < 4; ++j) { const f32x4 w = *(const LAS f32x4*)(wr + e * 1024 + 4 * lane + 256 * j);
                    a0 += (v[0][j].x * w.x + v[0][j].y * w.y) + (v[0][j].z * w.z + v[0][j].w * w.w);
                    a1 += (v[1][j].x * w.x + v[1][j].y * w.y) + (v[1][j].z * w.z + v[1][j].w * w.w); }
                pr[e] = a0; pr[16 + e] = a1; if ((e & 3) == 3) asm volatile("" ::: "memory"); }
            float q16[16], q8[8];
#pragma unroll
            for (int i = 0; i < 16; ++i) q16[i] = swap32_sum(pr[i], pr[i + 16]);
#pragma unroll
            for (int i = 0; i < 8; ++i) q8[i] = swap16_sum(q16[i], q16[i + 8]);
            const bool up8 = (lane & 8) != 0, up4 = (lane & 4) != 0, up2 = (lane & 2) != 0;
            float q4[4], q2[2];
#pragma unroll
            for (int i = 0; i < 4; ++i) { float lo = q8[i], hi = q8[i + 4]; asm volatile("" : "+v"(lo), "+v"(hi)); q4[i] = (up8 ? hi : lo) + dppf<DPP_XOR8>(up8 ? lo : hi); }
#pragma unroll
            for (int i = 0; i < 2; ++i) { float lo = q4[i], hi = q4[i + 2]; asm volatile("" : "+v"(lo), "+v"(hi)); q2[i] = (up4 ? hi : lo) + lane_xor4(up4 ? lo : hi); }
            float mylog;
            { float lo = q2[0], hi = q2[1]; asm volatile("" : "+v"(lo), "+v"(hi)); mylog = (up2 ? hi : lo) + dppf<DPP_XOR2>(up2 ? lo : hi); }
            mylog += dppf<DPP_XOR1>(mylog);
            float mx = mylog;
            mx = fmaxf(mx, dppf<DPP_XOR2>(mx)); mx = fmaxf(mx, lane_xor4(mx)); mx = fmaxf(mx, dppf<DPP_XOR8>(mx)); mx = swap16_max(mx);
            const float ex = __expf(mylog - mx); float sum = ex;
            sum += dppf<DPP_XOR2>(sum); sum += lane_xor4(sum); sum += dppf<DPP_XOR8>(sum); sum = swap16_sum(sum, sum);
            if ((lane & 1) == 0) AFF[(unsigned)(m + (lane >> 5)) * 16u + (unsigned)((lane >> 1) & 15)] = ex * __builtin_amdgcn_rcpf(sum);
        }
#undef P7_LOADX
        __syncthreads();
    }
    SEAM(7);

    if (IN(8)) {
        PH_IDS();
        LAS unsigned* vals = (LAS unsigned*)(lds + RING_OFF);
        LAS unsigned* hist = (LAS unsigned*)(lds + RING_OFF + 32768);
        LAS unsigned* sel = (LAS unsigned*)(lds + RING_OFF + 32768 + 1024);
        LAS unsigned* wtot = (LAS unsigned*)(lds + RING_OFF + 32768 + 2048);
        for (int item = vcu; item < 64; item += G) { const int b = item >> 4, e = item & 15;
            __syncthreads();
            for (int k = 0; k < 16; ++k) { const int t = tid + 512 * k; vals[t] = __builtin_bit_cast(unsigned, AFF[((size_t)b * SEQ + t) * 16 + e]); }
            __syncthreads();
            unsigned mv[16];
#pragma unroll
            for (int k = 0; k < 16; ++k) mv[k] = vals[tid + 512 * k];
            unsigned T = 0u;
            for (int bit = 30; bit >= 0; --bit) { const unsigned cand = T | (1u << bit);
                unsigned c = 0u;
#pragma unroll
                for (int k = 0; k < 16; ++k) c += (unsigned)__popcll(__ballot(mv[k] >= cand));
                if (lane == 0) wtot[(bit & 1) * 8 + wave] = c;
                __syncthreads();
                unsigned tot = 0u;
#pragma unroll
                for (int w = 0; w < 8; ++w) tot += wtot[(bit & 1) * 8 + w];
                if (tot >= (unsigned)CAP) T = cand; }
            unsigned cgt = 0u;
#pragma unroll
            for (int k = 0; k < 16; ++k) cgt += (unsigned)__popcll(__ballot(mv[k] > T));
            __syncthreads();
            if (lane == 0) wtot[wave] = cgt;
            __syncthreads();
            unsigned ngt = 0u;
#pragma unroll
            for (int w = 0; w < 8; ++w) ngt += wtot[w];
            const unsigned need_eq = (unsigned)CAP - ngt;
            __syncthreads();
            unsigned cg = 0u, ce = 0u;
            for (int k = 0; k < 16; ++k) { const unsigned v = vals[16 * tid + k]; cg += (v > T) ? 1u : 0u; ce += (v == T) ? 1u : 0u; }
            unsigned packed = cg | (ce << 16), incl = packed;
#pragma unroll
            for (int o = 1; o < 64; o <<= 1) { const unsigned n = __shfl_up(incl, o); if (lane >= o) incl += n; }
            if (lane == 63) wtot[wave] = incl;
            __syncthreads();
            unsigned wbase = 0u;
            for (int w = 0; w < wave; ++w) wbase += wtot[w];
            const unsigned excl = wbase + incl - packed;
            unsigned g_before = excl & 0xffffu, e_before = excl >> 16;
            for (int k = 0; k < 16; ++k) { const int t = 16 * tid + k; const unsigned v = vals[t]; int slot = -1;
                if (v > T) { slot = (int)(g_before + (e_before < need_eq ? e_before : need_eq)); ++g_before; }
                else if (v == T) { if (e_before < need_eq) slot = (int)(g_before + e_before); ++e_before; }
                SLOT[((size_t)b * SEQ + t) * 16 + e] = slot;
                if (slot >= 0) { IDX[item * CAP + slot] = t; GSEL[item * CAP + slot] = __builtin_bit_cast(float, v); } }
        }
        __syncthreads();
    }
    SEAM(8);

    if (IN(9)) {
        pg8::SchedFfn1 S{G, vcu, (const char*)HB, (const char*)WGU, IDX, DMODEL, DMODEL};
        pg8::EpiFfn1 E{(unsigned char*)HMID};
        pg8::gemm_phase<true>(lds + RING_OFF, 8, S, E);
    }
    SEAM(9);

    if (IN(10)) {
        pg8::SchedFfn2 S{G, vcu, (const char*)HMID, (const char*)WD, FF, FF};
        pg8::EpiFfn2 E{(unsigned char*)YBUF, GSEL};
        pg8::gemm_phase<true>(lds + RING_OFF, 16, S, E);
    }
    SEAM(10);

    if (IN(11)) {
        PH_IDS();
        f32x4 fgv[4];
#pragma unroll
        for (int j = 0; j < 4; ++j) fgv[j] = *(const f32x4*)(final_g + 4 * lane + 256 * j);
        f32x4 nx[4]; u32x2 ndl[4]; int nsl;
#define P11_LOADX(row_) do { const f32x4* p_ = (const f32x4*)(x + (size_t)(row_) * DMODEL) + lane; const u32x2* d_ = (const u32x2*)(DELTA + (size_t)(row_) * DMODEL) + lane; \
            _Pragma("unroll") for (int j_ = 0; j_ < 4; ++j_) { nx[j_] = __builtin_nontemporal_load(&p_[64 * j_]); ndl[j_] = __builtin_nontemporal_load(&d_[64 * j_]); } \
            nsl = (lane < 16) ? SLOT[(size_t)(row_) * 16 + lane] : -1; } while (0)
#define P11_ISSUE() do { _Pragma("unroll") for (int k_ = 0; k_ < 4; ++k_) { if (mask) { const int e_ = __builtin_ctz(mask); mask &= mask - 1u; const int s_ = __builtin_amdgcn_readlane(sl, e_); \
                const unsigned* yr_ = (const unsigned*)((const unsigned char*)YBUF + ((size_t)(b * 16 + e_) * CAP + s_) * DMODEL) + lane; _Pragma("unroll") for (int j_ = 0; j_ < 4; ++j_) y[k_][j_] = __builtin_nontemporal_load(&yr_[64 * j_]); } \
            else { _Pragma("unroll") for (int j_ = 0; j_ < 4; ++j_) y[k_][j_] = 0u; } } } while (0)
#define P11_ACC() do { _Pragma("unroll") for (int k_ = 0; k_ < 4; ++k_) _Pragma("unroll") for (int j_ = 0; j_ < 4; ++j_) { const unsigned w_ = y[k_][j_]; \
            const auto lo_ = __builtin_amdgcn_cvt_pk_f32_fp8((int)w_, false), hi_ = __builtin_amdgcn_cvt_pk_f32_fp8((int)w_, true); a[j_].x += lo_[0]; a[j_].y += lo_[1]; a[j_].z += hi_[0]; a[j_].w += hi_[1]; } } while (0)
        P11_LOADX(gw);
        for (int m = gw; m < MT; m += NGW) { const int b = m >> 13; const float* g2 = MOD + b * 6144 + 5120;
            f32x4 v[4], a[4], g2v[4]; const int sl = nsl;
#pragma unroll
            for (int j = 0; j < 4; ++j) { const u32x2 dd = ndl[j]; v[j] = nx[j] + (f32x4){bf_lo(dd.x), bf_hi(dd.x), bf_lo(dd.y), bf_hi(dd.y)}; a[j] = (f32x4){0.f, 0.f, 0.f, 0.f}; g2v[j] = *(const f32x4*)(g2 + 4 * lane + 256 * j) * (1.0f / F8_SC_Y); }
            unsigned mask = (unsigned)__ballot(sl >= 0) & 0xFFFFu;
            const int mn = (m + NGW < MT) ? m + NGW : m;
            unsigned y[4][4];
            P11_ISSUE();
            P11_LOADX(mn);
            P11_ACC();
            while (mask) { P11_ISSUE(); P11_ACC(); }
            float s2 = 0.f;
#pragma unroll
            for (int j = 0; j < 4; ++j) { v[j] = v[j] + g2v[j] * a[j]; s2 += (v[j].x * v[j].x + v[j].y * v[j].y) + (v[j].z * v[j].z + v[j].w * v[j].w); }
            const float rinv = __builtin_amdgcn_rsqf(wave_sum(s2) * (1.f / DMODEL) + EPS);
            f32x4* xr = (f32x4*)(out + (size_t)m * DMODEL) + lane;
#pragma unroll
            for (int j = 0; j < 4; ++j) __builtin_nontemporal_store(v[j] * rinv * fgv[j], &xr[64 * j]);
        }
#undef P11_LOADX
#undef P11_ISSUE
#undef P11_ACC
    }
#undef IN
#undef SEAM
}

extern "C" void kernel_launch(void* const* d_in, const int* in_sizes, int n_in, void* d_out, int out_size, void* d_ws, size_t ws_size, hipStream_t stream) {
    static int grid = 0;
    if (grid == 0) {
        if (n_in != 18 || in_sizes[0] != MT * DMODEL || out_size != MT * DMODEL || ws_size < WS_END) {
            fprintf(stderr, "kernel_launch: unexpected shapes / workspace: n_in %d in0 %d out %d ws %zu (need %zu); nothing launched\n", n_in, n_in > 0 ? in_sizes[0] : -1, out_size, ws_size, (size_t)WS_END); grid = -1; return; }
        int dev = 0, cus = 0, per_cu = 0;
        if (hipGetDevice(&dev) != hipSuccess || hipDeviceGetAttribute(&cus, hipDeviceAttributeMultiprocessorCount, dev) != hipSuccess) { grid = -1; return; }
        if (hipFuncSetAttribute((const void*)mk_fwd, hipFuncAttributeMaxDynamicSharedMemorySize, LDS_BYTES) != hipSuccess) { fprintf(stderr, "kernel_launch: hipFuncSetAttribute failed\n"); grid = -1; return; }
        if (hipOccupancyMaxActiveBlocksPerMultiprocessor(&per_cu, (const void*)mk_fwd, 512, LDS_BYTES) != hipSuccess || per_cu < 1) fprintf(stderr, "kernel_launch: occupancy query reports %d\n", per_cu);
        (void)hipGetLastError();
        grid = cus;
        if (grid != 256) fprintf(stderr, "kernel_launch: %d CUs (expected 256)\n", grid);
    }
    if (grid < 0) return;
    if (hipMemsetAsync((char*)d_ws + WS_CTL, 0, CTL_ZERO_BYTES, stream) != hipSuccess) return;
    Args a{};
    for (int i = 0; i < 18; ++i) a.in[i] = (const float*)d_in[i];
    a.out = (float*)d_out; a.ws = (unsigned char*)d_ws;
#ifndef PROBE_DUP
#define PROBE_DUP -1
#endif
    constexpr int NL = (PROBE_DUP >= 0) ? 2 : MK_N_LAUNCHES;
    for (int li = 0; li < NL; ++li) {
        if (PROBE_DUP >= 0) { a.ph_lo = li == 0 ? 0 : PROBE_DUP; a.ph_hi = li == 0 ? PROBE_DUP + 1 : NPHASE; }
        else { a.ph_lo = (NL == NPHASE) ? li : (li * NPHASE) / NL; a.ph_hi = (NL == NPHASE) ? li + 1 : ((li + 1) * NPHASE) / NL; }
        a.li = li; a.pad = 0;
        hipLaunchKernelGGL(mk_fwd, dim3(grid), dim3(512), LDS_BYTES, stream, a);
        const hipError_t le = hipPeekAtLastError();
        if (le != hipSuccess) { fprintf(stderr, "kernel_launch: launch %d failed: %s\n", li, hipGetErrorName(le)); break; }
    }
}
```

```cpp
#include <hip/hip_runtime.h>
#include <hip/hip_bf16.h>
#include <cstdio>
#include <cstdint>

#ifndef MK_N_LAUNCHES
#define MK_N_LAUNCHES 1
#endif

#define LAS __attribute__((address_space(3)))
#define GAS __attribute__((address_space(1)))
typedef unsigned short bf16_t;
typedef short bf16x8 __attribute__((ext_vector_type(8)));
typedef short s16x4 __attribute__((ext_vector_type(4)));
typedef float f32x4 __attribute__((ext_vector_type(4)));
typedef float f32x2 __attribute__((ext_vector_type(2)));
typedef float f32x16 __attribute__((ext_vector_type(16)));
typedef unsigned u32x4 __attribute__((ext_vector_type(4)));
typedef unsigned u32x2 __attribute__((ext_vector_type(2)));
typedef int v8i __attribute__((ext_vector_type(8)));
typedef int v4i __attribute__((ext_vector_type(4)));

constexpr int BATCH = 4, SEQ = 8192, DMODEL = 1024, MT = BATCH * SEQ;
constexpr int NQKV = 2304, NGATE = 2048, NIN = 4352;
constexpr int C_QNA = 0, C_KNA = 512, C_VNA = 1024, C_QG = 1536, C_KG = 2048, C_VG = 2176;
constexpr int NEXP = 16, CAP = 1024, FF = 2048;
constexpr float EPS = 1e-6f;
constexpr float LOG2E = 1.4426950408889634f;
constexpr float C2 = 0.125f * LOG2E;

__device__ __forceinline__ unsigned f2bf(float f) { unsigned u = __builtin_bit_cast(unsigned, f); return (u + 0x7fffu + ((u >> 16) & 1u)) >> 16; }
__device__ __forceinline__ unsigned pk2(float lo, float hi) { return f2bf(lo) | (f2bf(hi) << 16); }
__device__ __forceinline__ float bf_lo(unsigned w) { return __builtin_bit_cast(float, w << 16); }
__device__ __forceinline__ float bf_hi(unsigned w) { return __builtin_bit_cast(float, w & 0xffff0000u); }
__device__ __forceinline__ unsigned cvt_pk_bf16(float lo, float hi) { unsigned r; asm volatile("v_cvt_pk_bf16_f32 %0, %1, %2" : "=v"(r) : "v"(lo), "v"(hi)); return r; }
__device__ __forceinline__ unsigned pk4_fp8(float a, float b, float c, float d) {
    a = __builtin_amdgcn_fmed3f(a, -448.f, 448.f); b = __builtin_amdgcn_fmed3f(b, -448.f, 448.f); c = __builtin_amdgcn_fmed3f(c, -448.f, 448.f); d = __builtin_amdgcn_fmed3f(d, -448.f, 448.f);
    int w = 0; w = __builtin_amdgcn_cvt_pk_fp8_f32(a, b, w, false); w = __builtin_amdgcn_cvt_pk_fp8_f32(c, d, w, true); return (unsigned)w; }
__device__ __forceinline__ unsigned pk4_fp8_nc(float a, float b, float c, float d) { int w = 0; w = __builtin_amdgcn_cvt_pk_fp8_f32(a, b, w, false); w = __builtin_amdgcn_cvt_pk_fp8_f32(c, d, w, true); return (unsigned)w; }
constexpr float F8_SC_H2 = 8.0f, F8_SC_W = 64.0f, F8_SC_HMID = 4.0f, F8_SC_GA = 256.0f, F8_SC_R = 2.0f, F8_SC_Y = 32.0f;
__device__ __forceinline__ float sigmoidf_fast(float v) { return __builtin_amdgcn_rcpf(1.0f + __builtin_amdgcn_exp2f(-v * LOG2E)); }
__device__ __forceinline__ int fresh_tid() { int t = threadIdx.x; asm volatile("" : "+v"(t)); return t; }
template <int CTRL> __device__ __forceinline__ float dppf(float x) { return __builtin_bit_cast(float, __builtin_amdgcn_mov_dpp(__builtin_bit_cast(int, x), CTRL, 0xf, 0xf, true)); }
constexpr int DPP_XOR1 = 0xB1, DPP_XOR2 = 0x4E, DPP_XOR3 = 0x1B, DPP_XOR7 = 0x141, DPP_XOR8 = 0x128;
__device__ __forceinline__ float lane_xor4(float x) { return dppf<DPP_XOR3>(dppf<DPP_XOR7>(x)); }
__device__ __forceinline__ float swap16_sum(float a, float b) { asm("s_nop 1\n\tv_permlane16_swap_b32 %0, %1" : "+v"(a), "+v"(b)); return a + b; }
__device__ __forceinline__ float swap32_sum(float a, float b) { asm("s_nop 1\n\tv_permlane32_swap_b32 %0, %1" : "+v"(a), "+v"(b)); return a + b; }
__device__ __forceinline__ float swap16_max(float a) { float b = a; asm("s_nop 1\n\tv_permlane16_swap_b32 %0, %1" : "+v"(a), "+v"(b)); return fmaxf(a, b); }
__device__ __forceinline__ float swap32_max(float a) { float b = a; asm("s_nop 1\n\tv_permlane32_swap_b32 %0, %1" : "+v"(a), "+v"(b)); return fmaxf(a, b); }
__device__ __forceinline__ float wave_sum(float v) {
    v += dppf<DPP_XOR1>(v); v += dppf<DPP_XOR2>(v); v += lane_xor4(v); v += dppf<DPP_XOR8>(v);
    v = swap16_sum(v, v); return swap32_sum(v, v);
}

__constant__ float INV_FREQ_D[16] = {1.0f, 0.5623413251903491f, 0.31622776601683794f, 0.1778279410038923f, 0.1f, 0.05623413251903491f, 0.03162277660168379f, 0.01778279410038923f,
                                     0.01f, 0.005623413251903491f, 0.0031622776601683794f, 0.001778279410038923f, 0.001f, 0.0005623413251903491f, 0.00031622776601683794f, 0.0001778279410038923f};
namespace pg8 {
constexpr int BM = 256, BK = 64, HALF = 128, HTB = HALF * BK * 2, STAGE_BYTES = 8 * HTB, NXCD = 8, WGM = 8;
__host__ __device__ __forceinline__ int lds_byte(int r, int c) { const int st = (r >> 4) * 2 + (c >> 5), rr = r & 15, cc = c & 31, ob = rr * 64 + cc * 2; return st * 1024 + (ob ^ (((ob >> 9) & 1) << 5)); }
__host__ __device__ __forceinline__ void stage_rc(int b, int& R, int& C) { const int st = b / 1024, sb = b % 1024, swz = sb ^ (((sb >> 9) & 1) << 5); R = (st >> 1) * 16 + swz / 64; C = (st & 1) * 32 + (swz % 64) / 2; }
__host__ __device__ __forceinline__ int perm32(int rho) { const int n = rho >> 4, i = rho & 15; return 8 * (i >> 2) + 4 * n + (i & 3); }

struct Unit { int pm, pn, g; };

struct SchedPlain {
    int nM, nN, nwg, G, c; const char* A; const char* B; unsigned lda, ldb;
    static constexpr bool GATHER = false;
    __device__ void init(int M, int N, int G_, int c_, const void* A_, unsigned lda_, const void* B_, unsigned ldb_) { nM = M / BM; nN = N / BM; nwg = nM * nN; G = G_; c = c_; A = (const char*)A_; B = (const char*)B_; lda = lda_; ldb = ldb_; }
    __device__ bool next(int i, Unit& u) const {
        const long L = (long)i * G + c; if (L >= nwg) return false;
        int wgid = (int)L; { const int q = nwg / NXCD, r = nwg % NXCD, xcd = wgid % NXCD, off = wgid / NXCD; wgid = (xcd < r ? xcd * (q + 1) : r * (q + 1) + (xcd - r) * q) + off; }
        const int nig = WGM * nN, gid = wgid / nig, fm = gid * WGM, gsz = (nM - fm) < WGM ? (nM - fm) : WGM;
        u.pm = fm + ((wgid % nig) % gsz); u.pn = (wgid % nig) / gsz; u.g = 0; return true;
    }
    __device__ __forceinline__ const char* a_ptr(const Unit& u) const { return A + (size_t)u.pm * BM * lda; }
    __device__ __forceinline__ const char* b_ptr(const Unit& u) const { return B + (size_t)u.pn * BM * ldb; }
    __device__ __forceinline__ const int* rows(const Unit&) const { return nullptr; }
    const char* A2 = nullptr; const char* B2 = nullptr; int nt1 = 0;
    __device__ __forceinline__ const char* a_ptr2(const Unit& u) const { return A2 + (size_t)u.pm * BM * lda; }
    __device__ __forceinline__ const char* b_ptr2(const Unit& u) const { return B2 + (size_t)u.pn * BM * ldb; }
};
struct SchedGate {
    int G, c; const char* A; const char* B; unsigned lda, ldb;
    static constexpr bool GATHER = false;
    __device__ bool next(int i, Unit& u) const {
        int id;
        if (G == 256) { if (c < 128) { if (i >= 3) return false; id = c * 3 + i; } else { if (i >= 5) return false; id = 384 + (c - 128) * 5 + i; } }
        else { const long L = (long)i * G + c; if (L >= 1024) return false; id = (int)L; }
        u.pm = id >> 3; u.pn = id & 7; u.g = 0; return true;
    }
    __device__ __forceinline__ const char* a_ptr(const Unit& u) const { return A + (size_t)u.pm * BM * lda; }
    __device__ __forceinline__ const char* b_ptr(const Unit& u) const { return B + (size_t)u.pn * BM * ldb; }
    __device__ __forceinline__ const int* rows(const Unit&) const { return nullptr; }
};
struct SchedFfn1 {
    int G, vcu; const char* A; const char* B; const int* idx; unsigned lda, ldb;
    static constexpr bool GATHER = true;
    __device__ bool next(int i, Unit& u) const {
        const long L = (long)i * G + vcu; if (L >= 4096) return false;
        const int ii = (int)(L >> 8), v = (int)(L & 255), x = v >> 5, c = v & 31;
        const int e = 2 * x + (ii >> 3), b = (ii & 7) >> 1, half = ii & 1;
        u.g = b * 16 + e; u.pm = c & 3; u.pn = half * 8 + (c >> 2); return true;
    }
    __device__ __forceinline__ const char* a_ptr(const Unit& u) const { return A + (size_t)(u.g >> 4) * SEQ * lda; }
    __device__ __forceinline__ const char* b_ptr(const Unit& u) const { return B + ((size_t)(u.g & 15) * 4096 + (size_t)u.pn * BM) * ldb; }
    __device__ __forceinline__ const int* rows(const Unit& u) const { return idx + u.g * CAP + u.pm * BM; }
};
struct SchedFfn2 {
    int G, vcu; const char* A; const char* B; unsigned lda, ldb;
    static constexpr bool GATHER = false;
    __device__ bool next(int i, Unit& u) const {
        const long L = (long)i * G + vcu; if (L >= 1024) return false;
        const int ii = (int)(L >> 8), v = (int)(L & 255), x = v >> 5, c = v & 31;
        const int e = 2 * x + (ii >> 1), b = 2 * (ii & 1) + (c >> 4);
        u.g = b * 16 + e; u.pm = (c & 15) >> 2; u.pn = c & 3; return true;
    }
    __device__ __forceinline__ const char* a_ptr(const Unit& u) const { return A + ((size_t)u.g * CAP + (size_t)u.pm * BM) * lda; }
    __device__ __forceinline__ const char* b_ptr(const Unit& u) const { return B + ((size_t)(u.g & 15) * 1024 + (size_t)u.pn * BM) * ldb; }
    __device__ __forceinline__ const int* rows(const Unit&) const { return nullptr; }
};

typedef f32x4 Acc[2][2][4][2];

struct EpiProj {
    static constexpr bool PERM = true;
    bf16_t* QKV; unsigned char* Q8; unsigned char* K8; unsigned char* V8T; const float* qg; const float* kg; bool gqa_bf16;
    __device__ __forceinline__ void operator()(const Acc& acc, const Unit& u, int wr, int wc, int fr_, int fq_) const { run<false>(acc, u, wr, wc, fr_, fq_); }
    template <bool ASC8> __device__ __forceinline__ void run(const Acc& acc, const Unit& u, int wr, int wc, int fr_, int fq_) const {
        constexpr float asc = ASC8 ? 1.0f / (F8_SC_H2 * F8_SC_W) : 1.0f;
        int fr = fr_, fq = fq_; asm volatile("" : "+v"(fr), "+v"(fq));
        const int row0 = u.pm * BM + wr * 64 + fr;
        if (u.pn < 6) {
            const int col0 = u.pn * BM + wc * 32 + 8 * fq;
            const float sc = ((u.pn < 2) ? 0.125f : 1.0f) * asc;
#pragma unroll
            for (int ai = 0; ai < 2; ++ai)
#pragma unroll
                for (int m = 0; m < 4; ++m) { bf16_t* rowp = QKV + (size_t)(row0 + ai * HALF + m * 16) * NQKV + col0;
#pragma unroll
                    for (int bj = 0; bj < 2; ++bj) { const f32x4 v0 = acc[ai][bj][m][0] * sc, v1 = acc[ai][bj][m][1] * sc;
                        u32x4 w; w.x = cvt_pk_bf16(v0[0], v0[1]); w.y = cvt_pk_bf16(v0[2], v0[3]); w.z = cvt_pk_bf16(v1[0], v1[1]); w.w = cvt_pk_bf16(v1[2], v1[3]);
                        *(u32x4*)(rowp + bj * HALF) = w; } }
            return;
        }
        const int colb = u.pn * BM + wc * 64 + 8 * fq;
        const bool isv = (u.pn == 8) && (wc >= 2), isq = u.pn < 8;
        if (isv) {
            const int kvh = wc - 2;
#pragma unroll
            for (int ai = 0; ai < 2; ++ai)
#pragma unroll
                for (int m = 0; m < 4; ++m) { const int tok = row0 + ai * HALF + m * 16; bf16_t* rowp = QKV + (size_t)tok * NQKV + colb;
                    const int b = tok >> 13, t = tok & (SEQ - 1), kap = t & 63;
                    const int pos = 32 * ((kap >> 2) & 1) + 16 * (kap >> 5) + (kap & 3) + 4 * ((kap & 31) >> 3);
                    unsigned char* vt = V8T + ((size_t)(b * 2 + kvh) * SEQ + (size_t)(t & ~63)) * 64 + (8 * fq) * 64 + pos;
#pragma unroll
                    for (int bj = 0; bj < 2; ++bj) { const f32x4 v0 = acc[ai][bj][m][0] * asc, v1 = acc[ai][bj][m][1] * asc;
                        if (gqa_bf16) { u32x4 w; w.x = cvt_pk_bf16(v0[0], v0[1]); w.y = cvt_pk_bf16(v0[2], v0[3]); w.z = cvt_pk_bf16(v1[0], v1[1]); w.w = cvt_pk_bf16(v1[2], v1[3]);
                            *(u32x4*)(rowp + bj * 32) = w; }
                        const unsigned p0 = pk4_fp8(v0[0] * 8.f, v0[1] * 8.f, v0[2] * 8.f, v0[3] * 8.f), p1 = pk4_fp8(v1[0] * 8.f, v1[1] * 8.f, v1[2] * 8.f, v1[3] * 8.f);
#pragma unroll
                        for (int i = 0; i < 4; ++i) { vt[(32 * bj + i) * 64] = (unsigned char)(p0 >> (8 * i)); vt[(32 * bj + 4 + i) * 64] = (unsigned char)(p1 >> (8 * i)); } } }
            return;
        }
        const float* gp = (isq ? qg : kg) + 8 * fq;
        float frq[2][2];
#pragma unroll
        for (int n = 0; n < 2; ++n)
#pragma unroll
            for (int k = 0; k < 2; ++k) frq[n][k] = INV_FREQ_D[4 * fq + 2 * n + k] * 0.15915494309189535f;
        f32x4 gn[2][2];
#pragma unroll
        for (int bj = 0; bj < 2; ++bj) { gn[bj][0] = *(const f32x4*)(gp + 32 * bj); gn[bj][1] = *(const f32x4*)(gp + 32 * bj + 4); }
        const float osc = isq ? C2 : 1.0f, f8s = isq ? 32.0f : 8.0f;
        const int head = isq ? (u.pn - 6) * 4 + wc : wc;
#pragma unroll
        for (int ai = 0; ai < 2; ++ai)
#pragma unroll
            for (int m = 0; m < 4; ++m) { const int tok = row0 + ai * HALF + m * 16; const int t = tok & (SEQ - 1);
                float ss = 0.f;
#pragma unroll
                for (int bj = 0; bj < 2; ++bj)
#pragma unroll
                    for (int n = 0; n < 2; ++n) { const f32x4 v = acc[ai][bj][m][n]; ss += (v[0] * v[0] + v[1] * v[1]) + (v[2] * v[2] + v[3] * v[3]); }
                ss += __shfl_xor(ss, 16); ss += __shfl_xor(ss, 32);
                const float rinv = asc * __builtin_amdgcn_rsqf(ss * (asc * asc / 64.f) + EPS);
                bf16_t* rowp = QKV + ((unsigned)tok * (unsigned)NQKV + (unsigned)colb);
#pragma unroll
                for (int bj = 0; bj < 2; ++bj) { const float pos = (float)(bj == 0 ? (t >> 6) : (t & 63));
                    float ov[8];
#pragma unroll
                    for (int n = 0; n < 2; ++n)
#pragma unroll
                        for (int k = 0; k < 2; ++k) { float rev = pos * frq[n][k]; rev = rev - floorf(rev);
                            const float sn = __builtin_amdgcn_sinf(rev), cs = __builtin_amdgcn_cosf(rev);
                            const float y0 = acc[ai][bj][m][n][2 * k] * rinv * gn[bj][n][2 * k], y1 = acc[ai][bj][m][n][2 * k + 1] * rinv * gn[bj][n][2 * k + 1];
                            ov[4 * n + 2 * k] = (y0 * cs - y1 * sn) * osc; ov[4 * n + 2 * k + 1] = (y0 * sn + y1 * cs) * osc; }
                    if (gqa_bf16) { u32x4 w; w.x = cvt_pk_bf16(ov[0], ov[1]); w.y = cvt_pk_bf16(ov[2], ov[3]); w.z = cvt_pk_bf16(ov[4], ov[5]); w.w = cvt_pk_bf16(ov[6], ov[7]);
                        *(u32x4*)(rowp + bj * 32) = w; }
                    u32x2 f8; f8.x = pk4_fp8(ov[0] * f8s, ov[1] * f8s, ov[2] * f8s, ov[3] * f8s); f8.y = pk4_fp8(ov[4] * f8s, ov[5] * f8s, ov[6] * f8s, ov[7] * f8s);
                    if (isq) *(u32x2*)(Q8 + ((unsigned)tok * 512u + (unsigned)(head * 64 + 32 * bj + 8 * fq))) = f8;
                    else     *(u32x2*)(K8 + ((unsigned)tok * 128u + (unsigned)(head * 64 + 32 * bj + 8 * fq))) = f8; }
                __builtin_amdgcn_sched_barrier(0); }
    }
};
struct EpiGate {
    static constexpr bool PERM = true;
    bf16_t* GA; unsigned char* R8;
    __device__ __forceinline__ void operator()(const Acc& acc, const Unit& u, int wr, int wc, int fr, int fq) const {
        const size_t row0 = (size_t)u.pm * BM + wr * 64 + fr; const int col0 = u.pn * HALF + wc * 32 + 8 * fq;
        constexpr float inv = -LOG2E / (F8_SC_H2 * F8_SC_W);
#pragma unroll
        for (int ai = 0; ai < 2; ++ai)
#pragma unroll
            for (int m = 0; m < 4; ++m) { const size_t off = (row0 + ai * HALF + m * 16) * DMODEL + col0;
                float ga[8], rr[8];
#pragma unroll
                for (int n = 0; n < 2; ++n)
#pragma unroll
                    for (int i = 0; i < 4; ++i) { const float ea = 1.0f + __builtin_amdgcn_exp2f(acc[ai][0][m][n][i] * inv), eb = 1.0f + __builtin_amdgcn_exp2f(acc[ai][1][m][n][i] * inv);
                        ga[n * 4 + i] = __builtin_amdgcn_rcpf(ea); rr[n * 4 + i] = ea * __builtin_amdgcn_rcpf(eb) * F8_SC_R; }
                u32x4 w; w.x = cvt_pk_bf16(ga[0], ga[1]); w.y = cvt_pk_bf16(ga[2], ga[3]); w.z = cvt_pk_bf16(ga[4], ga[5]); w.w = cvt_pk_bf16(ga[6], ga[7]); *(u32x4*)(GA + off) = w;
                u32x2 q; q.x = pk4_fp8(rr[0], rr[1], rr[2], rr[3]); q.y = pk4_fp8(rr[4], rr[5], rr[6], rr[7]); *(u32x2*)(R8 + off) = q; }
    }
};
struct EpiHeadGate {
    static constexpr bool PERM = true;
    EpiProj P; EpiGate Gt;
    __device__ __forceinline__ void operator()(const Acc& acc, const Unit& u, int wr, int wc, int fr, int fq) const {
        Unit v = u;
        if (u.pn < 9) { P.run<true>(acc, v, wr, wc, fr, fq); }
        else { v.pn = u.pn - 9; Gt(acc, v, wr, wc, fr, fq); }
    }
};
struct EpiMerge {
    static constexpr bool PERM = true;
    bf16_t* MERGED; const bf16_t* GA; const unsigned char* R8;
    __device__ __forceinline__ void mid(Acc& acc, const Unit& u, int wr, int wc, int fr, int fq) const {
        const int row0 = u.pm * BM + wr * 64 + fr, col0 = u.pn * BM + wc * 32 + 8 * fq;
        u32x2 rq[2][4][2];
#pragma unroll
        for (int ai = 0; ai < 2; ++ai)
#pragma unroll
            for (int m = 0; m < 4; ++m)
#pragma unroll
                for (int bj = 0; bj < 2; ++bj) rq[ai][m][bj] = *(const u32x2*)(R8 + (size_t)(row0 + ai * HALF + m * 16) * DMODEL + col0 + bj * HALF);
        asm volatile("" ::: "memory");
#pragma unroll
        for (int ai = 0; ai < 2; ++ai)
#pragma unroll
            for (int m = 0; m < 4; ++m) {
#pragma unroll
                for (int bj = 0; bj < 2; ++bj) { const u32x2 q = rq[ai][m][bj];
                    const auto a = __builtin_amdgcn_cvt_pk_f32_fp8((int)q.x, false), b = __builtin_amdgcn_cvt_pk_f32_fp8((int)q.x, true), c = __builtin_amdgcn_cvt_pk_f32_fp8((int)q.y, false), d = __builtin_amdgcn_cvt_pk_f32_fp8((int)q.y, true);
                    constexpr float k = 1.0f / F8_SC_R;
                    acc[ai][bj][m][0][0] *= a[0] * k; acc[ai][bj][m][0][1] *= a[1] * k; acc[ai][bj][m][0][2] *= b[0] * k; acc[ai][bj][m][0][3] *= b[1] * k;
                    acc[ai][bj][m][1][0] *= c[0] * k; acc[ai][bj][m][1][1] *= c[1] * k; acc[ai][bj][m][1][2] *= d[0] * k; acc[ai][bj][m][1][3] *= d[1] * k; } }
    }
    __device__ __forceinline__ void operator()(const Acc& acc, const Unit& u, int wr, int wc, int fr, int fq) const {
        const int row0 = u.pm * BM + wr * 64 + fr, col0 = u.pn * BM + wc * 32 + 8 * fq;
        u32x4 gq[2][4][2];
#pragma unroll
        for (int ai = 0; ai < 2; ++ai)
#pragma unroll
            for (int m = 0; m < 4; ++m)
#pragma unroll
                for (int bj = 0; bj < 2; ++bj) gq[ai][m][bj] = *(const u32x4*)(GA + (size_t)(row0 + ai * HALF + m * 16) * DMODEL + col0 + bj * HALF);
        asm volatile("" ::: "memory");
#pragma unroll
        for (int ai = 0; ai < 2; ++ai)
#pragma unroll
            for (int m = 0; m < 4; ++m) { const size_t r = (size_t)(row0 + ai * HALF + m * 16);
#pragma unroll
                for (int bj = 0; bj < 2; ++bj) { const u32x4 g = gq[ai][m][bj];
                    const f32x4 v0 = acc[ai][bj][m][0], v1 = acc[ai][bj][m][1];
                    u32x4 w; w.x = cvt_pk_bf16(bf_lo(g.x) * v0[0], bf_hi(g.x) * v0[1]); w.y = cvt_pk_bf16(bf_lo(g.y) * v0[2], bf_hi(g.y) * v0[3]);
                    w.z = cvt_pk_bf16(bf_lo(g.z) * v1[0], bf_hi(g.z) * v1[1]); w.w = cvt_pk_bf16(bf_lo(g.w) * v1[2], bf_hi(g.w) * v1[3]);
                    *(u32x4*)(MERGED + r * DMODEL + col0 + bj * HALF) = w; } }
    }
};
struct EpiOut {
    static constexpr bool PERM = false;
    const float* x; float* out; const float* mod;
    __device__ __forceinline__ void operator()(const Acc& acc, const Unit& u, int wr, int wc, int fr, int fq) const {
        const int row0 = u.pm * BM + wr * 64 + fr, col0 = u.pn * BM + wc * 32 + 4 * fq;
        const float* g1 = mod + (size_t)(u.pm >> 5) * 6144 + 2048;
        f32x4 gv[2][2];
#pragma unroll
        for (int bj = 0; bj < 2; ++bj)
#pragma unroll
            for (int n = 0; n < 2; ++n) gv[bj][n] = *(const f32x4*)(g1 + col0 + bj * HALF + n * 16);
#pragma unroll
        for (int ai = 0; ai < 2; ++ai)
#pragma unroll
            for (int m = 0; m < 4; ++m) { const size_t off = (size_t)(row0 + ai * HALF + m * 16) * DMODEL + col0;
#pragma unroll
                for (int bj = 0; bj < 2; ++bj)
#pragma unroll
                    for (int n = 0; n < 2; ++n) { const f32x4 xv = __builtin_nontemporal_load((const f32x4*)(x + off + bj * HALF + n * 16)); *(f32x4*)(out + off + bj * HALF + n * 16) = xv + gv[bj][n] * acc[ai][bj][m][n]; } }
    }
};
struct EpiDelta {
    static constexpr bool PERM = true;
    bf16_t* DELTA; const float* mod;
    __device__ __forceinline__ void operator()(const Acc& acc, const Unit& u, int wr, int wc, int fr, int fq) const {
        const unsigned row0 = u.pm * BM + wr * 64 + fr, col0 = u.pn * BM + wc * 32 + 8 * fq;
        const float* g1 = mod + (size_t)(u.pm >> 5) * 6144 + 2048 + col0;
        f32x4 gv[2][2];
#pragma unroll
        for (int bj = 0; bj < 2; ++bj)
#pragma unroll
            for (int n = 0; n < 2; ++n) gv[bj][n] = *(const f32x4*)(g1 + bj * HALF + n * 4);
#pragma unroll
        for (int ai = 0; ai < 2; ++ai)
#pragma unroll
            for (int m = 0; m < 4; ++m) { bf16_t* rowp = DELTA + ((row0 + ai * HALF + m * 16) * (unsigned)DMODEL + col0);
#pragma unroll
                for (int bj = 0; bj < 2; ++bj) { const f32x4 v0 = acc[ai][bj][m][0] * gv[bj][0], v1 = acc[ai][bj][m][1] * gv[bj][1];
                    u32x4 w; w.x = cvt_pk_bf16(v0[0], v0[1]); w.y = cvt_pk_bf16(v0[2], v0[3]); w.z = cvt_pk_bf16(v1[0], v1[1]); w.w = cvt_pk_bf16(v1[2], v1[3]);
                    *(u32x4*)(rowp + bj * HALF) = w; } }
    }
};
struct EpiFfn1 {
    static constexpr bool PERM = true;
    unsigned char* HMID;
    __device__ __forceinline__ void operator()(const Acc& acc, const Unit& u, int wr, int wc, int fr, int fq) const {
        const size_t row0 = (size_t)u.g * CAP + u.pm * BM + wr * 64 + fr; const int col0 = u.pn * HALF + wc * 32 + 8 * fq;
        constexpr float inv = 1.0f / (F8_SC_H2 * F8_SC_W);
        constexpr float RC = 1.0f / (inv * inv * F8_SC_HMID);
        static_assert(RC == 65536.0f, "LOG2_RC below assumes 2^16");
        constexpr float LOG2_RC = 16.0f;
#pragma unroll
        for (int ai = 0; ai < 2; ++ai)
#pragma unroll
            for (int m = 0; m < 4; ++m) { unsigned char* rowp = HMID + (row0 + ai * HALF + m * 16) * FF + col0;
                float o[8];
#pragma unroll
                for (int n = 0; n < 2; ++n)
#pragma unroll
                    for (int i = 0; i < 4; i += 2) {
                        const f32x2 ag = {acc[ai][0][m][n][i], acc[ai][0][m][n][i + 1]}, au = {acc[ai][1][m][n][i], acc[ai][1][m][n][i + 1]};
                        const f32x2 e = ag * (-inv * LOG2E) + LOG2_RC;
                        f32x2 t; t.x = __builtin_amdgcn_exp2f(e.x); t.y = __builtin_amdgcn_exp2f(e.y);
                        t = t + RC;
                        f32x2 r; r.x = __builtin_amdgcn_rcpf(t.x); r.y = __builtin_amdgcn_rcpf(t.y);
                        const f32x2 q = (ag * au) * r;
                        o[n * 4 + i] = q.x; o[n * 4 + i + 1] = q.y; }
                u32x2 w; w.x = pk4_fp8(o[0], o[1], o[2], o[3]); w.y = pk4_fp8(o[4], o[5], o[6], o[7]);
                *(u32x2*)rowp = w; }
    }
};
struct EpiFfn2 {
    static constexpr bool PERM = true;
    unsigned char* YB8; const float* gsel;
    __device__ __forceinline__ void operator()(const Acc& acc, const Unit& u, int wr, int wc, int fr, int fq) const {
        const unsigned row0 = (unsigned)u.g * CAP + u.pm * BM + wr * 64 + fr; const unsigned col0 = u.pn * BM + wc * 32 + 8 * fq;
        float gsv[2][4];
#pragma unroll
        for (int ai = 0; ai < 2; ++ai)
#pragma unroll
            for (int m = 0; m < 4; ++m) gsv[ai][m] = gsel[row0 + ai * HALF + m * 16];
        asm volatile("" ::: "memory");
#pragma unroll
        for (int ai = 0; ai < 2; ++ai)
#pragma unroll
            for (int m = 0; m < 4; ++m) { const unsigned r = row0 + ai * HALF + m * 16; const float gs = gsv[ai][m] * (F8_SC_Y / (F8_SC_HMID * F8_SC_W)); unsigned char* rowp = YB8 + (r * (unsigned)DMODEL + col0);
#pragma unroll
                for (int bj = 0; bj < 2; ++bj) { const f32x4 v0 = acc[ai][bj][m][0] * gs, v1 = acc[ai][bj][m][1] * gs;
                    u32x2 w; w.x = pk4_fp8(v0[0], v0[1], v0[2], v0[3]); w.y = pk4_fp8(v1[0], v1[1], v1[2], v1[3]);
                    *(u32x2*)(rowp + bj * HALF) = w; } }
    }
};

template <bool F8> __device__ __forceinline__ f32x4 mma_step(bf16x8 b0, bf16x8 b1, bf16x8 a0, bf16x8 a1, f32x4 c) {
    if constexpr (F8) {
        const v8i b = __builtin_shufflevector(__builtin_bit_cast(v4i, b0), __builtin_bit_cast(v4i, b1), 0, 1, 2, 3, 4, 5, 6, 7);
        const v8i a = __builtin_shufflevector(__builtin_bit_cast(v4i, a0), __builtin_bit_cast(v4i, a1), 0, 1, 2, 3, 4, 5, 6, 7);
        asm volatile("v_mfma_f32_16x16x128_f8f6f4 %0, %1, %2, %0" : "+v"(c) : "v"(b), "v"(a));
        return c;
    } else {
        c = __builtin_amdgcn_mfma_f32_16x16x32_bf16(b0, a0, c, 0, 0, 0);
        return __builtin_amdgcn_mfma_f32_16x16x32_bf16(b1, a1, c, 0, 0, 0);
    }
}
__device__ __forceinline__ const char* uni_ptr(const char* p) {
    const unsigned long long v = (unsigned long long)p; const unsigned lo = __builtin_amdgcn_readfirstlane((unsigned)v), hi = __builtin_amdgcn_readfirstlane((unsigned)(v >> 32));
    return (const char*)(((unsigned long long)hi << 32) | lo); }
template <bool F8, class Epi, class Sched, bool SEG2 = false>
__device__ __forceinline__ void gemm_phase(LAS unsigned char* lds, const int nt, const Sched& S, const Epi& E) {
    const int tid = fresh_tid(), wid = __builtin_amdgcn_readfirstlane(tid >> 6), lane = tid & 63, wr = wid >> 2, wc = wid & 3, fr = lane & 15, fq = lane >> 4;
    constexpr bool GA = Sched::GATHER;
    int Rr[2], Cc[2];
#pragma unroll
    for (int i = 0; i < 2; ++i) stage_rc(tid * 16 + i * 8192, Rr[i], Cc[i]);
    unsigned voffB[2];
#pragma unroll
    for (int i = 0; i < 2; ++i) { const int Rb = Epi::PERM ? ((Rr[i] & ~31) + perm32(Rr[i] & 31)) : Rr[i]; voffB[i] = (unsigned)Rb * S.ldb + (unsigned)Cc[i] * 2u; }
    const size_t kstep = (size_t)(BK * 2);
    const size_t hstepB = (size_t)HALF * S.ldb;
    const size_t hstepA = GA ? (size_t)0 : (size_t)HALF * S.lda;
    const unsigned ldsw = (unsigned)wid * 1024u;
    const int aoff = lds_byte(wr * 64 + fr, fq * 8), boff = lds_byte(wc * 32 + fr, fq * 8);
#define PG8_SA(b, h) (((b) * 2 + (h)) * HTB)
#define PG8_SB(b, h) ((4 + (b) * 2 + (h)) * HTB)
#define PG8_STAGE(bufoff, gbase, voff) do { _Pragma("unroll") for (int _i = 0; _i < 2; ++_i) \
        __builtin_amdgcn_global_load_lds((GAS const unsigned*)((GAS const char*)(gbase) + (voff)[_i]), (LAS unsigned*)(lds + (bufoff) + ldsw + _i * 8192), 16, 0, 0); } while (0)
#define PG8_LDA(dst, b, h) do { _Pragma("unroll") for (int m = 0; m < 4; ++m) _Pragma("unroll") for (int k = 0; k < 2; ++k) dst[m][k] = *(const LAS bf16x8*)(lds + PG8_SA(b, h) + aoff + m * 2048 + k * 1024); } while (0)
#define PG8_LDB(dst, b, h) do { _Pragma("unroll") for (int n = 0; n < 2; ++n) _Pragma("unroll") for (int k = 0; k < 2; ++k) dst[n][k] = *(const LAS bf16x8*)(lds + PG8_SB(b, h) + boff + n * 2048 + k * 1024); } while (0)
#define PG8_MMA(ai, bj, At, Bt) do { __builtin_amdgcn_s_setprio(1); _Pragma("unroll") for (int m = 0; m < 4; ++m) _Pragma("unroll") for (int n = 0; n < 2; ++n) \
        acc[ai][bj][m][n] = mma_step<F8>(Bt[n][0], Bt[n][1], At[m][0], At[m][1], acc[ai][bj][m][n]); __builtin_amdgcn_s_setprio(0); } while (0)
#define PG8_WAIT_V(n) asm volatile("s_waitcnt vmcnt(" #n ")" ::: "memory")
#define PG8_WAIT_L(n) asm volatile("s_waitcnt lgkmcnt(" #n ")" ::: "memory")
#define PG8_BAR __builtin_amdgcn_s_barrier()
#define PG8_SCHED __builtin_amdgcn_sched_barrier(0)
#define PG8_ROWOFFS(dst, u_) do { if constexpr (GA) { const int* _rw = S.rows(u_); _Pragma("unroll") for (int _h = 0; _h < 2; ++_h) _Pragma("unroll") for (int _i = 0; _i < 2; ++_i) \
        dst[_h][_i] = (unsigned)_rw[_h * HALF + Rr[_i]] * S.lda + (unsigned)Cc[_i] * 2u; } } while (0)
    Unit cur, nxt; int ui = 0;
    if (!S.next(0, cur)) return;
    f32x4 acc[2][2][4][2];
#pragma unroll
    for (int a = 0; a < 2; ++a)
#pragma unroll
        for (int b = 0; b < 2; ++b)
#pragma unroll
            for (int m = 0; m < 4; ++m)
#pragma unroll
                for (int n = 0; n < 2; ++n) acc[a][b][m][n] = (f32x4){0.f, 0.f, 0.f, 0.f};
    bf16x8 At[4][2], B0[2][2], B1[2][2];
    unsigned voffP[2];
#pragma unroll
    for (int i = 0; i < 2; ++i) voffP[i] = (unsigned)Rr[i] * S.lda + (unsigned)Cc[i] * 2u;
    unsigned voffA[2][2], voffAn[2][2];
    PG8_ROWOFFS(voffA, cur);
#define PG8_VA(h) (GA ? voffA[h] : voffP)
#define PG8_VA2(h) (GA ? va2[h] : voffP)
    const char* cA = uni_ptr(S.a_ptr(cur)); const char* cB = uni_ptr(S.b_ptr(cur));
    const char* cA2 = cA; const char* cB2 = cB; int nt1 = nt;
    if constexpr (SEG2) { cA2 = uni_ptr(S.a_ptr2(cur)); cB2 = uni_ptr(S.b_ptr2(cur)); nt1 = S.nt1; }
#define PG8_KA(tau) ((!SEG2 || (tau) < nt1) ? cA + (size_t)(tau) * kstep : cA2 + (size_t)((tau) - nt1) * kstep)
#define PG8_KB(tau) ((!SEG2 || (tau) < nt1) ? cB + (size_t)(tau) * kstep : cB2 + (size_t)((tau) - nt1) * kstep)
    PG8_STAGE(PG8_SB(0, 0), cB, voffB); PG8_STAGE(PG8_SB(0, 1), cB + hstepB, voffB); PG8_STAGE(PG8_SA(0, 0), cA, PG8_VA(0)); PG8_STAGE(PG8_SA(0, 1), cA + hstepA, PG8_VA(1));
    if (wr == 1) PG8_BAR;
    PG8_WAIT_V(2); PG8_BAR;
    PG8_STAGE(PG8_SB(1, 0), cB + kstep, voffB); PG8_STAGE(PG8_SA(1, 0), cA + kstep, PG8_VA(0)); PG8_STAGE(PG8_SB(1, 1), cB + hstepB + kstep, voffB);
    PG8_WAIT_V(6); PG8_BAR;
    for (;;) {
        const bool has_next = S.next(ui + 1, nxt);
        const char* nA = has_next ? uni_ptr(S.a_ptr(nxt)) : cA; const char* nB = has_next ? uni_ptr(S.b_ptr(nxt)) : cB;
        if constexpr (GA) {
            if (has_next) { PG8_ROWOFFS(voffAn, nxt); } else {
#pragma unroll
                for (int h = 0; h < 2; ++h)
#pragma unroll
                    for (int i = 0; i < 2; ++i) voffAn[h][i] = voffA[h][i]; } }
        for (int t = 0; t < nt; t += 2) {
            const bool last = (t == nt - 2);
            const char* a1 = PG8_KA(t + 1);
            const char* a2 = last ? nA : PG8_KA(t + 2); const char* b2 = last ? nB : PG8_KB(t + 2);
            const char* a3 = a2 + kstep; const char* b3 = b2 + kstep;
            unsigned va2[2][2];
            if constexpr (GA) {
#pragma unroll
                for (int h = 0; h < 2; ++h)
#pragma unroll
                    for (int i = 0; i < 2; ++i) va2[h][i] = last ? voffAn[h][i] : voffA[h][i]; }
            PG8_LDB(B0, 0, 0); PG8_LDB(B1, 0, 1); PG8_SCHED; PG8_LDA(At, 0, 0); PG8_STAGE(PG8_SA(1, 1), a1 + hstepA, PG8_VA(1));
            PG8_WAIT_V(8); PG8_WAIT_L(0); PG8_BAR; PG8_MMA(0, 0, At, B0); PG8_MMA(0, 1, At, B1); PG8_BAR; PG8_SCHED;
            PG8_LDA(At, 0, 1); PG8_STAGE(PG8_SB(0, 0), b2, voffB); PG8_STAGE(PG8_SB(0, 1), b2 + hstepB, voffB); PG8_STAGE(PG8_SA(0, 0), a2, PG8_VA2(0));
            PG8_WAIT_V(8); PG8_WAIT_L(0); PG8_BAR; PG8_MMA(1, 0, At, B0); PG8_MMA(1, 1, At, B1); PG8_BAR; PG8_SCHED;
            PG8_LDB(B0, 1, 0); PG8_LDB(B1, 1, 1); PG8_SCHED; PG8_LDA(At, 1, 0); PG8_STAGE(PG8_SA(0, 1), a2 + hstepA, PG8_VA2(1));
            PG8_WAIT_V(8); PG8_WAIT_L(0); PG8_BAR; PG8_MMA(0, 0, At, B0); PG8_MMA(0, 1, At, B1); PG8_BAR; PG8_SCHED;
            PG8_LDA(At, 1, 1); PG8_STAGE(PG8_SB(1, 0), b3, voffB); PG8_STAGE(PG8_SB(1, 1), b3 + hstepB, voffB); PG8_STAGE(PG8_SA(1, 0), a3, PG8_VA2(0));
            PG8_WAIT_V(8); PG8_WAIT_L(0); PG8_BAR; PG8_MMA(1, 0, At, B0); PG8_MMA(1, 1, At, B1); PG8_BAR; PG8_SCHED;
            if constexpr (SEG2) { if (t + 2 == nt1) { E.mid(acc, cur, wr, wc, fr, fq); PG8_SCHED; } }
        }
        if (wr == 0) PG8_BAR;
        if constexpr (F8) asm volatile("s_nop 15\n\ts_nop 3" ::: "memory");
        E(acc, cur, wr, wc, fr, fq);
        if (!has_next) break;
#pragma unroll
        for (int a = 0; a < 2; ++a)
#pragma unroll
            for (int b = 0; b < 2; ++b)
#pragma unroll
                for (int m = 0; m < 4; ++m)
#pragma unroll
                    for (int n = 0; n < 2; ++n) acc[a][b][m][n] = (f32x4){0.f, 0.f, 0.f, 0.f};
        cur = nxt; cA = nA; cB = nB; ++ui;
        if constexpr (SEG2) { cA2 = uni_ptr(S.a_ptr2(cur)); cB2 = uni_ptr(S.b_ptr2(cur)); }
        if constexpr (GA) {
#pragma unroll
            for (int h = 0; h < 2; ++h)
#pragma unroll
                for (int i = 0; i < 2; ++i) voffA[h][i] = voffAn[h][i]; }
        if (wr == 1) PG8_BAR;
    }
    PG8_WAIT_V(0);
    PG8_BAR;
#undef PG8_SA
#undef PG8_SB
#undef PG8_STAGE
#undef PG8_LDA
#undef PG8_LDB
#undef PG8_MMA
#undef PG8_WAIT_V
#undef PG8_WAIT_L
#undef PG8_BAR
#undef PG8_SCHED
#undef PG8_ROWOFFS
#undef PG8_VA
#undef PG8_VA2
#undef PG8_KA
#undef PG8_KB
}
}

namespace attn_body {
using bf16 = __hip_bfloat16;
constexpr int D = 64, QP = NQKV, KP = NQKV, OP = DMODEL;
constexpr int NW = 8, QBLK = 32, QB = QBLK * NW, KVBLK = 64;
__device__ __forceinline__ int crow(int r, int hi) { return (r & 3) + 8 * (r >> 2) + 4 * hi; }
#define SBAR() __builtin_amdgcn_sched_barrier(0)
constexpr int NSLOT = 3, SLOTB = 8192;
constexpr int LDS_K = 0, LDS_V = NSLOT * SLOTB, LDS_WS = 2 * NSLOT * SLOTB, LDS_OST = LDS_WS + NW * 64 * 4, LDS_BYTES = LDS_OST + NW * 4096;
__device__ __forceinline__ void glds16(const void* gsrc, unsigned lds_dst) { unsigned keep;
    asm volatile("s_mov_b32 %0, m0\n\ts_mov_b32 m0, %2\n\ts_nop 0\n\tglobal_load_lds_dwordx4 %1, off\n\ts_mov_b32 m0, %0" : "=&s"(keep) : "v"(gsrc), "s"(lds_dst) : "memory"); }
__device__ __forceinline__ float max3f(float a, float b, float c) { float r; asm("v_max3_f32 %0, %1, %2, %3" : "=v"(r) : "v"(a), "v"(b), "v"(c)); return r; }
__device__ __forceinline__ float max2f(float a, float b) { float r; asm("v_max_f32_e32 %0, %1, %2" : "=v"(r) : "v"(a), "v"(b)); return r; }
__device__ __forceinline__ float fadd_s(float a, float b) { float r; asm("v_add_f32_e32 %0, %1, %2" : "=v"(r) : "v"(a), "v"(b)); return r; }
__device__ __forceinline__ float fsub_s(float a, float b) { float r; asm("v_sub_f32_e32 %0, %1, %2" : "=v"(r) : "v"(a), "v"(b)); return r; }
typedef float f32x2_t __attribute__((ext_vector_type(2))); typedef __bf16 bf16x2_t __attribute__((ext_vector_type(2)));
__device__ __forceinline__ unsigned cvtpk_s(float lo, float hi) { f32x2_t v = {lo, hi}; bf16x2_t b = __builtin_convertvector(v, bf16x2_t); return __builtin_bit_cast(unsigned, b); }
#define WAIT_BAR(N) asm volatile("s_waitcnt vmcnt(" #N ") lgkmcnt(0)\n\ts_barrier" ::: "memory")

__device__ __forceinline__ void qkt(f32x16& p0, f32x16& p1, const char* Kslot, const bf16x8* qr, const f32x16& negm, int r32, int hi) {
    const char* kb = Kslot + hi * 1024 + r32 * 16;
#pragma unroll
    for (int d0 = 0; d0 < 4; ++d0) {
        const bf16x8 b0 = *reinterpret_cast<const bf16x8*>(kb + d0 * 2048);
        const bf16x8 b1 = *reinterpret_cast<const bf16x8*>(kb + d0 * 2048 + 512);
        if (d0 == 0) { p0 = __builtin_amdgcn_mfma_f32_32x32x16_bf16(b0, qr[0], negm, 0, 0, 0); p1 = __builtin_amdgcn_mfma_f32_32x32x16_bf16(b1, qr[0], negm, 0, 0, 0); }
        else { p0 = __builtin_amdgcn_mfma_f32_32x32x16_bf16(b0, qr[d0], p0, 0, 0, 0); p1 = __builtin_amdgcn_mfma_f32_32x32x16_bf16(b1, qr[d0], p1, 0, 0, 0); } }
}
typedef LAS const char* lds_cptr;
typedef short v4i16_t __attribute__((ext_vector_type(4)));
__device__ __forceinline__ void kload8(bf16x8* kf, lds_cptr kp) {
    kf[0] = *(const LAS bf16x8*)(kp);        kf[1] = *(const LAS bf16x8*)(kp + 512);
    kf[2] = *(const LAS bf16x8*)(kp + 2048); kf[3] = *(const LAS bf16x8*)(kp + 2560);
    kf[4] = *(const LAS bf16x8*)(kp + 4096); kf[5] = *(const LAS bf16x8*)(kp + 4608);
    kf[6] = *(const LAS bf16x8*)(kp + 6144); kf[7] = *(const LAS bf16x8*)(kp + 6656);
}
__device__ __forceinline__ void kload2(bf16x8* kf, lds_cptr kp, int j) { kf[2 * j] = *(const LAS bf16x8*)(kp + j * 2048); kf[2 * j + 1] = *(const LAS bf16x8*)(kp + j * 2048 + 512); }
__device__ __forceinline__ s16x4 vtr(lds_cptr p) { return __builtin_bit_cast(s16x4, __builtin_amdgcn_ds_read_tr16_b64_v4i16((LAS v4i16_t*)p)); }
__device__ __forceinline__ float rowmax(const f32x16& p0, const f32x16& p1) {
    float a = max3f(p0[0], p0[1], p1[0]), b = max3f(p0[2], p0[3], p1[1]); a = max3f(a, p1[2], p1[3]);
#pragma unroll
    for (int r = 4; r < 16; r += 4) { a = max3f(a, p0[r], p0[r + 1]); b = max3f(b, p0[r + 2], p0[r + 3]); a = max3f(a, p1[r], p1[r + 1]); b = max3f(b, p1[r + 2], p1[r + 3]); }
    const float m = max2f(a, b);
    auto rr = __builtin_amdgcn_permlane32_swap(__float_as_uint(m), __float_as_uint(m), false, false);
    return max2f(__uint_as_float(rr[0]), __uint_as_float(rr[1]));
}
__device__ __forceinline__ void pv(f32x16* o, int vb, bf16x8 pa0, bf16x8 pa1, bf16x8 pa2, bf16x8 pa3) {
#pragma unroll
    for (int d0 = 0; d0 < 2; ++d0) { s16x4 lo[4], hi[4];
#pragma unroll
        for (int ks = 0; ks < 4; ++ks) {
            asm volatile("ds_read_b64_tr_b16 %0,%1 offset:%c2" : "=&v"(lo[ks]) : "v"(vb), "i"(d0 * 4096 + ks * 1024) : "memory");
            asm volatile("ds_read_b64_tr_b16 %0,%1 offset:%c2" : "=&v"(hi[ks]) : "v"(vb), "i"(d0 * 4096 + ks * 1024 + 512) : "memory"); }
        asm volatile("s_waitcnt lgkmcnt(0)" ::: "memory"); SBAR();
#define PK(k) (bf16x8){lo[k][0], lo[k][1], lo[k][2], lo[k][3], hi[k][0], hi[k][1], hi[k][2], hi[k][3]}
        o[d0] = __builtin_amdgcn_mfma_f32_32x32x16_bf16(pa0, PK(0), o[d0], 0, 0, 0);
        o[d0] = __builtin_amdgcn_mfma_f32_32x32x16_bf16(pa1, PK(1), o[d0], 0, 0, 0);
        o[d0] = __builtin_amdgcn_mfma_f32_32x32x16_bf16(pa2, PK(2), o[d0], 0, 0, 0);
        o[d0] = __builtin_amdgcn_mfma_f32_32x32x16_bf16(pa3, PK(3), o[d0], 0, 0, 0);
#undef PK
    }
}
#define ATTN_STORE16(p, v) (*(u32x4*)(p) = (v))
template <int THRL> __device__ __forceinline__ void attn_unit(int qb, const bf16* Qh, const bf16* __restrict__ Kh, const bf16* __restrict__ Vh, bf16* Oh, char* shm) {
    const int tid = fresh_tid(), lane = tid & 63, r32 = lane & 31, hi = lane >> 5; const int wid = __builtin_amdgcn_readfirstlane(tid >> 6);
    const int q0 = qb * QB;
    const bf16* Qw = Qh + (long)(q0 + wid * QBLK) * QP;
    const unsigned lds0 = (unsigned)(uintptr_t)shm;
    float* wsf = (float*)(shm + LDS_WS) + wid * 64;
    const bf16* ksrc = Kh + (long)lane * KP + wid * 8;
    const bf16* vsrc = Vh + (long)(16 * (wid & 3) + (lane >> 2)) * KP + (wid >> 2) * 32 + (lane & 3) * 8;
    const unsigned kdst = lds0 + LDS_K + wid * 1024, vdst = lds0 + LDS_V + wid * 1024;
#define DMA_K(t, slot) glds16(ksrc + (long)(t) * KVBLK * KP, (unsigned)__builtin_amdgcn_readfirstlane(kdst + (slot)))
#define DMA_V(t, slot) glds16(vsrc + (long)(t) * KVBLK * KP, (unsigned)__builtin_amdgcn_readfirstlane(vdst + (slot)))
    const int vb0 = (int)(lds0 + LDS_V) + ((lane >> 4) & 1) * 32 + (lane & 3) * 8 + (4 * hi + ((lane & 15) >> 2)) * 64;
    const char* Kbase = shm + LDS_K; bf16x8 kf[8];
    const lds_cptr shm3 = (lds_cptr)shm; const lds_cptr kp0 = shm3 + LDS_K + hi * 1024 + r32 * 16; const lds_cptr vp0 = shm3 + LDS_V + ((lane >> 4) & 1) * 32 + (lane & 3) * 8 + (4 * hi + ((lane & 15) >> 2)) * 64;
    constexpr int NT = SEQ / KVBLK;
    DMA_K(0, 0); DMA_V(0, 0); DMA_K(1, SLOTB);
    bf16x8 qr[4];
#pragma unroll
    for (int d0 = 0; d0 < 4; ++d0) qr[d0] = *reinterpret_cast<const bf16x8*>(&Qw[(long)r32 * QP + d0 * 16 + hi * 8]);
    float mhat = 0.f, l_reg = 0.f; f32x16 o[2]; o[0] = f32x16{}; o[1] = f32x16{}; f32x16 negm = f32x16{}; asm volatile("" : "+v"(negm));
    bool resc = false;
#define START(P0, P1) do { const float rm = rowmax(P0, P1); resc = false; \
    { const float dl = rm; mhat = fadd_s(mhat, dl); \
      _Pragma("unroll") for (int r = 0; r < 16; ++r) { P0[r] = fsub_s(P0[r], dl); P1[r] = fsub_s(P1[r], dl); } \
      _Pragma("unroll") for (int r = 0; r < 16; ++r) negm[r] = -mhat; asm volatile("" : "+v"(negm)); } \
    _Pragma("unroll") for (int r = 0; r < 16; ++r) P0[r] = __builtin_amdgcn_exp2f(P0[r]); } while (0)
#define RESC() do { if (resc) { asm volatile("s_waitcnt lgkmcnt(0)" ::: "memory"); \
      _Pragma("unroll") for (int d_ = 0; d_ < 2; ++d_) _Pragma("unroll") for (int r = 0; r < 16; ++r) o[d_][r] *= wsf[crow(r, hi)]; } } while (0)
    f32x16 pA0, pA1, pB0, pB1;
    int sl_prev = 0, sl_cur = 0, sl_next = SLOTB;
#define ROT() do { sl_prev = sl_cur; sl_cur = sl_next; sl_next = (sl_next == (NSLOT - 1) * SLOTB) ? 0 : sl_next + SLOTB; } while (0)
    DMA_K(2, 2 * SLOTB);
    WAIT_BAR(3);
    qkt(pA0, pA1, Kbase, qr, negm, r32, hi); asm volatile("s_nop 15\n\ts_nop 7" : "+v"(pA0), "+v"(pA1));
    START(pA0, pA1);
    _Pragma("unroll") for (int r = 0; r < 16; ++r) pA1[r] = __builtin_amdgcn_exp2f(pA1[r]);
    WAIT_BAR(0);
    DMA_K(3, 0); DMA_V(1, SLOTB);
    ROT();
    kload8(kf, kp0 + sl_cur);
    WAIT_BAR(2);
    s16x4 vlo[8], vhi[8]; u32x4 pw0, pw1, pw2, pw3;
#define PKW(P, B) cvtpk_s(P[B], P[B + 1])
#define PAF(k) __builtin_bit_cast(bf16x8, pw##k)
#define VFR(i) (bf16x8){vlo[i][0], vlo[i][1], vlo[i][2], vlo[i][3], vhi[i][0], vhi[i][1], vhi[i][2], vhi[i][3]}
#define PIN(x) asm volatile("" : "+v"(x))
#define MX3(a, b, c) __builtin_fmaxf(__builtin_fmaxf((a), (b)), (c))
#define GAPA(MF, A0, A1, A2, A3, W0, W1, PW) do { MF; sacc += A0; sacc += A1; sacc += A2; sacc += A3; PIN(sacc); W0; W1; PIN(PW); SBAR(); } while (0)
#define EX(v) __builtin_amdgcn_exp2f(v)
#define GAPB(MF, X, B) do { MF; X[B] = EX(X[B]); X[B + 1] = EX(X[B + 1]); X[B + 2] = EX(X[B + 2]); X[B + 3] = EX(X[B + 3]); PIN(X); SBAR(); } while (0)
#define VRD(i) do { vlo[i] = vtr(vp_ + (((i) >> 2) * 4096 + ((i) & 3) * 1024)); vhi[i] = vtr(vp_ + (((i) >> 2) * 4096 + ((i) & 3) * 1024 + 512)); } while (0)
#define KRD(G, j) do { if (G) { kload2(kf, kp0 + sl_next, j); SBAR(); } } while (0)
#define STEP(C0, C1, P0, P1, t, GK, GV, GL) do { SBAR(); \
    const lds_cptr vp_ = vp0 + sl_prev; \
    VRD(0); SBAR(); float sacc = (P0[0] + P0[1]); \
    GAPA(C0 = __builtin_amdgcn_mfma_f32_32x32x16_bf16(kf[0], qr[0], negm, 0, 0, 0), P0[2], P0[3], P0[4], P0[5],     pw0[0] = PKW(P0, 0), pw0[1] = PKW(P0, 2), pw0); \
    VRD(4); SBAR(); GAPA(C1 = __builtin_amdgcn_mfma_f32_32x32x16_bf16(kf[1], qr[0], negm, 0, 0, 0), P0[6], P0[7], P0[8], P0[9],     pw0[2] = PKW(P0, 4), pw0[3] = PKW(P0, 6), pw0); \
    VRD(1); SBAR(); GAPA(C0 = __builtin_amdgcn_mfma_f32_32x32x16_bf16(kf[2], qr[1], C0, 0, 0, 0),   P0[10], P0[11], P0[12], P0[13], pw1[0] = PKW(P0, 8), pw1[1] = PKW(P0, 10), pw1); \
    VRD(5); SBAR(); GAPA(C1 = __builtin_amdgcn_mfma_f32_32x32x16_bf16(kf[3], qr[1], C1, 0, 0, 0),   P0[14], P0[15], P1[0], P1[1],   pw1[2] = PKW(P0, 12), pw1[3] = PKW(P0, 14), pw1); \
    VRD(2); SBAR(); GAPA(C0 = __builtin_amdgcn_mfma_f32_32x32x16_bf16(kf[4], qr[2], C0, 0, 0, 0),   P1[2], P1[3], P1[4], P1[5],     pw2[0] = PKW(P1, 0), pw2[1] = PKW(P1, 2), pw2); \
    VRD(6); SBAR(); GAPA(C1 = __builtin_amdgcn_mfma_f32_32x32x16_bf16(kf[5], qr[2], C1, 0, 0, 0),   P1[6], P1[7], P1[8], P1[9],     pw2[2] = PKW(P1, 4), pw2[3] = PKW(P1, 6), pw2); \
    VRD(3); SBAR(); GAPA(C0 = __builtin_amdgcn_mfma_f32_32x32x16_bf16(kf[6], qr[3], C0, 0, 0, 0),   P1[10], P1[11], P1[12], P1[13], pw3[0] = PKW(P1, 8), pw3[1] = PKW(P1, 10), pw3); \
    VRD(7); SBAR(); GAPA(C1 = __builtin_amdgcn_mfma_f32_32x32x16_bf16(kf[7], qr[3], C1, 0, 0, 0),   P1[14], P1[15], 0.f, 0.f,       pw3[2] = PKW(P1, 12), pw3[3] = PKW(P1, 14), pw3); \
    l_reg += sacc; \
    if (GK) { DMA_K((t) + 3, sl_cur); } if (GV) { DMA_V((t) + 1, sl_next); } \
    { float a = MX3(C0[0], C0[1], C1[0]), b = MX3(C0[2], C0[3], C1[1]); a = MX3(a, C1[2], C1[3]); \
      _Pragma("unroll") for (int r = 4; r < 16; r += 4) { a = MX3(a, C0[r], C0[r + 1]); b = MX3(b, C0[r + 2], C0[r + 3]); a = MX3(a, C1[r], C1[r + 1]); b = MX3(b, C1[r + 2], C1[r + 3]); } \
      float rm = __builtin_fmaxf(a, b); { auto rr = __builtin_amdgcn_permlane32_swap(__float_as_uint(rm), __float_as_uint(rm), false, false); rm = __builtin_fmaxf(__uint_as_float(rr[0]), __uint_as_float(rr[1])); } \
      resc = false; \
      if (__builtin_expect(__any(rm > (float)THRL), 0)) { const float dl = __builtin_fmaxf(rm, 0.f); mhat += dl; \
        _Pragma("unroll") for (int r = 0; r < 16; ++r) { C0[r] -= dl; C1[r] -= dl; } \
        _Pragma("unroll") for (int r = 0; r < 16; ++r) negm[r] = -mhat; asm volatile("" : "+v"(negm)); \
        const float f = __builtin_amdgcn_exp2f(-dl); l_reg *= f; if (hi == 0) wsf[r32] = f; resc = true; } } \
    SBAR(); \
    GAPB(o[0] = __builtin_amdgcn_mfma_f32_32x32x16_bf16(PAF(0), VFR(0), o[0], 0, 0, 0), C0, 0); \
    GAPB(o[1] = __builtin_amdgcn_mfma_f32_32x32x16_bf16(PAF(0), VFR(4), o[1], 0, 0, 0), C0, 4); \
    KRD(GL, 0); GAPB(o[0] = __builtin_amdgcn_mfma_f32_32x32x16_bf16(PAF(1), VFR(1), o[0], 0, 0, 0), C0, 8); \
    KRD(GL, 1); GAPB(o[1] = __builtin_amdgcn_mfma_f32_32x32x16_bf16(PAF(1), VFR(5), o[1], 0, 0, 0), C0, 12); \
    KRD(GL, 2); GAPB(o[0] = __builtin_amdgcn_mfma_f32_32x32x16_bf16(PAF(2), VFR(2), o[0], 0, 0, 0), C1, 0); \
    KRD(GL, 3); GAPB(o[1] = __builtin_amdgcn_mfma_f32_32x32x16_bf16(PAF(2), VFR(6), o[1], 0, 0, 0), C1, 4); \
    GAPB(o[0] = __builtin_amdgcn_mfma_f32_32x32x16_bf16(PAF(3), VFR(3), o[0], 0, 0, 0), C1, 8); \
    GAPB(o[1] = __builtin_amdgcn_mfma_f32_32x32x16_bf16(PAF(3), VFR(7), o[1], 0, 0, 0), C1, 12); \
    } while (0)
    int t = 1;
    for (; t + 5 < NT; t += 2) {
        STEP(pB0, pB1, pA0, pA1, t, true, true, true);     WAIT_BAR(2); RESC(); ROT();
        STEP(pA0, pA1, pB0, pB1, t + 1, true, true, true); WAIT_BAR(2); RESC(); ROT();
    }
#define ENDW(tt) do { if ((tt) + 3 < NT) { WAIT_BAR(2); } else if ((tt) + 2 < NT) { WAIT_BAR(1); } else { WAIT_BAR(0); } } while (0)
    for (; t + 1 < NT; t += 2) {
        STEP(pB0, pB1, pA0, pA1, t, (t + 3 < NT), (t + 1 < NT), (t + 1 < NT));         ENDW(t);     RESC(); ROT();
        STEP(pA0, pA1, pB0, pB1, t + 1, (t + 4 < NT), (t + 2 < NT), (t + 2 < NT));     ENDW(t + 1); RESC(); ROT();
    }
    STEP(pB0, pB1, pA0, pA1, NT - 1, false, false, false); RESC();
    { float sacc = pB0[0] + pB0[1]; _Pragma("unroll") for (int r = 2; r < 16; ++r) sacc += pB0[r]; _Pragma("unroll") for (int r = 0; r < 16; ++r) sacc += pB1[r]; l_reg += sacc;
      pw0 = (u32x4){PKW(pB0, 0), PKW(pB0, 2), PKW(pB0, 4), PKW(pB0, 6)}; pw1 = (u32x4){PKW(pB0, 8), PKW(pB0, 10), PKW(pB0, 12), PKW(pB0, 14)}; pw2 = (u32x4){PKW(pB1, 0), PKW(pB1, 2), PKW(pB1, 4), PKW(pB1, 6)}; pw3 = (u32x4){PKW(pB1, 8), PKW(pB1, 10), PKW(pB1, 12), PKW(pB1, 14)};
      SBAR(); pv(o, vb0 + sl_cur, PAF(0), PAF(1), PAF(2), PAF(3)); }
#undef PKW
#undef PAF
#undef VFR
#undef PIN
#undef MX3
#undef GAPA
#undef GAPB
#undef EX
#undef VRD
#undef KRD
#undef STEP
#undef ENDW
    { auto rr = __builtin_amdgcn_permlane32_swap(__float_as_uint(l_reg), __float_as_uint(l_reg), false, false); l_reg = __uint_as_float(rr[0]) + __uint_as_float(rr[1]); }
    if (hi == 0) wsf[32 + r32] = l_reg; asm volatile("s_waitcnt lgkmcnt(0)" ::: "memory");
    float rli[16];
#pragma unroll
    for (int r = 0; r < 16; ++r) rli[r] = __builtin_amdgcn_rcpf(wsf[32 + crow(r, hi)]);
    bf16* Ow = Oh + (long)(q0 + wid * QBLK) * OP;
    { bf16* stg = (bf16*)(shm + LDS_OST) + wid * 2048;
#pragma unroll
      for (int r = 0; r < 16; ++r) { const int orow = crow(r, hi);
#pragma unroll
        for (int d0 = 0; d0 < 2; ++d0) stg[orow * 64 + d0 * 32 + r32] = __float2bfloat16(o[d0][r] * rli[r]); }
      asm volatile("s_waitcnt lgkmcnt(0)" ::: "memory");
#pragma unroll
      for (int i = 0; i < 4; ++i) { const int row = i * 8 + (lane >> 3), ch = lane & 7; const u32x4 v = *(const u32x4*)(stg + row * 64 + ch * 8); ATTN_STORE16(Ow + (long)row * OP + ch * 8, v); } }
    asm volatile("s_waitcnt lgkmcnt(0)\n\ts_barrier" ::: "memory");
#undef DMA_K
#undef DMA_V
#undef START
#undef RESC
#undef ROT
}

__device__ __forceinline__ void attn_unit_fast(int qb, const bf16* Qh, const bf16* __restrict__ Kh, const bf16* __restrict__ Vh, bf16* Oh, char* shm) {
    const int tid = fresh_tid(), lane = tid & 63, r32 = lane & 31, hi = lane >> 5; const int wid = __builtin_amdgcn_readfirstlane(tid >> 6);
    const int q0 = qb * QB;
    const bf16* Qw = Qh + (long)(q0 + wid * QBLK) * QP;
    const unsigned lds0 = (unsigned)(uintptr_t)shm;
    const bf16* ksrc = Kh + (long)lane * KP + wid * 8;
    const bf16* vsrc = Vh + (long)(16 * (wid & 3) + (lane >> 2)) * KP + (wid >> 2) * 32 + (lane & 3) * 8;
    const unsigned kdst = lds0 + LDS_K + wid * 1024, vdst = lds0 + LDS_V + wid * 1024;
#define DMA_K(t, slot) glds16(ksrc + (long)(t) * KVBLK * KP, (unsigned)__builtin_amdgcn_readfirstlane(kdst + (slot)))
#define DMA_V(t, slot) glds16(vsrc + (long)(t) * KVBLK * KP, (unsigned)__builtin_amdgcn_readfirstlane(vdst + (slot)))
    const int vb0 = (int)(lds0 + LDS_V) + ((lane >> 4) & 1) * 32 + (lane & 3) * 8 + (4 * hi + ((lane & 15) >> 2)) * 64;
    const char* Kbase = shm + LDS_K; bf16x8 kf[8];
    const lds_cptr shm3 = (lds_cptr)shm; const lds_cptr kp0 = shm3 + LDS_K + hi * 1024 + r32 * 16; const lds_cptr vp0 = shm3 + LDS_V + ((lane >> 4) & 1) * 32 + (lane & 3) * 8 + (4 * hi + ((lane & 15) >> 2)) * 64;
    constexpr int NT = SEQ / KVBLK;
    DMA_K(0, 0); DMA_V(0, 0); DMA_K(1, SLOTB);
    bf16x8 qr[4];
#pragma unroll
    for (int d0 = 0; d0 < 4; ++d0) qr[d0] = *reinterpret_cast<const bf16x8*>(&Qw[(long)r32 * QP + d0 * 16 + hi * 8]);
    f32x16 o[2]; o[0] = f32x16{}; o[1] = f32x16{}; f32x16 lsum = f32x16{};
    const f32x16 zero16 = f32x16{};
    bf16x8 ones; { const short one = (short)0x3F80; ones = (bf16x8){one, one, one, one, one, one, one, one}; asm volatile("" : "+v"(ones)); }
    f32x16 pA0, pA1, pB0, pB1;
    int sl_prev = 0, sl_cur = 0, sl_next = SLOTB;
#define ROT() do { sl_prev = sl_cur; sl_cur = sl_next; sl_next = (sl_next == (NSLOT - 1) * SLOTB) ? 0 : sl_next + SLOTB; } while (0)
    DMA_K(2, 2 * SLOTB);
    WAIT_BAR(3);
    qkt(pA0, pA1, Kbase, qr, zero16, r32, hi);
    _Pragma("unroll") for (int r = 0; r < 16; ++r) pA0[r] = __builtin_amdgcn_exp2f(pA0[r]);
    _Pragma("unroll") for (int r = 0; r < 16; ++r) pA1[r] = __builtin_amdgcn_exp2f(pA1[r]);
    WAIT_BAR(0);
    DMA_K(3, 0); DMA_V(1, SLOTB);
    ROT();
    kload8(kf, kp0 + sl_cur);
    WAIT_BAR(2);
    s16x4 vlo[8], vhi[8]; u32x4 pw0, pw1, pw2, pw3;
#define PKW(P, B) cvtpk_s(P[B], P[B + 1])
#define PAF(k) __builtin_bit_cast(bf16x8, pw##k)
#define VFR(i) (bf16x8){vlo[i][0], vlo[i][1], vlo[i][2], vlo[i][3], vhi[i][0], vhi[i][1], vhi[i][2], vhi[i][3]}
#define PIN(x) asm volatile("" : "+v"(x))
#define GAPA(MF, W0, W1, PW) do { MF; W0; W1; PIN(PW); SBAR(); } while (0)
#define EX(v) __builtin_amdgcn_exp2f(v)
#define GAPB(MF, X, B) do { MF; X[B] = EX(X[B]); X[B + 1] = EX(X[B + 1]); X[B + 2] = EX(X[B + 2]); PIN(X); SBAR(); } while (0)
#define GAPS(k, X, B) do { lsum = __builtin_amdgcn_mfma_f32_32x32x16_bf16(PAF(k), ones, lsum, 0, 0, 0); X[B] = EX(X[B]); X[B + 1] = EX(X[B + 1]); PIN(X); SBAR(); } while (0)
#define VRD(i) do { vlo[i] = vtr(vp_ + (((i) >> 2) * 4096 + ((i) & 3) * 1024)); vhi[i] = vtr(vp_ + (((i) >> 2) * 4096 + ((i) & 3) * 1024 + 512)); } while (0)
#define KRD(G, j) do { if (G) { kload2(kf, kp0 + sl_next, j); SBAR(); } } while (0)
#define STEP(C0, C1, P0, P1, t, GK, GV, GL) do { SBAR(); \
    const lds_cptr vp_ = vp0 + sl_prev; \
    VRD(0); SBAR(); \
    GAPA(C0 = __builtin_amdgcn_mfma_f32_32x32x16_bf16(kf[0], qr[0], zero16, 0, 0, 0), pw0[0] = PKW(P0, 0), pw0[1] = PKW(P0, 2), pw0); \
    VRD(4); SBAR(); GAPA(C1 = __builtin_amdgcn_mfma_f32_32x32x16_bf16(kf[1], qr[0], zero16, 0, 0, 0), pw0[2] = PKW(P0, 4), pw0[3] = PKW(P0, 6), pw0); \
    VRD(1); SBAR(); GAPA(C0 = __builtin_amdgcn_mfma_f32_32x32x16_bf16(kf[2], qr[1], C0, 0, 0, 0),   pw1[0] = PKW(P0, 8), pw1[1] = PKW(P0, 10), pw1); \
    VRD(5); SBAR(); GAPA(C1 = __builtin_amdgcn_mfma_f32_32x32x16_bf16(kf[3], qr[1], C1, 0, 0, 0),   pw1[2] = PKW(P0, 12), pw1[3] = PKW(P0, 14), pw1); \
    VRD(2); SBAR(); GAPA(C0 = __builtin_amdgcn_mfma_f32_32x32x16_bf16(kf[4], qr[2], C0, 0, 0, 0),   pw2[0] = PKW(P1, 0), pw2[1] = PKW(P1, 2), pw2); \
    VRD(6); SBAR(); GAPA(C1 = __builtin_amdgcn_mfma_f32_32x32x16_bf16(kf[5], qr[2], C1, 0, 0, 0),   pw2[2] = PKW(P1, 4), pw2[3] = PKW(P1, 6), pw2); \
    VRD(3); SBAR(); GAPA(C0 = __builtin_amdgcn_mfma_f32_32x32x16_bf16(kf[6], qr[3], C0, 0, 0, 0),   pw3[0] = PKW(P1, 8), pw3[1] = PKW(P1, 10), pw3); \
    VRD(7); SBAR(); GAPA(C1 = __builtin_amdgcn_mfma_f32_32x32x16_bf16(kf[7], qr[3], C1, 0, 0, 0),   pw3[2] = PKW(P1, 12), pw3[3] = PKW(P1, 14), pw3); \
    if (GK) { DMA_K((t) + 3, sl_cur); } if (GV) { DMA_V((t) + 1, sl_next); } \
    SBAR(); \
    GAPB(o[0] = __builtin_amdgcn_mfma_f32_32x32x16_bf16(PAF(0), VFR(0), o[0], 0, 0, 0), C0, 0); \
    GAPB(o[1] = __builtin_amdgcn_mfma_f32_32x32x16_bf16(PAF(0), VFR(4), o[1], 0, 0, 0), C0, 3); \
    KRD(GL, 0); GAPS(0, C0, 6); \
    GAPB(o[0] = __builtin_amdgcn_mfma_f32_32x32x16_bf16(PAF(1), VFR(1), o[0], 0, 0, 0), C0, 8); \
    KRD(GL, 1); GAPB(o[1] = __builtin_amdgcn_mfma_f32_32x32x16_bf16(PAF(1), VFR(5), o[1], 0, 0, 0), C0, 11); \
    GAPS(1, C0, 14); \
    KRD(GL, 2); GAPB(o[0] = __builtin_amdgcn_mfma_f32_32x32x16_bf16(PAF(2), VFR(2), o[0], 0, 0, 0), C1, 0); \
    KRD(GL, 3); GAPB(o[1] = __builtin_amdgcn_mfma_f32_32x32x16_bf16(PAF(2), VFR(6), o[1], 0, 0, 0), C1, 3); \
    GAPS(2, C1, 6); \
    GAPB(o[0] = __builtin_amdgcn_mfma_f32_32x32x16_bf16(PAF(3), VFR(3), o[0], 0, 0, 0), C1, 8); \
    GAPB(o[1] = __builtin_amdgcn_mfma_f32_32x32x16_bf16(PAF(3), VFR(7), o[1], 0, 0, 0), C1, 11); \
    GAPS(3, C1, 14); \
    } while (0)
    int t = 1;
    for (; t + 5 < NT; t += 2) {
        STEP(pB0, pB1, pA0, pA1, t, true, true, true);     WAIT_BAR(2); ROT();
        STEP(pA0, pA1, pB0, pB1, t + 1, true, true, true); WAIT_BAR(2); ROT();
    }
#define ENDW(tt) do { if ((tt) + 3 < NT) { WAIT_BAR(2); } else if ((tt) + 2 < NT) { WAIT_BAR(1); } else { WAIT_BAR(0); } } while (0)
    for (; t + 1 < NT; t += 2) {
        STEP(pB0, pB1, pA0, pA1, t, (t + 3 < NT), (t + 1 < NT), (t + 1 < NT));         ENDW(t);     ROT();
        STEP(pA0, pA1, pB0, pB1, t + 1, (t + 4 < NT), (t + 2 < NT), (t + 2 < NT));     ENDW(t + 1); ROT();
    }
    STEP(pB0, pB1, pA0, pA1, NT - 1, false, false, false);
    { pw0 = (u32x4){PKW(pB0, 0), PKW(pB0, 2), PKW(pB0, 4), PKW(pB0, 6)}; pw1 = (u32x4){PKW(pB0, 8), PKW(pB0, 10), PKW(pB0, 12), PKW(pB0, 14)}; pw2 = (u32x4){PKW(pB1, 0), PKW(pB1, 2), PKW(pB1, 4), PKW(pB1, 6)}; pw3 = (u32x4){PKW(pB1, 8), PKW(pB1, 10), PKW(pB1, 12), PKW(pB1, 14)};
      SBAR(); pv(o, vb0 + sl_cur, PAF(0), PAF(1), PAF(2), PAF(3));
      lsum = __builtin_amdgcn_mfma_f32_32x32x16_bf16(PAF(0), ones, lsum, 0, 0, 0); lsum = __builtin_amdgcn_mfma_f32_32x32x16_bf16(PAF(1), ones, lsum, 0, 0, 0);
      lsum = __builtin_amdgcn_mfma_f32_32x32x16_bf16(PAF(2), ones, lsum, 0, 0, 0); lsum = __builtin_amdgcn_mfma_f32_32x32x16_bf16(PAF(3), ones, lsum, 0, 0, 0); }
#undef PKW
#undef PAF
#undef VFR
#undef PIN
#undef GAPA
#undef GAPB
#undef GAPS
#undef EX
#undef VRD
#undef KRD
#undef STEP
#undef ENDW
    bf16* Ow = Oh + (long)(q0 + wid * QBLK) * OP;
    { bf16* stg = (bf16*)(shm + LDS_OST) + wid * 2048;
#pragma unroll
      for (int r = 0; r < 16; ++r) { const int orow = crow(r, hi); const float rl = __builtin_amdgcn_rcpf(lsum[r]);
#pragma unroll
        for (int d0 = 0; d0 < 2; ++d0) stg[orow * 64 + d0 * 32 + r32] = __float2bfloat16(o[d0][r] * rl); }
      asm volatile("s_waitcnt lgkmcnt(0)" ::: "memory");
#pragma unroll
      for (int i = 0; i < 4; ++i) { const int row = i * 8 + (lane >> 3), ch = lane & 7; const u32x4 v = *(const u32x4*)(stg + row * 64 + ch * 8); ATTN_STORE16(Ow + (long)row * OP + ch * 8, v); } }
    asm volatile("s_waitcnt lgkmcnt(0)\n\ts_barrier" ::: "memory");
#undef DMA_K
#undef DMA_V
#undef ROT
}
__device__ __forceinline__ void attn_unit_f8(int qb, const unsigned char* Q8h, const unsigned char* __restrict__ K8h, const unsigned char* __restrict__ V8Th, bf16* Oh, char* shm, float shift) {
    const int tid = fresh_tid(), lane = tid & 63, r32 = lane & 31, hi = lane >> 5; const int wid = __builtin_amdgcn_readfirstlane(tid >> 6);
    const int q0 = qb * QB;
    const unsigned lds0 = (unsigned)(uintptr_t)shm;
    constexpr int KSL = 4096;
    const int pw = wid & 3; const bool kcls = wid < 4;
    const int prow = 16 * pw + (lane >> 2), pch = ((lane & 3) ^ ((prow >> 2) & 3)) * 16;
    const unsigned char* dsrc = kcls ? K8h + (long)prow * 128 + pch : V8Th + (long)prow * 64 + pch;
    const unsigned ddst = lds0 + (kcls ? LDS_K : LDS_V) + pw * 1024;
#define DMA_K(t, slot) do { if (kcls) glds16(dsrc + (long)(t) * KVBLK * 128, (unsigned)__builtin_amdgcn_readfirstlane(ddst + (slot))); } while (0)
#define DMA_V(t, slot) do { if (!kcls) glds16(dsrc + (long)(t) * 4096, (unsigned)__builtin_amdgcn_readfirstlane(ddst + (slot))); } while (0)
    const lds_cptr shm3 = (lds_cptr)shm; const int ksw = (r32 >> 2) & 3;
    const int fo0 = r32 * 64 + (((2 * hi) ^ ksw) * 16), fo1 = r32 * 64 + (((2 * hi + 1) ^ ksw) * 16);
    const lds_cptr kp0 = shm3 + LDS_K, vp0 = shm3 + LDS_V;
    constexpr int NT = SEQ / KVBLK;
    DMA_K(0, 0); DMA_V(0, 0); DMA_K(1, KSL);
    v8i qf; { const unsigned char* qp = Q8h + (long)(q0 + wid * QBLK + r32) * 512 + hi * 32; qf = __builtin_shufflevector(*(const v4i*)qp, *(const v4i*)(qp + 16), 0, 1, 2, 3, 4, 5, 6, 7); }
    const int sc_k = 127 - 3, sc_q = 127 - 5, sc_v = 127 - 3, sc_1 = 127;
    v8i kf8[2], vf8[2], pa;
    v8i ones8; { const int o4 = 0x38383838; ones8 = (v8i){o4, o4, o4, o4, o4, o4, o4, o4}; asm volatile("" : "+v"(ones8)); }
    f32x16 cin; { const float ns = -shift; _Pragma("unroll") for (int r = 0; r < 16; ++r) cin[r] = ns; asm volatile("" : "+v"(cin)); }
#define LD8(dst, base, slotoff) do { _Pragma("unroll") for (int n_ = 0; n_ < 2; ++n_) dst[n_] = __builtin_shufflevector(*(const LAS v4i*)((base) + (slotoff) + n_ * 2048 + fo0), *(const LAS v4i*)((base) + (slotoff) + n_ * 2048 + fo1), 0, 1, 2, 3, 4, 5, 6, 7); } while (0)
#define QK8(n_) __builtin_amdgcn_mfma_scale_f32_32x32x64_f8f6f4(kf8[n_], qf, cin, 0, 0, 0, sc_k, 0, sc_q)
#define ACC8(acc, a_, b_, sb_) asm volatile("s_nop 1\n\tv_mfma_scale_f32_32x32x64_f8f6f4 %0, %1, %2, %0, %3, %4 op_sel_hi:[0,0,0]" : "+v"(acc) : "v"(a_), "v"(b_), "v"(sc_1), "v"(sb_))
#define PACK8(P0, P1) do { pa[0] = (int)pk4_fp8_nc(P0[0], P0[1], P0[2], P0[3]); pa[1] = (int)pk4_fp8_nc(P0[4], P0[5], P0[6], P0[7]); pa[2] = (int)pk4_fp8_nc(P0[8], P0[9], P0[10], P0[11]); pa[3] = (int)pk4_fp8_nc(P0[12], P0[13], P0[14], P0[15]); \
    pa[4] = (int)pk4_fp8_nc(P1[0], P1[1], P1[2], P1[3]); pa[5] = (int)pk4_fp8_nc(P1[4], P1[5], P1[6], P1[7]); pa[6] = (int)pk4_fp8_nc(P1[8], P1[9], P1[10], P1[11]); pa[7] = (int)pk4_fp8_nc(P1[12], P1[13], P1[14], P1[15]); } while (0)
    f32x16 o[2]; o[0] = f32x16{}; o[1] = f32x16{}; f32x16 lsum = f32x16{};
    f32x16 pA0, pA1, pB0, pB1;
    int sl_prev = 0, sl_cur = 0, sl_next = KSL;
#define ROT() do { sl_prev = sl_cur; sl_cur = sl_next; sl_next = (sl_next == (NSLOT - 1) * KSL) ? 0 : sl_next + KSL; } while (0)
    DMA_K(2, 2 * KSL);
    WAIT_BAR(2);
    LD8(kf8, kp0, 0); pA0 = QK8(0); pA1 = QK8(1);
    _Pragma("unroll") for (int r = 0; r < 16; ++r) pA0[r] = __builtin_amdgcn_exp2f(pA0[r]);
    _Pragma("unroll") for (int r = 0; r < 16; ++r) pA1[r] = __builtin_amdgcn_exp2f(pA1[r]);
    WAIT_BAR(0);
    DMA_K(3, 0); DMA_V(1, KSL);
    ROT();
    LD8(kf8, kp0, sl_cur);
    WAIT_BAR(1);
#define PIN(x) asm volatile("" : "+v"(x))
#define EX(v) __builtin_amdgcn_exp2f(v)
#define EX4(X, B) do { X[B] = EX(X[B]); X[B + 1] = EX(X[B + 1]); X[B + 2] = EX(X[B + 2]); X[B + 3] = EX(X[B + 3]); } while (0)
#define STEP(C0, C1, P0, P1, t, GK, GV, GL) do { SBAR(); \
    LD8(vf8, vp0, sl_prev); \
    C0 = QK8(0); PACK8(P0, P1); PIN(pa); \
    C1 = QK8(1); \
    if (GK) { DMA_K((t) + 3, sl_cur); } if (GV) { DMA_V((t) + 1, sl_next); } \
    \
    ACC8(o[0], pa, vf8[0], sc_v); EX4(C0, 0); EX4(C0, 4); EX4(C0, 8); PIN(C0); \
    ACC8(o[1], pa, vf8[1], sc_v); EX4(C0, 12); EX4(C1, 0); EX4(C1, 4); PIN(C0); PIN(C1); \
    if (GL) { LD8(kf8, kp0, sl_next); } \
    ACC8(lsum, pa, ones8, sc_1); EX4(C1, 8); EX4(C1, 12); PIN(C1); \
    } while (0)
    int t = 1;
    for (; t + 5 < NT; t += 2) {
        STEP(pB0, pB1, pA0, pA1, t, true, true, true);     WAIT_BAR(1); ROT();
        STEP(pA0, pA1, pB0, pB1, t + 1, true, true, true); WAIT_BAR(1); ROT();
    }
#define ENDW(tt) do { if (kcls ? ((tt) + 3 < NT) : ((tt) + 2 < NT)) { WAIT_BAR(1); } else { WAIT_BAR(0); } } while (0)
    for (; t + 1 < NT; t += 2) {
        STEP(pB0, pB1, pA0, pA1, t, (t + 3 < NT), (t + 1 < NT), (t + 1 < NT));         ENDW(t);     ROT();
        STEP(pA0, pA1, pB0, pB1, t + 1, (t + 4 < NT), (t + 2 < NT), (t + 2 < NT));     ENDW(t + 1); ROT();
    }
    STEP(pB0, pB1, pA0, pA1, NT - 1, false, false, false);
    { PACK8(pB0, pB1); PIN(pa); SBAR(); LD8(vf8, vp0, sl_cur); SBAR();
      ACC8(o[0], pa, vf8[0], sc_v); ACC8(o[1], pa, vf8[1], sc_v); ACC8(lsum, pa, ones8, sc_1); }
    asm volatile("s_nop 15\n\ts_nop 15" : "+v"(o[0]), "+v"(o[1]), "+v"(lsum));
#undef PIN
#undef EX
#undef EX4
#undef STEP
#undef ENDW
    bf16* Ow = Oh + (long)(q0 + wid * QBLK) * OP;
    { bf16* stg = (bf16*)(shm + LDS_OST) + wid * 2048;
#pragma unroll
      for (int r = 0; r < 16; ++r) { const int orow = crow(r, hi); const float rl = lsum[r] > 0.f ? __builtin_amdgcn_rcpf(lsum[r]) : 0.f;
#pragma unroll
        for (int d0 = 0; d0 < 2; ++d0) stg[orow * 64 + d0 * 32 + r32] = __float2bfloat16(o[d0][r] * rl); }
      asm volatile("s_waitcnt lgkmcnt(0)" ::: "memory");
#pragma unroll
      for (int i = 0; i < 4; ++i) { const int row = i * 8 + (lane >> 3), ch = lane & 7; const u32x4 v = *(const u32x4*)(stg + row * 64 + ch * 8); ATTN_STORE16(Ow + (long)row * OP + ch * 8, v); } }
    asm volatile("s_waitcnt lgkmcnt(0)\n\ts_barrier" ::: "memory");
#undef DMA_K
#undef DMA_V
#undef ROT
#undef LD8
#undef QK8
#undef ACC8
#undef PACK8
}
constexpr int ATTN_LDS_BYTES = LDS_BYTES;
#undef SBAR
#undef WAIT_BAR
}

namespace na_body {
constexpr int NA_K = 0, NA_V = 65536;
typedef short v4i16_t __attribute__((ext_vector_type(4)));
__device__ __forceinline__ int clampi(int v, int lo, int hi) { return v < lo ? lo : (v > hi ? hi : v); }
__device__ __forceinline__ void na_phase(LAS unsigned char* lds, LAS float* biasL, LAS float* xch, const bf16_t* QKV, bf16_t* Y, const float* rpb, int vcu) {
    const int tid = fresh_tid(), lane = tid & 63, wid = __builtin_amdgcn_readfirstlane(tid >> 6);
    const int bh = vcu >> 3, b = bh >> 3, h = bh & 7, rbase = (vcu & 7) * 16;
    for (int i = tid; i < 15 * 31; i += 512) biasL[i] = rpb[h * 465 + i];
    const int lc = tid >> 3, lch = tid & 7;
    const unsigned kwoff = (unsigned)(lc * 128 + ((lch ^ (lc & 7)) * 16));
    const unsigned vwoff = (unsigned)(lc * 128 + (((lch >> 1) ^ ((lc >> 1) & 3)) * 32) + (lch & 1) * 16);
    const int q = lane & 15, g = lane >> 4;
    { const int rs0 = clampi(rbase - 4, 0, 120);
      u32x4 kv[8], vv[8];
#pragma unroll
      for (int i = 0; i < 8; ++i) { const size_t tok = (size_t)b * SEQ + (size_t)(rs0 + i) * 64 + lc;
          kv[i] = *(const u32x4*)(QKV + tok * NQKV + C_KNA + h * 64 + lch * 8); vv[i] = *(const u32x4*)(QKV + tok * NQKV + C_VNA + h * 64 + lch * 8); }
#pragma unroll
      for (int i = 0; i < 8; ++i) { const int row = rs0 + i;
          *(LAS u32x4*)(lds + NA_K + (row & 7) * 8192 + kwoff) = kv[i]; *(LAS u32x4*)(lds + NA_V + (row & 7) * 8192 + vwoff) = vv[i]; } }
    __syncthreads();
    const int tile_ = wid & 3, c0_ = tile_ * 16;
    bf16x8 qn[2];
#pragma unroll
    for (int ks = 0; ks < 2; ++ks) qn[ks] = *(const bf16x8*)(QKV + ((size_t)b * SEQ + (size_t)rbase * 64 + c0_ + q) * NQKV + C_QNA + h * 64 + ks * 32 + g * 8);
    for (int rr = 0; rr < 16; ++rr) {
        const int r = rbase + rr, rs = clampi(r - 4, 0, 120);
        const int rsn = (rr < 15) ? clampi(r + 1 - 4, 0, 120) : rs; const bool pf = rsn != rs;
        u32x4 pk = (u32x4){0u, 0u, 0u, 0u}, pv = (u32x4){0u, 0u, 0u, 0u};
        if (pf) { const size_t tok = (size_t)b * SEQ + (size_t)(rsn + 7) * 64 + lc;
            pk = *(const u32x4*)(QKV + tok * NQKV + C_KNA + h * 64 + lch * 8); pv = *(const u32x4*)(QKV + tok * NQKV + C_VNA + h * 64 + lch * 8); }
        {
            const int tile = wid & 3, kh = wid >> 2;
            const int c0 = tile * 16, u0 = clampi(c0 - 8, 0, 32);
            const size_t tq = (size_t)b * SEQ + (size_t)r * 64 + c0 + q;
            bf16x8 qf[2]; qf[0] = qn[0]; qf[1] = qn[1];
            { const int rn = (rr < 15) ? r + 1 : r; const size_t tqn = (size_t)b * SEQ + (size_t)rn * 64 + c0 + q;
#pragma unroll
              for (int ks = 0; ks < 2; ++ks) qn[ks] = *(const bf16x8*)(QKV + tqn * NQKV + C_QNA + h * 64 + ks * 32 + g * 8); }
            f32x4 s[4][2];
#pragma unroll
            for (int kk = 0; kk < 4; ++kk) { const int slot = (rs + 4 * kh + kk) & 7;
#pragma unroll
                for (int hf = 0; hf < 2; ++hf) { const int kc = u0 + hf * 16 + q;
                    f32x4 a = (f32x4){0.f, 0.f, 0.f, 0.f};
#pragma unroll
                    for (int ks = 0; ks < 2; ++ks) { const bf16x8 kfr = *(const LAS bf16x8*)(lds + NA_K + slot * 8192 + kc * 128 + (((ks * 4 + g) ^ (kc & 7)) * 16));
                        a = __builtin_amdgcn_mfma_f32_16x16x32_bf16(kfr, qf[ks], a, 0, 0, 0); }
                    s[kk][hf] = a; } }
            const int c = c0 + q, cs = clampi(c - 8, 0, 48), lo = cs - u0;
            const int dcb = u0 - c + 15 + 4 * g;
            float mx = -1e30f;
#pragma unroll
            for (int kk = 0; kk < 4; ++kk) { const int dr = rs + 4 * kh + kk - r + 7;
#pragma unroll
                for (int hf = 0; hf < 2; ++hf)
#pragma unroll
                    for (int i = 0; i < 4; ++i) { const int kcl = 16 * hf + 4 * g + i; const bool valid = (kcl >= lo) && (kcl < lo + 16);
                        const int dc = clampi(dcb + 16 * hf + i, 0, 30);
                        const float v = valid ? (s[kk][hf][i] + biasL[dr * 31 + dc]) * LOG2E : -1e30f;
                        s[kk][hf][i] = v; mx = fmaxf(mx, v); } }
            mx = swap16_max(mx); mx = swap32_max(mx);
            float l = 0.f;
#pragma unroll
            for (int kk = 0; kk < 4; ++kk)
#pragma unroll
                for (int hf = 0; hf < 2; ++hf)
#pragma unroll
                    for (int i = 0; i < 4; ++i) { const float p = __builtin_amdgcn_exp2f(s[kk][hf][i] - mx); s[kk][hf][i] = p; l += p; }
            l = swap16_sum(l, l); l = swap32_sum(l, l);
            f32x4 o[4];
#pragma unroll
            for (int nb = 0; nb < 4; ++nb) o[nb] = (f32x4){0.f, 0.f, 0.f, 0.f};
            const int qq = (lane & 15) >> 2, pp = lane & 3;
            const int kcA = u0 + 4 * g + qq, kcB = kcA + 16;
#pragma unroll
            for (int kk = 0; kk < 4; ++kk) { const int slot = (rs + 4 * kh + kk) & 7;
                u32x4 pw; pw.x = pk2(s[kk][0][0], s[kk][0][1]); pw.y = pk2(s[kk][0][2], s[kk][0][3]); pw.z = pk2(s[kk][1][0], s[kk][1][1]); pw.w = pk2(s[kk][1][2], s[kk][1][3]);
                const bf16x8 pf = __builtin_bit_cast(bf16x8, pw);
#pragma unroll
                for (int nb = 0; nb < 4; ++nb) {
                    const s16x4 va = __builtin_bit_cast(s16x4, __builtin_amdgcn_ds_read_tr16_b64_v4i16((LAS v4i16_t*)(lds + NA_V + slot * 8192 + kcA * 128 + ((nb ^ ((kcA >> 1) & 3)) * 32) + pp * 8)));
                    const s16x4 vb = __builtin_bit_cast(s16x4, __builtin_amdgcn_ds_read_tr16_b64_v4i16((LAS v4i16_t*)(lds + NA_V + slot * 8192 + kcB * 128 + ((nb ^ ((kcB >> 1) & 3)) * 32) + pp * 8)));
                    const bf16x8 vf = (bf16x8){va[0], va[1], va[2], va[3], vb[0], vb[1], vb[2], vb[3]};
                    o[nb] = __builtin_amdgcn_mfma_f32_16x16x32_bf16(vf, pf, o[nb], 0, 0, 0); } }
            LAS float* px = xch + (size_t)(tile * 64 + lane) * 18;
            if (kh == 1) { px[0] = mx; px[1] = l;
#pragma unroll
                for (int nb = 0; nb < 4; ++nb)
#pragma unroll
                    for (int i = 0; i < 4; ++i) px[2 + nb * 4 + i] = o[nb][i]; }
            __syncthreads();
            if (kh == 0) { const float mb = px[0], lb = px[1]; const float m = fmaxf(mx, mb), fa = __builtin_amdgcn_exp2f(mx - m), fb = __builtin_amdgcn_exp2f(mb - m);
                const float rl = 1.0f / (l * fa + lb * fb);
#pragma unroll
                for (int nb = 0; nb < 4; ++nb) { float t[4];
#pragma unroll
                    for (int i = 0; i < 4; ++i) t[i] = (o[nb][i] * fa + px[2 + nb * 4 + i] * fb) * rl;
                    u32x2 w; w.x = pk2(t[0], t[1]); w.y = pk2(t[2], t[3]);
                    *(u32x2*)(Y + tq * DMODEL + h * 64 + nb * 16 + 4 * g) = w; } }
        }
        if (pf) { *(LAS u32x4*)(lds + NA_K + ((rsn + 7) & 7) * 8192 + kwoff) = pk; *(LAS u32x4*)(lds + NA_V + ((rsn + 7) & 7) * 8192 + vwoff) = pv; }
        __syncthreads();
    }
}
}

constexpr size_t MiB = 1u << 20;
constexpr size_t WS_CTL = 0, CTL_ZERO_BYTES = 1 * MiB;
constexpr size_t WS_MOD = 1 * MiB;
constexpr size_t WS_IDX = 2 * MiB;
constexpr size_t WS_GSEL = 2 * MiB + 256 * 1024;
constexpr size_t WS_AFF = 3 * MiB;
constexpr size_t WS_SLOT = 5 * MiB;
constexpr size_t WS_WIN = 7 * MiB;
constexpr size_t WS_WG8 = 12 * MiB;
constexpr size_t WS_WA = 16 * MiB, WS_WB = 17 * MiB, WS_WOUT = 18 * MiB;
constexpr size_t WS_WGU = 20 * MiB;
constexpr size_t WS_WD = 148 * MiB;
constexpr size_t WS_H = 212 * MiB;
constexpr size_t WS_QKV = 276 * MiB;
constexpr size_t WS_GATES = 420 * MiB;
constexpr size_t WS_END = 548 * MiB;
constexpr size_t WS_YBUF = WS_WGU;
static_assert(WS_QKV + (size_t)65536 * 2048 * 2 <= WS_END, "HMID fits");
constexpr int CW_BAR = 4096;

constexpr int RING_OFF = 0, RING_BYTES = 131072;
constexpr int LDSCTL_OFF = RING_BYTES, MISC_OFF = LDSCTL_OFF + 320;
constexpr int NABIAS_OFF = RING_BYTES + 1024;
constexpr int NAXCH_OFF = RING_BYTES + 4096;
constexpr int LDS_BYTES = 163840;

#define XB_TMO      128
#define XB_XCNT(j)  (256  + 64 * (j))
#define XB_XSUB(j)  (1280 + 64 * (j))
#define XB_XGEN(j)  (2304 + 64 * (j))
#define XB_TOP      3328
#define XB_TOPGEN   3392
#define XCD_BAR_WORDS 3456
#define XB_SPIN_CAP (1u << 22)
__device__ __forceinline__ unsigned xb_ld(unsigned* p)              { return __hip_atomic_load(p, __ATOMIC_RELAXED, __HIP_MEMORY_SCOPE_AGENT); }
__device__ __forceinline__ unsigned xb_add(unsigned* p, unsigned v) { return __hip_atomic_fetch_add(p, v, __ATOMIC_RELAXED, __HIP_MEMORY_SCOPE_AGENT); }
__device__ __forceinline__ unsigned xb_xcc_id() { return (unsigned)__builtin_amdgcn_s_getreg((3 << 11) | 20) & 0xFu; }
#define XB_SPIN(cond, bar) do { unsigned _sp = 0; while (cond) { __builtin_amdgcn_s_sleep(1); \
    if ((++_sp & 255u) == 0u) { if (xb_ld(&(bar)[XB_TMO])) break; if (_sp > XB_SPIN_CAP) { atomicAdd(&(bar)[XB_TMO], 1u); break; } } } } while (0)
struct XcdBarrier { unsigned* bar; unsigned x; volatile LAS unsigned* st; };
__device__ __forceinline__ XcdBarrier xcd_barrier_post(unsigned* bar, volatile LAS unsigned* st) {
    XcdBarrier b; b.bar = bar; b.x = xb_xcc_id(); b.st = st;
    if (threadIdx.x == 0) (void)xb_add(&bar[XB_XCNT(b.x)], 1u);
    return b;
}
__device__ __forceinline__ void xcd_barrier_complete(unsigned* bar, unsigned x, unsigned& nloc, unsigned& nx) {
    const unsigned G = gridDim.x * gridDim.y * gridDim.z;
    unsigned sum, cnt, mine, sp = 0u;
    for (;;) {
        sum = 0u; cnt = 0u; mine = 0u;
#pragma unroll
        for (unsigned j = 0; j < 16; ++j) { const unsigned c = xb_ld(&bar[XB_XCNT(j)]); sum += c; cnt += (c > 0u) ? 1u : 0u; mine = (j == x) ? c : mine; }
        if (sum == G) break;
        __builtin_amdgcn_s_sleep(1);
        if ((++sp & 255u) == 0u) { if (xb_ld(&bar[XB_TMO])) break; if (sp > XB_SPIN_CAP) { atomicAdd(&bar[XB_TMO], 1u); break; } }
    }
    nloc = mine > 0u ? mine : 1u; nx = cnt > 0u ? cnt : 1u;
}
__device__ __forceinline__ void xcd_barrier(const XcdBarrier& b) {
    asm volatile("s_waitcnt vmcnt(0)" ::: "memory");
    __syncthreads();
    if (threadIdx.x == 0) {
        unsigned* bar = b.bar;
        __builtin_amdgcn_s_waitcnt(0);
        unsigned nloc = b.st[0], nx = b.st[1];
        if (nloc == 0u) { xcd_barrier_complete(bar, b.x, nloc, nx); b.st[0] = nloc; b.st[1] = nx; }
        const unsigned old = xb_add(&bar[XB_XSUB(b.x)], 1u);
        const unsigned gen = old / nloc;
        if (old + 1u == (gen + 1u) * nloc) {
            __builtin_amdgcn_fence(__ATOMIC_RELEASE, "agent");
            asm volatile("s_waitcnt vmcnt(0)" ::: "memory");
            const unsigned og = xb_add(&bar[XB_TOP], 1u);
            const unsigned tg = og / nx;
            if (og + 1u == (tg + 1u) * nx) xb_add(&bar[XB_TOPGEN], 1u);
            else XB_SPIN(xb_ld(&bar[XB_TOPGEN]) == tg, bar);
            __builtin_amdgcn_fence(__ATOMIC_ACQUIRE, "agent");
            xb_add(&bar[XB_XGEN(b.x)], 1u);
            asm volatile("s_waitcnt vmcnt(0)" ::: "memory");
        } else {
            XB_SPIN(xb_ld(&bar[XB_XGEN(b.x)]) == gen, bar);
            __builtin_amdgcn_fence(__ATOMIC_ACQUIRE, "agent");
            asm volatile("s_waitcnt vmcnt(0)" ::: "memory");
        }
    }
    __syncthreads();
}

#define LDS_WAIT() asm volatile("s_waitcnt lgkmcnt(0)" ::: "memory")
template <class RowMap>
__device__ __forceinline__ void p0_transpose_item(const float* W, int K, int N, bf16_t* WT, LAS float* scr, int item, int lane, const RowMap& rowmap) {
    const int nblk = N / 32, kb = item / nblk, nb = item % nblk, k0 = 64 * kb, n0 = 32 * nb;
    float ld_[32];
#pragma unroll
    for (int i = 0; i < 32; ++i) ld_[i] = __builtin_nontemporal_load(&W[(size_t)(k0 + 2 * i + (lane >> 5)) * N + n0 + (lane & 31)]);
#pragma unroll
    for (int i = 0; i < 32; ++i) scr[(2 * i + (lane >> 5)) * 33 + (lane & 31)] = ld_[i];
    LDS_WAIT(); asm volatile("" ::: "memory");
    const int c = lane & 7;
#pragma unroll
    for (int j = 0; j < 4; ++j) { const int n = (lane >> 3) + 8 * j; const LAS float* s = scr + (8 * c) * 33 + n;
        u32x4 o; o.x = pk2(s[0 * 33], s[1 * 33]); o.y = pk2(s[2 * 33], s[3 * 33]); o.z = pk2(s[4 * 33], s[5 * 33]); o.w = pk2(s[6 * 33], s[7 * 33]);
        *(u32x4*)(WT + (size_t)rowmap(n0 + n) * K + k0 + 8 * c) = o; }
    LDS_WAIT(); asm volatile("" ::: "memory");
}
template <class RowMap>
__device__ __forceinline__ void p0_transpose_item_f8(const float* W, int K, int N, unsigned char* WT, LAS float* scr, int item, int lane, const RowMap& rowmap, float scale) {
    const int nblk = N / 32, kb = item / nblk, nb = item % nblk, k0 = 64 * kb, n0 = 32 * nb;
    float ld_[32];
#pragma unroll
    for (int i = 0; i < 32; ++i) ld_[i] = __builtin_nontemporal_load(&W[(size_t)(k0 + 2 * i + (lane >> 5)) * N + n0 + (lane & 31)]);
#pragma unroll
    for (int i = 0; i < 32; ++i) scr[(2 * i + (lane >> 5)) * 33 + (lane & 31)] = ld_[i];
    LDS_WAIT(); asm volatile("" ::: "memory");
#pragma unroll
    for (int j = 0; j < 2; ++j) { const int p = lane + 64 * j, n = p >> 2, c = p & 3; const LAS float* s = scr + (16 * c) * 33 + n;
        u32x4 o;
        o.x = pk4_fp8(s[0 * 33] * scale, s[1 * 33] * scale, s[2 * 33] * scale, s[3 * 33] * scale);
        o.y = pk4_fp8(s[4 * 33] * scale, s[5 * 33] * scale, s[6 * 33] * scale, s[7 * 33] * scale);
        o.z = pk4_fp8(s[8 * 33] * scale, s[9 * 33] * scale, s[10 * 33] * scale, s[11 * 33] * scale);
        o.w = pk4_fp8(s[12 * 33] * scale, s[13 * 33] * scale, s[14 * 33] * scale, s[15 * 33] * scale);
        *(u32x4*)(WT + (size_t)rowmap(n0 + n) * K + k0 + 16 * c) = o; }
    LDS_WAIT(); asm volatile("" ::: "memory");
}
struct RowId { __device__ __forceinline__ int operator()(int n) const { return n; } };
struct RowIn { __device__ __forceinline__ int operator()(int n) const { if (n < 1536) return n; const int oc = n & 255; return (n & ~255) + 128 * ((oc >> 5) & 1) + 32 * (oc >> 6) + (oc & 31); } };
struct RowGate { __device__ __forceinline__ int operator()(int n) const { const int g = n - NQKV, c = g & 1023; return 768 + (c >> 7) * 256 + (g >> 10) * 128 + (c & 127); } };
struct RowAll8 { __device__ __forceinline__ int operator()(int n) const { if (n < NQKV) return RowIn{}(n); const int g = n - NQKV, c = g & 1023; return NQKV + (c >> 7) * 256 + (g >> 10) * 128 + (c & 127); } };
struct RowHead8 { __device__ __forceinline__ int operator()(int n) const { return RowIn{}(n) - 1536; } };
struct RowGU { int up; __device__ __forceinline__ int operator()(int f) const { return (f >> 7) * 256 + up * 128 + (f & 127); } };

struct CvDesc { const float* W; unsigned char* WT; int K, N, k0, n0, gu, up; };
__device__ __forceinline__ CvDesc cv_decode(int r, const float* w_eg, const float* w_eu, const float* w_ed, unsigned char* WGU, unsigned char* WD) {
    constexpr int I_GU = 16 * 64, I_D = 32 * 32;
    CvDesc d; const int e = r / (2 * I_GU + I_D); int q = r - e * (2 * I_GU + I_D);
    if (q < 2 * I_GU) { d.up = q >= I_GU; q -= d.up * I_GU; d.W = (d.up ? w_eu : w_eg) + (size_t)e * 1024 * 2048; d.WT = WGU + (size_t)e * 4096 * 1024; d.K = 1024; d.N = 2048; d.gu = 1; }
    else { q -= 2 * I_GU; d.W = w_ed + (size_t)e * 2048 * 1024; d.WT = WD + (size_t)e * 1024 * 2048; d.K = 2048; d.N = 1024; d.gu = 0; d.up = 0; }
    const int nblk = d.N / 32; d.k0 = 64 * (q / nblk); d.n0 = 32 * (q % nblk);
    return d;
}
#define CV_LOAD(ld_, d_) do { _Pragma("unroll") for (int i_ = 0; i_ < 32; ++i_) ld_[i_] = __builtin_nontemporal_load(&(d_).W[(size_t)((d_).k0 + 2 * i_ + (lane >> 5)) * (d_).N + (d_).n0 + (lane & 31)]); } while (0)
#define CV_FINISH(ld_, d_) do { _Pragma("unroll") for (int i_ = 0; i_ < 32; ++i_) scr[(2 * i_ + (lane >> 5)) * 33 + (lane & 31)] = ld_[i_]; \
        LDS_WAIT(); asm volatile("" ::: "memory"); \
        _Pragma("unroll") for (int j_ = 0; j_ < 2; ++j_) { const int p_ = lane + 64 * j_, n_ = p_ >> 2, c_ = p_ & 3; const LAS float* s_ = scr + (16 * c_) * 33 + n_; const int f_ = (d_).n0 + n_; \
            const int row_ = (d_).gu ? ((f_ >> 7) * 256 + (d_).up * 128 + (f_ & 127)) : f_; u32x4 o_; \
            o_.x = pk4_fp8(s_[0 * 33] * F8_SC_W, s_[1 * 33] * F8_SC_W, s_[2 * 33] * F8_SC_W, s_[3 * 33] * F8_SC_W); \
            o_.y = pk4_fp8(s_[4 * 33] * F8_SC_W, s_[5 * 33] * F8_SC_W, s_[6 * 33] * F8_SC_W, s_[7 * 33] * F8_SC_W); \
            o_.z = pk4_fp8(s_[8 * 33] * F8_SC_W, s_[9 * 33] * F8_SC_W, s_[10 * 33] * F8_SC_W, s_[11 * 33] * F8_SC_W); \
            o_.w = pk4_fp8(s_[12 * 33] * F8_SC_W, s_[13 * 33] * F8_SC_W, s_[14 * 33] * F8_SC_W, s_[15 * 33] * F8_SC_W); \
            *(u32x4*)((d_).WT + (size_t)row_ * (d_).K + (d_).k0 + 16 * c_) = o_; } \
        LDS_WAIT(); asm volatile("" ::: "memory"); } while (0)
__device__ __forceinline__ void conv_experts_pipelined(int first, int end, int step, int lane, LAS float* scr, const float* w_eg, const float* w_eu, const float* w_ed, unsigned char* WGU, unsigned char* WD) {
    float ldA[32], ldB[32]; CvDesc dA, dB; int itA = first, itB = first + step;
    if (itA < end) { dA = cv_decode(itA, w_eg, w_eu, w_ed, WGU, WD); CV_LOAD(ldA, dA); }
    if (itB < end) { dB = cv_decode(itB, w_eg, w_eu, w_ed, WGU, WD); CV_LOAD(ldB, dB); }
    for (;;) {
        if (itA >= end) break;
        CV_FINISH(ldA, dA); itA += 2 * step;
        if (itA < end) { dA = cv_decode(itA, w_eg, w_eu, w_ed, WGU, WD); CV_LOAD(ldA, dA); }
        if (itB >= end) break;
        CV_FINISH(ldB, dB); itB += 2 * step;
        if (itB < end) { dB = cv_decode(itB, w_eg, w_eu, w_ed, WGU, WD); CV_LOAD(ldB, dB); }
    }
}
#undef CV_LOAD
#undef CV_FINISH

__constant__ float INV_FREQ[16] = {1.0f, 0.5623413251903491f, 0.31622776601683794f, 0.1778279410038923f, 0.1f, 0.05623413251903491f, 0.03162277660168379f, 0.01778279410038923f,
                                   0.01f, 0.005623413251903491f, 0.0031622776601683794f, 0.001778279410038923f, 0.001f, 0.0005623413251903491f, 0.00031622776601683794f, 0.0001778279410038923f};

struct Args { const float* in[18]; float* out; unsigned char* ws; int ph_lo, ph_hi, li, pad; };
constexpr int NPHASE = 12;

__global__ void __launch_bounds__(512, 2) mk_fwd(Args args) {
    extern __shared__ __attribute__((aligned(16))) unsigned char lds_raw[];
    LAS unsigned char* lds = (LAS unsigned char*)lds_raw;
    volatile LAS unsigned* MISC = (volatile LAS unsigned*)(lds + MISC_OFF);
    const int G = gridDim.x; const int bx = blockIdx.x; const int vcu = (G % 8 == 0) ? (bx % 8) * (G / 8) + bx / 8 : bx;
    const int NGW = G * 8;
#define PH_IDS() const int tid = fresh_tid(), lane = tid & 63, wave = __builtin_amdgcn_readfirstlane(tid >> 6), gw = vcu * 8 + wave; (void)lane; (void)gw
    constexpr int I_IN = 16 * 136, I_BR = 8 * 32, I_OUT = 16 * 32, I_GU = 16 * 64, I_D = 32 * 32;
    constexpr int N_SMALL_ITEMS = I_IN + 2 * I_BR + I_OUT, N_EXP_ITEMS = 16 * (2 * I_GU + I_D);
#define CONV_ITEM(it_) do { LAS float* scr_ = (LAS float*)(lds + RING_OFF + wave * 16384); int r_ = (it_); \
        if (r_ < I_IN) { p0_transpose_item_f8(w_in, 1024, NIN, WG8, scr_, r_, lane, RowAll8{}, F8_SC_W); break; } r_ -= I_IN; \
        if (r_ < I_BR) { p0_transpose_item(w_bna, 512, 1024, WA, scr_, r_, lane, RowId{}); break; } r_ -= I_BR; \
        if (r_ < I_BR) { p0_transpose_item(w_bgqa, 512, 1024, WB, scr_, r_, lane, RowId{}); break; } r_ -= I_BR; \
        if (r_ < I_OUT) { p0_transpose_item(w_out, 1024, 1024, WOUT, scr_, r_, lane, RowId{}); break; } r_ -= I_OUT; \
        const int e_ = r_ / (2 * I_GU + I_D); r_ -= e_ * (2 * I_GU + I_D); \
        if (r_ < I_GU) { p0_transpose_item_f8(w_eg + (size_t)e_ * 1024 * 2048, 1024, 2048, (unsigned char*)WGU + (size_t)e_ * 4096 * 1024, scr_, r_, lane, RowGU{0}, F8_SC_W); break; } r_ -= I_GU; \
        if (r_ < I_GU) { p0_transpose_item_f8(w_eu + (size_t)e_ * 1024 * 2048, 1024, 2048, (unsigned char*)WGU + (size_t)e_ * 4096 * 1024, scr_, r_, lane, RowGU{1}, F8_SC_W); break; } r_ -= I_GU; \
        p0_transpose_item_f8(w_ed + (size_t)e_ * 2048 * 1024, 2048, 1024, (unsigned char*)WD + (size_t)e_ * 1024 * 2048, scr_, r_, lane, RowId{}, F8_SC_W); } while (0)
    unsigned char* ws = args.ws;
    const float* x = args.in[0]; const float* cvec = args.in[1]; const float* w_ada = args.in[2]; const float* b_ada = args.in[3]; const float* norm1_g = args.in[4];
    const float* w_in = args.in[5]; const float* q_norm_g = args.in[6]; const float* k_norm_g = args.in[7]; const float* na_rpb = args.in[8];
    const float* w_bna = args.in[9]; const float* w_bgqa = args.in[10]; const float* w_out = args.in[11]; const float* norm2_g = args.in[12]; const float* w_router = args.in[13];
    const float* w_eg = args.in[14]; const float* w_eu = args.in[15]; const float* w_ed = args.in[16]; const float* final_g = args.in[17];
    float* out = args.out;
    unsigned* ctl = (unsigned*)(ws + WS_CTL);
    float* MOD = (float*)(ws + WS_MOD); int* IDX = (int*)(ws + WS_IDX); float* GSEL = (float*)(ws + WS_GSEL); float* AFF = (float*)(ws + WS_AFF); int* SLOT = (int*)(ws + WS_SLOT);
    bf16_t* WIN = (bf16_t*)(ws + WS_WIN); bf16_t* WA = (bf16_t*)(ws + WS_WA); bf16_t* WB = (bf16_t*)(ws + WS_WB); bf16_t* WOUT = (bf16_t*)(ws + WS_WOUT);
    bf16_t* WGU = (bf16_t*)(ws + WS_WGU); bf16_t* WD = (bf16_t*)(ws + WS_WD);
    bf16_t* HB = (bf16_t*)(ws + WS_H); bf16_t* QKV = (bf16_t*)(ws + WS_QKV);
    bf16_t* GA = (bf16_t*)(ws + WS_GATES); unsigned char* R8 = ws + WS_GATES + 64 * MiB; unsigned char* H8 = ws + WS_GATES + 96 * MiB; unsigned char* WG8 = ws + WS_WIN;
    unsigned char* Q8 = ws + WS_WGU + 64 * MiB; unsigned char* K8 = ws + WS_WGU + 80 * MiB; unsigned char* V8T = ws + WS_WGU + 84 * MiB;
    bf16_t* DELTA = (bf16_t*)(ws + WS_GATES);
    bf16_t* MERGED = (bf16_t*)(ws + WS_QKV); bf16_t* HMID = (bf16_t*)(ws + WS_QKV); bf16_t* YBUF = (bf16_t*)(ws + WS_YBUF);

    { PH_IDS(); for (int u = tid; u < (LDS_BYTES - LDSCTL_OFF) / 4; u += 512) ((LAS unsigned*)(lds + LDSCTL_OFF))[u] = 0u; }
    __syncthreads();
    const bool use_bar = (MK_N_LAUNCHES != NPHASE);
    XcdBarrier bar; bar.bar = ctl + CW_BAR + args.li * XCD_BAR_WORDS; bar.x = 0; bar.st = nullptr;
    if (use_bar) bar = xcd_barrier_post(ctl + CW_BAR + args.li * XCD_BAR_WORDS, MISC + 8);
    const int lo = args.ph_lo, hi = args.ph_hi;
#ifndef PHASE_MASK
#define PHASE_MASK 0xFFF
#endif
#define IN(k) (((PHASE_MASK >> (k)) & 1) && lo <= (k) && (k) < hi)
#define SEAM(k) do { if (IN(k) && IN((k) + 1)) xcd_barrier(bar); } while (0)

    if (IN(0)) {
        PH_IDS();
        LAS float* scr = (LAS float*)(lds + RING_OFF + wave * 16384);
        if (vcu < 96) {
            LAS float* sl = (LAS float*)(lds + RING_OFF);
            for (int i = tid; i < 4096; i += 512) { const float cv = cvec[i]; sl[i] = cv * sigmoidf_fast(cv); }
            __syncthreads();
        }
        for (int it = vcu; it < 96; it += G) {
            const LAS float* sl = (const LAS float*)(lds + RING_OFF);
            const int col = it * 64 + lane; float a0 = 0.f, a1 = 0.f, a2 = 0.f, a3 = 0.f;
#pragma unroll 16
            for (int dd = 0; dd < 128; ++dd) { const int d = wave * 128 + dd; const float w = w_ada[(size_t)d * 6144 + col];
                a0 += sl[d] * w; a1 += sl[1024 + d] * w; a2 += sl[2048 + d] * w; a3 += sl[3072 + d] * w; }
            LAS float* part = (LAS float*)(lds + RING_OFF + 8 * 16384 - 8192);
            part[(wave * 4 + 0) * 64 + lane] = a0; part[(wave * 4 + 1) * 64 + lane] = a1; part[(wave * 4 + 2) * 64 + lane] = a2; part[(wave * 4 + 3) * 64 + lane] = a3;
            __syncthreads();
            if (tid < 256) { const int bb = tid >> 6, l = tid & 63; float s = 0.f;
#pragma unroll
                for (int w = 0; w < 8; ++w) s += part[(w * 4 + bb) * 64 + l];
                MOD[bb * 6144 + it * 64 + l] = s + b_ada[it * 64 + l]; }
            __syncthreads();
        }
        for (int it = gw; it < N_SMALL_ITEMS; it += NGW) { CONV_ITEM(it); }
    }
    SEAM(0);

    if (IN(1)) {
        PH_IDS();
        f32x4 gnv[4], nx[4];
#pragma unroll
        for (int j = 0; j < 4; ++j) { gnv[j] = *(const f32x4*)(norm1_g + 4 * lane + 256 * j); nx[j] = __builtin_nontemporal_load((const f32x4*)(x + (size_t)gw * DMODEL) + lane + 64 * j); }
        for (int m = gw; m < MT; m += NGW) { const int b = m >> 13; const float* mb = MOD + b * 6144;
            f32x4 v[4], scv[4], shv[4]; float s = 0.f;
#pragma unroll
            for (int j = 0; j < 4; ++j) { v[j] = nx[j]; scv[j] = *(const f32x4*)(mb + 1024 + 4 * lane + 256 * j); shv[j] = *(const f32x4*)(mb + 4 * lane + 256 * j); }
            const int mn = (m + NGW < MT) ? m + NGW : m;
#pragma unroll
            for (int j = 0; j < 4; ++j) nx[j] = __builtin_nontemporal_load((const f32x4*)(x + (size_t)mn * DMODEL) + lane + 64 * j);
#pragma unroll
            for (int j = 0; j < 4; ++j) s += (v[j].x * v[j].x + v[j].y * v[j].y) + (v[j].z * v[j].z + v[j].w * v[j].w);
            const float rinv = __builtin_amdgcn_rsqf(wave_sum(s) * (1.f / DMODEL) + EPS);
#pragma unroll
            for (int j = 0; j < 4; ++j) {
                const f32x4 hv = v[j] * rinv * gnv[j] * (scv[j] + 1.0f) + shv[j];
                ((unsigned*)(H8 + (size_t)m * DMODEL) + lane)[64 * j] = pk4_fp8(hv.x * F8_SC_H2, hv.y * F8_SC_H2, hv.z * F8_SC_H2, hv.w * F8_SC_H2); }
        }
    }
    SEAM(1);

#define ATTN_BOUND() float smaxp; { const int l_ = fresh_tid() & 63; float mq_ = fabsf(q_norm_g[l_]), mk_ = fabsf(k_norm_g[l_]); \
        _Pragma("unroll") for (int o_ = 1; o_ < 64; o_ <<= 1) { mq_ = fmaxf(mq_, __shfl_xor(mq_, o_)); mk_ = fmaxf(mk_, __shfl_xor(mk_, o_)); } smaxp = LOG2E * 8.0f * mq_ * mk_; } \
        const bool fast = __builtin_amdgcn_readfirstlane((int)(smaxp <= 24.0f)) != 0
    if (IN(2)) {
        ATTN_BOUND();
        { pg8::SchedPlain S; S.init(MT, NIN, G, bx, H8, DMODEL, WG8, DMODEL);
          pg8::EpiHeadGate E{pg8::EpiProj{QKV, Q8, K8, V8T, q_norm_g, k_norm_g, !fast}, pg8::EpiGate{GA, R8}};
          pg8::gemm_phase<true>(lds + RING_OFF, 8, S, E); }
    }
    SEAM(2);


    if (IN(4)) {
        PH_IDS();
#define CONV_EXPERTS() do { conv_experts_pipelined(gw, N_EXP_ITEMS, NGW, lane, (LAS float*)(lds + RING_OFF + wave * 16384), w_eg, w_eu, w_ed, (unsigned char*)WGU, (unsigned char*)WD); __syncthreads(); } while (0)
        const int cls = vcu & 3;
        if (cls == 0) CONV_EXPERTS();
        if (G == 256) na_body::na_phase(lds + RING_OFF, (LAS float*)(lds + NABIAS_OFF), (LAS float*)(lds + NAXCH_OFF), QKV, HB, na_rpb, vcu);
        if (cls == 1) CONV_EXPERTS();
        static_assert(attn_body::ATTN_LDS_BYTES <= RING_BYTES, "attention LDS");
        ATTN_BOUND(); const float shiftv = fmaxf(smaxp - 8.0f, 0.0f);
        for (int i = 0; i < 4; ++i) { const long L = (long)i * G + vcu; if (L >= 1024) break;
            if ((cls == 2 && i == 1) || (cls == 3 && i == 2)) { PH_IDS(); CONV_EXPERTS(); }
            const int ii = (int)(L >> 8), v = (int)(L & 255), bh = v >> 3, qb = (v & 7) * 4 + ii, b = bh >> 3, h = bh & 7;
            const attn_body::bf16* base = (const attn_body::bf16*)QKV + (size_t)b * SEQ * NQKV;
            if (fast) attn_body::attn_unit_f8(qb, Q8 + (size_t)b * SEQ * 512 + h * 64, K8 + (size_t)b * SEQ * 128 + (h >> 2) * 64, V8T + (size_t)(b * 2 + (h >> 2)) * 64 * SEQ,
                                    (attn_body::bf16*)HB + (size_t)b * SEQ * DMODEL + 512 + h * 64, (char*)lds_raw + RING_OFF, shiftv);
            else attn_body::attn_unit<8>(qb, base + C_QG + h * 64, base + C_KG + (h >> 2) * 64, base + C_VG + (h >> 2) * 64,
                                    (attn_body::bf16*)HB + (size_t)b * SEQ * DMODEL + 512 + h * 64, (char*)lds_raw + RING_OFF); }
#undef CONV_EXPERTS
    }
    SEAM(4);

    if (IN(5)) {
        pg8::SchedPlain S; S.init(MT, DMODEL, G, bx, HB + 512, DMODEL * 2, WB, 512 * 2); S.A2 = (const char*)HB; S.B2 = (const char*)WA; S.nt1 = 8;
        pg8::EpiMerge E{MERGED, GA, R8};
        pg8::gemm_phase<false, pg8::EpiMerge, pg8::SchedPlain, true>(lds + RING_OFF, 16, S, E);
    }
    SEAM(5);

    if (IN(6)) {
        pg8::SchedPlain S; S.init(MT, DMODEL, G, bx, MERGED, DMODEL * 2, WOUT, DMODEL * 2);
        pg8::EpiDelta E{DELTA, MOD};
        pg8::gemm_phase<false>(lds + RING_OFF, 16, S, E);
    }
    SEAM(6);

    if (IN(7)) {
        PH_IDS();
        f32x4 nv[2][4]; u32x2 nd[2][4];
#define P7_LOADX(row_) do { const f32x4* p_ = (const f32x4*)(x + (size_t)(row_) * DMODEL) + lane; const u32x2* d_ = (const u32x2*)(DELTA + (size_t)(row_) * DMODEL) + lane; \
            _Pragma("unroll") for (int j_ = 0; j_ < 4; ++j_) { nv[0][j_] = __builtin_nontemporal_load(&p_[64 * j_]); nv[1][j_] = __builtin_nontemporal_load(&p_[256 + 64 * j_]); \
                nd[0][j_] = d_[64 * j_]; nd[1][j_] = d_[256 + 64 * j_]; } } while (0)
        P7_LOADX(gw * 2);
        LAS float* wr = (LAS float*)(lds + RING_OFF);
        for (int i = tid; i < 16384; i += 512) { const int d = i >> 4, e = i & 15; wr[e * 1024 + d] = w_router[i]; }
        __syncthreads();
        for (int m = gw * 2; m < MT; m += NGW * 2) { const int b = m >> 13; const float* mb = MOD + b * 6144;
            f32x4 v[2][4], gnv[4], scv[4], shv[4]; float s0 = 0.f, s1 = 0.f;
            const int mn = (m + NGW * 2 < MT) ? m + NGW * 2 : m;
#pragma unroll
            for (int j = 0; j < 4; ++j) { const int col = 4 * lane + 256 * j;
#pragma unroll
                for (int r = 0; r < 2; ++r) { const u32x2 dd = nd[r][j]; v[r][j] = nv[r][j] + (f32x4){bf_lo(dd.x), bf_hi(dd.x), bf_lo(dd.y), bf_hi(dd.y)}; }
                gnv[j] = *(const f32x4*)(norm2_g + col); scv[j] = *(const f32x4*)(mb + 4096 + col); shv[j] = *(const f32x4*)(mb + 3072 + col); }
            P7_LOADX(mn);
            asm volatile("" ::: "memory");
#pragma unroll
            for (int j = 0; j < 4; ++j) {
                s0 += (v[0][j].x * v[0][j].x + v[0][j].y * v[0][j].y) + (v[0][j].z * v[0][j].z + v[0][j].w * v[0][j].w);
                s1 += (v[1][j].x * v[1][j].x + v[1][j].y * v[1][j].y) + (v[1][j].z * v[1][j].z + v[1][j].w * v[1][j].w); }
            s0 = wave_sum(s0); s1 = wave_sum(s1);
            const float rinv0 = __builtin_amdgcn_rsqf(s0 * (1.f / DMODEL) + EPS), rinv1 = __builtin_amdgcn_rsqf(s1 * (1.f / DMODEL) + EPS);
#pragma unroll
            for (int j = 0; j < 4; ++j) {
                const f32x4 a = gnv[j] * (scv[j] + 1.0f);
                v[0][j] = v[0][j] * rinv0 * a + shv[j]; v[1][j] = v[1][j] * rinv1 * a + shv[j];
                ((unsigned*)((unsigned char*)HB + (size_t)m * DMODEL) + lane)[64 * j] = pk4_fp8(v[0][j].x * F8_SC_H2, v[0][j].y * F8_SC_H2, v[0][j].z * F8_SC_H2, v[0][j].w * F8_SC_H2);
                ((unsigned*)((unsigned char*)HB + (size_t)(m + 1) * DMODEL) + lane)[64 * j] = pk4_fp8(v[1][j].x * F8_SC_H2, v[1][j].y * F8_SC_H2, v[1][j].z * F8_SC_H2, v[1][j].w * F8_SC_H2); }
            float pr[32];
#pragma unroll
            for (int e = 0; e < 16; ++e) { float a0 = 0.f, a1 = 0.f;
#pragma unroll
                for (int j = 0; j < 4; ++j) { const f32x4 w = *(const LAS f32x4*)(wr + e * 1024 + 4 * lane + 256 * j);
                    a0 += (v[0][j].x * w.x + v[0][j].y * w.y) + (v[0][j].z * w.z + v[0][j].w * w.w);
                    a1 += (v[1][j].x * w.x + v[1][j].y * w.y) + (v[1][j].z * w.z + v[1][j].w * w.w); }
                pr[e] = a0; pr[16 + e] = a1; if ((e & 3) == 3) asm volatile("" ::: "memory"); }
            float q16[16], q8[8];
#pragma unroll
            for (int i = 0; i < 16; ++i) q16[i] = swap32_sum(pr[i], pr[i + 16]);
#pragma unroll
            for (int i = 0; i < 8; ++i) q8[i] = swap16_sum(q16[i], q16[i + 8]);
            const bool up8 = (lane & 8) != 0, up4 = (lane & 4) != 0, up2 = (lane & 2) != 0;
            float q4[4], q2[2];
#pragma unroll
            for (int i = 0; i < 4; ++i) { float lo = q8[i], hi = q8[i + 4]; asm volatile("" : "+v"(lo), "+v"(hi)); q4[i] = (up8 ? hi : lo) + dppf<DPP_XOR8>(up8 ? lo : hi); }
#pragma unroll
            for (int i = 0; i < 2; ++i) { float lo = q4[i], hi = q4[i + 2]; asm volatile("" : "+v"(lo), "+v"(hi)); q2[i] = (up4 ? hi : lo) + lane_xor4(up4 ? lo : hi); }
            float mylog;
            { float lo = q2[0], hi = q2[1]; asm volatile("" : "+v"(lo), "+v"(hi)); mylog = (up2 ? hi : lo) + dppf<DPP_XOR2>(up2 ? lo : hi); }
            mylog += dppf<DPP_XOR1>(mylog);
            float mx = mylog;
            mx = fmaxf(mx, dppf<DPP_XOR2>(mx)); mx = fmaxf(mx, lane_xor4(mx)); mx = fmaxf(mx, dppf<DPP_XOR8>(mx)); mx = swap16_max(mx);
            const float ex = __expf(mylog - mx); float sum = ex;
            sum += dppf<DPP_XOR2>(sum); sum += lane_xor4(sum); sum += dppf<DPP_XOR8>(sum); sum = swap16_sum(sum, sum);
            if ((lane & 1) == 0) AFF[(unsigned)(m + (lane >> 5)) * 16u + (unsigned)((lane >> 1) & 15)] = ex * __builtin_amdgcn_rcpf(sum);
        }
#undef P7_LOADX
        __syncthreads();
    }
    SEAM(7);

    if (IN(8)) {
        PH_IDS();
        LAS unsigned* vals = (LAS unsigned*)(lds + RING_OFF);
        LAS unsigned* hist = (LAS unsigned*)(lds + RING_OFF + 32768);
        LAS unsigned* sel = (LAS unsigned*)(lds + RING_OFF + 32768 + 1024);
        LAS unsigned* wtot = (LAS unsigned*)(lds + RING_OFF + 32768 + 2048);
        for (int item = vcu; item < 64; item += G) { const int b = item >> 4, e = item & 15;
            __syncthreads();
            for (int k = 0; k < 16; ++k) { const int t = tid + 512 * k; vals[t] = __builtin_bit_cast(unsigned, AFF[((size_t)b * SEQ + t) * 16 + e]); }
            __syncthreads();
            unsigned mv[16];
#pragma unroll
            for (int k = 0; k < 16; ++k) mv[k] = vals[tid + 512 * k];
            unsigned T = 0u;
            for (int bit = 30; bit >= 0; --bit) { const unsigned cand = T | (1u << bit);
                unsigned c = 0u;
#pragma unroll
                for (int k = 0; k < 16; ++k) c += (unsigned)__popcll(__ballot(mv[k] >= cand));
                if (lane == 0) wtot[(bit & 1) * 8 + wave] = c;
                __syncthreads();
                unsigned tot = 0u;
#pragma unroll
                for (int w = 0; w < 8; ++w) tot += wtot[(bit & 1) * 8 + w];
                if (tot >= (unsigned)CAP) T = cand; }
            unsigned cgt = 0u;
#pragma unroll
            for (int k = 0; k < 16; ++k) cgt += (unsigned)__popcll(__ballot(mv[k] > T));
            __syncthreads();
            if (lane == 0) wtot[wave] = cgt;
            __syncthreads();
            unsigned ngt = 0u;
#pragma unroll
            for (int w = 0; w < 8; ++w) ngt += wtot[w];
            const unsigned need_eq = (unsigned)CAP - ngt;
            __syncthreads();
            unsigned cg = 0u, ce = 0u;
            for (int k = 0; k < 16; ++k) { const unsigned v = vals[16 * tid + k]; cg += (v > T) ? 1u : 0u; ce += (v == T) ? 1u : 0u; }
            unsigned packed = cg | (ce << 16), incl = packed;
#pragma unroll
            for (int o = 1; o < 64; o <<= 1) { const unsigned n = __shfl_up(incl, o); if (lane >= o) incl += n; }
            if (lane == 63) wtot[wave] = incl;
            __syncthreads();
            unsigned wbase = 0u;
            for (int w = 0; w < wave; ++w) wbase += wtot[w];
            const unsigned excl = wbase + incl - packed;
            unsigned g_before = excl & 0xffffu, e_before = excl >> 16;
            for (int k = 0; k < 16; ++k) { const int t = 16 * tid + k; const unsigned v = vals[t]; int slot = -1;
                if (v > T) { slot = (int)(g_before + (e_before < need_eq ? e_before : need_eq)); ++g_before; }
                else if (v == T) { if (e_before < need_eq) slot = (int)(g_before + e_before); ++e_before; }
                SLOT[((size_t)b * SEQ + t) * 16 + e] = slot;
                if (slot >= 0) { IDX[item * CAP + slot] = t; GSEL[item * CAP + slot] = __builtin_bit_cast(float, v); } }
        }
        __syncthreads();
    }
    SEAM(8);

    if (IN(9)) {
        pg8::SchedFfn1 S{G, vcu, (const char*)HB, (const char*)WGU, IDX, DMODEL, DMODEL};
        pg8::EpiFfn1 E{(unsigned char*)HMID};
        pg8::gemm_phase<true>(lds + RING_OFF, 8, S, E);
    }
    SEAM(9);

    if (IN(10)) {
        pg8::SchedFfn2 S{G, vcu, (const char*)HMID, (const char*)WD, FF, FF};
        pg8::EpiFfn2 E{(unsigned char*)YBUF, GSEL};
        pg8::gemm_phase<true>(lds + RING_OFF, 16, S, E);
    }
    SEAM(10);

    if (IN(11)) {
        PH_IDS();
        f32x4 fgv[4];
#pragma unroll
        for (int j = 0; j < 4; ++j) fgv[j] = *(const f32x4*)(final_g + 4 * lane + 256 * j);
        f32x4 nx[4]; u32x2 ndl[4]; int nsl;
#define P11_LOADX(row_) do { const f32x4* p_ = (const f32x4*)(x + (size_t)(row_) * DMODEL) + lane; const u32x2* d_ = (const u32x2*)(DELTA + (size_t)(row_) * DMODEL) + lane; \
            _Pragma("unroll") for (int j_ = 0; j_ < 4; ++j_) { nx[j_] = __builtin_nontemporal_load(&p_[64 * j_]); ndl[j_] = __builtin_nontemporal_load(&d_[64 * j_]); } \
            nsl = (lane < 16) ? SLOT[(size_t)(row_) * 16 + lane] : -1; } while (0)
#define P11_ISSUE() do { _Pragma("unroll") for (int k_ = 0; k_ < 4; ++k_) { if (mask) { const int e_ = __builtin_ctz(mask); mask &= mask - 1u; const int s_ = __builtin_amdgcn_readlane(sl, e_); \
                const unsigned* yr_ = (const unsigned*)((const unsigned char*)YBUF + ((size_t)(b * 16 + e_) * CAP + s_) * DMODEL) + lane; _Pragma("unroll") for (int j_ = 0; j_ < 4; ++j_) y[k_][j_] = __builtin_nontemporal_load(&yr_[64 * j_]); } \
            else { _Pragma("unroll") for (int j_ = 0; j_ < 4; ++j_) y[k_][j_] = 0u; } } } while (0)
#define P11_ACC() do { _Pragma("unroll") for (int k_ = 0; k_ < 4; ++k_) _Pragma("unroll") for (int j_ = 0; j_ < 4; ++j_) { const unsigned w_ = y[k_][j_]; \
            const auto lo_ = __builtin_amdgcn_cvt_pk_f32_fp8((int)w_, false), hi_ = __builtin_amdgcn_cvt_pk_f32_fp8((int)w_, true); a[j_].x += lo_[0]; a[j_].y += lo_[1]; a[j_].z += hi_[0]; a[j_].w += hi_[1]; } } while (0)
        P11_LOADX(gw);
        for (int m = gw; m < MT; m += NGW) { const int b = m >> 13; const float* g2 = MOD + b * 6144 + 5120;
            f32x4 v[4], a[4], g2v[4]; const int sl = nsl;
#pragma unroll
            for (int j = 0; j < 4; ++j) { const u32x2 dd = ndl[j]; v[j] = nx[j] + (f32x4){bf_lo(dd.x), bf_hi(dd.x), bf_lo(dd.y), bf_hi(dd.y)}; a[j] = (f32x4){0.f, 0.f, 0.f, 0.f}; g2v[j] = *(const f32x4*)(g2 + 4 * lane + 256 * j) * (1.0f / F8_SC_Y); }
            unsigned mask = (unsigned)__ballot(sl >= 0) & 0xFFFFu;
            const int mn = (m + NGW < MT) ? m + NGW : m;
            unsigned y[4][4];
            P11_ISSUE();
            P11_LOADX(mn);
            P11_ACC();
            while (mask) { P11_ISSUE(); P11_ACC(); }
            float s2 = 0.f;
#pragma unroll
            for (int j = 0; j < 4; ++j) { v[j] = v[j] + g2v[j] * a[j]; s2 += (v[j].x * v[j].x + v[j].y * v[j].y) + (v[j].z * v[j].z + v[j].w * v[j].w); }
            const float rinv = __builtin_amdgcn_rsqf(wave_sum(s2) * (1.f / DMODEL) + EPS);
            f32x4* xr = (f32x4*)(out + (size_t)m * DMODEL) + lane;
#pragma unroll
            for (int j = 0; j < 4; ++j) __builtin_nontemporal_store(v[j] * rinv * fgv[j], &xr[64 * j]);
        }
#undef P11_LOADX
#undef P11_ISSUE
#undef P11_ACC
    }
#undef IN
#undef SEAM
}

extern "C" void kernel_launch(void* const* d_in, const int* in_sizes, int n_in, void* d_out, int out_size, void* d_ws, size_t ws_size, hipStream_t stream) {
    static int grid = 0;
    if (grid == 0) {
        if (n_in != 18 || in_sizes[0] != MT * DMODEL || out_size != MT * DMODEL || ws_size < WS_END) {
            fprintf(stderr, "kernel_launch: unexpected shapes / workspace: n_in %d in0 %d out %d ws %zu (need %zu); nothing launched\n", n_in, n_in > 0 ? in_sizes[0] : -1, out_size, ws_size, (size_t)WS_END); grid = -1; return; }
        int dev = 0, cus = 0, per_cu = 0;
        if (hipGetDevice(&dev) != hipSuccess || hipDeviceGetAttribute(&cus, hipDeviceAttributeMultiprocessorCount, dev) != hipSuccess) { grid = -1; return; }
        if (hipFuncSetAttribute((const void*)mk_fwd, hipFuncAttributeMaxDynamicSharedMemorySize, LDS_BYTES) != hipSuccess) { fprintf(stderr, "kernel_launch: hipFuncSetAttribute failed\n"); grid = -1; return; }
        if (hipOccupancyMaxActiveBlocksPerMultiprocessor(&per_cu, (const void*)mk_fwd, 512, LDS_BYTES) != hipSuccess || per_cu < 1) fprintf(stderr, "kernel_launch: occupancy query reports %d\n", per_cu);
        (void)hipGetLastError();
        grid = cus;
        if (grid != 256) fprintf(stderr, "kernel_launch: %d CUs (expected 256)\n", grid);
    }
    if (grid < 0) return;
    if (hipMemsetAsync((char*)d_ws + WS_CTL, 0, CTL_ZERO_BYTES, stream) != hipSuccess) return;
    Args a{};
    for (int i = 0; i < 18; ++i) a.in[i] = (const float*)d_in[i];
    a.out = (float*)d_out; a.ws = (unsigned char*)d_ws;
#ifndef PROBE_DUP
#define PROBE_DUP -1
#endif
    constexpr int NL = (PROBE_DUP >= 0) ? 2 : MK_N_LAUNCHES;
    for (int li = 0; li < NL; ++li) {
        if (PROBE_DUP >= 0) { a.ph_lo = li == 0 ? 0 : PROBE_DUP; a.ph_hi = li == 0 ? PROBE_DUP + 1 : NPHASE; }
        else { a.ph_lo = (NL == NPHASE) ? li : (li * NPHASE) / NL; a.ph_hi = (NL == NPHASE) ? li + 1 : ((li + 1) * NPHASE) / NL; }
        a.li = li; a.pad = 0;
        hipLaunchKernelGGL(mk_fwd, dim3(grid), dim3(512), LDS_BYTES, stream, a);
        const hipError_t le = hipPeekAtLastError();
        if (le != hipSuccess) { fprintf(stderr, "kernel_launch: launch %d failed: %s\n", li, hipGetErrorName(le)); break; }
    }
}
```

```cpp
#include <hip/hip_runtime.h>
#include <hip/hip_bf16.h>
#include <cstdio>
#include <cstdint>

#ifndef MK_N_LAUNCHES
#define MK_N_LAUNCHES 1
#endif

#define LAS __attribute__((address_space(3)))
#define GAS __attribute__((address_space(1)))
typedef unsigned short bf16_t;
typedef short bf16x8 __attribute__((ext_vector_type(8)));
typedef short s16x4 __attribute__((ext_vector_type(4)));
typedef float f32x4 __attribute__((ext_vector_type(4)));
typedef float f32x2 __attribute__((ext_vector_type(2)));
typedef float f32x16 __attribute__((ext_vector_type(16)));
typedef unsigned u32x4 __attribute__((ext_vector_type(4)));
typedef unsigned u32x2 __attribute__((ext_vector_type(2)));
typedef int v8i __attribute__((ext_vector_type(8)));
typedef int v4i __attribute__((ext_vector_type(4)));

constexpr int BATCH = 4, SEQ = 8192, DMODEL = 1024, MT = BATCH * SEQ;
constexpr int NQKV = 2304, NGATE = 2048, NIN = 4352;
constexpr int C_QNA = 0, C_KNA = 512, C_VNA = 1024, C_QG = 1536, C_KG = 2048, C_VG = 2176;
constexpr int NEXP = 16, CAP = 1024, FF = 2048;
constexpr float EPS = 1e-6f;
constexpr float LOG2E = 1.4426950408889634f;
constexpr float C2 = 0.125f * LOG2E;

__device__ __forceinline__ unsigned f2bf(float f) { unsigned u = __builtin_bit_cast(unsigned, f); return (u + 0x7fffu + ((u >> 16) & 1u)) >> 16; }
__device__ __forceinline__ unsigned pk2(float lo, float hi) { unsigned r; asm("v_cvt_pk_bf16_f32 %0, %1, %2" : "=v"(r) : "v"(lo), "v"(hi)); return r; }
__device__ __forceinline__ float bf_lo(unsigned w) { return __builtin_bit_cast(float, w << 16); }
__device__ __forceinline__ float bf_hi(unsigned w) { return __builtin_bit_cast(float, w & 0xffff0000u); }
__device__ __forceinline__ unsigned cvt_pk_bf16(float lo, float hi) { unsigned r; asm volatile("v_cvt_pk_bf16_f32 %0, %1, %2" : "=v"(r) : "v"(lo), "v"(hi)); return r; }
__device__ __forceinline__ unsigned pk4_fp8_nc(float a, float b, float c, float d) { unsigned w;
    asm("v_cvt_pk_fp8_f32 %0, %1, %2" : "=v"(w) : "v"(a), "v"(b)); asm("v_cvt_pk_fp8_f32 %0, %1, %2 op_sel:[0,0,1]" : "+v"(w) : "v"(c), "v"(d)); return w; }
__device__ __forceinline__ unsigned pk4_fp8(float a, float b, float c, float d) {
    a = __builtin_amdgcn_fmed3f(a, -448.f, 448.f); b = __builtin_amdgcn_fmed3f(b, -448.f, 448.f); c = __builtin_amdgcn_fmed3f(c, -448.f, 448.f); d = __builtin_amdgcn_fmed3f(d, -448.f, 448.f);
    return pk4_fp8_nc(a, b, c, d); }
constexpr float F8_SC_H2 = 8.0f, F8_SC_W = 64.0f, F8_SC_HMID = 4.0f, F8_SC_GA = 256.0f, F8_SC_R = 2.0f, F8_SC_Y = 32.0f;
__device__ __forceinline__ float sigmoidf_fast(float v) { return __builtin_amdgcn_rcpf(1.0f + __builtin_amdgcn_exp2f(-v * LOG2E)); }
__device__ __forceinline__ int fresh_tid() { int t = threadIdx.x; asm volatile("" : "+v"(t)); return t; }
template <int CTRL> __device__ __forceinline__ float dppf(float x) { return __builtin_bit_cast(float, __builtin_amdgcn_mov_dpp(__builtin_bit_cast(int, x), CTRL, 0xf, 0xf, true)); }
constexpr int DPP_XOR1 = 0xB1, DPP_XOR2 = 0x4E, DPP_XOR3 = 0x1B, DPP_XOR7 = 0x141, DPP_XOR8 = 0x128;
__device__ __forceinline__ float lane_xor4(float x) { return dppf<DPP_XOR3>(dppf<DPP_XOR7>(x)); }
__device__ __forceinline__ float swap16_sum(float a, float b) { asm("s_nop 1\n\tv_permlane16_swap_b32 %0, %1" : "+v"(a), "+v"(b)); return a + b; }
__device__ __forceinline__ float swap32_sum(float a, float b) { asm("s_nop 1\n\tv_permlane32_swap_b32 %0, %1" : "+v"(a), "+v"(b)); return a + b; }
__device__ __forceinline__ float swap16_max(float a) { float b = a; asm("s_nop 1\n\tv_permlane16_swap_b32 %0, %1" : "+v"(a), "+v"(b)); return fmaxf(a, b); }
__device__ __forceinline__ float swap32_max(float a) { float b = a; asm("s_nop 1\n\tv_permlane32_swap_b32 %0, %1" : "+v"(a), "+v"(b)); return fmaxf(a, b); }
__device__ __forceinline__ float wave_sum(float v) {
    v += dppf<DPP_XOR1>(v); v += dppf<DPP_XOR2>(v); v += lane_xor4(v); v += dppf<DPP_XOR8>(v);
    v = swap16_sum(v, v); return swap32_sum(v, v);
}

__constant__ float INV_FREQ_D[16] = {1.0f, 0.5623413251903491f, 0.31622776601683794f, 0.1778279410038923f, 0.1f, 0.05623413251903491f, 0.03162277660168379f, 0.01778279410038923f,
                                     0.01f, 0.005623413251903491f, 0.0031622776601683794f, 0.001778279410038923f, 0.001f, 0.0005623413251903491f, 0.00031622776601683794f, 0.0001778279410038923f};
namespace pg8 {
constexpr int BM = 256, BK = 64, HALF = 128, HTB = HALF * BK * 2, STAGE_BYTES = 8 * HTB, NXCD = 8, WGM = 8;
__host__ __device__ __forceinline__ int lds_byte(int r, int c) { const int st = (r >> 4) * 2 + (c >> 5), rr = r & 15, cc = c & 31, ob = rr * 64 + cc * 2; return st * 1024 + (ob ^ (((ob >> 9) & 1) << 5)); }
__host__ __device__ __forceinline__ void stage_rc(int b, int& R, int& C) { const int st = b / 1024, sb = b % 1024, swz = sb ^ (((sb >> 9) & 1) << 5); R = (st >> 1) * 16 + swz / 64; C = (st & 1) * 32 + (swz % 64) / 2; }
__host__ __device__ __forceinline__ int perm32(int rho) { const int n = rho >> 4, i = rho & 15; return 8 * (i >> 2) + 4 * n + (i & 3); }

struct Unit { int pm, pn, g; };

struct SchedPlain {
    int nM, nN, nwg, G, c; const char* A; const char* B; unsigned lda, ldb;
    static constexpr bool GATHER = false;
    __device__ void init(int M, int N, int G_, int c_, const void* A_, unsigned lda_, const void* B_, unsigned ldb_) { nM = M / BM; nN = N / BM; nwg = nM * nN; G = G_; c = c_; A = (const char*)A_; B = (const char*)B_; lda = lda_; ldb = ldb_; }
    __device__ bool next(int i, Unit& u) const {
        const long L = (long)i * G + c; if (L >= nwg) return false;
        int wgid = (int)L; { const int q = nwg / NXCD, r = nwg % NXCD, xcd = wgid % NXCD, off = wgid / NXCD; wgid = (xcd < r ? xcd * (q + 1) : r * (q + 1) + (xcd - r) * q) + off; }
        const int nig = WGM * nN, gid = wgid / nig, fm = gid * WGM, gsz = (nM - fm) < WGM ? (nM - fm) : WGM;
        u.pm = fm + ((wgid % nig) % gsz); u.pn = (wgid % nig) / gsz; if (flip) u.pn = nN - 1 - u.pn; u.g = 0; return true;
    }
    bool flip = false;
    __device__ __forceinline__ const char* a_ptr(const Unit& u) const { return A + (size_t)u.pm * BM * lda; }
    __device__ __forceinline__ const char* b_ptr(const Unit& u) const { return B + (size_t)u.pn * BM * ldb; }
    __device__ __forceinline__ const int* rows(const Unit&) const { return nullptr; }
    const char* A2 = nullptr; const char* B2 = nullptr; int nt1 = 0;
    __device__ __forceinline__ const char* a_ptr2(const Unit& u) const { return A2 + (size_t)u.pm * BM * lda; }
    __device__ __forceinline__ const char* b_ptr2(const Unit& u) const { return B2 + (size_t)u.pn * BM * ldb; }
};
struct SchedGate {
    int G, c; const char* A; const char* B; unsigned lda, ldb;
    static constexpr bool GATHER = false;
    __device__ bool next(int i, Unit& u) const {
        int id;
        if (G == 256) { if (c < 128) { if (i >= 3) return false; id = c * 3 + i; } else { if (i >= 5) return false; id = 384 + (c - 128) * 5 + i; } }
        else { const long L = (long)i * G + c; if (L >= 1024) return false; id = (int)L; }
        u.pm = id >> 3; u.pn = id & 7; u.g = 0; return true;
    }
    __device__ __forceinline__ const char* a_ptr(const Unit& u) const { return A + (size_t)u.pm * BM * lda; }
    __device__ __forceinline__ const char* b_ptr(const Unit& u) const { return B + (size_t)u.pn * BM * ldb; }
    __device__ __forceinline__ const int* rows(const Unit&) const { return nullptr; }
};
struct SchedFfn1 {
    int G, vcu; const char* A; const char* B; const int* idx; unsigned lda, ldb;
    static constexpr bool GATHER = true;
    __device__ bool next(int i, Unit& u) const {
        const long L = (long)i * G + vcu; if (L >= 4096) return false;
        const int ii = (int)(L >> 8), v = (int)(L & 255), x = v >> 5, c = v & 31;
        const int e = 2 * x + (ii >> 3), b = ii & 3, half = (ii & 7) >> 2;
        u.g = b * 16 + e; u.pm = c & 3; u.pn = half * 8 + (c >> 2); return true;
    }
    __device__ __forceinline__ const char* a_ptr(const Unit& u) const { return A + (size_t)(u.g >> 4) * SEQ * lda; }
    __device__ __forceinline__ const char* b_ptr(const Unit& u) const { return B + ((size_t)(u.g & 15) * 4096 + (size_t)u.pn * BM) * ldb; }
    __device__ __forceinline__ const int* rows(const Unit& u) const { return idx + u.g * CAP + u.pm * BM; }
};
struct SchedFfn2 {
    int G, vcu; const char* A; const char* B; unsigned lda, ldb;
    static constexpr bool GATHER = false;
    __device__ bool next(int i, Unit& u) const {
        const long L = (long)i * G + vcu; if (L >= 1024) return false;
        const int ii = (int)(L >> 8), v = (int)(L & 255), x = v >> 5, c = v & 31;
        const int e = 2 * x + (ii >> 1), b = 2 * (ii & 1) + (c >> 4);
        u.g = b * 16 + e; u.pm = (c & 15) >> 2; u.pn = c & 3; return true;
    }
    __device__ __forceinline__ const char* a_ptr(const Unit& u) const { return A + ((size_t)u.g * CAP + (size_t)u.pm * BM) * lda; }
    __device__ __forceinline__ const char* b_ptr(const Unit& u) const { return B + ((size_t)(u.g & 15) * 1024 + (size_t)u.pn * BM) * ldb; }
    __device__ __forceinline__ const int* rows(const Unit&) const { return nullptr; }
};

typedef f32x4 Acc[2][2][4][2];

struct EpiProj {
    static constexpr bool PERM = true;
    bf16_t* QKV; unsigned char* Q8; unsigned char* K8; unsigned char* V8T; const float* qg; const float* kg; bool gqa_bf16;
    __device__ __forceinline__ void operator()(const Acc& acc, const Unit& u, int wr, int wc, int fr_, int fq_) const { run<false>(acc, u, wr, wc, fr_, fq_); }
    template <bool ASC8> __device__ __forceinline__ void run(const Acc& acc, const Unit& u, int wr, int wc, int fr_, int fq_) const {
        constexpr float asc = ASC8 ? 1.0f / (F8_SC_H2 * F8_SC_W) : 1.0f;
        int fr = fr_, fq = fq_; asm volatile("" : "+v"(fr), "+v"(fq));
        const int row0 = u.pm * BM + wr * 64 + fr;
        if (u.pn < 6) {
            const int col0 = u.pn * BM + wc * 32 + 8 * fq;
            const float sc = ((u.pn < 2) ? 0.125f : 1.0f) * asc;
#pragma unroll
            for (int ai = 0; ai < 2; ++ai)
#pragma unroll
                for (int m = 0; m < 4; ++m) { bf16_t* rowp = QKV + (size_t)(row0 + ai * HALF + m * 16) * NQKV + col0;
#pragma unroll
                    for (int bj = 0; bj < 2; ++bj) { const f32x4 v0 = acc[ai][bj][m][0] * sc, v1 = acc[ai][bj][m][1] * sc;
                        u32x4 w; w.x = cvt_pk_bf16(v0[0], v0[1]); w.y = cvt_pk_bf16(v0[2], v0[3]); w.z = cvt_pk_bf16(v1[0], v1[1]); w.w = cvt_pk_bf16(v1[2], v1[3]);
                        *(u32x4*)(rowp + bj * HALF) = w; } }
            return;
        }
        const int colb = u.pn * BM + wc * 64 + 8 * fq;
        const bool isv = (u.pn == 8) && (wc >= 2), isq = u.pn < 8;
        if (isv) {
            const int kvh = wc - 2;
#pragma unroll
            for (int ai = 0; ai < 2; ++ai)
#pragma unroll
                for (int m = 0; m < 4; ++m) { const int tok = row0 + ai * HALF + m * 16; bf16_t* rowp = QKV + (size_t)tok * NQKV + colb;
                    const int b = tok >> 13, t = tok & (SEQ - 1), kap = t & 63;
                    const int pos = 32 * ((kap >> 2) & 1) + 16 * (kap >> 5) + (kap & 3) + 4 * ((kap & 31) >> 3);
                    unsigned char* vt = V8T + ((size_t)(b * 2 + kvh) * SEQ + (size_t)(t & ~63)) * 64 + (8 * fq) * 64 + pos;
#pragma unroll
                    for (int bj = 0; bj < 2; ++bj) { const f32x4 v0 = acc[ai][bj][m][0] * asc, v1 = acc[ai][bj][m][1] * asc;
                        if (gqa_bf16) { u32x4 w; w.x = cvt_pk_bf16(v0[0], v0[1]); w.y = cvt_pk_bf16(v0[2], v0[3]); w.z = cvt_pk_bf16(v1[0], v1[1]); w.w = cvt_pk_bf16(v1[2], v1[3]);
                            *(u32x4*)(rowp + bj * 32) = w; }
                        const unsigned p0 = pk4_fp8(v0[0] * 8.f, v0[1] * 8.f, v0[2] * 8.f, v0[3] * 8.f), p1 = pk4_fp8(v1[0] * 8.f, v1[1] * 8.f, v1[2] * 8.f, v1[3] * 8.f);
#pragma unroll
                        for (int i = 0; i < 4; ++i) { vt[(32 * bj + i) * 64] = (unsigned char)(p0 >> (8 * i)); vt[(32 * bj + 4 + i) * 64] = (unsigned char)(p1 >> (8 * i)); } } }
            return;
        }
        const float* gp = (isq ? qg : kg) + 8 * fq;
        float frq[2][2];
#pragma unroll
        for (int n = 0; n < 2; ++n)
#pragma unroll
            for (int k = 0; k < 2; ++k) frq[n][k] = INV_FREQ_D[4 * fq + 2 * n + k] * 0.15915494309189535f;
        f32x4 gn[2][2];
#pragma unroll
        for (int bj = 0; bj < 2; ++bj) { gn[bj][0] = *(const f32x4*)(gp + 32 * bj); gn[bj][1] = *(const f32x4*)(gp + 32 * bj + 4); }
        const float osc = isq ? C2 : 1.0f, f8s = isq ? 32.0f : 8.0f;
        const int head = isq ? (u.pn - 6) * 4 + wc : wc;
#pragma unroll
        for (int ai = 0; ai < 2; ++ai)
#pragma unroll
            for (int m = 0; m < 4; ++m) { const int tok = row0 + ai * HALF + m * 16; const int t = tok & (SEQ - 1);
                float ss = 0.f;
#pragma unroll
                for (int bj = 0; bj < 2; ++bj)
#pragma unroll
                    for (int n = 0; n < 2; ++n) { const f32x4 v = acc[ai][bj][m][n]; ss += (v[0] * v[0] + v[1] * v[1]) + (v[2] * v[2] + v[3] * v[3]); }
                ss += __shfl_xor(ss, 16); ss += __shfl_xor(ss, 32);
                const float rinv = asc * __builtin_amdgcn_rsqf(ss * (asc * asc / 64.f) + EPS);
                bf16_t* rowp = QKV + ((unsigned)tok * (unsigned)NQKV + (unsigned)colb);
#pragma unroll
                for (int bj = 0; bj < 2; ++bj) { const float pos = (float)(bj == 0 ? (t >> 6) : (t & 63));
                    float ov[8];
#pragma unroll
                    for (int n = 0; n < 2; ++n)
#pragma unroll
                        for (int k = 0; k < 2; ++k) { float rev = pos * frq[n][k]; rev = rev - floorf(rev);
                            const float sn = __builtin_amdgcn_sinf(rev), cs = __builtin_amdgcn_cosf(rev);
                            const float y0 = acc[ai][bj][m][n][2 * k] * rinv * gn[bj][n][2 * k], y1 = acc[ai][bj][m][n][2 * k + 1] * rinv * gn[bj][n][2 * k + 1];
                            ov[4 * n + 2 * k] = (y0 * cs - y1 * sn) * osc; ov[4 * n + 2 * k + 1] = (y0 * sn + y1 * cs) * osc; }
                    if (gqa_bf16) { u32x4 w; w.x = cvt_pk_bf16(ov[0], ov[1]); w.y = cvt_pk_bf16(ov[2], ov[3]); w.z = cvt_pk_bf16(ov[4], ov[5]); w.w = cvt_pk_bf16(ov[6], ov[7]);
                        *(u32x4*)(rowp + bj * 32) = w; }
                    u32x2 f8; f8.x = pk4_fp8(ov[0] * f8s, ov[1] * f8s, ov[2] * f8s, ov[3] * f8s); f8.y = pk4_fp8(ov[4] * f8s, ov[5] * f8s, ov[6] * f8s, ov[7] * f8s);
                    if (isq) *(u32x2*)(Q8 + ((unsigned)tok * 512u + (unsigned)(head * 64 + 32 * bj + 8 * fq))) = f8;
                    else     *(u32x2*)(K8 + ((((unsigned)tok >> 13) * 2u + (unsigned)head) * (unsigned)(SEQ * 64) + ((unsigned)tok & 8191u) * 64u + (unsigned)(32 * bj + 8 * fq))) = f8; }
                __builtin_amdgcn_sched_barrier(0); }
    }
};
struct EpiGate {
    static constexpr bool PERM = true;
    bf16_t* GA; unsigned char* R8;
    __device__ __forceinline__ void operator()(const Acc& acc, const Unit& u, int wr, int wc, int fr, int fq) const {
        const size_t row0 = (size_t)u.pm * BM + wr * 64 + fr; const int col0 = u.pn * HALF + wc * 32 + 8 * fq;
        constexpr float inv = -LOG2E / (F8_SC_H2 * F8_SC_W);
#pragma unroll
        for (int ai = 0; ai < 2; ++ai)
#pragma unroll
            for (int m = 0; m < 4; ++m) { const size_t off = (row0 + ai * HALF + m * 16) * DMODEL + col0;
                float ga[8], rr[8];
#pragma unroll
                for (int n = 0; n < 2; ++n)
#pragma unroll
                    for (int i = 0; i < 4; ++i) { const float ea = 1.0f + __builtin_amdgcn_exp2f(acc[ai][0][m][n][i] * inv), eb = 1.0f + __builtin_amdgcn_exp2f(acc[ai][1][m][n][i] * inv);
                        ga[n * 4 + i] = __builtin_amdgcn_rcpf(ea); rr[n * 4 + i] = ea * __builtin_amdgcn_rcpf(eb) * F8_SC_R; }
                u32x4 w; w.x = cvt_pk_bf16(ga[0], ga[1]); w.y = cvt_pk_bf16(ga[2], ga[3]); w.z = cvt_pk_bf16(ga[4], ga[5]); w.w = cvt_pk_bf16(ga[6], ga[7]); *(u32x4*)(GA + off) = w;
                u32x2 q; q.x = pk4_fp8(rr[0], rr[1], rr[2], rr[3]); q.y = pk4_fp8(rr[4], rr[5], rr[6], rr[7]); *(u32x2*)(R8 + off) = q; }
    }
};
struct EpiHeadGate {
    static constexpr bool PERM = true;
    EpiProj P; EpiGate Gt;
    __device__ __forceinline__ void operator()(const Acc& acc, const Unit& u, int wr, int wc, int fr, int fq) const {
        Unit v = u;
        if (u.pn < 9) { P.run<true>(acc, v, wr, wc, fr, fq); }
        else { v.pn = u.pn - 9; Gt(acc, v, wr, wc, fr, fq); }
    }
};
struct EpiMerge {
    static constexpr bool PERM = true;
    bf16_t* MERGED; const bf16_t* GA; const unsigned char* R8;
    __device__ __forceinline__ void mid(Acc& acc, const Unit& u, int wr, int wc, int fr, int fq) const {
        const int row0 = u.pm * BM + wr * 64 + fr, col0 = u.pn * BM + wc * 32 + 8 * fq;
        u32x2 rq[2][4][2];
#pragma unroll
        for (int ai = 0; ai < 2; ++ai)
#pragma unroll
            for (int m = 0; m < 4; ++m)
#pragma unroll
                for (int bj = 0; bj < 2; ++bj) rq[ai][m][bj] = *(const u32x2*)(R8 + (size_t)(row0 + ai * HALF + m * 16) * DMODEL + col0 + bj * HALF);
        asm volatile("" ::: "memory");
#pragma unroll
        for (int ai = 0; ai < 2; ++ai)
#pragma unroll
            for (int m = 0; m < 4; ++m) {
#pragma unroll
                for (int bj = 0; bj < 2; ++bj) { const u32x2 q = rq[ai][m][bj];
                    const auto a = __builtin_amdgcn_cvt_pk_f32_fp8((int)q.x, false), b = __builtin_amdgcn_cvt_pk_f32_fp8((int)q.x, true), c = __builtin_amdgcn_cvt_pk_f32_fp8((int)q.y, false), d = __builtin_amdgcn_cvt_pk_f32_fp8((int)q.y, true);
                    constexpr float k = 1.0f / F8_SC_R;
                    acc[ai][bj][m][0][0] *= a[0] * k; acc[ai][bj][m][0][1] *= a[1] * k; acc[ai][bj][m][0][2] *= b[0] * k; acc[ai][bj][m][0][3] *= b[1] * k;
                    acc[ai][bj][m][1][0] *= c[0] * k; acc[ai][bj][m][1][1] *= c[1] * k; acc[ai][bj][m][1][2] *= d[0] * k; acc[ai][bj][m][1][3] *= d[1] * k; } }
    }
    __device__ __forceinline__ void operator()(const Acc& acc, const Unit& u, int wr, int wc, int fr, int fq) const {
        const int row0 = u.pm * BM + wr * 64 + fr, col0 = u.pn * BM + wc * 32 + 8 * fq;
        u32x4 gq[2][4][2];
#pragma unroll
        for (int ai = 0; ai < 2; ++ai)
#pragma unroll
            for (int m = 0; m < 4; ++m)
#pragma unroll
                for (int bj = 0; bj < 2; ++bj) gq[ai][m][bj] = *(const u32x4*)(GA + (size_t)(row0 + ai * HALF + m * 16) * DMODEL + col0 + bj * HALF);
        asm volatile("" ::: "memory");
#pragma unroll
        for (int ai = 0; ai < 2; ++ai)
#pragma unroll
            for (int m = 0; m < 4; ++m) { const size_t r = (size_t)(row0 + ai * HALF + m * 16);
#pragma unroll
                for (int bj = 0; bj < 2; ++bj) { const u32x4 g = gq[ai][m][bj];
                    const f32x4 v0 = acc[ai][bj][m][0], v1 = acc[ai][bj][m][1];
                    u32x4 w; w.x = cvt_pk_bf16(bf_lo(g.x) * v0[0], bf_hi(g.x) * v0[1]); w.y = cvt_pk_bf16(bf_lo(g.y) * v0[2], bf_hi(g.y) * v0[3]);
                    w.z = cvt_pk_bf16(bf_lo(g.z) * v1[0], bf_hi(g.z) * v1[1]); w.w = cvt_pk_bf16(bf_lo(g.w) * v1[2], bf_hi(g.w) * v1[3]);
                    *(u32x4*)(MERGED + r * DMODEL + col0 + bj * HALF) = w; } }
    }
};
struct EpiOut {
    static constexpr bool PERM = false;
    const float* x; float* out; const float* mod;
    __device__ __forceinline__ void operator()(const Acc& acc, const Unit& u, int wr, int wc, int fr, int fq) const {
        const int row0 = u.pm * BM + wr * 64 + fr, col0 = u.pn * BM + wc * 32 + 4 * fq;
        const float* g1 = mod + (size_t)(u.pm >> 5) * 6144 + 2048;
        f32x4 gv[2][2];
#pragma unroll
        for (int bj = 0; bj < 2; ++bj)
#pragma unroll
            for (int n = 0; n < 2; ++n) gv[bj][n] = *(const f32x4*)(g1 + col0 + bj * HALF + n * 16);
#pragma unroll
        for (int ai = 0; ai < 2; ++ai)
#pragma unroll
            for (int m = 0; m < 4; ++m) { const size_t off = (size_t)(row0 + ai * HALF + m * 16) * DMODEL + col0;
#pragma unroll
                for (int bj = 0; bj < 2; ++bj)
#pragma unroll
                    for (int n = 0; n < 2; ++n) { const f32x4 xv = __builtin_nontemporal_load((const f32x4*)(x + off + bj * HALF + n * 16)); *(f32x4*)(out + off + bj * HALF + n * 16) = xv + gv[bj][n] * acc[ai][bj][m][n]; } }
    }
};
struct EpiDelta {
    static constexpr bool PERM = true;
    bf16_t* DELTA; const float* mod;
    __device__ __forceinline__ void operator()(const Acc& acc, const Unit& u, int wr, int wc, int fr, int fq) const {
        const unsigned row0 = u.pm * BM + wr * 64 + fr, col0 = u.pn * BM + wc * 32 + 8 * fq;
        const float* g1 = mod + (size_t)(u.pm >> 5) * 6144 + 2048 + col0;
        f32x4 gv[2][2];
#pragma unroll
        for (int bj = 0; bj < 2; ++bj)
#pragma unroll
            for (int n = 0; n < 2; ++n) gv[bj][n] = *(const f32x4*)(g1 + bj * HALF + n * 4);
#pragma unroll
        for (int ai = 0; ai < 2; ++ai)
#pragma unroll
            for (int m = 0; m < 4; ++m) { bf16_t* rowp = DELTA + ((row0 + ai * HALF + m * 16) * (unsigned)DMODEL + col0);
#pragma unroll
                for (int bj = 0; bj < 2; ++bj) { const f32x4 v0 = acc[ai][bj][m][0] * gv[bj][0], v1 = acc[ai][bj][m][1] * gv[bj][1];
                    u32x4 w; w.x = cvt_pk_bf16(v0[0], v0[1]); w.y = cvt_pk_bf16(v0[2], v0[3]); w.z = cvt_pk_bf16(v1[0], v1[1]); w.w = cvt_pk_bf16(v1[2], v1[3]);
                    *(u32x4*)(rowp + bj * HALF) = w; } }
    }
};
struct EpiFfn1 {
    static constexpr bool PERM = true;
    unsigned char* HMID;
    __device__ __forceinline__ void operator()(const Acc& acc, const Unit& u, int wr, int wc, int fr, int fq) const {
        const size_t row0 = (size_t)u.g * CAP + u.pm * BM + wr * 64 + fr; const int col0 = u.pn * HALF + wc * 32 + 8 * fq;
        constexpr float inv = 1.0f / (F8_SC_H2 * F8_SC_W);
        constexpr float RC = 1.0f / (inv * inv * F8_SC_HMID);
        static_assert(RC == 65536.0f, "LOG2_RC below assumes 2^16");
        constexpr float LOG2_RC = 16.0f;
#pragma unroll
        for (int ai = 0; ai < 2; ++ai)
#pragma unroll
            for (int m = 0; m < 4; ++m) { unsigned char* rowp = HMID + (row0 + ai * HALF + m * 16) * FF + col0;
                float o[8];
#pragma unroll
                for (int n = 0; n < 2; ++n)
#pragma unroll
                    for (int i = 0; i < 4; i += 2) {
                        const f32x2 ag = {acc[ai][0][m][n][i], acc[ai][0][m][n][i + 1]}, au = {acc[ai][1][m][n][i], acc[ai][1][m][n][i + 1]};
                        const f32x2 e = ag * (-inv * LOG2E) + LOG2_RC;
                        f32x2 t; t.x = __builtin_amdgcn_exp2f(e.x); t.y = __builtin_amdgcn_exp2f(e.y);
                        t = t + RC;
                        f32x2 r; r.x = __builtin_amdgcn_rcpf(t.x); r.y = __builtin_amdgcn_rcpf(t.y);
                        const f32x2 q = (ag * au) * r;
                        o[n * 4 + i] = q.x; o[n * 4 + i + 1] = q.y; }
                u32x2 w; w.x = pk4_fp8(o[0], o[1], o[2], o[3]); w.y = pk4_fp8(o[4], o[5], o[6], o[7]);
                *(u32x2*)rowp = w; }
    }
};
struct EpiFfn2 {
    static constexpr bool PERM = true;
    unsigned char* YB8; const float* gsel;
    __device__ __forceinline__ void operator()(const Acc& acc, const Unit& u, int wr, int wc, int fr, int fq) const {
        const unsigned row0 = (unsigned)u.g * CAP + u.pm * BM + wr * 64 + fr; const unsigned col0 = u.pn * BM + wc * 32 + 8 * fq;
        float gsv[2][4];
#pragma unroll
        for (int ai = 0; ai < 2; ++ai)
#pragma unroll
            for (int m = 0; m < 4; ++m) gsv[ai][m] = gsel[row0 + ai * HALF + m * 16];
        asm volatile("" ::: "memory");
#pragma unroll
        for (int ai = 0; ai < 2; ++ai)
#pragma unroll
            for (int m = 0; m < 4; ++m) { const unsigned r = row0 + ai * HALF + m * 16; const float gs = gsv[ai][m] * (F8_SC_Y / (F8_SC_HMID * F8_SC_W)); unsigned char* rowp = YB8 + (r * (unsigned)DMODEL + col0);
#pragma unroll
                for (int bj = 0; bj < 2; ++bj) { const f32x4 v0 = acc[ai][bj][m][0] * gs, v1 = acc[ai][bj][m][1] * gs;
                    u32x2 w; w.x = pk4_fp8(v0[0], v0[1], v0[2], v0[3]); w.y = pk4_fp8(v1[0], v1[1], v1[2], v1[3]);
                    *(u32x2*)(rowp + bj * HALF) = w; } }
    }
};

template <bool F8> __device__ __forceinline__ f32x4 mma_step(bf16x8 b0, bf16x8 b1, bf16x8 a0, bf16x8 a1, f32x4 c) {
    if constexpr (F8) {
        const v8i b = __builtin_shufflevector(__builtin_bit_cast(v4i, b0), __builtin_bit_cast(v4i, b1), 0, 1, 2, 3, 4, 5, 6, 7);
        const v8i a = __builtin_shufflevector(__builtin_bit_cast(v4i, a0), __builtin_bit_cast(v4i, a1), 0, 1, 2, 3, 4, 5, 6, 7);
        asm volatile("v_mfma_f32_16x16x128_f8f6f4 %0, %1, %2, %0" : "+v"(c) : "v"(b), "v"(a));
        return c;
    } else {
        c = __builtin_amdgcn_mfma_f32_16x16x32_bf16(b0, a0, c, 0, 0, 0);
        return __builtin_amdgcn_mfma_f32_16x16x32_bf16(b1, a1, c, 0, 0, 0);
    }
}
__device__ __forceinline__ const char* uni_ptr(const char* p) {
    const unsigned long long v = (unsigned long long)p; const unsigned lo = __builtin_amdgcn_readfirstlane((unsigned)v), hi = __builtin_amdgcn_readfirstlane((unsigned)(v >> 32));
    return (const char*)(((unsigned long long)hi << 32) | lo); }
template <bool F8, class Epi, class Sched, bool SEG2 = false>
__device__ __forceinline__ void gemm_phase(LAS unsigned char* lds, const int nt, const Sched& S, const Epi& E) {
    const int tid = fresh_tid(), wid = __builtin_amdgcn_readfirstlane(tid >> 6), lane = tid & 63, wr = wid >> 2, wc = wid & 3, fr = lane & 15, fq = lane >> 4;
    constexpr bool GA = Sched::GATHER;
    int Rr[2], Cc[2];
#pragma unroll
    for (int i = 0; i < 2; ++i) stage_rc(tid * 16 + i * 8192, Rr[i], Cc[i]);
    unsigned voffB[2];
#pragma unroll
    for (int i = 0; i < 2; ++i) { const int Rb = Epi::PERM ? ((Rr[i] & ~31) + perm32(Rr[i] & 31)) : Rr[i]; voffB[i] = (unsigned)Rb * S.ldb + (unsigned)Cc[i] * 2u; }
    const size_t kstep = (size_t)(BK * 2);
    const size_t hstepB = (size_t)HALF * S.ldb;
    const size_t hstepA = GA ? (size_t)0 : (size_t)HALF * S.lda;
    const unsigned ldsw = (unsigned)wid * 1024u;
    const int aoff = lds_byte(wr * 64 + fr, fq * 8), boff = lds_byte(wc * 32 + fr, fq * 8);
#define PG8_SA(b, h) (((b) * 2 + (h)) * HTB)
#define PG8_SB(b, h) ((4 + (b) * 2 + (h)) * HTB)
#define PG8_STAGE(bufoff, gbase, voff) do { _Pragma("unroll") for (int _i = 0; _i < 2; ++_i) \
        __builtin_amdgcn_global_load_lds((GAS const unsigned*)((GAS const char*)(gbase) + (voff)[_i]), (LAS unsigned*)(lds + (bufoff) + ldsw + _i * 8192), 16, 0, 0); } while (0)
#define PG8_LDA(dst, b, h) do { _Pragma("unroll") for (int m = 0; m < 4; ++m) _Pragma("unroll") for (int k = 0; k < 2; ++k) dst[m][k] = *(const LAS bf16x8*)(lds + PG8_SA(b, h) + aoff + m * 2048 + k * 1024); } while (0)
#define PG8_LDB(dst, b, h) do { _Pragma("unroll") for (int n = 0; n < 2; ++n) _Pragma("unroll") for (int k = 0; k < 2; ++k) dst[n][k] = *(const LAS bf16x8*)(lds + PG8_SB(b, h) + boff + n * 2048 + k * 1024); } while (0)
#define PG8_MMA(ai, bj, At, Bt) do { __builtin_amdgcn_s_setprio(1); _Pragma("unroll") for (int m = 0; m < 4; ++m) _Pragma("unroll") for (int n = 0; n < 2; ++n) \
        acc[ai][bj][m][n] = mma_step<F8>(Bt[n][0], Bt[n][1], At[m][0], At[m][1], acc[ai][bj][m][n]); __builtin_amdgcn_s_setprio(0); } while (0)
#define PG8_WAIT_V(n) asm volatile("s_waitcnt vmcnt(" #n ")" ::: "memory")
#define PG8_WAIT_L(n) asm volatile("s_waitcnt lgkmcnt(" #n ")" ::: "memory")
#define PG8_BAR __builtin_amdgcn_s_barrier()
#define PG8_SCHED __builtin_amdgcn_sched_barrier(0)
#define PG8_ROWOFFS(dst, u_) do { if constexpr (GA) { const int* _rw = S.rows(u_); _Pragma("unroll") for (int _h = 0; _h < 2; ++_h) _Pragma("unroll") for (int _i = 0; _i < 2; ++_i) \
        dst[_h][_i] = (unsigned)_rw[_h * HALF + Rr[_i]] * S.lda + (unsigned)Cc[_i] * 2u; } } while (0)
    Unit cur, nxt; int ui = 0;
    if (!S.next(0, cur)) return;
    f32x4 acc[2][2][4][2];
#pragma unroll
    for (int a = 0; a < 2; ++a)
#pragma unroll
        for (int b = 0; b < 2; ++b)
#pragma unroll
            for (int m = 0; m < 4; ++m)
#pragma unroll
                for (int n = 0; n < 2; ++n) acc[a][b][m][n] = (f32x4){0.f, 0.f, 0.f, 0.f};
    bf16x8 At[4][2], B0[2][2], B1[2][2];
    unsigned voffP[2];
#pragma unroll
    for (int i = 0; i < 2; ++i) voffP[i] = (unsigned)Rr[i] * S.lda + (unsigned)Cc[i] * 2u;
    unsigned voffA[2][2], voffAn[2][2];
    PG8_ROWOFFS(voffA, cur);
#define PG8_VA(h) (GA ? voffA[h] : voffP)
#define PG8_VA2(h) (GA ? va2[h] : voffP)
    const char* cA = uni_ptr(S.a_ptr(cur)); const char* cB = uni_ptr(S.b_ptr(cur));
    const char* cA2 = cA; const char* cB2 = cB; int nt1 = nt;
    if constexpr (SEG2) { cA2 = uni_ptr(S.a_ptr2(cur)); cB2 = uni_ptr(S.b_ptr2(cur)); nt1 = S.nt1; }
#define PG8_KA(tau) ((!SEG2 || (tau) < nt1) ? cA + (size_t)(tau) * kstep : cA2 + (size_t)((tau) - nt1) * kstep)
#define PG8_KB(tau) ((!SEG2 || (tau) < nt1) ? cB + (size_t)(tau) * kstep : cB2 + (size_t)((tau) - nt1) * kstep)
    PG8_STAGE(PG8_SB(0, 0), cB, voffB); PG8_STAGE(PG8_SB(0, 1), cB + hstepB, voffB); PG8_STAGE(PG8_SA(0, 0), cA, PG8_VA(0)); PG8_STAGE(PG8_SA(0, 1), cA + hstepA, PG8_VA(1));
    if (wr == 1) PG8_BAR;
    PG8_WAIT_V(2); PG8_BAR;
    PG8_STAGE(PG8_SB(1, 0), cB + kstep, voffB); PG8_STAGE(PG8_SA(1, 0), cA + kstep, PG8_VA(0)); PG8_STAGE(PG8_SB(1, 1), cB + hstepB + kstep, voffB);
    PG8_WAIT_V(6); PG8_BAR;
    for (;;) {
        const bool has_next = S.next(ui + 1, nxt);
        const char* nA = has_next ? uni_ptr(S.a_ptr(nxt)) : cA; const char* nB = has_next ? uni_ptr(S.b_ptr(nxt)) : cB;
        if constexpr (GA) {
            if (has_next) { PG8_ROWOFFS(voffAn, nxt); } else {
#pragma unroll
                for (int h = 0; h < 2; ++h)
#pragma unroll
                    for (int i = 0; i < 2; ++i) voffAn[h][i] = voffA[h][i]; } }
        for (int t = 0; t < nt; t += 2) {
            const bool last = (t == nt - 2);
            const char* a1 = PG8_KA(t + 1);
            const char* a2 = last ? nA : PG8_KA(t + 2); const char* b2 = last ? nB : PG8_KB(t + 2);
            const char* a3 = a2 + kstep; const char* b3 = b2 + kstep;
            unsigned va2[2][2];
            if constexpr (GA) {
#pragma unroll
                for (int h = 0; h < 2; ++h)
#pragma unroll
                    for (int i = 0; i < 2; ++i) va2[h][i] = last ? voffAn[h][i] : voffA[h][i]; }
            PG8_LDB(B0, 0, 0); PG8_LDB(B1, 0, 1); PG8_SCHED; PG8_LDA(At, 0, 0); PG8_STAGE(PG8_SA(1, 1), a1 + hstepA, PG8_VA(1));
            PG8_WAIT_V(8); PG8_WAIT_L(0); PG8_BAR; PG8_MMA(0, 0, At, B0); PG8_MMA(0, 1, At, B1); PG8_BAR; PG8_SCHED;
            PG8_LDA(At, 0, 1); PG8_STAGE(PG8_SB(0, 0), b2, voffB); PG8_STAGE(PG8_SB(0, 1), b2 + hstepB, voffB); PG8_STAGE(PG8_SA(0, 0), a2, PG8_VA2(0));
            PG8_WAIT_V(8); PG8_WAIT_L(0); PG8_BAR; PG8_MMA(1, 0, At, B0); PG8_MMA(1, 1, At, B1); PG8_BAR; PG8_SCHED;
            PG8_LDB(B0, 1, 0); PG8_LDB(B1, 1, 1); PG8_SCHED; PG8_LDA(At, 1, 0); PG8_STAGE(PG8_SA(0, 1), a2 + hstepA, PG8_VA2(1));
            PG8_WAIT_V(8); PG8_WAIT_L(0); PG8_BAR; PG8_MMA(0, 0, At, B0); PG8_MMA(0, 1, At, B1); PG8_BAR; PG8_SCHED;
            PG8_LDA(At, 1, 1); PG8_STAGE(PG8_SB(1, 0), b3, voffB); PG8_STAGE(PG8_SB(1, 1), b3 + hstepB, voffB); PG8_STAGE(PG8_SA(1, 0), a3, PG8_VA2(0));
            PG8_WAIT_V(8); PG8_WAIT_L(0); PG8_BAR; PG8_MMA(1, 0, At, B0); PG8_MMA(1, 1, At, B1); PG8_BAR; PG8_SCHED;
            if constexpr (SEG2) { if (t + 2 == nt1) { E.mid(acc, cur, wr, wc, fr, fq); PG8_SCHED; } }
        }
        if (wr == 0) PG8_BAR;
        if constexpr (F8) asm volatile("s_nop 15\n\ts_nop 3" ::: "memory");
        E(acc, cur, wr, wc, fr, fq);
        if (!has_next) break;
#pragma unroll
        for (int a = 0; a < 2; ++a)
#pragma unroll
            for (int b = 0; b < 2; ++b)
#pragma unroll
                for (int m = 0; m < 4; ++m)
#pragma unroll
                    for (int n = 0; n < 2; ++n) acc[a][b][m][n] = (f32x4){0.f, 0.f, 0.f, 0.f};
        cur = nxt; cA = nA; cB = nB; ++ui;
        if constexpr (SEG2) { cA2 = uni_ptr(S.a_ptr2(cur)); cB2 = uni_ptr(S.b_ptr2(cur)); }
        if constexpr (GA) {
#pragma unroll
            for (int h = 0; h < 2; ++h)
#pragma unroll
                for (int i = 0; i < 2; ++i) voffA[h][i] = voffAn[h][i]; }
        if (wr == 1) PG8_BAR;
    }
    PG8_WAIT_V(0);
    PG8_BAR;
#undef PG8_SA
#undef PG8_SB
#undef PG8_STAGE
#undef PG8_LDA
#undef PG8_LDB
#undef PG8_MMA
#undef PG8_WAIT_V
#undef PG8_WAIT_L
#undef PG8_BAR
#undef PG8_SCHED
#undef PG8_ROWOFFS
#undef PG8_VA
#undef PG8_VA2
#undef PG8_KA
#undef PG8_KB
}
}

struct ConvRide { const float* w_eg; const float* w_eu; const float* w_ed; unsigned char* WGU; unsigned char* WD; int u0; };
namespace attn_body {
using bf16 = __hip_bfloat16;
constexpr int D = 64, QP = NQKV, KP = NQKV, OP = DMODEL;
constexpr int NW = 8, QBLK = 32, QB = QBLK * NW, KVBLK = 64;
__device__ __forceinline__ int crow(int r, int hi) { return (r & 3) + 8 * (r >> 2) + 4 * hi; }
#define SBAR() __builtin_amdgcn_sched_barrier(0)
constexpr int NSLOT = 3, SLOTB = 8192;
constexpr int LDS_K = 0, LDS_V = NSLOT * SLOTB, LDS_WS = 2 * NSLOT * SLOTB, LDS_OST = LDS_WS + NW * 64 * 4, LDS_BYTES = LDS_OST + NW * 4096;
__device__ __forceinline__ void glds16(const void* gsrc, unsigned lds_dst) { unsigned keep;
    asm volatile("s_mov_b32 %0, m0\n\ts_mov_b32 m0, %2\n\ts_nop 0\n\tglobal_load_lds_dwordx4 %1, off\n\ts_mov_b32 m0, %0" : "=&s"(keep) : "v"(gsrc), "s"(lds_dst) : "memory"); }
__device__ __forceinline__ float max3f(float a, float b, float c) { float r; asm("v_max3_f32 %0, %1, %2, %3" : "=v"(r) : "v"(a), "v"(b), "v"(c)); return r; }
__device__ __forceinline__ float max2f(float a, float b) { float r; asm("v_max_f32_e32 %0, %1, %2" : "=v"(r) : "v"(a), "v"(b)); return r; }
__device__ __forceinline__ float fadd_s(float a, float b) { float r; asm("v_add_f32_e32 %0, %1, %2" : "=v"(r) : "v"(a), "v"(b)); return r; }
__device__ __forceinline__ float fsub_s(float a, float b) { float r; asm("v_sub_f32_e32 %0, %1, %2" : "=v"(r) : "v"(a), "v"(b)); return r; }
typedef float f32x2_t __attribute__((ext_vector_type(2))); typedef __bf16 bf16x2_t __attribute__((ext_vector_type(2)));
__device__ __forceinline__ unsigned cvtpk_s(float lo, float hi) { f32x2_t v = {lo, hi}; bf16x2_t b = __builtin_convertvector(v, bf16x2_t); return __builtin_bit_cast(unsigned, b); }
#define WAIT_BAR(N) asm volatile("s_waitcnt vmcnt(" #N ") lgkmcnt(0)\n\ts_barrier" ::: "memory")

__device__ __forceinline__ void qkt(f32x16& p0, f32x16& p1, const char* Kslot, const bf16x8* qr, const f32x16& negm, int r32, int hi) {
    const char* kb = Kslot + hi * 1024 + r32 * 16;
#pragma unroll
    for (int d0 = 0; d0 < 4; ++d0) {
        const bf16x8 b0 = *reinterpret_cast<const bf16x8*>(kb + d0 * 2048);
        const bf16x8 b1 = *reinterpret_cast<const bf16x8*>(kb + d0 * 2048 + 512);
        if (d0 == 0) { p0 = __builtin_amdgcn_mfma_f32_32x32x16_bf16(b0, qr[0], negm, 0, 0, 0); p1 = __builtin_amdgcn_mfma_f32_32x32x16_bf16(b1, qr[0], negm, 0, 0, 0); }
        else { p0 = __builtin_amdgcn_mfma_f32_32x32x16_bf16(b0, qr[d0], p0, 0, 0, 0); p1 = __builtin_amdgcn_mfma_f32_32x32x16_bf16(b1, qr[d0], p1, 0, 0, 0); } }
}
typedef LAS const char* lds_cptr;
typedef short v4i16_t __attribute__((ext_vector_type(4)));
__device__ __forceinline__ void kload8(bf16x8* kf, lds_cptr kp) {
    kf[0] = *(const LAS bf16x8*)(kp);        kf[1] = *(const LAS bf16x8*)(kp + 512);
    kf[2] = *(const LAS bf16x8*)(kp + 2048); kf[3] = *(const LAS bf16x8*)(kp + 2560);
    kf[4] = *(const LAS bf16x8*)(kp + 4096); kf[5] = *(const LAS bf16x8*)(kp + 4608);
    kf[6] = *(const LAS bf16x8*)(kp + 6144); kf[7] = *(const LAS bf16x8*)(kp + 6656);
}
__device__ __forceinline__ void kload2(bf16x8* kf, lds_cptr kp, int j) { kf[2 * j] = *(const LAS bf16x8*)(kp + j * 2048); kf[2 * j + 1] = *(const LAS bf16x8*)(kp + j * 2048 + 512); }
__device__ __forceinline__ s16x4 vtr(lds_cptr p) { return __builtin_bit_cast(s16x4, __builtin_amdgcn_ds_read_tr16_b64_v4i16((LAS v4i16_t*)p)); }
__device__ __forceinline__ float rowmax(const f32x16& p0, const f32x16& p1) {
    float a = max3f(p0[0], p0[1], p1[0]), b = max3f(p0[2], p0[3], p1[1]); a = max3f(a, p1[2], p1[3]);
#pragma unroll
    for (int r = 4; r < 16; r += 4) { a = max3f(a, p0[r], p0[r + 1]); b = max3f(b, p0[r + 2], p0[r + 3]); a = max3f(a, p1[r], p1[r + 1]); b = max3f(b, p1[r + 2], p1[r + 3]); }
    const float m = max2f(a, b);
    auto rr = __builtin_amdgcn_permlane32_swap(__float_as_uint(m), __float_as_uint(m), false, false);
    return max2f(__uint_as_float(rr[0]), __uint_as_float(rr[1]));
}
__device__ __forceinline__ void pv(f32x16* o, int vb, bf16x8 pa0, bf16x8 pa1, bf16x8 pa2, bf16x8 pa3) {
#pragma unroll
    for (int d0 = 0; d0 < 2; ++d0) { s16x4 lo[4], hi[4];
#pragma unroll
        for (int ks = 0; ks < 4; ++ks) {
            asm volatile("ds_read_b64_tr_b16 %0,%1 offset:%c2" : "=&v"(lo[ks]) : "v"(vb), "i"(d0 * 4096 + ks * 1024) : "memory");
            asm volatile("ds_read_b64_tr_b16 %0,%1 offset:%c2" : "=&v"(hi[ks]) : "v"(vb), "i"(d0 * 4096 + ks * 1024 + 512) : "memory"); }
        asm volatile("s_waitcnt lgkmcnt(0)" ::: "memory"); SBAR();
#define PK(k) (bf16x8){lo[k][0], lo[k][1], lo[k][2], lo[k][3], hi[k][0], hi[k][1], hi[k][2], hi[k][3]}
        o[d0] = __builtin_amdgcn_mfma_f32_32x32x16_bf16(pa0, PK(0), o[d0], 0, 0, 0);
        o[d0] = __builtin_amdgcn_mfma_f32_32x32x16_bf16(pa1, PK(1), o[d0], 0, 0, 0);
        o[d0] = __builtin_amdgcn_mfma_f32_32x32x16_bf16(pa2, PK(2), o[d0], 0, 0, 0);
        o[d0] = __builtin_amdgcn_mfma_f32_32x32x16_bf16(pa3, PK(3), o[d0], 0, 0, 0);
#undef PK
    }
}
#define ATTN_STORE16(p, v) (*(u32x4*)(p) = (v))
template <int THRL> __device__ __forceinline__ void attn_unit(int qb, const bf16* Qh, const bf16* __restrict__ Kh, const bf16* __restrict__ Vh, bf16* Oh, char* shm) {
    const int tid = fresh_tid(), lane = tid & 63, r32 = lane & 31, hi = lane >> 5; const int wid = __builtin_amdgcn_readfirstlane(tid >> 6);
    const int q0 = qb * QB;
    const bf16* Qw = Qh + (long)(q0 + wid * QBLK) * QP;
    const unsigned lds0 = (unsigned)(uintptr_t)shm;
    float* wsf = (float*)(shm + LDS_WS) + wid * 64;
    const bf16* ksrc = Kh + (long)lane * KP + wid * 8;
    const bf16* vsrc = Vh + (long)(16 * (wid & 3) + (lane >> 2)) * KP + (wid >> 2) * 32 + (lane & 3) * 8;
    const unsigned kdst = lds0 + LDS_K + wid * 1024, vdst = lds0 + LDS_V + wid * 1024;
#define DMA_K(t, slot) glds16(ksrc + (long)(t) * KVBLK * KP, (unsigned)__builtin_amdgcn_readfirstlane(kdst + (slot)))
#define DMA_V(t, slot) glds16(vsrc + (long)(t) * KVBLK * KP, (unsigned)__builtin_amdgcn_readfirstlane(vdst + (slot)))
    const int vb0 = (int)(lds0 + LDS_V) + ((lane >> 4) & 1) * 32 + (lane & 3) * 8 + (4 * hi + ((lane & 15) >> 2)) * 64;
    const char* Kbase = shm + LDS_K; bf16x8 kf[8];
    const lds_cptr shm3 = (lds_cptr)shm; const lds_cptr kp0 = shm3 + LDS_K + hi * 1024 + r32 * 16; const lds_cptr vp0 = shm3 + LDS_V + ((lane >> 4) & 1) * 32 + (lane & 3) * 8 + (4 * hi + ((lane & 15) >> 2)) * 64;
    constexpr int NT = SEQ / KVBLK;
    DMA_K(0, 0); DMA_V(0, 0); DMA_K(1, SLOTB);
    bf16x8 qr[4];
#pragma unroll
    for (int d0 = 0; d0 < 4; ++d0) qr[d0] = *reinterpret_cast<const bf16x8*>(&Qw[(long)r32 * QP + d0 * 16 + hi * 8]);
    float mhat = 0.f, l_reg = 0.f; f32x16 o[2]; o[0] = f32x16{}; o[1] = f32x16{}; f32x16 negm = f32x16{}; asm volatile("" : "+v"(negm));
    bool resc = false;
#define START(P0, P1) do { const float rm = rowmax(P0, P1); resc = false; \
    { const float dl = rm; mhat = fadd_s(mhat, dl); \
      _Pragma("unroll") for (int r = 0; r < 16; ++r) { P0[r] = fsub_s(P0[r], dl); P1[r] = fsub_s(P1[r], dl); } \
      _Pragma("unroll") for (int r = 0; r < 16; ++r) negm[r] = -mhat; asm volatile("" : "+v"(negm)); } \
    _Pragma("unroll") for (int r = 0; r < 16; ++r) P0[r] = __builtin_amdgcn_exp2f(P0[r]); } while (0)
#define RESC() do { if (resc) { asm volatile("s_waitcnt lgkmcnt(0)" ::: "memory"); \
      _Pragma("unroll") for (int d_ = 0; d_ < 2; ++d_) _Pragma("unroll") for (int r = 0; r < 16; ++r) o[d_][r] *= wsf[crow(r, hi)]; } } while (0)
    f32x16 pA0, pA1, pB0, pB1;
    int sl_prev = 0, sl_cur = 0, sl_next = SLOTB;
#define ROT() do { sl_prev = sl_cur; sl_cur = sl_next; sl_next = (sl_next == (NSLOT - 1) * SLOTB) ? 0 : sl_next + SLOTB; } while (0)
    DMA_K(2, 2 * SLOTB);
    WAIT_BAR(3);
    qkt(pA0, pA1, Kbase, qr, negm, r32, hi); asm volatile("s_nop 15\n\ts_nop 7" : "+v"(pA0), "+v"(pA1));
    START(pA0, pA1);
    _Pragma("unroll") for (int r = 0; r < 16; ++r) pA1[r] = __builtin_amdgcn_exp2f(pA1[r]);
    WAIT_BAR(0);
    DMA_K(3, 0); DMA_V(1, SLOTB);
    ROT();
    kload8(kf, kp0 + sl_cur);
    WAIT_BAR(2);
    s16x4 vlo[8], vhi[8]; u32x4 pw0, pw1, pw2, pw3;
#define PKW(P, B) cvtpk_s(P[B], P[B + 1])
#define PAF(k) __builtin_bit_cast(bf16x8, pw##k)
#define VFR(i) (bf16x8){vlo[i][0], vlo[i][1], vlo[i][2], vlo[i][3], vhi[i][0], vhi[i][1], vhi[i][2], vhi[i][3]}
#define PIN(x) asm volatile("" : "+v"(x))
#define MX3(a, b, c) __builtin_fmaxf(__builtin_fmaxf((a), (b)), (c))
#define GAPA(MF, A0, A1, A2, A3, W0, W1, PW) do { MF; sacc += A0; sacc += A1; sacc += A2; sacc += A3; PIN(sacc); W0; W1; PIN(PW); SBAR(); } while (0)
#define EX(v) __builtin_amdgcn_exp2f(v)
#define GAPB(MF, X, B) do { MF; X[B] = EX(X[B]); X[B + 1] = EX(X[B + 1]); X[B + 2] = EX(X[B + 2]); X[B + 3] = EX(X[B + 3]); PIN(X); SBAR(); } while (0)
#define VRD(i) do { vlo[i] = vtr(vp_ + (((i) >> 2) * 4096 + ((i) & 3) * 1024)); vhi[i] = vtr(vp_ + (((i) >> 2) * 4096 + ((i) & 3) * 1024 + 512)); } while (0)
#define KRD(G, j) do { if (G) { kload2(kf, kp0 + sl_next, j); SBAR(); } } while (0)
#define STEP(C0, C1, P0, P1, t, GK, GV, GL) do { SBAR(); \
    const lds_cptr vp_ = vp0 + sl_prev; \
    VRD(0); SBAR(); float sacc = (P0[0] + P0[1]); \
    GAPA(C0 = __builtin_amdgcn_mfma_f32_32x32x16_bf16(kf[0], qr[0], negm, 0, 0, 0), P0[2], P0[3], P0[4], P0[5],     pw0[0] = PKW(P0, 0), pw0[1] = PKW(P0, 2), pw0); \
    VRD(4); SBAR(); GAPA(C1 = __builtin_amdgcn_mfma_f32_32x32x16_bf16(kf[1], qr[0], negm, 0, 0, 0), P0[6], P0[7], P0[8], P0[9],     pw0[2] = PKW(P0, 4), pw0[3] = PKW(P0, 6), pw0); \
    VRD(1); SBAR(); GAPA(C0 = __builtin_amdgcn_mfma_f32_32x32x16_bf16(kf[2], qr[1], C0, 0, 0, 0),   P0[10], P0[11], P0[12], P0[13], pw1[0] = PKW(P0, 8), pw1[1] = PKW(P0, 10), pw1); \
    VRD(5); SBAR(); GAPA(C1 = __builtin_amdgcn_mfma_f32_32x32x16_bf16(kf[3], qr[1], C1, 0, 0, 0),   P0[14], P0[15], P1[0], P1[1],   pw1[2] = PKW(P0, 12), pw1[3] = PKW(P0, 14), pw1); \
    VRD(2); SBAR(); GAPA(C0 = __builtin_amdgcn_mfma_f32_32x32x16_bf16(kf[4], qr[2], C0, 0, 0, 0),   P1[2], P1[3], P1[4], P1[5],     pw2[0] = PKW(P1, 0), pw2[1] = PKW(P1, 2), pw2); \
    VRD(6); SBAR(); GAPA(C1 = __builtin_amdgcn_mfma_f32_32x32x16_bf16(kf[5], qr[2], C1, 0, 0, 0),   P1[6], P1[7], P1[8], P1[9],     pw2[2] = PKW(P1, 4), pw2[3] = PKW(P1, 6), pw2); \
    VRD(3); SBAR(); GAPA(C0 = __builtin_amdgcn_mfma_f32_32x32x16_bf16(kf[6], qr[3], C0, 0, 0, 0),   P1[10], P1[11], P1[12], P1[13], pw3[0] = PKW(P1, 8), pw3[1] = PKW(P1, 10), pw3); \
    VRD(7); SBAR(); GAPA(C1 = __builtin_amdgcn_mfma_f32_32x32x16_bf16(kf[7], qr[3], C1, 0, 0, 0),   P1[14], P1[15], 0.f, 0.f,       pw3[2] = PKW(P1, 12), pw3[3] = PKW(P1, 14), pw3); \
    l_reg += sacc; \
    if (GK) { DMA_K((t) + 3, sl_cur); } if (GV) { DMA_V((t) + 1, sl_next); } \
    { float a = MX3(C0[0], C0[1], C1[0]), b = MX3(C0[2], C0[3], C1[1]); a = MX3(a, C1[2], C1[3]); \
      _Pragma("unroll") for (int r = 4; r < 16; r += 4) { a = MX3(a, C0[r], C0[r + 1]); b = MX3(b, C0[r + 2], C0[r + 3]); a = MX3(a, C1[r], C1[r + 1]); b = MX3(b, C1[r + 2], C1[r + 3]); } \
      float rm = __builtin_fmaxf(a, b); { auto rr = __builtin_amdgcn_permlane32_swap(__float_as_uint(rm), __float_as_uint(rm), false, false); rm = __builtin_fmaxf(__uint_as_float(rr[0]), __uint_as_float(rr[1])); } \
      resc = false; \
      if (__builtin_expect(__any(rm > (float)THRL), 0)) { const float dl = __builtin_fmaxf(rm, 0.f); mhat += dl; \
        _Pragma("unroll") for (int r = 0; r < 16; ++r) { C0[r] -= dl; C1[r] -= dl; } \
        _Pragma("unroll") for (int r = 0; r < 16; ++r) negm[r] = -mhat; asm volatile("" : "+v"(negm)); \
        const float f = __builtin_amdgcn_exp2f(-dl); l_reg *= f; if (hi == 0) wsf[r32] = f; resc = true; } } \
    SBAR(); \
    GAPB(o[0] = __builtin_amdgcn_mfma_f32_32x32x16_bf16(PAF(0), VFR(0), o[0], 0, 0, 0), C0, 0); \
    GAPB(o[1] = __builtin_amdgcn_mfma_f32_32x32x16_bf16(PAF(0), VFR(4), o[1], 0, 0, 0), C0, 4); \
    KRD(GL, 0); GAPB(o[0] = __builtin_amdgcn_mfma_f32_32x32x16_bf16(PAF(1), VFR(1), o[0], 0, 0, 0), C0, 8); \
    KRD(GL, 1); GAPB(o[1] = __builtin_amdgcn_mfma_f32_32x32x16_bf16(PAF(1), VFR(5), o[1], 0, 0, 0), C0, 12); \
    KRD(GL, 2); GAPB(o[0] = __builtin_amdgcn_mfma_f32_32x32x16_bf16(PAF(2), VFR(2), o[0], 0, 0, 0), C1, 0); \
    KRD(GL, 3); GAPB(o[1] = __builtin_amdgcn_mfma_f32_32x32x16_bf16(PAF(2), VFR(6), o[1], 0, 0, 0), C1, 4); \
    GAPB(o[0] = __builtin_amdgcn_mfma_f32_32x32x16_bf16(PAF(3), VFR(3), o[0], 0, 0, 0), C1, 8); \
    GAPB(o[1] = __builtin_amdgcn_mfma_f32_32x32x16_bf16(PAF(3), VFR(7), o[1], 0, 0, 0), C1, 12); \
    } while (0)
    int t = 1;
    for (; t + 5 < NT; t += 2) {
        STEP(pB0, pB1, pA0, pA1, t, true, true, true);     WAIT_BAR(2); RESC(); ROT();
        STEP(pA0, pA1, pB0, pB1, t + 1, true, true, true); WAIT_BAR(2); RESC(); ROT();
    }
#define ENDW(tt) do { if ((tt) + 3 < NT) { WAIT_BAR(2); } else if ((tt) + 2 < NT) { WAIT_BAR(1); } else { WAIT_BAR(0); } } while (0)
    for (; t + 1 < NT; t += 2) {
        STEP(pB0, pB1, pA0, pA1, t, (t + 3 < NT), (t + 1 < NT), (t + 1 < NT));         ENDW(t);     RESC(); ROT();
        STEP(pA0, pA1, pB0, pB1, t + 1, (t + 4 < NT), (t + 2 < NT), (t + 2 < NT));     ENDW(t + 1); RESC(); ROT();
    }
    STEP(pB0, pB1, pA0, pA1, NT - 1, false, false, false); RESC();
    { float sacc = pB0[0] + pB0[1]; _Pragma("unroll") for (int r = 2; r < 16; ++r) sacc += pB0[r]; _Pragma("unroll") for (int r = 0; r < 16; ++r) sacc += pB1[r]; l_reg += sacc;
      pw0 = (u32x4){PKW(pB0, 0), PKW(pB0, 2), PKW(pB0, 4), PKW(pB0, 6)}; pw1 = (u32x4){PKW(pB0, 8), PKW(pB0, 10), PKW(pB0, 12), PKW(pB0, 14)}; pw2 = (u32x4){PKW(pB1, 0), PKW(pB1, 2), PKW(pB1, 4), PKW(pB1, 6)}; pw3 = (u32x4){PKW(pB1, 8), PKW(pB1, 10), PKW(pB1, 12), PKW(pB1, 14)};
      SBAR(); pv(o, vb0 + sl_cur, PAF(0), PAF(1), PAF(2), PAF(3)); }
#undef PKW
#undef PAF
#undef VFR
#undef PIN
#undef MX3
#undef GAPA
#undef GAPB
#undef EX
#undef VRD
#undef KRD
#undef STEP
#undef ENDW
    { auto rr = __builtin_amdgcn_permlane32_swap(__float_as_uint(l_reg), __float_as_uint(l_reg), false, false); l_reg = __uint_as_float(rr[0]) + __uint_as_float(rr[1]); }
    if (hi == 0) wsf[32 + r32] = l_reg; asm volatile("s_waitcnt lgkmcnt(0)" ::: "memory");
    float rli[16];
#pragma unroll
    for (int r = 0; r < 16; ++r) rli[r] = __builtin_amdgcn_rcpf(wsf[32 + crow(r, hi)]);
    bf16* Ow = Oh + (long)(q0 + wid * QBLK) * OP;
    { bf16* stg = (bf16*)(shm + LDS_OST) + wid * 2048;
#pragma unroll
      for (int r = 0; r < 16; ++r) { const int orow = crow(r, hi);
#pragma unroll
        for (int d0 = 0; d0 < 2; ++d0) stg[orow * 64 + d0 * 32 + r32] = __float2bfloat16(o[d0][r] * rli[r]); }
      asm volatile("s_waitcnt lgkmcnt(0)" ::: "memory");
#pragma unroll
      for (int i = 0; i < 4; ++i) { const int row = i * 8 + (lane >> 3), ch = lane & 7; const u32x4 v = *(const u32x4*)(stg + row * 64 + ch * 8); ATTN_STORE16(Ow + (long)row * OP + ch * 8, v); } }
    asm volatile("s_waitcnt lgkmcnt(0)\n\ts_barrier" ::: "memory");
#undef DMA_K
#undef DMA_V
#undef START
#undef RESC
#undef ROT
}

__device__ __forceinline__ void attn_unit_fast(int qb, const bf16* Qh, const bf16* __restrict__ Kh, const bf16* __restrict__ Vh, bf16* Oh, char* shm) {
    const int tid = fresh_tid(), lane = tid & 63, r32 = lane & 31, hi = lane >> 5; const int wid = __builtin_amdgcn_readfirstlane(tid >> 6);
    const int q0 = qb * QB;
    const bf16* Qw = Qh + (long)(q0 + wid * QBLK) * QP;
    const unsigned lds0 = (unsigned)(uintptr_t)shm;
    const bf16* ksrc = Kh + (long)lane * KP + wid * 8;
    const bf16* vsrc = Vh + (long)(16 * (wid & 3) + (lane >> 2)) * KP + (wid >> 2) * 32 + (lane & 3) * 8;
    const unsigned kdst = lds0 + LDS_K + wid * 1024, vdst = lds0 + LDS_V + wid * 1024;
#define DMA_K(t, slot) glds16(ksrc + (long)(t) * KVBLK * KP, (unsigned)__builtin_amdgcn_readfirstlane(kdst + (slot)))
#define DMA_V(t, slot) glds16(vsrc + (long)(t) * KVBLK * KP, (unsigned)__builtin_amdgcn_readfirstlane(vdst + (slot)))
    const int vb0 = (int)(lds0 + LDS_V) + ((lane >> 4) & 1) * 32 + (lane & 3) * 8 + (4 * hi + ((lane & 15) >> 2)) * 64;
    const char* Kbase = shm + LDS_K; bf16x8 kf[8];
    const lds_cptr shm3 = (lds_cptr)shm; const lds_cptr kp0 = shm3 + LDS_K + hi * 1024 + r32 * 16; const lds_cptr vp0 = shm3 + LDS_V + ((lane >> 4) & 1) * 32 + (lane & 3) * 8 + (4 * hi + ((lane & 15) >> 2)) * 64;
    constexpr int NT = SEQ / KVBLK;
    DMA_K(0, 0); DMA_V(0, 0); DMA_K(1, SLOTB);
    bf16x8 qr[4];
#pragma unroll
    for (int d0 = 0; d0 < 4; ++d0) qr[d0] = *reinterpret_cast<const bf16x8*>(&Qw[(long)r32 * QP + d0 * 16 + hi * 8]);
    f32x16 o[2]; o[0] = f32x16{}; o[1] = f32x16{}; f32x16 lsum = f32x16{};
    const f32x16 zero16 = f32x16{};
    bf16x8 ones; { const short one = (short)0x3F80; ones = (bf16x8){one, one, one, one, one, one, one, one}; asm volatile("" : "+v"(ones)); }
    f32x16 pA0, pA1, pB0, pB1;
    int sl_prev = 0, sl_cur = 0, sl_next = SLOTB;
#define ROT() do { sl_prev = sl_cur; sl_cur = sl_next; sl_next = (sl_next == (NSLOT - 1) * SLOTB) ? 0 : sl_next + SLOTB; } while (0)
    DMA_K(2, 2 * SLOTB);
    WAIT_BAR(3);
    qkt(pA0, pA1, Kbase, qr, zero16, r32, hi);
    _Pragma("unroll") for (int r = 0; r < 16; ++r) pA0[r] = __builtin_amdgcn_exp2f(pA0[r]);
    _Pragma("unroll") for (int r = 0; r < 16; ++r) pA1[r] = __builtin_amdgcn_exp2f(pA1[r]);
    WAIT_BAR(0);
    DMA_K(3, 0); DMA_V(1, SLOTB);
    ROT();
    kload8(kf, kp0 + sl_cur);
    WAIT_BAR(2);
    s16x4 vlo[8], vhi[8]; u32x4 pw0, pw1, pw2, pw3;
#define PKW(P, B) cvtpk_s(P[B], P[B + 1])
#define PAF(k) __builtin_bit_cast(bf16x8, pw##k)
#define VFR(i) (bf16x8){vlo[i][0], vlo[i][1], vlo[i][2], vlo[i][3], vhi[i][0], vhi[i][1], vhi[i][2], vhi[i][3]}
#define PIN(x) asm volatile("" : "+v"(x))
#define GAPA(MF, W0, W1, PW) do { MF; W0; W1; PIN(PW); SBAR(); } while (0)
#define EX(v) __builtin_amdgcn_exp2f(v)
#define GAPB(MF, X, B) do { MF; X[B] = EX(X[B]); X[B + 1] = EX(X[B + 1]); X[B + 2] = EX(X[B + 2]); PIN(X); SBAR(); } while (0)
#define GAPS(k, X, B) do { lsum = __builtin_amdgcn_mfma_f32_32x32x16_bf16(PAF(k), ones, lsum, 0, 0, 0); X[B] = EX(X[B]); X[B + 1] = EX(X[B + 1]); PIN(X); SBAR(); } while (0)
#define VRD(i) do { vlo[i] = vtr(vp_ + (((i) >> 2) * 4096 + ((i) & 3) * 1024)); vhi[i] = vtr(vp_ + (((i) >> 2) * 4096 + ((i) & 3) * 1024 + 512)); } while (0)
#define KRD(G, j) do { if (G) { kload2(kf, kp0 + sl_next, j); SBAR(); } } while (0)
#define STEP(C0, C1, P0, P1, t, GK, GV, GL) do { SBAR(); \
    const lds_cptr vp_ = vp0 + sl_prev; \
    VRD(0); SBAR(); \
    GAPA(C0 = __builtin_amdgcn_mfma_f32_32x32x16_bf16(kf[0], qr[0], zero16, 0, 0, 0), pw0[0] = PKW(P0, 0), pw0[1] = PKW(P0, 2), pw0); \
    VRD(4); SBAR(); GAPA(C1 = __builtin_amdgcn_mfma_f32_32x32x16_bf16(kf[1], qr[0], zero16, 0, 0, 0), pw0[2] = PKW(P0, 4), pw0[3] = PKW(P0, 6), pw0); \
    VRD(1); SBAR(); GAPA(C0 = __builtin_amdgcn_mfma_f32_32x32x16_bf16(kf[2], qr[1], C0, 0, 0, 0),   pw1[0] = PKW(P0, 8), pw1[1] = PKW(P0, 10), pw1); \
    VRD(5); SBAR(); GAPA(C1 = __builtin_amdgcn_mfma_f32_32x32x16_bf16(kf[3], qr[1], C1, 0, 0, 0),   pw1[2] = PKW(P0, 12), pw1[3] = PKW(P0, 14), pw1); \
    VRD(2); SBAR(); GAPA(C0 = __builtin_amdgcn_mfma_f32_32x32x16_bf16(kf[4], qr[2], C0, 0, 0, 0),   pw2[0] = PKW(P1, 0), pw2[1] = PKW(P1, 2), pw2); \
    VRD(6); SBAR(); GAPA(C1 = __builtin_amdgcn_mfma_f32_32x32x16_bf16(kf[5], qr[2], C1, 0, 0, 0),   pw2[2] = PKW(P1, 4), pw2[3] = PKW(P1, 6), pw2); \
    VRD(3); SBAR(); GAPA(C0 = __builtin_amdgcn_mfma_f32_32x32x16_bf16(kf[6], qr[3], C0, 0, 0, 0),   pw3[0] = PKW(P1, 8), pw3[1] = PKW(P1, 10), pw3); \
    VRD(7); SBAR(); GAPA(C1 = __builtin_amdgcn_mfma_f32_32x32x16_bf16(kf[7], qr[3], C1, 0, 0, 0),   pw3[2] = PKW(P1, 12), pw3[3] = PKW(P1, 14), pw3); \
    if (GK) { DMA_K((t) + 3, sl_cur); } if (GV) { DMA_V((t) + 1, sl_next); } \
    SBAR(); \
    GAPB(o[0] = __builtin_amdgcn_mfma_f32_32x32x16_bf16(PAF(0), VFR(0), o[0], 0, 0, 0), C0, 0); \
    GAPB(o[1] = __builtin_amdgcn_mfma_f32_32x32x16_bf16(PAF(0), VFR(4), o[1], 0, 0, 0), C0, 3); \
    KRD(GL, 0); GAPS(0, C0, 6); \
    GAPB(o[0] = __builtin_amdgcn_mfma_f32_32x32x16_bf16(PAF(1), VFR(1), o[0], 0, 0, 0), C0, 8); \
    KRD(GL, 1); GAPB(o[1] = __builtin_amdgcn_mfma_f32_32x32x16_bf16(PAF(1), VFR(5), o[1], 0, 0, 0), C0, 11); \
    GAPS(1, C0, 14); \
    KRD(GL, 2); GAPB(o[0] = __builtin_amdgcn_mfma_f32_32x32x16_bf16(PAF(2), VFR(2), o[0], 0, 0, 0), C1, 0); \
    KRD(GL, 3); GAPB(o[1] = __builtin_amdgcn_mfma_f32_32x32x16_bf16(PAF(2), VFR(6), o[1], 0, 0, 0), C1, 3); \
    GAPS(2, C1, 6); \
    GAPB(o[0] = __builtin_amdgcn_mfma_f32_32x32x16_bf16(PAF(3), VFR(3), o[0], 0, 0, 0), C1, 8); \
    GAPB(o[1] = __builtin_amdgcn_mfma_f32_32x32x16_bf16(PAF(3), VFR(7), o[1], 0, 0, 0), C1, 11); \
    GAPS(3, C1, 14); \
    } while (0)
    int t = 1;
    for (; t + 5 < NT; t += 2) {
        STEP(pB0, pB1, pA0, pA1, t, true, true, true);     WAIT_BAR(2); ROT();
        STEP(pA0, pA1, pB0, pB1, t + 1, true, true, true); WAIT_BAR(2); ROT();
    }
#define ENDW(tt) do { if ((tt) + 3 < NT) { WAIT_BAR(2); } else if ((tt) + 2 < NT) { WAIT_BAR(1); } else { WAIT_BAR(0); } } while (0)
    for (; t + 1 < NT; t += 2) {
        STEP(pB0, pB1, pA0, pA1, t, (t + 3 < NT), (t + 1 < NT), (t + 1 < NT));         ENDW(t);     ROT();
        STEP(pA0, pA1, pB0, pB1, t + 1, (t + 4 < NT), (t + 2 < NT), (t + 2 < NT));     ENDW(t + 1); ROT();
    }
    STEP(pB0, pB1, pA0, pA1, NT - 1, false, false, false);
    { pw0 = (u32x4){PKW(pB0, 0), PKW(pB0, 2), PKW(pB0, 4), PKW(pB0, 6)}; pw1 = (u32x4){PKW(pB0, 8), PKW(pB0, 10), PKW(pB0, 12), PKW(pB0, 14)}; pw2 = (u32x4){PKW(pB1, 0), PKW(pB1, 2), PKW(pB1, 4), PKW(pB1, 6)}; pw3 = (u32x4){PKW(pB1, 8), PKW(pB1, 10), PKW(pB1, 12), PKW(pB1, 14)};
      SBAR(); pv(o, vb0 + sl_cur, PAF(0), PAF(1), PAF(2), PAF(3));
      lsum = __builtin_amdgcn_mfma_f32_32x32x16_bf16(PAF(0), ones, lsum, 0, 0, 0); lsum = __builtin_amdgcn_mfma_f32_32x32x16_bf16(PAF(1), ones, lsum, 0, 0, 0);
      lsum = __builtin_amdgcn_mfma_f32_32x32x16_bf16(PAF(2), ones, lsum, 0, 0, 0); lsum = __builtin_amdgcn_mfma_f32_32x32x16_bf16(PAF(3), ones, lsum, 0, 0, 0); }
#undef PKW
#undef PAF
#undef VFR
#undef PIN
#undef GAPA
#undef GAPB
#undef GAPS
#undef EX
#undef VRD
#undef KRD
#undef STEP
#undef ENDW
    bf16* Ow = Oh + (long)(q0 + wid * QBLK) * OP;
    { bf16* stg = (bf16*)(shm + LDS_OST) + wid * 2048;
#pragma unroll
      for (int r = 0; r < 16; ++r) { const int orow = crow(r, hi); const float rl = __builtin_amdgcn_rcpf(lsum[r]);
#pragma unroll
        for (int d0 = 0; d0 < 2; ++d0) stg[orow * 64 + d0 * 32 + r32] = __float2bfloat16(o[d0][r] * rl); }
      asm volatile("s_waitcnt lgkmcnt(0)" ::: "memory");
#pragma unroll
      for (int i = 0; i < 4; ++i) { const int row = i * 8 + (lane >> 3), ch = lane & 7; const u32x4 v = *(const u32x4*)(stg + row * 64 + ch * 8); ATTN_STORE16(Ow + (long)row * OP + ch * 8, v); } }
    asm volatile("s_waitcnt lgkmcnt(0)\n\ts_barrier" ::: "memory");
#undef DMA_K
#undef DMA_V
#undef ROT
}
__device__ __forceinline__ void attn_unit_f8(int qb, const unsigned char* Q8h, const unsigned char* __restrict__ K8h, const unsigned char* __restrict__ V8Th, bf16* Oh, char* shm, float shift, const ConvRide cr) {
    const int tid = fresh_tid(), lane = tid & 63, r32 = lane & 31, hi = lane >> 5; const int wid = __builtin_amdgcn_readfirstlane(tid >> 6);
    const int q0 = qb * QB;
    const unsigned lds0 = (unsigned)(uintptr_t)shm;
    constexpr int KSL = 4096, RMASK = 4 * KSL - 1;
    const int pw = wid & 3; const bool kcls = wid < 4;
    const int prow = 16 * pw + (lane >> 2), pch = ((lane & 3) ^ ((prow >> 2) & 3)) * 16;
    const unsigned char* dsrc = kcls ? K8h + (long)prow * 64 + pch : V8Th + (long)prow * 64 + pch;
    const unsigned ddst = lds0 + (kcls ? LDS_K : LDS_V) + pw * 1024;
#define DMA_K(t, slot) do { if (kcls) glds16(dsrc + (long)(t) * KVBLK * 64, (unsigned)__builtin_amdgcn_readfirstlane(ddst + (slot))); } while (0)
#define DMA_V(t, slot) do { if (!kcls) glds16(dsrc + (long)(t) * 4096, (unsigned)__builtin_amdgcn_readfirstlane(ddst + (slot))); } while (0)
    const lds_cptr shm3 = (lds_cptr)shm; const int ksw = (r32 >> 2) & 3;
    const int fo0 = r32 * 64 + (((2 * hi) ^ ksw) * 16), fo1 = r32 * 64 + (((2 * hi + 1) ^ ksw) * 16);
    const lds_cptr kp0 = shm3 + LDS_K, vp0 = shm3 + LDS_V;
    constexpr int NT = SEQ / KVBLK;
    DMA_K(0, 0); DMA_V(0, 0); DMA_K(1, KSL); DMA_V(1, KSL);
    v8i qf; { const unsigned char* qp = Q8h + (long)(q0 + wid * QBLK + r32) * 512 + hi * 32; qf = __builtin_shufflevector(*(const v4i*)qp, *(const v4i*)(qp + 16), 0, 1, 2, 3, 4, 5, 6, 7); }
    const int sc_k = 127 - 3, sc_q = 127 - 5, sc_v = 127 - 3, sc_1 = 127;
    v8i kf8[2], vf8[2], pa;
    v8i ones8; { const int o4 = 0x38383838; ones8 = (v8i){o4, o4, o4, o4, o4, o4, o4, o4}; asm volatile("" : "+v"(ones8)); }
    f32x16 cin; { const float ns = -shift; _Pragma("unroll") for (int r = 0; r < 16; ++r) cin[r] = ns; asm volatile("" : "+v"(cin)); }
#define LD8(dst, base, slotoff) do { _Pragma("unroll") for (int n_ = 0; n_ < 2; ++n_) dst[n_] = __builtin_shufflevector(*(const LAS v4i*)((base) + (slotoff) + n_ * 2048 + fo0), *(const LAS v4i*)((base) + (slotoff) + n_ * 2048 + fo1), 0, 1, 2, 3, 4, 5, 6, 7); } while (0)
#define QK8(n_) __builtin_amdgcn_mfma_scale_f32_32x32x64_f8f6f4(kf8[n_], qf, cin, 0, 0, 0, sc_k, 0, sc_q)
#define ACC8(acc, a_, b_, sb_) asm volatile("s_nop 1\n\tv_mfma_scale_f32_32x32x64_f8f6f4 %0, %1, %2, %0, %3, %4 op_sel_hi:[0,0,0]" : "+v"(acc) : "v"(a_), "v"(b_), "v"(sc_1), "v"(sb_))
#define PACK8(P0, P1) do { pa[0] = (int)pk4_fp8_nc(P0[0], P0[1], P0[2], P0[3]); pa[1] = (int)pk4_fp8_nc(P0[4], P0[5], P0[6], P0[7]); pa[2] = (int)pk4_fp8_nc(P0[8], P0[9], P0[10], P0[11]); pa[3] = (int)pk4_fp8_nc(P0[12], P0[13], P0[14], P0[15]); \
    pa[4] = (int)pk4_fp8_nc(P1[0], P1[1], P1[2], P1[3]); pa[5] = (int)pk4_fp8_nc(P1[4], P1[5], P1[6], P1[7]); pa[6] = (int)pk4_fp8_nc(P1[8], P1[9], P1[10], P1[11]); pa[7] = (int)pk4_fp8_nc(P1[12], P1[13], P1[14], P1[15]); } while (0)
    f32x16 o[2]; o[0] = f32x16{}; o[1] = f32x16{}; f32x16 lsum = f32x16{};
    f32x16 pA0, pA1, pB0, pB1;
    int sl_m2 = 2 * KSL, sl_prev = 3 * KSL, sl_cur = 0, sl_next = KSL;
#define ROT() do { sl_m2 = sl_prev; sl_prev = sl_cur; sl_cur = sl_next; sl_next = (sl_next + KSL) & RMASK; } while (0)
    DMA_K(2, 2 * KSL); DMA_K(3, 3 * KSL);
    WAIT_BAR(0);
    LD8(kf8, kp0, 0); pA0 = QK8(0); pA1 = QK8(1);
    _Pragma("unroll") for (int r = 0; r < 16; ++r) pA0[r] = __builtin_amdgcn_exp2f(pA0[r]);
    _Pragma("unroll") for (int r = 0; r < 16; ++r) pA1[r] = __builtin_amdgcn_exp2f(pA1[r]);
    WAIT_BAR(0);
    DMA_K(4, 0); DMA_V(2, 2 * KSL);
    ROT();
    LD8(kf8, kp0, sl_cur);
    WAIT_BAR(2);
#define PIN(x) asm volatile("" : "+v"(x))
#define EX(v) __builtin_amdgcn_exp2f(v)
#define EX4(X, B) do { X[B] = EX(X[B]); X[B + 1] = EX(X[B + 1]); X[B + 2] = EX(X[B + 2]); X[B + 3] = EX(X[B + 3]); } while (0)
#define STEP(C0, C1, P0, P1, t, GK, GV, GL, HT, HK) do { SBAR(); HT; \
    LD8(vf8, vp0, sl_prev); \
    C0 = QK8(0); PACK8(P0, P1); PIN(pa); \
    C1 = QK8(1); \
    if (GK) { DMA_K((t) + 4, sl_cur); } if (GV) { DMA_V((t) + 2, sl_m2); } HK; \
    \
    ACC8(o[0], pa, vf8[0], sc_v); EX4(C0, 0); EX4(C0, 4); EX4(C0, 8); PIN(C0); \
    ACC8(o[1], pa, vf8[1], sc_v); EX4(C0, 12); EX4(C1, 0); EX4(C1, 4); PIN(C0); PIN(C1); \
    if (GL) { LD8(kf8, kp0, sl_next); } \
    ACC8(lsum, pa, ones8, sc_1); EX4(C1, 8); EX4(C1, 12); PIN(C1); \
    } while (0)
    int t = 1;
    { const float* cbase = nullptr; unsigned char* cdst = nullptr; unsigned char* cdst_p = nullptr; int cN = 0; bool cv_on = false, st_on = false; float ca[16]; u32x4 co = {0u, 0u, 0u, 0u}; const unsigned cvoff = (unsigned)lane * 4u;
      const float csc = 1.0f / F8_SC_W;
#define CV_LOAD4(g_) do { if (cv_on) { _Pragma("unroll") for (int i_ = 16 * (g_); i_ < 16 * (g_) + 16; ++i_) asm volatile("global_load_dword %0, %1, %2 nt" : "=v"(ca[i_]) : "v"(cvoff), "s"(cbase + (size_t)i_ * cN) : "memory"); } } while (0)
#define CV_PACK() do { if (cv_on) { _Pragma("unroll") for (int i_ = 0; i_ < 16; ++i_) asm volatile("" : "+v"(ca[i_])); \
        asm("v_cvt_scalef32_pk_fp8_f32 %0, %4, %5, %20\n\tv_cvt_scalef32_pk_fp8_f32 %1, %8, %9, %20\n\tv_cvt_scalef32_pk_fp8_f32 %2, %12, %13, %20\n\tv_cvt_scalef32_pk_fp8_f32 %3, %16, %17, %20\n\t" \
            "v_cvt_scalef32_pk_fp8_f32 %0, %6, %7, %20 op_sel:[0,0,0,1]\n\tv_cvt_scalef32_pk_fp8_f32 %1, %10, %11, %20 op_sel:[0,0,0,1]\n\tv_cvt_scalef32_pk_fp8_f32 %2, %14, %15, %20 op_sel:[0,0,0,1]\n\tv_cvt_scalef32_pk_fp8_f32 %3, %18, %19, %20 op_sel:[0,0,0,1]" \
            : "=&v"(co.x), "=&v"(co.y), "=&v"(co.z), "=&v"(co.w) : "v"(ca[0]), "v"(ca[1]), "v"(ca[2]), "v"(ca[3]), "v"(ca[4]), "v"(ca[5]), "v"(ca[6]), "v"(ca[7]), \
              "v"(ca[8]), "v"(ca[9]), "v"(ca[10]), "v"(ca[11]), "v"(ca[12]), "v"(ca[13]), "v"(ca[14]), "v"(ca[15]), "v"(csc)); cdst_p = cdst; st_on = true; } } while (0)
#define CV_STORE() do { if (st_on) { __builtin_nontemporal_store(co, (u32x4*)cdst_p); st_on = false; } } while (0)
#define WAITC(NC, N0) do { if (cv_on) { WAIT_BAR(NC); } else { WAIT_BAR(N0); } } while (0)
      for (; t + 11 < NT; t += 8) {
        { const int it = (t - 1) >> 3; cv_on = cr.u0 >= 0 && it < 12;
          if (cv_on) { const int u = __builtin_amdgcn_readfirstlane(cr.u0 + it * 256); const int e = u / 768; int q = u - e * 768;
            const float* W; unsigned char* WT; int K, n0, k0, row;
            if (q < 512) { const int up = q >> 8; q &= 255; W = (up ? cr.w_eu : cr.w_eg) + (size_t)e * 1024 * 2048; WT = cr.WGU + (size_t)e * 4096 * 1024; K = 1024; cN = 2048; n0 = 64 * (q & 31); k0 = 128 * (q >> 5);
                const int f = n0 + lane; row = (f >> 7) * 256 + up * 128 + (f & 127); }
            else { q -= 512; W = cr.w_ed + (size_t)e * 2048 * 1024; WT = cr.WD + (size_t)e * 1024 * 2048; K = 2048; cN = 1024; n0 = 64 * (q & 15); k0 = 128 * (q >> 4); row = n0 + lane; }
            cbase = W + (size_t)(k0 + 16 * wid) * cN + n0; cdst = WT + (size_t)row * K + k0 + 16 * wid; } }
        STEP(pB0, pB1, pA0, pA1, t, true, true, true, (void)0, CV_LOAD4(0));      WAITC(18, 2); ROT();
        STEP(pA0, pA1, pB0, pB1, t + 1, true, true, true, (void)0, (void)0);  WAITC(18, 2); ROT();
        STEP(pB0, pB1, pA0, pA1, t + 2, true, true, true, (void)0, (void)0);  WAITC(18, 2); ROT();
        STEP(pA0, pA1, pB0, pB1, t + 3, true, true, true, (void)0, (void)0);  WAIT_BAR(2); ROT();
        STEP(pB0, pB1, pA0, pA1, t + 4, true, true, true, (void)0, CV_PACK());      WAIT_BAR(2); ROT();
        STEP(pA0, pA1, pB0, pB1, t + 5, true, true, true, CV_STORE(), (void)0);      WAIT_BAR(2); ROT();
        STEP(pB0, pB1, pA0, pA1, t + 6, true, true, true, (void)0, (void)0);      WAIT_BAR(2); ROT();
        STEP(pA0, pA1, pB0, pB1, t + 7, true, true, true, (void)0, (void)0);    WAIT_BAR(2); ROT();
      }
      CV_STORE();
#undef CV_LOAD4
#undef CV_PACK
#undef CV_STORE
#undef WAITC
    }
    for (; t + 5 < NT; t += 2) {
        STEP(pB0, pB1, pA0, pA1, t, true, true, true, (void)0, (void)0);     WAIT_BAR(2); ROT();
        STEP(pA0, pA1, pB0, pB1, t + 1, true, true, true, (void)0, (void)0); WAIT_BAR(2); ROT();
    }
#define ENDW(tt) do { const int c_ = kcls ? (NT - 3 - (tt)) : (((tt) == NT - 2) ? 0 : (NT - 1 - (tt))); if (c_ >= 2) { WAIT_BAR(2); } else if (c_ == 1) { WAIT_BAR(1); } else { WAIT_BAR(0); } } while (0)
    for (; t + 1 < NT; t += 2) {
        STEP(pB0, pB1, pA0, pA1, t, (t + 4 < NT), (t + 2 < NT), (t + 1 < NT), (void)0, (void)0);         ENDW(t);     ROT();
        STEP(pA0, pA1, pB0, pB1, t + 1, (t + 5 < NT), (t + 3 < NT), (t + 2 < NT), (void)0, (void)0);     ENDW(t + 1); ROT();
    }
    STEP(pB0, pB1, pA0, pA1, NT - 1, false, false, false, (void)0, (void)0);
    { PACK8(pB0, pB1); PIN(pa); SBAR(); LD8(vf8, vp0, sl_cur); SBAR();
      ACC8(o[0], pa, vf8[0], sc_v); ACC8(o[1], pa, vf8[1], sc_v); ACC8(lsum, pa, ones8, sc_1); }
    asm volatile("s_nop 15\n\ts_nop 15" : "+v"(o[0]), "+v"(o[1]), "+v"(lsum));
#undef PIN
#undef EX
#undef EX4
#undef STEP
#undef ENDW
    bf16* Ow = Oh + (long)(q0 + wid * QBLK) * OP;
    { bf16* stg = (bf16*)(shm + LDS_OST) + wid * 2048;
#pragma unroll
      for (int r = 0; r < 16; ++r) { const int orow = crow(r, hi); const float rl = lsum[r] > 0.f ? __builtin_amdgcn_rcpf(lsum[r]) : 0.f;
#pragma unroll
        for (int d0 = 0; d0 < 2; ++d0) stg[orow * 64 + d0 * 32 + r32] = __float2bfloat16(o[d0][r] * rl); }
      asm volatile("s_waitcnt lgkmcnt(0)" ::: "memory");
#pragma unroll
      for (int i = 0; i < 4; ++i) { const int row = i * 8 + (lane >> 3), ch = lane & 7; const u32x4 v = *(const u32x4*)(stg + row * 64 + ch * 8); ATTN_STORE16(Ow + (long)row * OP + ch * 8, v); } }
    asm volatile("s_waitcnt lgkmcnt(0)\n\ts_barrier" ::: "memory");
#undef DMA_K
#undef DMA_V
#undef ROT
#undef LD8
#undef QK8
#undef ACC8
#undef PACK8
}
constexpr int ATTN_LDS_BYTES = LDS_BYTES;
#undef SBAR
#undef WAIT_BAR
}

namespace na_body {
constexpr int NA_K = 0, NA_V = 65536;
typedef short v4i16_t __attribute__((ext_vector_type(4)));
__device__ __forceinline__ int clampi(int v, int lo, int hi) { return v < lo ? lo : (v > hi ? hi : v); }
__device__ __forceinline__ void na_phase(LAS unsigned char* lds, LAS float* biasL, LAS float* xch, const bf16_t* QKV, bf16_t* Y, const float* rpb, int vcu) {
    const int tid = fresh_tid(), lane = tid & 63, wid = __builtin_amdgcn_readfirstlane(tid >> 6);
    const int bh = vcu >> 3, b = bh >> 3, h = bh & 7, rbase = (vcu & 7) * 16;
    for (int i = tid; i < 15 * 31; i += 512) biasL[i] = rpb[h * 465 + i];
    const int lc = tid >> 3, lch = tid & 7;
    const unsigned kwoff = (unsigned)(lc * 128 + ((lch ^ (lc & 7)) * 16));
    const unsigned vwoff = (unsigned)(lc * 128 + (((lch >> 1) ^ ((lc >> 1) & 3)) * 32) + (lch & 1) * 16);
    const int q = lane & 15, g = lane >> 4;
    { const int rt0 = clampi(rbase - 4, 0, 104); const char* pg = (const char*)(QKV + ((size_t)b * SEQ + (size_t)rt0 * 64) * NQKV); unsigned acc = 0u;
      constexpr int NPG = (24 * 64 * NQKV * 2 + 4095) / 4096;
#pragma unroll
      for (int i = 0; i < (NPG + 511) / 512; ++i) { const int pgi = tid + 512 * i; if (pgi < NPG) acc += *(const unsigned*)(pg + (size_t)pgi * 4096); }
      asm volatile("" :: "v"(acc)); }
    { const int rs0 = clampi(rbase - 4, 0, 120);
      u32x4 kv[8], vv[8];
#pragma unroll
      for (int i = 0; i < 8; ++i) { const size_t tok = (size_t)b * SEQ + (size_t)(rs0 + i) * 64 + lc;
          kv[i] = *(const u32x4*)(QKV + tok * NQKV + C_KNA + h * 64 + lch * 8); vv[i] = *(const u32x4*)(QKV + tok * NQKV + C_VNA + h * 64 + lch * 8); }
#pragma unroll
      for (int i = 0; i < 8; ++i) { const int row = rs0 + i;
          *(LAS u32x4*)(lds + NA_K + (row & 7) * 8192 + kwoff) = kv[i]; *(LAS u32x4*)(lds + NA_V + (row & 7) * 8192 + vwoff) = vv[i]; } }
    __syncthreads();
    const int tile_ = wid & 3, c0_ = tile_ * 16;
    bf16x8 qn[2];
#pragma unroll
    for (int ks = 0; ks < 2; ++ks) qn[ks] = *(const bf16x8*)(QKV + ((size_t)b * SEQ + (size_t)rbase * 64 + c0_ + q) * NQKV + C_QNA + h * 64 + ks * 32 + g * 8);
    float bt[4][2][4]; int bt_delta = 1 << 20;
    u32x4 pkN, pvN;
    { const int rs0 = clampi(rbase - 4, 0, 120), rsn0 = clampi(rbase + 1 - 4, 0, 120); (void)rs0; const size_t tok = (size_t)b * SEQ + (size_t)(rsn0 + 7) * 64 + lc;
      pkN = *(const u32x4*)(QKV + tok * NQKV + C_KNA + h * 64 + lch * 8); pvN = *(const u32x4*)(QKV + tok * NQKV + C_VNA + h * 64 + lch * 8); }
    for (int rr = 0; rr < 16; ++rr) {
        const int r = rbase + rr, rs = clampi(r - 4, 0, 120);
        const int rsn = (rr < 15) ? clampi(r + 1 - 4, 0, 120) : rs; const bool pf = rsn != rs;
        const u32x4 pk = pkN, pv = pvN;
        { const int r2 = (rr < 14) ? r + 2 : rbase + 15; const int rsn2 = clampi(r2 - 4, 0, 120); const size_t tok = (size_t)b * SEQ + (size_t)(rsn2 + 7) * 64 + lc;
          pkN = *(const u32x4*)(QKV + tok * NQKV + C_KNA + h * 64 + lch * 8); pvN = *(const u32x4*)(QKV + tok * NQKV + C_VNA + h * 64 + lch * 8); }
        {
            const int tile = wid & 3, kh = wid >> 2;
            const int c0 = tile * 16, u0 = clampi(c0 - 8, 0, 32);
            const size_t tq = (size_t)b * SEQ + (size_t)r * 64 + c0 + q;
            bf16x8 qf[2]; qf[0] = qn[0]; qf[1] = qn[1];
            { const int rn = (rr < 15) ? r + 1 : r; const size_t tqn = (size_t)b * SEQ + (size_t)rn * 64 + c0 + q;
#pragma unroll
              for (int ks = 0; ks < 2; ++ks) qn[ks] = *(const bf16x8*)(QKV + tqn * NQKV + C_QNA + h * 64 + ks * 32 + g * 8); }
            f32x4 s[4][2];
#pragma unroll
            for (int kk = 0; kk < 4; ++kk) { const int slot = (rs + 4 * kh + kk) & 7;
#pragma unroll
                for (int hf = 0; hf < 2; ++hf) { const int kc = u0 + hf * 16 + q;
                    f32x4 a = (f32x4){0.f, 0.f, 0.f, 0.f};
#pragma unroll
                    for (int ks = 0; ks < 2; ++ks) { const bf16x8 kfr = *(const LAS bf16x8*)(lds + NA_K + slot * 8192 + kc * 128 + (((ks * 4 + g) ^ (kc & 7)) * 16));
                        a = __builtin_amdgcn_mfma_f32_16x16x32_bf16(kfr, qf[ks], a, 0, 0, 0); }
                    s[kk][hf] = a; } }
            if (rs - r != bt_delta) { bt_delta = rs - r;
                const int c = c0 + q, cs = clampi(c - 8, 0, 48), lo = cs - u0;
                const int dcb = u0 - c + 15 + 4 * g;
#pragma unroll
                for (int kk = 0; kk < 4; ++kk) { const int dr = bt_delta + 4 * kh + kk + 7;
#pragma unroll
                    for (int hf = 0; hf < 2; ++hf)
#pragma unroll
                        for (int i = 0; i < 4; ++i) { const int kcl = 16 * hf + 4 * g + i; const bool valid = (kcl >= lo) && (kcl < lo + 16);
                            const int dc = clampi(dcb + 16 * hf + i, 0, 30);
                            bt[kk][hf][i] = valid ? biasL[dr * 31 + dc] * LOG2E : -1e30f; } } }
            float mx = -1e30f;
#pragma unroll
            for (int kk = 0; kk < 4; ++kk)
#pragma unroll
                for (int hf = 0; hf < 2; ++hf)
#pragma unroll
                    for (int i = 0; i < 4; ++i) { const float v = fmaf(s[kk][hf][i], LOG2E, bt[kk][hf][i]); s[kk][hf][i] = v; mx = fmaxf(mx, v); }
            mx = swap16_max(mx); mx = swap32_max(mx);
            float l = 0.f;
#pragma unroll
            for (int kk = 0; kk < 4; ++kk)
#pragma unroll
                for (int hf = 0; hf < 2; ++hf)
#pragma unroll
                    for (int i = 0; i < 4; ++i) { const float p = __builtin_amdgcn_exp2f(s[kk][hf][i] - mx); s[kk][hf][i] = p; l += p; }
            l = swap16_sum(l, l); l = swap32_sum(l, l);
            f32x4 o[4];
#pragma unroll
            for (int nb = 0; nb < 4; ++nb) o[nb] = (f32x4){0.f, 0.f, 0.f, 0.f};
            const int qq = (lane & 15) >> 2, pp = lane & 3;
            const int kcA = u0 + 4 * g + qq, kcB = kcA + 16;
#pragma unroll
            for (int kk = 0; kk < 4; ++kk) { const int slot = (rs + 4 * kh + kk) & 7;
                u32x4 pw; pw.x = pk2(s[kk][0][0], s[kk][0][1]); pw.y = pk2(s[kk][0][2], s[kk][0][3]); pw.z = pk2(s[kk][1][0], s[kk][1][1]); pw.w = pk2(s[kk][1][2], s[kk][1][3]);
                const bf16x8 pf = __builtin_bit_cast(bf16x8, pw);
#pragma unroll
                for (int nb = 0; nb < 4; ++nb) {
                    const s16x4 va = __builtin_bit_cast(s16x4, __builtin_amdgcn_ds_read_tr16_b64_v4i16((LAS v4i16_t*)(lds + NA_V + slot * 8192 + kcA * 128 + ((nb ^ ((kcA >> 1) & 3)) * 32) + pp * 8)));
                    const s16x4 vb = __builtin_bit_cast(s16x4, __builtin_amdgcn_ds_read_tr16_b64_v4i16((LAS v4i16_t*)(lds + NA_V + slot * 8192 + kcB * 128 + ((nb ^ ((kcB >> 1) & 3)) * 32) + pp * 8)));
                    const bf16x8 vf = (bf16x8){va[0], va[1], va[2], va[3], vb[0], vb[1], vb[2], vb[3]};
                    o[nb] = __builtin_amdgcn_mfma_f32_16x16x32_bf16(vf, pf, o[nb], 0, 0, 0); } }
            LAS float* px = xch + (size_t)(tile * 64 + lane) * 18;
            if (kh == 1) { px[0] = mx; px[1] = l;
#pragma unroll
                for (int nb = 0; nb < 4; ++nb)
#pragma unroll
                    for (int i = 0; i < 4; ++i) px[2 + nb * 4 + i] = o[nb][i]; }
            __syncthreads();
            if (kh == 0) { const float mb = px[0], lb = px[1]; const float m = fmaxf(mx, mb), fa = __builtin_amdgcn_exp2f(mx - m), fb = __builtin_amdgcn_exp2f(mb - m);
                const float rl = 1.0f / (l * fa + lb * fb);
#pragma unroll
                for (int nb = 0; nb < 4; ++nb) { float t[4];
#pragma unroll
                    for (int i = 0; i < 4; ++i) t[i] = (o[nb][i] * fa + px[2 + nb * 4 + i] * fb) * rl;
                    u32x2 w; w.x = pk2(t[0], t[1]); w.y = pk2(t[2], t[3]);
                    *(u32x2*)(Y + tq * DMODEL + h * 64 + nb * 16 + 4 * g) = w; } }
        }
        if (pf) { *(LAS u32x4*)(lds + NA_K + ((rsn + 7) & 7) * 8192 + kwoff) = pk; *(LAS u32x4*)(lds + NA_V + ((rsn + 7) & 7) * 8192 + vwoff) = pv; }
        __syncthreads();
    }
}
}

constexpr size_t MiB = 1u << 20;
constexpr size_t WS_CTL = 0, CTL_ZERO_BYTES = 1 * MiB;
constexpr size_t WS_MOD = 1 * MiB;
constexpr size_t WS_IDX = 2 * MiB;
constexpr size_t WS_GSEL = 2 * MiB + 256 * 1024;
constexpr size_t WS_AFF = 3 * MiB;
constexpr size_t WS_SLOT = 5 * MiB;
constexpr size_t WS_WIN = 7 * MiB;
constexpr size_t WS_WG8 = 12 * MiB;
constexpr size_t WS_WA = 16 * MiB, WS_WB = 17 * MiB, WS_WOUT = 18 * MiB;
constexpr size_t WS_WGU = 20 * MiB;
constexpr size_t WS_WD = 148 * MiB;
constexpr size_t WS_H = 212 * MiB;
constexpr size_t WS_QKV = 276 * MiB;
constexpr size_t WS_GATES = 420 * MiB;
constexpr size_t WS_END = 548 * MiB;
constexpr size_t WS_YBUF = WS_WGU;
static_assert(WS_QKV + (size_t)65536 * 2048 * 2 <= WS_END, "HMID fits");
constexpr int CW_BAR = 4096;

constexpr int RING_OFF = 0, RING_BYTES = 131072;
constexpr int LDSCTL_OFF = RING_BYTES, MISC_OFF = LDSCTL_OFF + 320;
constexpr int NABIAS_OFF = RING_BYTES + 1024;
constexpr int NAXCH_OFF = RING_BYTES + 4096;
constexpr int LDS_BYTES = 163840;

#define XB_TMO      128
#define XB_XCNT(j)  (256  + 64 * (j))
#define XB_XSUB(j)  (1280 + 64 * (j))
#define XB_XGEN(j)  (2304 + 64 * (j))
#define XB_TOP      3328
#define XB_TOPGEN   3392
#define XCD_BAR_WORDS 3456
#define XB_SPIN_CAP (1u << 22)
__device__ __forceinline__ unsigned xb_ld(unsigned* p)              { return __hip_atomic_load(p, __ATOMIC_RELAXED, __HIP_MEMORY_SCOPE_AGENT); }
__device__ __forceinline__ unsigned xb_add(unsigned* p, unsigned v) { return __hip_atomic_fetch_add(p, v, __ATOMIC_RELAXED, __HIP_MEMORY_SCOPE_AGENT); }
__device__ __forceinline__ unsigned xb_xcc_id() { return (unsigned)__builtin_amdgcn_s_getreg((3 << 11) | 20) & 0xFu; }
#define XB_SPIN(cond, bar) do { unsigned _sp = 0; while (cond) { __builtin_amdgcn_s_sleep(1); \
    if ((++_sp & 255u) == 0u) { if (xb_ld(&(bar)[XB_TMO])) break; if (_sp > XB_SPIN_CAP) { atomicAdd(&(bar)[XB_TMO], 1u); break; } } } } while (0)
struct XcdBarrier { unsigned* bar; unsigned x; volatile LAS unsigned* st; };
__device__ __forceinline__ XcdBarrier xcd_barrier_post(unsigned* bar, volatile LAS unsigned* st) {
    XcdBarrier b; b.bar = bar; b.x = xb_xcc_id(); b.st = st;
    if (threadIdx.x == 0) (void)xb_add(&bar[XB_XCNT(b.x)], 1u);
    return b;
}
__device__ __forceinline__ void xcd_barrier_complete(unsigned* bar, unsigned x, unsigned& nloc, unsigned& nx) {
    const unsigned G = gridDim.x * gridDim.y * gridDim.z;
    unsigned sum, cnt, mine, sp = 0u;
    for (;;) {
        sum = 0u; cnt = 0u; mine = 0u;
#pragma unroll
        for (unsigned j = 0; j < 16; ++j) { const unsigned c = xb_ld(&bar[XB_XCNT(j)]); sum += c; cnt += (c > 0u) ? 1u : 0u; mine = (j == x) ? c : mine; }
        if (sum == G) break;
        __builtin_amdgcn_s_sleep(1);
        if ((++sp & 255u) == 0u) { if (xb_ld(&bar[XB_TMO])) break; if (sp > XB_SPIN_CAP) { atomicAdd(&bar[XB_TMO], 1u); break; } }
    }
    nloc = mine > 0u ? mine : 1u; nx = cnt > 0u ? cnt : 1u;
}
__device__ __forceinline__ void xcd_barrier(const XcdBarrier& b) {
    asm volatile("s_waitcnt vmcnt(0)" ::: "memory");
    __syncthreads();
    if (threadIdx.x == 0) {
        unsigned* bar = b.bar;
        __builtin_amdgcn_s_waitcnt(0);
        unsigned nloc = b.st[0], nx = b.st[1];
        if (nloc == 0u) { xcd_barrier_complete(bar, b.x, nloc, nx); b.st[0] = nloc; b.st[1] = nx; }
        const unsigned old = xb_add(&bar[XB_XSUB(b.x)], 1u);
        const unsigned gen = old / nloc;
        if (old + 1u == (gen + 1u) * nloc) {
            __builtin_amdgcn_fence(__ATOMIC_RELEASE, "agent");
            asm volatile("s_waitcnt vmcnt(0)" ::: "memory");
            const unsigned og = xb_add(&bar[XB_TOP], 1u);
            const unsigned tg = og / nx;
            if (og + 1u == (tg + 1u) * nx) xb_add(&bar[XB_TOPGEN], 1u);
            else XB_SPIN(xb_ld(&bar[XB_TOPGEN]) == tg, bar);
            __builtin_amdgcn_fence(__ATOMIC_ACQUIRE, "agent");
            xb_add(&bar[XB_XGEN(b.x)], 1u);
            asm volatile("s_waitcnt vmcnt(0)" ::: "memory");
        } else {
            XB_SPIN(xb_ld(&bar[XB_XGEN(b.x)]) == gen, bar);
            __builtin_amdgcn_fence(__ATOMIC_ACQUIRE, "agent");
            asm volatile("s_waitcnt vmcnt(0)" ::: "memory");
        }
    }
    __syncthreads();
}

#define LDS_WAIT() asm volatile("s_waitcnt lgkmcnt(0)" ::: "memory")
template <class RowMap>
__device__ __forceinline__ void p0_transpose_item(const float* W, int K, int N, bf16_t* WT, LAS float* scr, int item, int lane, const RowMap& rowmap) {
    const int nblk = N / 32, kb = item / nblk, nb = item % nblk, k0 = 64 * kb, n0 = 32 * nb;
    float ld_[32];
#pragma unroll
    for (int i = 0; i < 32; ++i) ld_[i] = __builtin_nontemporal_load(&W[(size_t)(k0 + 2 * i + (lane >> 5)) * N + n0 + (lane & 31)]);
#pragma unroll
    for (int i = 0; i < 32; ++i) scr[(2 * i + (lane >> 5)) * 33 + (lane & 31)] = ld_[i];
    LDS_WAIT(); asm volatile("" ::: "memory");
    const int c = lane & 7;
#pragma unroll
    for (int j = 0; j < 4; ++j) { const int n = (lane >> 3) + 8 * j; const LAS float* s = scr + (8 * c) * 33 + n;
        u32x4 o; o.x = pk2(s[0 * 33], s[1 * 33]); o.y = pk2(s[2 * 33], s[3 * 33]); o.z = pk2(s[4 * 33], s[5 * 33]); o.w = pk2(s[6 * 33], s[7 * 33]);
        *(u32x4*)(WT + (size_t)rowmap(n0 + n) * K + k0 + 8 * c) = o; }
    LDS_WAIT(); asm volatile("" ::: "memory");
}
template <class RowMap>
__device__ __forceinline__ void p0_transpose_item_f8(const float* W, int K, int N, unsigned char* WT, LAS float* scr, int item, int lane, const RowMap& rowmap, float scale) {
    const int nblk = N / 32, kb = item / nblk, nb = item % nblk, k0 = 64 * kb, n0 = 32 * nb;
    float ld_[32];
#pragma unroll
    for (int i = 0; i < 32; ++i) ld_[i] = __builtin_nontemporal_load(&W[(size_t)(k0 + 2 * i + (lane >> 5)) * N + n0 + (lane & 31)]);
#pragma unroll
    for (int i = 0; i < 32; ++i) scr[(2 * i + (lane >> 5)) * 33 + (lane & 31)] = ld_[i];
    LDS_WAIT(); asm volatile("" ::: "memory");
#pragma unroll
    for (int j = 0; j < 2; ++j) { const int p = lane + 64 * j, n = p >> 2, c = p & 3; const LAS float* s = scr + (16 * c) * 33 + n;
        u32x4 o;
        o.x = pk4_fp8(s[0 * 33] * scale, s[1 * 33] * scale, s[2 * 33] * scale, s[3 * 33] * scale);
        o.y = pk4_fp8(s[4 * 33] * scale, s[5 * 33] * scale, s[6 * 33] * scale, s[7 * 33] * scale);
        o.z = pk4_fp8(s[8 * 33] * scale, s[9 * 33] * scale, s[10 * 33] * scale, s[11 * 33] * scale);
        o.w = pk4_fp8(s[12 * 33] * scale, s[13 * 33] * scale, s[14 * 33] * scale, s[15 * 33] * scale);
        *(u32x4*)(WT + (size_t)rowmap(n0 + n) * K + k0 + 16 * c) = o; }
    LDS_WAIT(); asm volatile("" ::: "memory");
}
struct RowId { __device__ __forceinline__ int operator()(int n) const { return n; } };
struct RowIn { __device__ __forceinline__ int operator()(int n) const { if (n < 1536) return n; const int oc = n & 255; return (n & ~255) + 128 * ((oc >> 5) & 1) + 32 * (oc >> 6) + (oc & 31); } };
struct RowGate { __device__ __forceinline__ int operator()(int n) const { const int g = n - NQKV, c = g & 1023; return 768 + (c >> 7) * 256 + (g >> 10) * 128 + (c & 127); } };
struct RowAll8 { __device__ __forceinline__ int operator()(int n) const { if (n < NQKV) return RowIn{}(n); const int g = n - NQKV, c = g & 1023; return NQKV + (c >> 7) * 256 + (g >> 10) * 128 + (c & 127); } };
struct RowHead8 { __device__ __forceinline__ int operator()(int n) const { return RowIn{}(n) - 1536; } };
struct RowGU { int up; __device__ __forceinline__ int operator()(int f) const { return (f >> 7) * 256 + up * 128 + (f & 127); } };

struct CvDesc { const float* W; unsigned char* WT; int K, N, k0, n0, gu, up; };
__device__ __forceinline__ CvDesc cv_decode(int r, const float* w_eg, const float* w_eu, const float* w_ed, unsigned char* WGU, unsigned char* WD) {
    constexpr int I_GU = 16 * 64, I_D = 32 * 32;
    CvDesc d; const int e = r / (2 * I_GU + I_D); int q = r - e * (2 * I_GU + I_D);
    if (q < 2 * I_GU) { d.up = q >= I_GU; q -= d.up * I_GU; d.W = (d.up ? w_eu : w_eg) + (size_t)e * 1024 * 2048; d.WT = WGU + (size_t)e * 4096 * 1024; d.K = 1024; d.N = 2048; d.gu = 1; }
    else { q -= 2 * I_GU; d.W = w_ed + (size_t)e * 2048 * 1024; d.WT = WD + (size_t)e * 1024 * 2048; d.K = 2048; d.N = 1024; d.gu = 0; d.up = 0; }
    const int nblk = d.N / 32; d.k0 = 64 * (q / nblk); d.n0 = 32 * (q % nblk);
    return d;
}
#define CV_LOAD(ld_, d_) do { _Pragma("unroll") for (int i_ = 0; i_ < 32; ++i_) ld_[i_] = __builtin_nontemporal_load(&(d_).W[(size_t)((d_).k0 + 2 * i_ + (lane >> 5)) * (d_).N + (d_).n0 + (lane & 31)]); } while (0)
#define CV_FINISH(ld_, d_) do { _Pragma("unroll") for (int i_ = 0; i_ < 32; ++i_) scr[(2 * i_ + (lane >> 5)) * 33 + (lane & 31)] = ld_[i_]; \
        LDS_WAIT(); asm volatile("" ::: "memory"); \
        _Pragma("unroll") for (int j_ = 0; j_ < 2; ++j_) { const int p_ = lane + 64 * j_, n_ = p_ >> 2, c_ = p_ & 3; const LAS float* s_ = scr + (16 * c_) * 33 + n_; const int f_ = (d_).n0 + n_; \
            const int row_ = (d_).gu ? ((f_ >> 7) * 256 + (d_).up * 128 + (f_ & 127)) : f_; u32x4 o_; \
            o_.x = pk4_fp8(s_[0 * 33] * F8_SC_W, s_[1 * 33] * F8_SC_W, s_[2 * 33] * F8_SC_W, s_[3 * 33] * F8_SC_W); \
            o_.y = pk4_fp8(s_[4 * 33] * F8_SC_W, s_[5 * 33] * F8_SC_W, s_[6 * 33] * F8_SC_W, s_[7 * 33] * F8_SC_W); \
            o_.z = pk4_fp8(s_[8 * 33] * F8_SC_W, s_[9 * 33] * F8_SC_W, s_[10 * 33] * F8_SC_W, s_[11 * 33] * F8_SC_W); \
            o_.w = pk4_fp8(s_[12 * 33] * F8_SC_W, s_[13 * 33] * F8_SC_W, s_[14 * 33] * F8_SC_W, s_[15 * 33] * F8_SC_W); \
            *(u32x4*)((d_).WT + (size_t)row_ * (d_).K + (d_).k0 + 16 * c_) = o_; } \
        LDS_WAIT(); asm volatile("" ::: "memory"); } while (0)
__device__ __forceinline__ void conv_experts_pipelined(int first, int end, int step, int lane, LAS float* scr, const float* w_eg, const float* w_eu, const float* w_ed, unsigned char* WGU, unsigned char* WD) {
    float ldA[32], ldB[32]; CvDesc dA, dB; int itA = first, itB = first + step;
    if (itA < end) { dA = cv_decode(itA, w_eg, w_eu, w_ed, WGU, WD); CV_LOAD(ldA, dA); }
    if (itB < end) { dB = cv_decode(itB, w_eg, w_eu, w_ed, WGU, WD); CV_LOAD(ldB, dB); }
    for (;;) {
        if (itA >= end) break;
        CV_FINISH(ldA, dA); itA += 2 * step;
        if (itA < end) { dA = cv_decode(itA, w_eg, w_eu, w_ed, WGU, WD); CV_LOAD(ldA, dA); }
        if (itB >= end) break;
        CV_FINISH(ldB, dB); itB += 2 * step;
        if (itB < end) { dB = cv_decode(itB, w_eg, w_eu, w_ed, WGU, WD); CV_LOAD(ldB, dB); }
    }
}
#undef CV_LOAD
#undef CV_FINISH

__constant__ float INV_FREQ[16] = {1.0f, 0.5623413251903491f, 0.31622776601683794f, 0.1778279410038923f, 0.1f, 0.05623413251903491f, 0.03162277660168379f, 0.01778279410038923f,
                                   0.01f, 0.005623413251903491f, 0.0031622776601683794f, 0.001778279410038923f, 0.001f, 0.0005623413251903491f, 0.00031622776601683794f, 0.0001778279410038923f};

struct Args { const float* in[18]; float* out; unsigned char* ws; int ph_lo, ph_hi, li, pad; };
constexpr int NPHASE = 12;

__global__ void __launch_bounds__(512, 2) mk_fwd(Args args) {
    extern __shared__ __attribute__((aligned(16))) unsigned char lds_raw[];
    LAS unsigned char* lds = (LAS unsigned char*)lds_raw;
    volatile LAS unsigned* MISC = (volatile LAS unsigned*)(lds + MISC_OFF);
    const int G = gridDim.x; const int bx = blockIdx.x; const int vcu = (G % 8 == 0) ? (bx % 8) * (G / 8) + bx / 8 : bx;
    const int NGW = G * 8;
#define PH_IDS() const int tid = fresh_tid(), lane = tid & 63, wave = __builtin_amdgcn_readfirstlane(tid >> 6), gw = vcu * 8 + wave; (void)lane; (void)gw
    constexpr int I_IN = 16 * 136, I_BR = 8 * 32, I_OUT = 16 * 32, I_GU = 16 * 64, I_D = 32 * 32;
    constexpr int N_SMALL_ITEMS = I_IN + 2 * I_BR + I_OUT, N_EXP_ITEMS = 16 * (2 * I_GU + I_D);
#define CONV_ITEM(it_) do { LAS float* scr_ = (LAS float*)(lds + RING_OFF + wave * 16384); int r_ = (it_); \
        if (r_ < I_IN) { p0_transpose_item_f8(w_in, 1024, NIN, WG8, scr_, r_, lane, RowAll8{}, F8_SC_W); break; } r_ -= I_IN; \
        if (r_ < I_BR) { p0_transpose_item(w_bna, 512, 1024, WA, scr_, r_, lane, RowId{}); break; } r_ -= I_BR; \
        if (r_ < I_BR) { p0_transpose_item(w_bgqa, 512, 1024, WB, scr_, r_, lane, RowId{}); break; } r_ -= I_BR; \
        if (r_ < I_OUT) { p0_transpose_item(w_out, 1024, 1024, WOUT, scr_, r_, lane, RowId{}); break; } r_ -= I_OUT; \
        const int e_ = r_ / (2 * I_GU + I_D); r_ -= e_ * (2 * I_GU + I_D); \
        if (r_ < I_GU) { p0_transpose_item_f8(w_eg + (size_t)e_ * 1024 * 2048, 1024, 2048, (unsigned char*)WGU + (size_t)e_ * 4096 * 1024, scr_, r_, lane, RowGU{0}, F8_SC_W); break; } r_ -= I_GU; \
        if (r_ < I_GU) { p0_transpose_item_f8(w_eu + (size_t)e_ * 1024 * 2048, 1024, 2048, (unsigned char*)WGU + (size_t)e_ * 4096 * 1024, scr_, r_, lane, RowGU{1}, F8_SC_W); break; } r_ -= I_GU; \
        p0_transpose_item_f8(w_ed + (size_t)e_ * 2048 * 1024, 2048, 1024, (unsigned char*)WD + (size_t)e_ * 1024 * 2048, scr_, r_, lane, RowId{}, F8_SC_W); } while (0)
    unsigned char* ws = args.ws;
    const float* x = args.in[0]; const float* cvec = args.in[1]; const float* w_ada = args.in[2]; const float* b_ada = args.in[3]; const float* norm1_g = args.in[4];
    const float* w_in = args.in[5]; const float* q_norm_g = args.in[6]; const float* k_norm_g = args.in[7]; const float* na_rpb = args.in[8];
    const float* w_bna = args.in[9]; const float* w_bgqa = args.in[10]; const float* w_out = args.in[11]; const float* norm2_g = args.in[12]; const float* w_router = args.in[13];
    const float* w_eg = args.in[14]; const float* w_eu = args.in[15]; const float* w_ed = args.in[16]; const float* final_g = args.in[17];
    float* out = args.out;
    unsigned* ctl = (unsigned*)(ws + WS_CTL);
    float* MOD = (float*)(ws + WS_MOD); int* IDX = (int*)(ws + WS_IDX); float* GSEL = (float*)(ws + WS_GSEL); float* AFF = (float*)(ws + WS_AFF); int* SLOT = (int*)(ws + WS_SLOT);
    bf16_t* WIN = (bf16_t*)(ws + WS_WIN); bf16_t* WA = (bf16_t*)(ws + WS_WA); bf16_t* WB = (bf16_t*)(ws + WS_WB); bf16_t* WOUT = (bf16_t*)(ws + WS_WOUT);
    bf16_t* WGU = (bf16_t*)(ws + WS_WGU); bf16_t* WD = (bf16_t*)(ws + WS_WD);
    bf16_t* HB = (bf16_t*)(ws + WS_H); bf16_t* QKV = (bf16_t*)(ws + WS_QKV);
    bf16_t* GA = (bf16_t*)(ws + WS_GATES); unsigned char* R8 = ws + WS_GATES + 64 * MiB; unsigned char* H8 = ws + WS_GATES + 96 * MiB; unsigned char* WG8 = ws + WS_WIN;
    unsigned char* Q8 = ws + WS_WGU + 64 * MiB; unsigned char* K8 = ws + WS_WGU + 80 * MiB; unsigned char* V8T = ws + WS_WGU + 84 * MiB;
    bf16_t* DELTA = (bf16_t*)(ws + WS_GATES);
    bf16_t* MERGED = (bf16_t*)(ws + WS_QKV); bf16_t* HMID = (bf16_t*)(ws + WS_QKV); bf16_t* YBUF = (bf16_t*)(ws + WS_YBUF);

    { PH_IDS(); for (int u = tid; u < (LDS_BYTES - LDSCTL_OFF) / 4; u += 512) ((LAS unsigned*)(lds + LDSCTL_OFF))[u] = 0u; }
    __syncthreads();
    const bool use_bar = (MK_N_LAUNCHES != NPHASE);
    XcdBarrier bar; bar.bar = ctl + CW_BAR + args.li * XCD_BAR_WORDS; bar.x = 0; bar.st = nullptr;
    if (use_bar) bar = xcd_barrier_post(ctl + CW_BAR + args.li * XCD_BAR_WORDS, MISC + 8);
    const int lo = args.ph_lo, hi = args.ph_hi;
#ifndef PHASE_MASK
#define PHASE_MASK 0xFFF
#endif
#define IN(k) (((PHASE_MASK >> (k)) & 1) && lo <= (k) && (k) < hi)
#define SEAM(k) do { if (IN(k) && IN((k) + 1)) xcd_barrier(bar); } while (0)

    if (IN(0)) {
        PH_IDS();
        LAS float* scr = (LAS float*)(lds + RING_OFF + wave * 16384);
        const bool p0s = (G == 256); const int xj = vcu & 31, xc = vcu >> 5; const bool gemv_cu = p0s ? (xj < 12) : (vcu < 96); const int it0 = p0s ? (gemv_cu ? xc * 12 + xj : 96) : vcu;
        if (gemv_cu) {
            LAS float* sl = (LAS float*)(lds + RING_OFF);
            for (int i = tid; i < 4096; i += 512) { const float cv = cvec[i]; sl[i] = cv * sigmoidf_fast(cv); }
            __syncthreads();
        }
        for (int it = it0; it < 96; it += G) {
            const LAS float* sl = (const LAS float*)(lds + RING_OFF);
            const int col = it * 64 + lane; float a0 = 0.f, a1 = 0.f, a2 = 0.f, a3 = 0.f;
#pragma unroll 16
            for (int dd = 0; dd < 128; ++dd) { const int d = wave * 128 + dd; const float w = w_ada[(size_t)d * 6144 + col];
                a0 += sl[d] * w; a1 += sl[1024 + d] * w; a2 += sl[2048 + d] * w; a3 += sl[3072 + d] * w; }
            LAS float* part = (LAS float*)(lds + RING_OFF + 8 * 16384 - 8192);
            part[(wave * 4 + 0) * 64 + lane] = a0; part[(wave * 4 + 1) * 64 + lane] = a1; part[(wave * 4 + 2) * 64 + lane] = a2; part[(wave * 4 + 3) * 64 + lane] = a3;
            __syncthreads();
            if (tid < 256) { const int bb = tid >> 6, l = tid & 63; float s = 0.f;
#pragma unroll
                for (int w = 0; w < 8; ++w) s += part[(w * 4 + bb) * 64 + l];
                MOD[bb * 6144 + it * 64 + l] = s + b_ada[it * 64 + l]; }
            __syncthreads();
        }
        if (p0s) { if (!gemv_cu) for (int it = (xc * 20 + xj - 12) * 8 + wave; it < N_SMALL_ITEMS; it += 160 * 8) { CONV_ITEM(it); } }
        else for (int it = gw; it < N_SMALL_ITEMS; it += NGW) { CONV_ITEM(it); }
    }
    SEAM(0);

    if (IN(1)) {
        PH_IDS();
        f32x4 gnv[4], nx[4];
#pragma unroll
        for (int j = 0; j < 4; ++j) { gnv[j] = *(const f32x4*)(norm1_g + 4 * lane + 256 * j); nx[j] = __builtin_nontemporal_load((const f32x4*)(x + (size_t)gw * DMODEL) + lane + 64 * j); }
        for (int m = gw; m < MT; m += NGW) { const int b = m >> 13; const float* mb = MOD + b * 6144;
            f32x4 v[4], scv[4], shv[4]; float s = 0.f;
#pragma unroll
            for (int j = 0; j < 4; ++j) { v[j] = nx[j]; scv[j] = *(const f32x4*)(mb + 1024 + 4 * lane + 256 * j); shv[j] = *(const f32x4*)(mb + 4 * lane + 256 * j); }
            const int mn = (m + NGW < MT) ? m + NGW : m;
#pragma unroll
            for (int j = 0; j < 4; ++j) nx[j] = __builtin_nontemporal_load((const f32x4*)(x + (size_t)mn * DMODEL) + lane + 64 * j);
#pragma unroll
            for (int j = 0; j < 4; ++j) s += (v[j].x * v[j].x + v[j].y * v[j].y) + (v[j].z * v[j].z + v[j].w * v[j].w);
            const float rinv = __builtin_amdgcn_rsqf(wave_sum(s) * (1.f / DMODEL) + EPS);
#pragma unroll
            for (int j = 0; j < 4; ++j) {
                const f32x4 hv = v[j] * rinv * gnv[j] * (scv[j] + 1.0f) + shv[j];
                ((unsigned*)(H8 + (size_t)m * DMODEL) + lane)[64 * j] = pk4_fp8(hv.x * F8_SC_H2, hv.y * F8_SC_H2, hv.z * F8_SC_H2, hv.w * F8_SC_H2); }
        }
    }
    SEAM(1);

#define ATTN_BOUND() float smaxp; { const int l_ = fresh_tid() & 63; float mq_ = fabsf(q_norm_g[l_]), mk_ = fabsf(k_norm_g[l_]); \
        _Pragma("unroll") for (int o_ = 1; o_ < 64; o_ <<= 1) { mq_ = fmaxf(mq_, __shfl_xor(mq_, o_)); mk_ = fmaxf(mk_, __shfl_xor(mk_, o_)); } smaxp = LOG2E * 8.0f * mq_ * mk_; } \
        const bool fast = __builtin_amdgcn_readfirstlane((int)(smaxp <= 24.0f)) != 0
    if (IN(2)) {
        ATTN_BOUND();
        { pg8::SchedPlain S; S.init(MT, NIN, G, bx, H8, DMODEL, WG8, DMODEL); S.flip = true;
          pg8::EpiHeadGate E{pg8::EpiProj{QKV, Q8, K8, V8T, q_norm_g, k_norm_g, !fast}, pg8::EpiGate{GA, R8}};
          pg8::gemm_phase<true>(lds + RING_OFF, 8, S, E); }
    }
    SEAM(2);


    if (IN(4)) {
        PH_IDS();
#define CONV_EXPERTS() do { conv_experts_pipelined(gw, N_EXP_ITEMS, NGW, lane, (LAS float*)(lds + RING_OFF + wave * 16384), w_eg, w_eu, w_ed, (unsigned char*)WGU, (unsigned char*)WD); __syncthreads(); } while (0)
        const int cls = vcu & 3;
        ATTN_BOUND(); const float shiftv = fmaxf(smaxp - 8.0f, 0.0f);
        const bool ride = fast && G == 256;
        if (cls == 0 && !ride) CONV_EXPERTS();
        const bool na_last = ride && (vcu & 1);
        if (G == 256 && !na_last) na_body::na_phase(lds + RING_OFF, (LAS float*)(lds + NABIAS_OFF), (LAS float*)(lds + NAXCH_OFF), QKV, HB, na_rpb, vcu);
        if (cls == 1 && !ride) CONV_EXPERTS();
        static_assert(attn_body::ATTN_LDS_BYTES <= RING_BYTES, "attention LDS");
        for (int i = 0; i < 4; ++i) { const long L = (long)i * G + vcu; if (L >= 1024) break;
            if (!ride && ((cls == 2 && i == 1) || (cls == 3 && i == 2))) { PH_IDS(); CONV_EXPERTS(); }
            const int ii = (int)(L >> 8), v = (int)(L & 255), bh = v >> 3, qb = (v & 7) * 4 + ii, b = bh >> 3, h = bh & 7;
            const attn_body::bf16* base = (const attn_body::bf16*)QKV + (size_t)b * SEQ * NQKV;
            if (fast) attn_body::attn_unit_f8(qb, Q8 + (size_t)b * SEQ * 512 + h * 64, K8 + (size_t)(b * 2 + (h >> 2)) * SEQ * 64, V8T + (size_t)(b * 2 + (h >> 2)) * 64 * SEQ,
                                    (attn_body::bf16*)HB + (size_t)b * SEQ * DMODEL + 512 + h * 64, (char*)lds_raw + RING_OFF, shiftv,
                                    ConvRide{w_eg, w_eu, w_ed, (unsigned char*)WGU, (unsigned char*)WD, ride ? i * 3072 + vcu : -1});
            else attn_body::attn_unit<8>(qb, base + C_QG + h * 64, base + C_KG + (h >> 2) * 64, base + C_VG + (h >> 2) * 64,
                                    (attn_body::bf16*)HB + (size_t)b * SEQ * DMODEL + 512 + h * 64, (char*)lds_raw + RING_OFF); }
        if (G == 256 && na_last) { __syncthreads(); na_body::na_phase(lds + RING_OFF, (LAS float*)(lds + NABIAS_OFF), (LAS float*)(lds + NAXCH_OFF), QKV, HB, na_rpb, vcu); }
#undef CONV_EXPERTS
    }
    SEAM(4);

    if (IN(5)) {
        pg8::SchedPlain S; S.init(MT, DMODEL, G, bx, HB + 512, DMODEL * 2, WB, 512 * 2); S.A2 = (const char*)HB; S.B2 = (const char*)WA; S.nt1 = 8;
        pg8::EpiMerge E{MERGED, GA, R8};
        pg8::gemm_phase<false, pg8::EpiMerge, pg8::SchedPlain, true>(lds + RING_OFF, 16, S, E);
    }
    SEAM(5);

    if (IN(6)) {
        pg8::SchedPlain S; S.init(MT, DMODEL, G, bx, MERGED, DMODEL * 2, WOUT, DMODEL * 2);
        pg8::EpiDelta E{DELTA, MOD};
        pg8::gemm_phase<false>(lds + RING_OFF, 16, S, E);
    }
    SEAM(6);

    if (IN(7)) {
        PH_IDS();
        f32x4 nv[2][4]; u32x2 nd[2][4];
#define P7_LOADX(row_) do { const f32x4* p_ = (const f32x4*)(x + (size_t)(row_) * DMODEL) + lane; const u32x2* d_ = (const u32x2*)(DELTA + (size_t)(row_) * DMODEL) + lane; \
            _Pragma("unroll") for (int j_ = 0; j_ < 4; ++j_) { nv[0][j_] = __builtin_nontemporal_load(&p_[64 * j_]); nv[1][j_] = __builtin_nontemporal_load(&p_[256 + 64 * j_]); \
                nd[0][j_] = d_[64 * j_]; nd[1][j_] = d_[256 + 64 * j_]; } } while (0)
        P7_LOADX(gw * 2);
        LAS float* wr = (LAS float*)(lds + RING_OFF);
        for (int i = tid; i < 16384; i += 512) { const int d = i >> 4, e = i & 15; wr[e * 1024 + d] = w_router[i]; }
        __syncthreads();
        for (int m = gw * 2; m < MT; m += NGW * 2) { const int b = m >> 13; const float* mb = MOD + b * 6144;
            f32x4 v[2][4], gnv[4], scv[4], shv[4]; float s0 = 0.f, s1 = 0.f;
            const int mn = (m + NGW * 2 < MT) ? m + NGW * 2 : m;
#pragma unroll
            for (int j = 0; j < 4; ++j) { const int col = 4 * lane + 256 * j;
#pragma unroll
                for (int r = 0; r < 2; ++r) { const u32x2 dd = nd[r][j]; v[r][j] = nv[r][j] + (f32x4){bf_lo(dd.x), bf_hi(dd.x), bf_lo(dd.y), bf_hi(dd.y)}; }
                gnv[j] = *(const f32x4*)(norm2_g + col); scv[j] = *(const f32x4*)(mb + 4096 + col); shv[j] = *(const f32x4*)(mb + 3072 + col); }
            P7_LOADX(mn);
            asm volatile("" ::: "memory");
#pragma unroll
            for (int j = 0; j < 4; ++j) {
                s0 += (v[0][j].x * v[0][j].x + v[0][j].y * v[0][j].y) + (v[0][j].z * v[0][j].z + v[0][j].w * v[0][j].w);
                s1 += (v[1][j].x * v[1][j].x + v[1][j].y * v[1][j].y) + (v[1][j].z * v[1][j].z + v[1][j].w * v[1][j].w); }
            s0 = wave_sum(s0); s1 = wave_sum(s1);
            const float rinv0 = __builtin_amdgcn_rsqf(s0 * (1.f / DMODEL) + EPS), rinv1 = __builtin_amdgcn_rsqf(s1 * (1.f / DMODEL) + EPS);
#pragma unroll
            for (int j = 0; j < 4; ++j) {
                const f32x4 a = gnv[j] * (scv[j] + 1.0f);
                v[0][j] = v[0][j] * rinv0 * a + shv[j]; v[1][j] = v[1][j] * rinv1 * a + shv[j];
                ((unsigned*)((unsigned char*)HB + (size_t)m * DMODEL) + lane)[64 * j] = pk4_fp8(v[0][j].x * F8_SC_H2, v[0][j].y * F8_SC_H2, v[0][j].z * F8_SC_H2, v[0][j].w * F8_SC_H2);
                ((unsigned*)((unsigned char*)HB + (size_t)(m + 1) * DMODEL) + lane)[64 * j] = pk4_fp8(v[1][j].x * F8_SC_H2, v[1][j].y * F8_SC_H2, v[1][j].z * F8_SC_H2, v[1][j].w * F8_SC_H2); }
            float pr[32];
#pragma unroll
            for (int e = 0; e < 16; ++e) { float a0 = 0.f, a1 = 0.f;
#pragma unroll
                for (int j = 0; j < 4; ++j) { const f32x4 w = *(const LAS f32x4*)(wr + e * 1024 + 4 * lane + 256 * j);
                    a0 += (v[0][j].x * w.x + v[0][j].y * w.y) + (v[0][j].z * w.z + v[0][j].w * w.w);
                    a1 += (v[1][j].x * w.x + v[1][j].y * w.y) + (v[1][j].z * w.z + v[1][j].w * w.w); }
                pr[e] = a0; pr[16 + e] = a1; if ((e & 3) == 3) asm volatile("" ::: "memory"); }
            float q16[16], q8[8];
#pragma unroll
            for (int i = 0; i < 16; ++i) q16[i] = swap32_sum(pr[i], pr[i + 16]);
#pragma unroll
            for (int i = 0; i < 8; ++i) q8[i] = swap16_sum(q16[i], q16[i + 8]);
            const bool up8 = (lane & 8) != 0, up4 = (lane & 4) != 0, up2 = (lane & 2) != 0;
            float q4[4], q2[2];
#pragma unroll
            for (int i = 0; i < 4; ++i) { float lo = q8[i], hi = q8[i + 4]; asm volatile("" : "+v"(lo), "+v"(hi)); q4[i] = (up8 ? hi : lo) + dppf<DPP_XOR8>(up8 ? lo : hi); }
#pragma unroll
            for (int i = 0; i < 2; ++i) { float lo = q4[i], hi = q4[i + 2]; asm volatile("" : "+v"(lo), "+v"(hi)); q2[i] = (up4 ? hi : lo) + lane_xor4(up4 ? lo : hi); }
            float mylog;
            { float lo = q2[0], hi = q2[1]; asm volatile("" : "+v"(lo), "+v"(hi)); mylog = (up2 ? hi : lo) + dppf<DPP_XOR2>(up2 ? lo : hi); }
            mylog += dppf<DPP_XOR1>(mylog);
            float mx = mylog;
            mx = fmaxf(mx, dppf<DPP_XOR2>(mx)); mx = fmaxf(mx, lane_xor4(mx)); mx = fmaxf(mx, dppf<DPP_XOR8>(mx)); mx = swap16_max(mx);
            const float ex = __expf(mylog - mx); float sum = ex;
            sum += dppf<DPP_XOR2>(sum); sum += lane_xor4(sum); sum += dppf<DPP_XOR8>(sum); sum = swap16_sum(sum, sum);
            if ((lane & 1) == 0) AFF[(unsigned)(m + (lane >> 5)) * 16u + (unsigned)((lane >> 1) & 15)] = ex * __builtin_amdgcn_rcpf(sum);
        }
#undef P7_LOADX
        __syncthreads();
    }
    SEAM(7);

    if (IN(8)) {
        PH_IDS();
        LAS unsigned* vals = (LAS unsigned*)(lds + RING_OFF);
        LAS unsigned* hist = (LAS unsigned*)(lds + RING_OFF + 32768);
        LAS unsigned* sel = (LAS unsigned*)(lds + RING_OFF + 32768 + 4096);
        LAS unsigned* wtot = (LAS unsigned*)(lds + RING_OFF + 32768 + 4096 + 256);
        const bool p8q = (G == 256); const int part = vcu & 3;
        for (int item = p8q ? (vcu >> 2) : vcu; item < 64; item += G) { const int b = item >> 4, e = item & 15;
            __syncthreads();
            for (int k = 0; k < 16; ++k) { const int t = tid + 512 * k; vals[t] = __builtin_bit_cast(unsigned, AFF[((size_t)b * SEQ + t) * 16 + e]); }
            __syncthreads();
            unsigned mv[16];
#pragma unroll
            for (int k = 0; k < 16; ++k) mv[k] = vals[tid + 512 * k];
            unsigned T = 0u, rem = (unsigned)CAP;
#pragma unroll 1
            for (int pass = 0; pass < 3; ++pass) { const int lo = 20 - 10 * pass;
                hist[tid] = 0u; hist[tid + 512] = 0u;
                __syncthreads();
#pragma unroll
                for (int k = 0; k < 16; ++k) { const unsigned v = mv[k];
                    if (pass == 0 || ((v ^ T) >> (lo + 10)) == 0u) __hip_atomic_fetch_add(&hist[(v >> lo) & 1023u], 1u, __ATOMIC_RELAXED, __HIP_MEMORY_SCOPE_WORKGROUP); }
                __syncthreads();
                const unsigned h1 = hist[1023 - 2 * tid], h0 = hist[1022 - 2 * tid], s2 = h1 + h0; unsigned incl = s2;
#pragma unroll
                for (int o = 1; o < 64; o <<= 1) { const unsigned n = __shfl_up(incl, o); if (lane >= o) incl += n; }
                if (lane == 63) wtot[wave] = incl;
                __syncthreads();
                unsigned above = incl - s2;
                for (int w = 0; w < wave; ++w) above += wtot[w];
                if (above < rem && rem <= above + h1) { sel[0] = (unsigned)(1023 - 2 * tid); sel[1] = rem - above; }
                else if (above + h1 < rem && rem <= above + s2) { sel[0] = (unsigned)(1022 - 2 * tid); sel[1] = rem - above - h1; }
                __syncthreads();
                T |= sel[0] << lo; rem = sel[1]; }
            unsigned cgt = 0u;
#pragma unroll
            for (int k = 0; k < 16; ++k) cgt += (unsigned)__popcll(__ballot(mv[k] > T));
            __syncthreads();
            if (lane == 0) wtot[wave] = cgt;
            __syncthreads();
            unsigned ngt = 0u;
#pragma unroll
            for (int w = 0; w < 8; ++w) ngt += wtot[w];
            const unsigned need_eq = (unsigned)CAP - ngt;
            __syncthreads();
            unsigned cg = 0u, ce = 0u;
            for (int k = 0; k < 16; ++k) { const unsigned v = vals[16 * tid + k]; cg += (v > T) ? 1u : 0u; ce += (v == T) ? 1u : 0u; }
            unsigned packed = cg | (ce << 16), incl = packed;
#pragma unroll
            for (int o = 1; o < 64; o <<= 1) { const unsigned n = __shfl_up(incl, o); if (lane >= o) incl += n; }
            if (lane == 63) wtot[wave] = incl;
            __syncthreads();
            unsigned wbase = 0u;
            for (int w = 0; w < wave; ++w) wbase += wtot[w];
            const unsigned excl = wbase + incl - packed;
            unsigned g_before = excl & 0xffffu, e_before = excl >> 16;
            if (!p8q || (tid >> 7) == part)
            for (int k = 0; k < 16; ++k) { const int t = 16 * tid + k; const unsigned v = vals[t]; int slot = -1;
                if (v > T) { slot = (int)(g_before + (e_before < need_eq ? e_before : need_eq)); ++g_before; }
                else if (v == T) { if (e_before < need_eq) slot = (int)(g_before + e_before); ++e_before; }
                SLOT[((size_t)b * SEQ + t) * 16 + e] = slot;
                if (slot >= 0) { IDX[item * CAP + slot] = t; GSEL[item * CAP + slot] = __builtin_bit_cast(float, v); } }
        }
        __syncthreads();
    }
    SEAM(8);

    if (IN(9)) {
        pg8::SchedFfn1 S{G, vcu, (const char*)HB, (const char*)WGU, IDX, DMODEL, DMODEL};
        pg8::EpiFfn1 E{(unsigned char*)HMID};
        pg8::gemm_phase<true>(lds + RING_OFF, 8, S, E);
    }
    SEAM(9);

    if (IN(10)) {
        pg8::SchedFfn2 S{G, vcu, (const char*)HMID, (const char*)WD, FF, FF};
        pg8::EpiFfn2 E{(unsigned char*)YBUF, GSEL};
        pg8::gemm_phase<true>(lds + RING_OFF, 16, S, E);
    }
    SEAM(10);

    if (IN(11)) {
        PH_IDS();
        f32x4 fgv[4];
#pragma unroll
        for (int j = 0; j < 4; ++j) fgv[j] = *(const f32x4*)(final_g + 4 * lane + 256 * j);
        f32x4 nx[4]; u32x2 ndl[4]; int nsl;
#define P11_LOADX(row_) do { const f32x4* p_ = (const f32x4*)(x + (size_t)(row_) * DMODEL) + lane; const u32x2* d_ = (const u32x2*)(DELTA + (size_t)(row_) * DMODEL) + lane; \
            _Pragma("unroll") for (int j_ = 0; j_ < 4; ++j_) { nx[j_] = __builtin_nontemporal_load(&p_[64 * j_]); ndl[j_] = __builtin_nontemporal_load(&d_[64 * j_]); } \
            nsl = (lane < 16) ? SLOT[(size_t)(row_) * 16 + lane] : -1; } while (0)
#define P11_ISSUE() do { _Pragma("unroll") for (int k_ = 0; k_ < 4; ++k_) { if (mask) { const int e_ = __builtin_ctz(mask); mask &= mask - 1u; const int s_ = __builtin_amdgcn_readlane(sl, e_); \
                const unsigned* yr_ = (const unsigned*)((const unsigned char*)YBUF + ((size_t)(b * 16 + e_) * CAP + s_) * DMODEL) + lane; _Pragma("unroll") for (int j_ = 0; j_ < 4; ++j_) y[k_][j_] = __builtin_nontemporal_load(&yr_[64 * j_]); } \
            else { _Pragma("unroll") for (int j_ = 0; j_ < 4; ++j_) y[k_][j_] = 0u; } } } while (0)
#define P11_ACC() do { _Pragma("unroll") for (int k_ = 0; k_ < 4; ++k_) _Pragma("unroll") for (int j_ = 0; j_ < 4; ++j_) { const unsigned w_ = y[k_][j_]; \
            const auto lo_ = __builtin_amdgcn_cvt_pk_f32_fp8((int)w_, false), hi_ = __builtin_amdgcn_cvt_pk_f32_fp8((int)w_, true); a[j_].x += lo_[0]; a[j_].y += lo_[1]; a[j_].z += hi_[0]; a[j_].w += hi_[1]; } } while (0)
        P11_LOADX(gw);
        for (int m = gw; m < MT; m += NGW) { const int b = m >> 13; const float* g2 = MOD + b * 6144 + 5120;
            f32x4 v[4], a[4], g2v[4]; const int sl = nsl;
#pragma unroll
            for (int j = 0; j < 4; ++j) { const u32x2 dd = ndl[j]; v[j] = nx[j] + (f32x4){bf_lo(dd.x), bf_hi(dd.x), bf_lo(dd.y), bf_hi(dd.y)}; a[j] = (f32x4){0.f, 0.f, 0.f, 0.f}; g2v[j] = *(const f32x4*)(g2 + 4 * lane + 256 * j) * (1.0f / F8_SC_Y); }
            unsigned mask = (unsigned)__ballot(sl >= 0) & 0xFFFFu;
            const int mn = (m + NGW < MT) ? m + NGW : m;
            unsigned y[4][4];
            P11_ISSUE();
            P11_LOADX(mn);
            P11_ACC();
            while (mask) { P11_ISSUE(); P11_ACC(); }
            float s2 = 0.f;
#pragma unroll
            for (int j = 0; j < 4; ++j) { v[j] = v[j] + g2v[j] * a[j]; s2 += (v[j].x * v[j].x + v[j].y * v[j].y) + (v[j].z * v[j].z + v[j].w * v[j].w); }
            const float rinv = __builtin_amdgcn_rsqf(wave_sum(s2) * (1.f / DMODEL) + EPS);
            f32x4* xr = (f32x4*)(out + (size_t)m * DMODEL) + lane;
#pragma unroll
            for (int j = 0; j < 4; ++j) __builtin_nontemporal_store(v[j] * rinv * fgv[j], &xr[64 * j]);
        }
#undef P11_LOADX
#undef P11_ISSUE
#undef P11_ACC
    }
#undef IN
#undef SEAM
}

extern "C" void kernel_launch(void* const* d_in, const int* in_sizes, int n_in, void* d_out, int out_size, void* d_ws, size_t ws_size, hipStream_t stream) {
    static int grid = 0;
    if (grid == 0) {
        if (n_in != 18 || in_sizes[0] != MT * DMODEL || out_size != MT * DMODEL || ws_size < WS_END) {
            fprintf(stderr, "kernel_launch: unexpected shapes / workspace: n_in %d in0 %d out %d ws %zu (need %zu); nothing launched\n", n_in, n_in > 0 ? in_sizes[0] : -1, out_size, ws_size, (size_t)WS_END); grid = -1; return; }
        int dev = 0, cus = 0, per_cu = 0;
        if (hipGetDevice(&dev) != hipSuccess || hipDeviceGetAttribute(&cus, hipDeviceAttributeMultiprocessorCount, dev) != hipSuccess) { grid = -1; return; }
        if (hipFuncSetAttribute((const void*)mk_fwd, hipFuncAttributeMaxDynamicSharedMemorySize, LDS_BYTES) != hipSuccess) { fprintf(stderr, "kernel_launch: hipFuncSetAttribute failed\n"); grid = -1; return; }
        if (hipOccupancyMaxActiveBlocksPerMultiprocessor(&per_cu, (const void*)mk_fwd, 512, LDS_BYTES) != hipSuccess || per_cu < 1) fprintf(stderr, "kernel_launch: occupancy query reports %d\n", per_cu);
        (void)hipGetLastError();
        grid = cus;
        if (grid != 256) fprintf(stderr, "kernel_launch: %d CUs (expected 256)\n", grid);
    }
    if (grid < 0) return;
    if (hipMemsetAsync((char*)d_ws + WS_CTL, 0, CTL_ZERO_BYTES, stream) != hipSuccess) return;
    Args a{};
    for (int i = 0; i < 18; ++i) a.in[i] = (const float*)d_in[i];
    a.out = (float*)d_out; a.ws = (unsigned char*)d_ws;
#ifndef PROBE_DUP
#define PROBE_DUP -1
#endif
    constexpr int NL = (PROBE_DUP >= 0) ? 2 : MK_N_LAUNCHES;
    for (int li = 0; li < NL; ++li) {
        if (PROBE_DUP >= 0) { a.ph_lo = li == 0 ? 0 : PROBE_DUP; a.ph_hi = li == 0 ? PROBE_DUP + 1 : NPHASE; }
        else { a.ph_lo = (NL == NPHASE) ? li : (li * NPHASE) / NL; a.ph_hi = (NL == NPHASE) ? li + 1 : ((li + 1) * NPHASE) / NL; }
        a.li = li; a.pad = 0;
        hipLaunchKernelGGL(mk_fwd, dim3(grid), dim3(512), LDS_BYTES, stream, a);
        const hipError_t le = hipPeekAtLastError();
        if (le != hipSuccess) { fprintf(stderr, "kernel_launch: launch %d failed: %s\n", li, hipGetErrorName(le)); break; }
    }
}
```
